# Optimizing an MI355X kernel written in HIP

```python
import numpy as np
import jax
import jax.numpy as jnp
from jax import lax

D_MODEL = 1024
BATCH = 8
SEQ = 4096
DEPTH = 2

CONV_CH = D_MODEL // 2
CONV_WIDTH = 31
NSA_HEADS = 8
NSA_KV_HEADS = 2
HEAD_DIM = (D_MODEL // 2) // NSA_HEADS
CMP_BLOCK = 32
CMP_STRIDE = 16
CMP_HIDDEN = 256
SEL_BLOCK = 64
SEL_TOP_N = 16
WINDOW = 512
Q_BLOCK = 128
FORCE_SCORE = 1e4
SHORT_CONV_WIDTH = 3
MEM_LEN = 256
XA_HEADS = 4
XA_HEAD_DIM = D_MODEL // XA_HEADS
N_GROUPS = 4
EXPERTS_PER_GROUP = 8
N_EXPERTS = N_GROUPS * EXPERTS_PER_GROUP
EXPERT_HIDDEN = D_MODEL // 2
EXPERT_TOP_K = 2
DISPATCH_ROWS = 256
DN_ALPHA = (2 * DEPTH) ** 0.25
DN_BETA = (8 * DEPTH) ** -0.25
LN_EPS = 1e-5
NEG_INF = -1e30

KV_COLS = NSA_KV_HEADS * HEAD_DIM
EVEN_SPLIT_SIZES = (CONV_CH, CONV_CH, NSA_HEADS * HEAD_DIM, KV_COLS, KV_COLS, KV_COLS, KV_COLS, KV_COLS, KV_COLS, 3 * NSA_HEADS)
EVEN_IN_COLS = sum(EVEN_SPLIT_SIZES)

kernel_name = 'hybrid_conformer_nsa_shortconv_hmoe'


def layer_norm(x, g, b):
    xf = x.astype(jnp.float32)
    mu = jnp.mean(xf, -1, keepdims=True)
    var = jnp.mean(jnp.square(xf - mu), -1, keepdims=True)
    y = (xf - mu) * lax.rsqrt(var + LN_EPS)
    return (y * g.astype(jnp.float32) + b.astype(jnp.float32)).astype(x.dtype)


def causal_depthwise_conv(u, w):
    k = w.shape[0]
    return lax.conv_general_dilated(u, w[:, None, :].astype(u.dtype), window_strides=(1,), padding=((k - 1, 0),), dimension_numbers=('NWC', 'WIO', 'NWC'), feature_group_count=u.shape[-1])


def masked_softmax(s, mask):
    p = jax.nn.softmax(jnp.where(mask, s, NEG_INF), axis=-1)
    return jnp.where(mask, p, 0.0)


def compress_blocks(kv, pe, w1, w2):
    b, s, g, dh = kv.shape
    n_cmp = (s - CMP_BLOCK) // CMP_STRIDE + 1
    idx = np.arange(n_cmp)[:, None] * CMP_STRIDE + np.arange(CMP_BLOCK)[None, :]
    blocks = kv[:, idx] + pe[None, None, :, None, :].astype(kv.dtype)
    blocks = jnp.transpose(blocks, (0, 1, 3, 2, 4)).reshape(b, n_cmp, g, CMP_BLOCK * dh)
    return jax.nn.gelu(blocks @ w1) @ w2


def cmp_to_sel_matrix(n_cmp, n_sel):
    c0 = np.arange(n_cmp) * CMP_STRIDE
    s0 = np.arange(n_sel) * SEL_BLOCK
    ov = np.minimum(c0[:, None] + CMP_BLOCK, s0[None, :] + SEL_BLOCK) - np.maximum(c0[:, None], s0[None, :])
    return (np.clip(ov, 0, None) / CMP_BLOCK).astype(np.float32)


def nsa_attention(q, k_cmp, v_cmp, k_sel, v_sel, k_win, v_win, gates):
    b, s, h, dh = q.shape
    g = NSA_KV_HEADS
    hg = h // g
    n_cmp = k_cmp.shape[1]
    n_sel = s // SEL_BLOCK
    top_n = min(SEL_TOP_N, n_sel)
    scale = dh ** -0.5
    m_sel = jnp.asarray(cmp_to_sel_matrix(n_cmp, n_sel))
    cmp_end = jnp.arange(n_cmp) * CMP_STRIDE + CMP_BLOCK - 1
    blk_ids = jnp.arange(n_sel)
    ks_blk = k_sel.reshape(b, n_sel, SEL_BLOCK, g, dh).transpose(0, 3, 1, 2, 4)
    vs_blk = v_sel.reshape(b, n_sel, SEL_BLOCK, g, dh).transpose(0, 3, 1, 2, 4)
    zpad = jnp.zeros((b, WINDOW, g, dh), k_win.dtype)
    kw_pad = jnp.concatenate([zpad, k_win], axis=1)
    vw_pad = jnp.concatenate([zpad, v_win], axis=1)
    bi = jnp.arange(b)[:, None, None, None]
    gi = jnp.arange(g)[None, :, None, None]
    f32 = jnp.float32

    def query_block(c):
        q0 = c * Q_BLOCK
        t = q0 + jnp.arange(Q_BLOCK)
        qc = lax.dynamic_slice_in_dim(q, q0, Q_BLOCK, axis=1).reshape(b, Q_BLOCK, g, hg, dh)
        gc = lax.dynamic_slice_in_dim(gates, q0, Q_BLOCK, axis=1).reshape(b, Q_BLOCK, g, hg, 3)
        s_c = jnp.einsum('bqghd,bngd->bghqn', qc, k_cmp, preferred_element_type=f32) * scale
        p_c = masked_softmax(s_c, cmp_end[None, :] <= t[:, None])
        o_c = jnp.einsum('bghqn,bngd->bqghd', p_c.astype(v_cmp.dtype), v_cmp)
        imp = jnp.einsum('bghqn,nm->bgqm', p_c, m_sel)
        cur = t // SEL_BLOCK
        forced = (blk_ids[None, :] == 0) | (blk_ids[None, :] == cur[:, None]) | (blk_ids[None, :] == cur[:, None] - 1)
        score = jnp.where(forced, FORCE_SCORE, imp)
        score = jnp.where(blk_ids[None, :] * SEL_BLOCK <= t[:, None], score, NEG_INF)
        top_score, top_idx = lax.top_k(score, top_n)
        blk_ok = top_score > 0.5 * NEG_INF
        k_g = ks_blk[bi, gi, top_idx]
        v_g = vs_blk[bi, gi, top_idx]
        s_s = jnp.einsum('bqghd,bgqnld->bghqnl', qc, k_g, preferred_element_type=f32) * scale
        key_pos = top_idx[..., None] * SEL_BLOCK + jnp.arange(SEL_BLOCK)
        mask_s = (blk_ok[..., None] & (key_pos <= t[None, None, :, None, None]))[:, :, None]
        p_s = masked_softmax(s_s.reshape(b, g, hg, Q_BLOCK, top_n * SEL_BLOCK), mask_s.reshape(b, g, 1, Q_BLOCK, top_n * SEL_BLOCK))
        p_s = p_s.reshape(b, g, hg, Q_BLOCK, top_n, SEL_BLOCK).astype(v_g.dtype)
        o_s = jnp.einsum('bghqnl,bgqnld->bqghd', p_s, v_g)
        kw = lax.dynamic_slice_in_dim(kw_pad, q0, WINDOW + Q_BLOCK, axis=1)
        vw = lax.dynamic_slice_in_dim(vw_pad, q0, WINDOW + Q_BLOCK, axis=1)
        kpos = q0 - WINDOW + jnp.arange(WINDOW + Q_BLOCK)
        mask_w = (kpos[None, :] <= t[:, None]) & (kpos[None, :] > t[:, None] - WINDOW) & (kpos[None, :] >= 0)
        s_w = jnp.einsum('bqghd,bkgd->bghqk', qc, kw, preferred_element_type=f32) * scale
        p_w = masked_softmax(s_w, mask_w)
        o_w = jnp.einsum('bghqk,bkgd->bqghd', p_w.astype(vw.dtype), vw)
        o = gc[..., 0:1] * o_c + gc[..., 1:2] * o_s + gc[..., 2:3] * o_w
        return o.reshape(b, Q_BLOCK, h * dh)

    out = lax.map(query_block, jnp.arange(s // Q_BLOCK))
    return jnp.transpose(out, (1, 0, 2, 3)).reshape(b, s, h * dh)


def even_mixer(x, w_in, conv_w, conv_b, cn_g, cn_b, pe_k, w1_k, w2_k, pe_v, w1_v, w2_v, w_out):
    b, s, _ = x.shape
    split_pts = np.cumsum(EVEN_SPLIT_SIZES)[:-1].tolist()
    a_val, a_gate, q, kc, vc, ks, vs, kw, vw, gl = jnp.split(x @ w_in, split_pts, axis=-1)
    a = a_val * jax.nn.sigmoid(a_gate)
    a = causal_depthwise_conv(a, conv_w) + conv_b.astype(a.dtype)
    a = jax.nn.silu(layer_norm(a, cn_g, cn_b))
    kvs = lambda u: u.reshape(b, s, NSA_KV_HEADS, HEAD_DIM)
    k_cmp = compress_blocks(kvs(kc), pe_k, w1_k, w2_k)
    v_cmp = compress_blocks(kvs(vc), pe_v, w1_v, w2_v)
    gates = jax.nn.sigmoid(gl).reshape(b, s, NSA_HEADS, 3)
    o = nsa_attention(q.reshape(b, s, NSA_HEADS, HEAD_DIM), k_cmp, v_cmp, kvs(ks), kvs(vs), kvs(kw), kvs(vw), gates)
    return jnp.concatenate([a, o], axis=-1) @ w_out


def odd_mixer(x, w_in, conv_w, w_out):
    gate_b, gate_c, h = jnp.split(x @ w_in, 3, axis=-1)
    return (gate_b * causal_depthwise_conv(gate_c * h, conv_w)) @ w_out


def memory_cross_attention(x, mem_k, mem_v, wq, wo):
    b, s, d = x.shape
    q = (x @ wq).reshape(b, s, XA_HEADS, XA_HEAD_DIM)
    sc = jnp.einsum('bshd,bmhd->bhsm', q, mem_k, preferred_element_type=jnp.float32) * XA_HEAD_DIM ** -0.5
    p = jax.nn.softmax(sc, axis=-1).astype(x.dtype)
    return jnp.einsum('bhsm,bmhd->bshd', p, mem_v).reshape(b, s, d) @ wo


def hierarchical_moe(x, wg, bg, we, be, w1, w3, w2):
    b, s, d = x.shape
    n_tok = b * s
    xt = x.reshape(n_tok, d)
    xf = xt.astype(jnp.float32)
    g_logits = xf @ wg.astype(jnp.float32) + bg.astype(jnp.float32)
    g_star = jnp.argmax(g_logits, axis=-1)
    p_group = jnp.take_along_axis(jax.nn.softmax(g_logits, axis=-1), g_star[:, None], axis=-1)
    e_logits = jnp.einsum('td,dge->tge', xf, we.astype(jnp.float32)) + be.astype(jnp.float32)
    e_logits = jnp.take_along_axis(e_logits, g_star[:, None, None], axis=1)[:, 0]
    top_val, top_idx = lax.top_k(e_logits, EXPERT_TOP_K)
    gate = (p_group * jax.nn.softmax(top_val, axis=-1)).reshape(-1)
    expert = (g_star[:, None] * EXPERTS_PER_GROUP + top_idx).reshape(-1).astype(jnp.int32)
    token = jnp.repeat(jnp.arange(n_tok, dtype=jnp.int32), EXPERT_TOP_K)
    n_assign = n_tok * EXPERT_TOP_K
    n_blocks = n_assign // DISPATCH_ROWS + N_EXPERTS + 1
    order = jnp.argsort(expert)
    e_sorted = expert[order]
    tok_sorted = token[order]
    gate_sorted = gate[order]
    counts = jnp.bincount(expert, length=N_EXPERTS)
    start = jnp.cumsum(counts) - counts
    padded = (counts + DISPATCH_ROWS - 1) // DISPATCH_ROWS * DISPATCH_ROWS
    pad_end = jnp.cumsum(padded)
    pad_start = pad_end - padded
    dest = pad_start[e_sorted] + jnp.arange(n_assign) - start[e_sorted]
    x_disp = jnp.zeros((n_blocks * DISPATCH_ROWS, d), x.dtype).at[dest].set(xt[tok_sorted])
    block_expert = jnp.minimum(jnp.searchsorted(pad_end, jnp.arange(n_blocks) * DISPATCH_ROWS, side='right'), N_EXPERTS - 1)

    def expert_block(args):
        xb, e = args
        return (jax.nn.silu(xb @ w1[e]) * (xb @ w3[e])) @ w2[e]

    y_disp = lax.map(expert_block, (x_disp.reshape(n_blocks, DISPATCH_ROWS, d), block_expert))
    y = y_disp.reshape(-1, d)[dest] * gate_sorted[:, None].astype(x.dtype)
    return jax.ops.segment_sum(y, tok_sorted, num_segments=n_tok).reshape(b, s, d)


def setup_inputs(seed: int = 0) -> dict:
    key = jax.random.key(seed)
    keys = list(jax.random.split(key, 40))

    def nrm(shape, scale):
        return jax.random.normal(keys.pop(), shape, jnp.float32) * scale

    def gain(shape):
        return 1.0 + nrm(shape, 0.02)

    d = D_MODEL
    ne = (DEPTH + 1) // 2
    no = DEPTH // 2
    return {
        'x': nrm((BATCH, SEQ, d), 1.0),
        'mem': nrm((BATCH, MEM_LEN, d), 1.0),
        'mem_wk': nrm((d, d), d ** -0.5),
        'mem_wv': nrm((d, d), d ** -0.5),
        'ev_w_in': nrm((ne, d, EVEN_IN_COLS), d ** -0.5),
        'ev_conv_w': nrm((ne, CONV_WIDTH, CONV_CH), CONV_WIDTH ** -0.5),
        'ev_conv_b': nrm((ne, CONV_CH), 0.02),
        'ev_cnorm_g': gain((ne, CONV_CH)),
        'ev_cnorm_b': nrm((ne, CONV_CH), 0.02),
        'ev_cmp_pe_k': nrm((ne, CMP_BLOCK, HEAD_DIM), 0.02),
        'ev_cmp_w1_k': nrm((ne, CMP_BLOCK * HEAD_DIM, CMP_HIDDEN), (CMP_BLOCK * HEAD_DIM) ** -0.5),
        'ev_cmp_w2_k': nrm((ne, CMP_HIDDEN, HEAD_DIM), CMP_HIDDEN ** -0.5),
        'ev_cmp_pe_v': nrm((ne, CMP_BLOCK, HEAD_DIM), 0.02),
        'ev_cmp_w1_v': nrm((ne, CMP_BLOCK * HEAD_DIM, CMP_HIDDEN), (CMP_BLOCK * HEAD_DIM) ** -0.5),
        'ev_cmp_w2_v': nrm((ne, CMP_HIDDEN, HEAD_DIM), CMP_HIDDEN ** -0.5),
        'ev_w_out': nrm((ne, CONV_CH + NSA_HEADS * HEAD_DIM, d), (CONV_CH + NSA_HEADS * HEAD_DIM) ** -0.5 * DN_BETA),
        'od_w_in': nrm((no, d, 3 * d), d ** -0.5),
        'od_conv_w': nrm((no, SHORT_CONV_WIDTH, d), SHORT_CONV_WIDTH ** -0.5),
        'od_w_out': nrm((no, d, d), d ** -0.5 * DN_BETA),
        'ln_mix_g': gain((DEPTH, d)),
        'ln_mix_b': nrm((DEPTH, d), 0.02),
        'xa_wq': nrm((DEPTH, d, d), d ** -0.5),
        'xa_wo': nrm((DEPTH, d, d), d ** -0.5 * DN_BETA),
        'ln_xa_g': gain((DEPTH, d)),
        'ln_xa_b': nrm((DEPTH, d), 0.02),
        'moe_wg': nrm((DEPTH, d, N_GROUPS), d ** -0.5),
        'moe_bg': nrm((DEPTH, N_GROUPS), 0.01),
        'moe_we': nrm((DEPTH, d, N_GROUPS, EXPERTS_PER_GROUP), d ** -0.5),
        'moe_be': nrm((DEPTH, N_GROUPS, EXPERTS_PER_GROUP), 0.01),
        'moe_w1': nrm((DEPTH, N_EXPERTS, d, EXPERT_HIDDEN), d ** -0.5),
        'moe_w3': nrm((DEPTH, N_EXPERTS, d, EXPERT_HIDDEN), d ** -0.5),
        'moe_w2': nrm((DEPTH, N_EXPERTS, EXPERT_HIDDEN, d), EXPERT_HIDDEN ** -0.5 * DN_BETA),
        'ln_ffn_g': gain((DEPTH, d)),
        'ln_ffn_b': nrm((DEPTH, d), 0.02),
    }


def reference(x, mem, mem_wk, mem_wv, ev_w_in, ev_conv_w, ev_conv_b, ev_cnorm_g, ev_cnorm_b, ev_cmp_pe_k, ev_cmp_w1_k, ev_cmp_w2_k, ev_cmp_pe_v, ev_cmp_w1_v, ev_cmp_w2_v, ev_w_out, od_w_in, od_conv_w, od_w_out, ln_mix_g, ln_mix_b, xa_wq, xa_wo, ln_xa_g, ln_xa_b, moe_wg, moe_bg, moe_we, moe_be, moe_w1, moe_w3, moe_w2, ln_ffn_g, ln_ffn_b):
    b = x.shape[0]
    m_len = mem.shape[1]
    mem_k = (mem @ mem_wk).reshape(b, m_len, XA_HEADS, XA_HEAD_DIM)
    mem_v = (mem @ mem_wv).reshape(b, m_len, XA_HEADS, XA_HEAD_DIM)
    for layer in range(DEPTH):
        i = layer // 2
        if layer % 2 == 0:
            mix = even_mixer(x, ev_w_in[i], ev_conv_w[i], ev_conv_b[i], ev_cnorm_g[i], ev_cnorm_b[i], ev_cmp_pe_k[i], ev_cmp_w1_k[i], ev_cmp_w2_k[i], ev_cmp_pe_v[i], ev_cmp_w1_v[i], ev_cmp_w2_v[i], ev_w_out[i])
        else:
            mix = odd_mixer(x, od_w_in[i], od_conv_w[i], od_w_out[i])
        x = layer_norm(DN_ALPHA * x + mix, ln_mix_g[layer], ln_mix_b[layer])
        x = layer_norm(DN_ALPHA * x + memory_cross_attention(x, mem_k, mem_v, xa_wq[layer], xa_wo[layer]), ln_xa_g[layer], ln_xa_b[layer])
        x = layer_norm(DN_ALPHA * x + hierarchical_moe(x, moe_wg[layer], moe_bg[layer], moe_we[layer], moe_be[layer], moe_w1[layer], moe_w3[layer], moe_w2[layer]), ln_ffn_g[layer], ln_ffn_b[layer])
    return x
```

```cpp
#include <hip/hip_runtime.h>
#include <hip/hip_cooperative_groups.h>
#include <cstdint>
#include <cstdio>
namespace cg = cooperative_groups;

#ifndef N_LAUNCH_MODE
#define N_LAUNCH_MODE 0
#endif

typedef unsigned short bf16_t;
typedef short bf16x8 __attribute__((ext_vector_type(8)));
typedef float f32x4 __attribute__((ext_vector_type(4)));
typedef unsigned u32x4 __attribute__((ext_vector_type(4)));
typedef unsigned u32x2 __attribute__((ext_vector_type(2)));
#define DEV __device__ __forceinline__

constexpr int NB = 8, SEQ = 4096, DM = 1024, NT = NB * SEQ;
constexpr int MEML = 256, NMEM = NB * MEML;
constexpr int EIN = 2328, EINP = 2560;
constexpr int C_AV = 0, C_AG = 512, C_Q = 1024, C_KC = 1536, C_VC = 1664, C_KS = 1792, C_VS = 1920, C_KW = 2048, C_VW = 2176, C_GL = 2304;
constexpr int NCMP = 255;
constexpr int NEXP = 32, EH = 512, LCAP = 32768;
constexpr float DN_ALPHA = 1.41421356237f;
constexpr float LN_EPS = 1e-5f;
constexpr int NWAVES = 8, NTHREADS = 512;

constexpr size_t MiB = 1u << 20;
constexpr size_t WS_CTL = 0;
constexpr size_t WS_CMPB = 1 * MiB;
constexpr size_t WS_KCMP = 2 * MiB;
constexpr size_t WS_VCMP = 3 * MiB;
constexpr size_t WS_PK = 4 * MiB;
constexpr size_t WS_PV = 12 * MiB;
constexpr size_t WS_LIST = 20 * MiB;
constexpr size_t WS_GATE = 24 * MiB;
constexpr size_t WS_MEMB = 25 * MiB;
constexpr size_t WS_MEMK = 29 * MiB;
constexpr size_t WS_MEMV = 33 * MiB;
constexpr size_t WS_W_IN = 40 * MiB;
constexpr size_t WS_W_OUT = 45 * MiB;
constexpr size_t WS_OD_IN = 47 * MiB;
constexpr size_t WS_OD_OUT = 53 * MiB;
constexpr size_t WS_WQ = 55 * MiB;
constexpr size_t WS_WO = 59 * MiB;
constexpr size_t WS_WK = 63 * MiB;
constexpr size_t WS_WV = 65 * MiB;
constexpr size_t WS_CW1 = 67 * MiB;
constexpr size_t WS_W13 = 72 * MiB;
constexpr size_t WS_W2 = 136 * MiB;
constexpr size_t WS_XA = 168 * MiB;
constexpr size_t WS_XB = 232 * MiB;
constexpr size_t WS_SCR = 296 * MiB;
constexpr size_t WS_END = 520 * MiB;
constexpr size_t SC_Y0 = WS_SCR;
constexpr size_t SC_CAT = WS_SCR + 160 * MiB;
constexpr size_t SC_Z = WS_SCR;
constexpr size_t SC_Q = WS_SCR;
constexpr size_t SC_CTX = WS_SCR + 128 * MiB;
constexpr size_t SC_H = WS_SCR;
constexpr size_t SC_Y = WS_SCR + 80 * MiB;

DEV float bf2f(bf16_t b) { return __uint_as_float(((unsigned)b) << 16); }
DEV unsigned f2bf(float f) { unsigned u = __float_as_uint(f); return (u + 0x7fffu + ((u >> 16) & 1u)) >> 16; }
DEV unsigned pk2(float lo, float hi) { return f2bf(lo) | (f2bf(hi) << 16); }
DEV float wsum(float v) {
#pragma unroll
    for (int o = 1; o < 64; o <<= 1) v += __shfl_xor(v, o);
    return v;
}
DEV float gsum16(float v) { v += __shfl_xor(v, 1); v += __shfl_xor(v, 2); v += __shfl_xor(v, 4); v += __shfl_xor(v, 8); return v; }
DEV float sigmoidf_(float x) { return 1.f / (1.f + __expf(-x)); }
DEV float siluf_(float x) { return x / (1.f + __expf(-x)); }
DEV float gelu_tanh(float x) { const float u = 0.7978845608028654f * (x + 0.044715f * x * x * x); return 0.5f * x * (1.f + tanhf(u)); }
#define LDS_WAIT() asm volatile("s_waitcnt lgkmcnt(0)" ::: "memory")
DEV void ld4bf(const bf16_t* p, float* o) { const u32x2 w = *(const u32x2*)p; o[0] = __uint_as_float(w.x << 16); o[1] = __uint_as_float(w.x & 0xffff0000u); o[2] = __uint_as_float(w.y << 16); o[3] = __uint_as_float(w.y & 0xffff0000u); }
DEV void st4bf(bf16_t* p, float a, float b, float c, float d) { u32x2 w; w.x = pk2(a, b); w.y = pk2(c, d); *(u32x2*)p = w; }

struct Params {
    const float* in[34];
    float* out;
    unsigned char* ws;
    int ph_lo, ph_hi;
};
struct Ctx {
    const Params* p;
    unsigned char* ws;
    float* lds;
    int tid, lane, wave, gw, ngw;
};

template <class AF, class BF, class EF>
DEV void ngemm(const Ctx& c, int mtiles, int ntiles, int K, AF af, BF bf, EF ef) {
    const int fr = c.lane & 15, fq = c.lane >> 4;
    for (int it = c.gw; it < mtiles * ntiles; it += c.ngw) {
        const int mt = it / ntiles, nt = it % ntiles;
        f32x4 acc[4][4];
#pragma unroll
        for (int i = 0; i < 4; ++i)
#pragma unroll
            for (int j = 0; j < 4; ++j) acc[i][j] = (f32x4){0.f, 0.f, 0.f, 0.f};
        const bf16_t* bp[4];
#pragma unroll
        for (int j = 0; j < 4; ++j) bp[j] = bf(nt * 64 + j * 16 + fr, mt) + fq * 8;
        for (int k0 = 0; k0 < K; k0 += 32) {
            bf16x8 a[4], b[4];
#pragma unroll
            for (int i = 0; i < 4; ++i) a[i] = *(const bf16x8*)(af(mt * 64 + i * 16 + fr, k0) + fq * 8);
#pragma unroll
            for (int j = 0; j < 4; ++j) b[j] = *(const bf16x8*)(bp[j] + k0);
#pragma unroll
            for (int i = 0; i < 4; ++i)
#pragma unroll
                for (int j = 0; j < 4; ++j) acc[i][j] = __builtin_amdgcn_mfma_f32_16x16x32_bf16(b[j], a[i], acc[i][j], 0, 0, 0);
        }
#pragma unroll
        for (int i = 0; i < 4; ++i)
#pragma unroll
            for (int j = 0; j < 4; ++j) ef(mt * 64 + i * 16 + fr, nt * 64 + j * 16 + 4 * fq, acc[i][j]);
    }
}

template <class RM>
DEV void tr_item(const float* W, int ldw, int N, bf16_t* WT, int ldd, RM rowmap, int item, int nblk, float* scr, int lane) {
    const int kb = item / nblk, nb = item % nblk, k0 = 64 * kb, n0 = 32 * nb;
    const int n = n0 + (lane & 31);
#pragma unroll 8
    for (int i = 0; i < 32; ++i) { const int kk = 2 * i + (lane >> 5); scr[kk * 33 + (lane & 31)] = (n < N) ? W[(size_t)(k0 + kk) * ldw + n] : 0.f; }
    LDS_WAIT();
    const int ch = lane & 7;
#pragma unroll
    for (int j = 0; j < 4; ++j) {
        const int nl = (lane >> 3) + 8 * j, nn = n0 + nl;
        const float* s = scr + (8 * ch) * 33 + nl;
        u32x4 o; o.x = pk2(s[0], s[33]); o.y = pk2(s[66], s[99]); o.z = pk2(s[132], s[165]); o.w = pk2(s[198], s[231]);
        if (nn < N) *(u32x4*)(WT + (size_t)rowmap(nn) * ldd + k0 + 8 * ch) = o;
    }
    LDS_WAIT();
}
template <class RM>
DEV void tr_all(const Ctx& c, const float* W, int K, int N, bf16_t* WT, int ldd, RM rm) {
    float* scr = c.lds + c.wave * (64 * 33);
    const int nblk = (N + 31) / 32, nitems = (K / 64) * nblk;
    for (int it = c.gw; it < nitems; it += c.ngw) tr_item(W, N, N, WT, ldd, rm, it, nblk, scr, c.lane);
}
DEV void moe_weights(const Ctx& c, int layer) {
    float* scr = c.lds + c.wave * (64 * 33);
    const float* w1 = c.p->in[29] + (size_t)layer * NEXP * DM * EH;
    const float* w3 = c.p->in[30] + (size_t)layer * NEXP * DM * EH;
    const float* w2 = c.p->in[31] + (size_t)layer * NEXP * EH * DM;
    bf16_t* W13 = (bf16_t*)(c.ws + WS_W13); bf16_t* W2 = (bf16_t*)(c.ws + WS_W2);
    for (int it = c.gw; it < NEXP * 768; it += c.ngw) {
        const int e = it / 768, r = it % 768, mat = r >> 8, sub = r & 255;
        if (mat == 0) tr_item(w1 + (size_t)e * DM * EH, EH, EH, W13 + (size_t)e * DM * DM, DM, [](int n) { return (n >> 7) * 256 + (n & 127); }, sub, 16, scr, c.lane);
        else if (mat == 1) tr_item(w3 + (size_t)e * DM * EH, EH, EH, W13 + (size_t)e * DM * DM, DM, [](int n) { return (n >> 7) * 256 + 128 + (n & 127); }, sub, 16, scr, c.lane);
        else tr_item(w2 + (size_t)e * EH * DM, DM, DM, W2 + (size_t)e * DM * EH, EH, [](int n) { return n; }, sub, 32, scr, c.lane);
    }
}
DEV void cvt_rows(const Ctx& c, const float* src, bf16_t* dst, size_t n) {
    const size_t nth = (size_t)c.ngw * 64, t0 = (size_t)c.gw * 64 + c.lane;
    for (size_t i = t0; i < n / 8; i += nth) {
        const f32x4 a = *(const f32x4*)(src + i * 8), b = *(const f32x4*)(src + i * 8 + 4);
        u32x4 o; o.x = pk2(a.x, a.y); o.y = pk2(a.z, a.w); o.z = pk2(b.x, b.y); o.w = pk2(b.z, b.w);
        *(u32x4*)(dst + i * 8) = o;
    }
}
DEV void phase_prep(const Ctx& c) {
    const Params& p = *c.p; unsigned char* ws = c.ws;
    auto id = [](int n) { return n; };
    if (blockIdx.x == 0 && c.tid < 64) ((int*)(ws + WS_CTL))[c.tid] = 0;
    tr_all(c, p.in[4], DM, EIN, (bf16_t*)(ws + WS_W_IN), DM, id);
    {
        bf16_t* w = (bf16_t*)(ws + WS_W_IN) + (size_t)EIN * DM; const size_t n = (size_t)(EINP - EIN) * DM / 8;
        for (size_t i = (size_t)c.gw * 64 + c.lane; i < n; i += (size_t)c.ngw * 64) *(u32x4*)(w + i * 8) = (u32x4){0u, 0u, 0u, 0u};
    }
    tr_all(c, p.in[15], DM, DM, (bf16_t*)(ws + WS_W_OUT), DM, id);
    tr_all(c, p.in[16], DM, 3 * DM, (bf16_t*)(ws + WS_OD_IN), DM, id);
    tr_all(c, p.in[18], DM, DM, (bf16_t*)(ws + WS_OD_OUT), DM, id);
    for (int l = 0; l < 2; ++l) {
        tr_all(c, p.in[21] + (size_t)l * DM * DM, DM, DM, (bf16_t*)(ws + WS_WQ) + (size_t)l * DM * DM, DM, id);
        tr_all(c, p.in[22] + (size_t)l * DM * DM, DM, DM, (bf16_t*)(ws + WS_WO) + (size_t)l * DM * DM, DM, id);
    }
    tr_all(c, p.in[2], DM, DM, (bf16_t*)(ws + WS_WK), DM, id);
    tr_all(c, p.in[3], DM, DM, (bf16_t*)(ws + WS_WV), DM, id);
    for (int kv = 0; kv < 2; ++kv) {
        const float* w1 = p.in[kv ? 13 : 10];
        bf16_t* d = (bf16_t*)(ws + WS_CW1) + (size_t)kv * 512 * DM;
        tr_all(c, w1, 1024, 256, d, DM, id);
        tr_all(c, w1 + (size_t)1024 * 256, 1024, 256, d + (size_t)256 * DM, DM, id);
    }
    moe_weights(c, 0);
    cvt_rows(c, p.in[0], (bf16_t*)(ws + WS_XA), (size_t)NT * DM);
    cvt_rows(c, p.in[1], (bf16_t*)(ws + WS_MEMB), (size_t)NMEM * DM);
    for (int it = c.gw; it < 512; it += c.ngw) {
        const int kv = it >> 8, col = it & 255;
        const float* pe = p.in[kv ? 12 : 9]; const float* w1 = p.in[kv ? 13 : 10];
        float s = 0.f;
        for (int kk = c.lane; kk < 2048; kk += 64) s += pe[kk] * w1[(size_t)kk * 256 + col];
        s = wsum(s);
        if (c.lane == 0) ((float*)(ws + WS_CMPB))[it] = s;
    }
}

struct EpiStoreBf16 { bf16_t* C; int ldc; DEV void operator()(int m, int n, f32x4 v) const { st4bf(C + (size_t)m * ldc + n, v.x, v.y, v.z, v.w); } };
struct EpiStoreF32 { float* C; int ldc; DEV void operator()(int m, int n, f32x4 v) const { *(f32x4*)(C + (size_t)m * ldc + n) = v; } };
struct EpiResF32 { float* Z; const float* res; DEV void operator()(int m, int n, f32x4 v) const { const f32x4 r = *(const f32x4*)(res + (size_t)m * DM + n); *(f32x4*)(Z + (size_t)m * DM + n) = r * DN_ALPHA + v; } };
struct EpiResBf16 { float* Z; const bf16_t* res; DEV void operator()(int m, int n, f32x4 v) const { float r[4]; ld4bf(res + (size_t)m * DM + n, r); *(f32x4*)(Z + (size_t)m * DM + n) = (f32x4){r[0] * DN_ALPHA + v.x, r[1] * DN_ALPHA + v.y, r[2] * DN_ALPHA + v.z, r[3] * DN_ALPHA + v.w}; } };

struct ARowPlain { const bf16_t* A; int lda; DEV const bf16_t* operator()(int m, int k0) const { return A + (size_t)m * lda + k0; } };
struct BRowPlain { const bf16_t* B; int ldb; DEV const bf16_t* operator()(int n, int) const { return B + (size_t)n * ldb; } };

DEV void conv_branch(const Ctx& c) {
    const Params& p = *c.p;
    const bf16_t* Y0 = (const bf16_t*)(c.ws + SC_Y0); bf16_t* CAT = (bf16_t*)(c.ws + SC_CAT);
    const float* cw = p.in[5]; const float* cb = p.in[6]; const float* g = p.in[7]; const float* bb = p.in[8];
    for (int row = c.gw; row < NT; row += c.ngw) {
        const int t = row & (SEQ - 1);
        float acc[8];
#pragma unroll
        for (int i = 0; i < 8; ++i) acc[i] = cb[c.lane + 64 * i];
        const int kmin = (t >= 30) ? 0 : 30 - t;
        for (int k = kmin; k < 31; ++k) {
            const bf16_t* yr = Y0 + (size_t)(row - 30 + k) * EINP;
#pragma unroll
            for (int i = 0; i < 8; ++i) { const int ch = c.lane + 64 * i; const float a = bf2f(yr[C_AV + ch]) * sigmoidf_(bf2f(yr[C_AG + ch])); acc[i] += cw[k * 512 + ch] * a; }
        }
        float s = 0.f;
#pragma unroll
        for (int i = 0; i < 8; ++i) s += acc[i];
        const float mean = wsum(s) * (1.f / 512.f);
        float s2 = 0.f;
#pragma unroll
        for (int i = 0; i < 8; ++i) { acc[i] -= mean; s2 += acc[i] * acc[i]; }
        const float rstd = rsqrtf(wsum(s2) * (1.f / 512.f) + LN_EPS);
#pragma unroll
        for (int i = 0; i < 8; ++i) { const int ch = c.lane + 64 * i; const float y = acc[i] * rstd * g[ch] + bb[ch]; CAT[(size_t)row * DM + ch] = (bf16_t)f2bf(siluf_(y)); }
    }
}
struct ARowCmp { const bf16_t* Y0; int coff; DEV const bf16_t* operator()(int m, int k0) const { const int g = m & 1, bj = m >> 1; return Y0 + ((size_t)bj * 16 + (k0 >> 6)) * EINP + coff + g * 64 + (k0 & 63); } };
DEV void cmp_gemm(const Ctx& c) {
    const bf16_t* Y0 = (const bf16_t*)(c.ws + SC_Y0);
    for (int kv = 0; kv < 2; ++kv) {
        ARowCmp af{Y0, kv ? C_VC : C_KC}; BRowPlain bf{(const bf16_t*)(c.ws + WS_CW1) + (size_t)kv * 512 * DM, DM};
        EpiStoreF32 ef{(float*)(c.ws + (kv ? WS_PV : WS_PK)), 512};
        ngemm(c, 4096 / 64, 512 / 64, 1024, af, bf, ef);
    }
}
DEV void cmp_finish(const Ctx& c) {
    const Params& p = *c.p;
    float* hid = c.lds + c.wave * 256;
    for (int it = c.gw; it < 2 * NB * NCMP * 2; it += c.ngw) {
        const int kv = it / (NB * NCMP * 2), r = it % (NB * NCMP * 2), g = r & 1, bn = r >> 1, b = bn / NCMP, n = bn % NCMP;
        const float* P = (const float*)(c.ws + (kv ? WS_PV : WS_PK));
        const float* cbias = (const float*)(c.ws + WS_CMPB) + kv * 256;
        const float* w2 = p.in[kv ? 14 : 11];
        const int r0 = (b * 256 + n) * 2 + g, r1 = (b * 256 + n + 1) * 2 + g;
#pragma unroll
        for (int i = 0; i < 4; ++i) { const int cc = c.lane + 64 * i; hid[cc] = gelu_tanh(P[(size_t)r0 * 512 + cc] + P[(size_t)r1 * 512 + 256 + cc] + cbias[cc]); }
        LDS_WAIT();
        float o = 0.f;
        for (int cc = 0; cc < 256; ++cc) o += hid[cc] * w2[cc * 64 + c.lane];
        ((float*)(c.ws + (kv ? WS_VCMP : WS_KCMP)))[(size_t)((b * NCMP + n) * 2 + g) * 64 + c.lane] = o;
        LDS_WAIT();
    }
}

DEV void nsa_naive(const Ctx& c) {
    const bf16_t* Y0 = (const bf16_t*)(c.ws + SC_Y0); bf16_t* CAT = (bf16_t*)(c.ws + SC_CAT);
    const float* KC = (const float*)(c.ws + WS_KCMP); const float* VC = (const float*)(c.ws + WS_VCMP);
    float* pc = c.lds + c.wave * 1024;
    const int hh = c.lane >> 4, dq = c.lane & 15;
    for (int it = c.gw; it < NT * 2; it += c.ngw) {
        const int g = it & 1, row = it >> 1, b = row >> 12, t = row & (SEQ - 1);
        const int h = g * 4 + hh;
        const bf16_t* yrow = Y0 + (size_t)row * EINP;
        float q[4]; ld4bf(yrow + C_Q + h * 64 + dq * 4, q);
#pragma unroll
        for (int i = 0; i < 4; ++i) q[i] *= 0.125f;
        const int ncv = (t >= 31) ? min(NCMP, (t - 31) / 16 + 1) : 0;
        float oc[4] = {0.f, 0.f, 0.f, 0.f};
        float mx = -INFINITY;
        for (int n = 0; n < ncv; ++n) {
            const f32x4 k4 = *(const f32x4*)(KC + (size_t)((b * NCMP + n) * 2 + g) * 64 + dq * 4);
            float s = q[0] * k4.x + q[1] * k4.y + q[2] * k4.z + q[3] * k4.w; s = gsum16(s);
            if (dq == 0) pc[hh * 256 + n] = s;
            mx = fmaxf(mx, s);
        }
        LDS_WAIT();
        float l = 0.f;
        for (int n = 0; n < ncv; ++n) l += __expf(pc[hh * 256 + n] - mx);
        const float inv = (ncv > 0) ? 1.f / l : 0.f;
        for (int n = 0; n < ncv; ++n) {
            const float pr = __expf(pc[hh * 256 + n] - mx) * inv;
            const f32x4 v4 = *(const f32x4*)(VC + (size_t)((b * NCMP + n) * 2 + g) * 64 + dq * 4);
            oc[0] += pr * v4.x; oc[1] += pr * v4.y; oc[2] += pr * v4.z; oc[3] += pr * v4.w;
            LDS_WAIT();
            if (dq == 0) pc[hh * 256 + n] = pr;
        }
        LDS_WAIT();
        const int m = c.lane, cur = t >> 6;
        float imp = 0.f;
#pragma unroll
        for (int h2 = 0; h2 < 4; ++h2)
#pragma unroll
            for (int dn = -1; dn <= 3; ++dn) { const int n = 4 * m + dn; if (n >= 0 && n < ncv) imp += pc[h2 * 256 + n] * ((dn == -1 || dn == 3) ? 0.5f : 1.f); }
        const bool causal = m <= cur, forced = (m == 0) || (m == cur) || (m == cur - 1);
        const float score = causal ? (forced ? 1e4f : imp) : -1e30f;
        int rank = 0;
        for (int m2 = 0; m2 < 64; ++m2) { const float s2 = __shfl(score, m2); rank += ((s2 > score) || (s2 == score && m2 < m)) ? 1 : 0; }
        unsigned long long selmask = __ballot(causal && rank < 16);
        LDS_WAIT();
        float ms = -INFINITY, ls = 0.f, os[4] = {0.f, 0.f, 0.f, 0.f};
        while (selmask) {
            const int mb = __builtin_ctzll(selmask); selmask &= selmask - 1;
            const int jmax = min(63, t - 64 * mb);
            const bf16_t* kb = Y0 + (size_t)(b * SEQ + 64 * mb) * EINP + g * 64 + dq * 4;
            for (int j = 0; j <= jmax; ++j) {
                float k4[4], v4[4]; ld4bf(kb + (size_t)j * EINP + C_KS, k4); ld4bf(kb + (size_t)j * EINP + C_VS, v4);
                float s = q[0] * k4[0] + q[1] * k4[1] + q[2] * k4[2] + q[3] * k4[3]; s = gsum16(s);
                const float mn = fmaxf(ms, s), cf = __expf(ms - mn), pp = __expf(s - mn);
                ls = ls * cf + pp;
#pragma unroll
                for (int i = 0; i < 4; ++i) os[i] = os[i] * cf + pp * v4[i];
                ms = mn;
            }
        }
        float mw = -INFINITY, lw = 0.f, ow[4] = {0.f, 0.f, 0.f, 0.f};
        {
            const int k0 = max(0, t - 511);
            const bf16_t* kb = Y0 + (size_t)(b * SEQ) * EINP + g * 64 + dq * 4;
            for (int kp = k0; kp <= t; ++kp) {
                float k4[4], v4[4]; ld4bf(kb + (size_t)kp * EINP + C_KW, k4); ld4bf(kb + (size_t)kp * EINP + C_VW, v4);
                float s = q[0] * k4[0] + q[1] * k4[1] + q[2] * k4[2] + q[3] * k4[3]; s = gsum16(s);
                const float mn = fmaxf(mw, s), cf = __expf(mw - mn), pp = __expf(s - mn);
                lw = lw * cf + pp;
#pragma unroll
                for (int i = 0; i < 4; ++i) ow[i] = ow[i] * cf + pp * v4[i];
                mw = mn;
            }
        }
        const float gc = sigmoidf_(bf2f(yrow[C_GL + h * 3 + 0])), gs = sigmoidf_(bf2f(yrow[C_GL + h * 3 + 1])) / ls, gwn = sigmoidf_(bf2f(yrow[C_GL + h * 3 + 2])) / lw;
        st4bf(CAT + (size_t)row * DM + 512 + h * 64 + dq * 4, gc * oc[0] + gs * os[0] + gwn * ow[0], gc * oc[1] + gs * os[1] + gwn * ow[1], gc * oc[2] + gs * os[2] + gwn * ow[2], gc * oc[3] + gs * os[3] + gwn * ow[3]);
    }
}

template <bool ROUTER>
DEV void ln_pass(const Ctx& c, const float* Z, const float* g, const float* b, bf16_t* X, int layer) {
    const Params& p = *c.p;
    const float* wg = p.in[25] + (size_t)layer * DM * 4; const float* bg = p.in[26] + layer * 4;
    const float* we = p.in[27] + (size_t)layer * DM * 32; const float* be = p.in[28] + layer * 32;
    int* cnt = (int*)(c.ws + WS_CTL) + layer * 32; int* list = (int*)(c.ws + WS_LIST); float* gate = (float*)(c.ws + WS_GATE);
    for (int row = c.gw; row < NT; row += c.ngw) {
        f32x4 v[4]; float s = 0.f;
#pragma unroll
        for (int j = 0; j < 4; ++j) { v[j] = *(const f32x4*)(Z + (size_t)row * DM + 256 * j + 4 * c.lane); s += (v[j].x + v[j].y) + (v[j].z + v[j].w); }
        const float mean = wsum(s) * (1.f / DM); float s2 = 0.f;
#pragma unroll
        for (int j = 0; j < 4; ++j) { v[j] = v[j] - mean; s2 += (v[j].x * v[j].x + v[j].y * v[j].y) + (v[j].z * v[j].z + v[j].w * v[j].w); }
        const float rstd = rsqrtf(wsum(s2) * (1.f / DM) + LN_EPS);
#pragma unroll
        for (int j = 0; j < 4; ++j) {
            const f32x4 gg = *(const f32x4*)(g + 256 * j + 4 * c.lane), bb = *(const f32x4*)(b + 256 * j + 4 * c.lane);
            v[j] = v[j] * rstd * gg + bb;
            st4bf(X + (size_t)row * DM + 256 * j + 4 * c.lane, v[j].x, v[j].y, v[j].z, v[j].w);
        }
        if (ROUTER) {
            float* xs = c.lds + c.wave * 1024;
#pragma unroll
            for (int j = 0; j < 4; ++j) *(f32x4*)(xs + 256 * j + 4 * c.lane) = v[j];
            LDS_WAIT();
            float lgt = 0.f;
            if (c.lane < 36) {
                const int o = c.lane;
                const float* wp = (o < 4) ? (wg + o) : (we + (o - 4));
                const int st = (o < 4) ? 4 : 32;
#pragma unroll 8
                for (int k = 0; k < DM; ++k) lgt += xs[k] * wp[(size_t)k * st];
                lgt += (o < 4) ? bg[o] : be[o - 4];
            }
            LDS_WAIT();
            float gl[4]; int gs = 0;
#pragma unroll
            for (int o = 0; o < 4; ++o) gl[o] = __shfl(lgt, o);
            float gm = gl[0];
#pragma unroll
            for (int o = 1; o < 4; ++o) if (gl[o] > gm) { gm = gl[o]; gs = o; }
            float den = 0.f;
#pragma unroll
            for (int o = 0; o < 4; ++o) den += __expf(gl[o] - gm);
            const float pgroup = 1.f / den;
            float el[8];
#pragma unroll
            for (int o = 0; o < 8; ++o) el[o] = __shfl(lgt, 4 + gs * 8 + o);
            int i0 = 0; float v0 = el[0];
#pragma unroll
            for (int o = 1; o < 8; ++o) if (el[o] > v0) { v0 = el[o]; i0 = o; }
            int i1 = -1; float v1 = -INFINITY;
#pragma unroll
            for (int o = 0; o < 8; ++o) if (o != i0 && el[o] > v1) { v1 = el[o]; i1 = o; }
            const float e1 = __expf(v1 - v0), g0 = pgroup / (1.f + e1), g1 = pgroup * e1 / (1.f + e1);
            if (c.lane < 2) {
                const int ex = gs * 8 + (c.lane == 0 ? i0 : i1);
                const int pos = atomicAdd(cnt + ex, 1);
                list[ex * LCAP + pos] = row * 2 + c.lane;
                gate[row * 2 + c.lane] = (c.lane == 0) ? g0 : g1;
            }
        }
    }
}

DEV void xattn_naive(const Ctx& c) {
    const bf16_t* Q = (const bf16_t*)(c.ws + SC_Q); bf16_t* CTXo = (bf16_t*)(c.ws + SC_CTX);
    const bf16_t* MK = (const bf16_t*)(c.ws + WS_MEMK); const bf16_t* MV = (const bf16_t*)(c.ws + WS_MEMV);
    for (int it = c.gw; it < NT * 4; it += c.ngw) {
        const int h = it & 3, row = it >> 2, b = row >> 12;
        float q[4]; ld4bf(Q + (size_t)row * DM + h * 256 + 4 * c.lane, q);
#pragma unroll
        for (int i = 0; i < 4; ++i) q[i] *= 0.0625f;
        float ms = -INFINITY, ls = 0.f, o[4] = {0.f, 0.f, 0.f, 0.f};
        for (int m = 0; m < MEML; ++m) {
            float k4[4], v4[4]; ld4bf(MK + (size_t)(b * MEML + m) * DM + h * 256 + 4 * c.lane, k4); ld4bf(MV + (size_t)(b * MEML + m) * DM + h * 256 + 4 * c.lane, v4);
            float s = q[0] * k4[0] + q[1] * k4[1] + q[2] * k4[2] + q[3] * k4[3]; s = wsum(s);
            const float mn = fmaxf(ms, s), cf = __expf(ms - mn), pp = __expf(s - mn);
            ls = ls * cf + pp;
#pragma unroll
            for (int i = 0; i < 4; ++i) o[i] = o[i] * cf + pp * v4[i];
            ms = mn;
        }
        const float inv = 1.f / ls;
        st4bf(CTXo + (size_t)row * DM + h * 256 + 4 * c.lane, o[0] * inv, o[1] * inv, o[2] * inv, o[3] * inv);
    }
}

DEV int moe_nblk(const int* cnt) { int nb = 0; for (int e = 0; e < NEXP; ++e) nb += (cnt[e] + 255) >> 8; return nb; }
DEV void moe_find(const int* cnt, int pr, int& e, int& r) { int base = 0; e = 0; r = 0; for (int x = 0; x < NEXP; ++x) { const int nb = (cnt[x] + 255) >> 8; if (pr < (base + nb) * 256) { e = x; r = pr - base * 256; return; } base += nb; } e = NEXP - 1; r = 1 << 30; }
DEV void moe_gemm1(const Ctx& c, const bf16_t* X, int layer) {
    const int* cnt = (const int*)(c.ws + WS_CTL) + layer * 32; const int* list = (const int*)(c.ws + WS_LIST);
    const bf16_t* W13 = (const bf16_t*)(c.ws + WS_W13); bf16_t* H = (bf16_t*)(c.ws + SC_H);
    const int nblk = moe_nblk(cnt), mtiles = nblk * 4, ntiles = EH / 32;
    const int fr = c.lane & 15, fq = c.lane >> 4;
    for (int it = c.gw; it < mtiles * ntiles; it += c.ngw) {
        const int mt = it / ntiles, nt = it % ntiles;
        int e, r0; moe_find(cnt, mt * 64, e, r0);
        const int ce = cnt[e];
        const bf16_t* ap[4];
#pragma unroll
        for (int i = 0; i < 4; ++i) { const int r = r0 + i * 16 + fr; const int tok = (r < ce) ? (list[e * LCAP + r] >> 1) : 0; ap[i] = X + (size_t)tok * DM + fq * 8; }
        const bf16_t* b1[2]; const bf16_t* b3[2];
#pragma unroll
        for (int j = 0; j < 2; ++j) { const int n = nt * 32 + j * 16 + fr; b1[j] = W13 + (size_t)e * DM * DM + (size_t)((n >> 7) * 256 + (n & 127)) * DM + fq * 8; b3[j] = b1[j] + (size_t)128 * DM; }
        f32x4 a1[4][2], a3[4][2];
#pragma unroll
        for (int i = 0; i < 4; ++i)
#pragma unroll
            for (int j = 0; j < 2; ++j) { a1[i][j] = (f32x4){0.f, 0.f, 0.f, 0.f}; a3[i][j] = (f32x4){0.f, 0.f, 0.f, 0.f}; }
        for (int k0 = 0; k0 < DM; k0 += 32) {
            bf16x8 a[4], w1[2], w3[2];
#pragma unroll
            for (int i = 0; i < 4; ++i) a[i] = *(const bf16x8*)(ap[i] + k0);
#pragma unroll
            for (int j = 0; j < 2; ++j) { w1[j] = *(const bf16x8*)(b1[j] + k0); w3[j] = *(const bf16x8*)(b3[j] + k0); }
#pragma unroll
            for (int i = 0; i < 4; ++i)
#pragma unroll
                for (int j = 0; j < 2; ++j) { a1[i][j] = __builtin_amdgcn_mfma_f32_16x16x32_bf16(w1[j], a[i], a1[i][j], 0, 0, 0); a3[i][j] = __builtin_amdgcn_mfma_f32_16x16x32_bf16(w3[j], a[i], a3[i][j], 0, 0, 0); }
        }
#pragma unroll
        for (int i = 0; i < 4; ++i)
#pragma unroll
            for (int j = 0; j < 2; ++j) {
                const int pr = mt * 64 + i * 16 + fr, n = nt * 32 + j * 16 + 4 * fq;
                const f32x4 x1 = a1[i][j], x3 = a3[i][j];
                st4bf(H + (size_t)pr * EH + n, siluf_(x1.x) * x3.x, siluf_(x1.y) * x3.y, siluf_(x1.z) * x3.z, siluf_(x1.w) * x3.w);
            }
    }
}
struct BRowMoe2 { const bf16_t* W2; const int* cnt; DEV const bf16_t* operator()(int n, int mt) const { int e, r; moe_find(cnt, mt * 64, e, r); return W2 + (size_t)e * DM * EH + (size_t)n * EH; } };
struct EpiMoe2 { bf16_t* Y; const int* cnt; const int* list; const float* gate;
    DEV void operator()(int m, int n, f32x4 v) const { int e, r; moe_find(cnt, m, e, r); if (r < cnt[e]) { const int aid = list[e * LCAP + r]; const float gt = gate[aid]; st4bf(Y + (size_t)aid * DM + n, v.x * gt, v.y * gt, v.z * gt, v.w * gt); } } };
DEV void moe_gemm2(const Ctx& c, int layer) {
    const int* cnt = (const int*)(c.ws + WS_CTL) + layer * 32;
    const int nblk = moe_nblk(cnt);
    ARowPlain af{(const bf16_t*)(c.ws + SC_H), EH}; BRowMoe2 bf{(const bf16_t*)(c.ws + WS_W2), cnt};
    EpiMoe2 ef{(bf16_t*)(c.ws + SC_Y), cnt, (const int*)(c.ws + WS_LIST), (const float*)(c.ws + WS_GATE)};
    ngemm(c, nblk * 4, DM / 64, EH, af, bf, ef);
}
DEV void moe_combine(const Ctx& c, const bf16_t* Xin, const float* g, const float* b, bf16_t* Xo, float* outf) {
    const bf16_t* Y = (const bf16_t*)(c.ws + SC_Y);
    for (int row = c.gw; row < NT; row += c.ngw) {
        f32x4 v[4]; float s = 0.f;
#pragma unroll
        for (int j = 0; j < 4; ++j) {
            float x[4], y0[4], y1[4]; const int col = 256 * j + 4 * c.lane;
            ld4bf(Xin + (size_t)row * DM + col, x); ld4bf(Y + (size_t)(2 * row) * DM + col, y0); ld4bf(Y + (size_t)(2 * row + 1) * DM + col, y1);
            v[j] = (f32x4){x[0] * DN_ALPHA + (y0[0] + y1[0]), x[1] * DN_ALPHA + (y0[1] + y1[1]), x[2] * DN_ALPHA + (y0[2] + y1[2]), x[3] * DN_ALPHA + (y0[3] + y1[3])};
            s += (v[j].x + v[j].y) + (v[j].z + v[j].w);
        }
        const float mean = wsum(s) * (1.f / DM); float s2 = 0.f;
#pragma unroll
        for (int j = 0; j < 4; ++j) { v[j] = v[j] - mean; s2 += (v[j].x * v[j].x + v[j].y * v[j].y) + (v[j].z * v[j].z + v[j].w * v[j].w); }
        const float rstd = rsqrtf(wsum(s2) * (1.f / DM) + LN_EPS);
#pragma unroll
        for (int j = 0; j < 4; ++j) {
            const int col = 256 * j + 4 * c.lane;
            const f32x4 gg = *(const f32x4*)(g + col), bb = *(const f32x4*)(b + col);
            v[j] = v[j] * rstd * gg + bb;
            if (Xo) st4bf(Xo + (size_t)row * DM + col, v[j].x, v[j].y, v[j].z, v[j].w);
            if (outf) *(f32x4*)(outf + (size_t)row * DM + col) = v[j];
        }
    }
}

DEV void odd_conv(const Ctx& c) {
    const bf16_t* Y1 = (const bf16_t*)(c.ws + SC_Y0); bf16_t* V = (bf16_t*)(c.ws + WS_XA);
    const float* cw = c.p->in[17];
    for (int row = c.gw; row < NT; row += c.ngw) {
        const int t = row & (SEQ - 1);
#pragma unroll
        for (int j = 0; j < 4; ++j) {
            const int col = 256 * j + 4 * c.lane;
            float acc[4] = {0.f, 0.f, 0.f, 0.f};
#pragma unroll
            for (int k = 0; k < 3; ++k) {
                if (t - 2 + k >= 0) {
                    const bf16_t* yr = Y1 + (size_t)(row - 2 + k) * 3072;
                    float gcv[4], hv[4]; ld4bf(yr + 1024 + col, gcv); ld4bf(yr + 2048 + col, hv);
                    const f32x4 w = *(const f32x4*)(cw + k * DM + col);
                    acc[0] += w.x * gcv[0] * hv[0]; acc[1] += w.y * gcv[1] * hv[1]; acc[2] += w.z * gcv[2] * hv[2]; acc[3] += w.w * gcv[3] * hv[3];
                }
            }
            float gb[4]; ld4bf(Y1 + (size_t)row * 3072 + col, gb);
            st4bf(V + (size_t)row * DM + col, gb[0] * acc[0], gb[1] * acc[1], gb[2] * acc[2], gb[3] * acc[3]);
        }
    }
}

constexpr int N_PHASES = 25;
constexpr int LDS_BYTES = 147456;
__global__ void __launch_bounds__(NTHREADS, 2) fwd_kernel(Params prm) {
    extern __shared__ __attribute__((aligned(16))) unsigned char lds_raw[];
    Ctx c; c.p = &prm; c.ws = prm.ws; c.lds = (float*)lds_raw;
    c.tid = threadIdx.x; c.lane = c.tid & 63; c.wave = __builtin_amdgcn_readfirstlane(c.tid >> 6);
    c.gw = blockIdx.x * NWAVES + c.wave; c.ngw = gridDim.x * NWAVES;
    unsigned char* ws = prm.ws;
    bf16_t* XA = (bf16_t*)(ws + WS_XA); bf16_t* XB = (bf16_t*)(ws + WS_XB);
    float* Z = (float*)(ws + SC_Z);
    const float* const* in = prm.in;
#ifndef ONLY_PHASE
#define ONLY_PHASE -1
#endif
#define PHASE(k, ...) if ((ONLY_PHASE < 0 || ONLY_PHASE == (k)) && prm.ph_lo <= (k) && (k) < prm.ph_hi) { __VA_ARGS__; if ((k) + 1 < prm.ph_hi) { __threadfence(); cg::this_grid().sync(); } }
    PHASE(0, phase_prep(c))
    PHASE(1,
        ngemm(c, NT / 64, EINP / 64, DM, ARowPlain{XA, DM}, BRowPlain{(const bf16_t*)(ws + WS_W_IN), DM}, EpiStoreBf16{(bf16_t*)(ws + SC_Y0), EINP});
        ngemm(c, NMEM / 64, DM / 64, DM, ARowPlain{(const bf16_t*)(ws + WS_MEMB), DM}, BRowPlain{(const bf16_t*)(ws + WS_WK), DM}, EpiStoreBf16{(bf16_t*)(ws + WS_MEMK), DM});
        ngemm(c, NMEM / 64, DM / 64, DM, ARowPlain{(const bf16_t*)(ws + WS_MEMB), DM}, BRowPlain{(const bf16_t*)(ws + WS_WV), DM}, EpiStoreBf16{(bf16_t*)(ws + WS_MEMV), DM}))
    PHASE(2, conv_branch(c); cmp_gemm(c))
    PHASE(3, cmp_finish(c))
    PHASE(4, nsa_naive(c))
    PHASE(5, ngemm(c, NT / 64, DM / 64, DM, ARowPlain{(const bf16_t*)(ws + SC_CAT), DM}, BRowPlain{(const bf16_t*)(ws + WS_W_OUT), DM}, EpiResF32{Z, in[0]}))
    PHASE(6, ln_pass<false>(c, Z, in[19], in[20], XB, 0))
    PHASE(7, ngemm(c, NT / 64, DM / 64, DM, ARowPlain{XB, DM}, BRowPlain{(const bf16_t*)(ws + WS_WQ), DM}, EpiStoreBf16{(bf16_t*)(ws + SC_Q), DM}))
    PHASE(8, xattn_naive(c))
    PHASE(9, ngemm(c, NT / 64, DM / 64, DM, ARowPlain{(const bf16_t*)(ws + SC_CTX), DM}, BRowPlain{(const bf16_t*)(ws + WS_WO), DM}, EpiResBf16{Z, XB}))
    PHASE(10, ln_pass<true>(c, Z, in[23], in[24], XA, 0))
    PHASE(11, moe_gemm1(c, XA, 0))
    PHASE(12, moe_gemm2(c, 0))
    PHASE(13, moe_combine(c, XA, in[32], in[33], XB, nullptr); moe_weights(c, 1))
    PHASE(14, ngemm(c, NT / 64, 3 * DM / 64, DM, ARowPlain{XB, DM}, BRowPlain{(const bf16_t*)(ws + WS_OD_IN), DM}, EpiStoreBf16{(bf16_t*)(ws + SC_Y0), 3 * DM}))
    PHASE(15, odd_conv(c))
    PHASE(16, ngemm(c, NT / 64, DM / 64, DM, ARowPlain{XA, DM}, BRowPlain{(const bf16_t*)(ws + WS_OD_OUT), DM}, EpiResBf16{Z, XB}))
    PHASE(17, ln_pass<false>(c, Z, in[19] + DM, in[20] + DM, XA, 1))
    PHASE(18, ngemm(c, NT / 64, DM / 64, DM, ARowPlain{XA, DM}, BRowPlain{(const bf16_t*)(ws + WS_WQ) + (size_t)DM * DM, DM}, EpiStoreBf16{(bf16_t*)(ws + SC_Q), DM}))
    PHASE(19, xattn_naive(c))
    PHASE(20, ngemm(c, NT / 64, DM / 64, DM, ARowPlain{(const bf16_t*)(ws + SC_CTX), DM}, BRowPlain{(const bf16_t*)(ws + WS_WO) + (size_t)DM * DM, DM}, EpiResBf16{Z, XA}))
    PHASE(21, ln_pass<true>(c, Z, in[23] + DM, in[24] + DM, XB, 1))
    PHASE(22, moe_gemm1(c, XB, 1))
    PHASE(23, moe_gemm2(c, 1))
    PHASE(24, moe_combine(c, XB, in[32] + DM, in[33] + DM, nullptr, prm.out))
}

extern "C" void kernel_launch(void* const* d_in, const int* in_sizes, int n_in, void* d_out, int out_size, void* d_ws, size_t ws_size, hipStream_t stream) {
    static int grid = 0;
    if (grid == 0) {
        if (n_in != 34 || ws_size < WS_END) { fprintf(stderr, "kernel_launch: unexpected n_in %d or ws_size %zu\n", n_in, ws_size); grid = -1; return; }
        int dev = 0, cus = 0, per_cu = 0;
        (void)hipGetDevice(&dev);
        (void)hipDeviceGetAttribute(&cus, hipDeviceAttributeMultiprocessorCount, dev);
        (void)hipFuncSetAttribute((const void*)fwd_kernel, hipFuncAttributeMaxDynamicSharedMemorySize, LDS_BYTES);
        (void)hipOccupancyMaxActiveBlocksPerMultiprocessor(&per_cu, (const void*)fwd_kernel, NTHREADS, LDS_BYTES);
        if (per_cu < 1) { fprintf(stderr, "kernel_launch: occupancy query says %d blocks/CU\n", per_cu); per_cu = 1; }
        grid = cus * per_cu;
    }
    if (grid < 0) return;
    Params prm{};
    for (int i = 0; i < 34; ++i) prm.in[i] = (const float*)d_in[i];
    prm.out = (float*)d_out; prm.ws = (unsigned char*)d_ws;
#if N_LAUNCH_MODE == 1
    for (int ph = 0; ph < N_PHASES; ++ph) {
        prm.ph_lo = ph; prm.ph_hi = ph + 1;
        hipLaunchKernelGGL(fwd_kernel, dim3(grid), dim3(NTHREADS), LDS_BYTES, stream, prm);
    }
#else
    prm.ph_lo = 0; prm.ph_hi = N_PHASES;
    void* args[] = {&prm};
    hipError_t e = hipLaunchCooperativeKernel((const void*)fwd_kernel, dim3(grid), dim3(NTHREADS), args, LDS_BYTES, stream);
    if (e != hipSuccess) fprintf(stderr, "cooperative launch failed: %s (grid %d)\n", hipGetErrorString(e), grid);
#endif
}
```

```cpp
#include <hip/hip_runtime.h>
#include <hip/hip_cooperative_groups.h>
#include <cstdint>
#include <cstdio>
namespace cg = cooperative_groups;

#ifndef N_LAUNCH_MODE
#define N_LAUNCH_MODE 0
#endif

typedef unsigned short bf16_t;
typedef short bf16x8 __attribute__((ext_vector_type(8)));
typedef float f32x4 __attribute__((ext_vector_type(4)));
typedef unsigned u32x4 __attribute__((ext_vector_type(4)));
typedef unsigned u32x2 __attribute__((ext_vector_type(2)));
#define DEV __device__ __forceinline__

constexpr int NB = 8, SEQ = 4096, DM = 1024, NT = NB * SEQ;
constexpr int MEML = 256, NMEM = NB * MEML;
constexpr int EIN = 2328, EINP = 2560;
constexpr int C_AV = 0, C_AG = 512, C_Q = 1024, C_KC = 1536, C_VC = 1664, C_KS = 1792, C_VS = 1920, C_KW = 2048, C_VW = 2176, C_GL = 2304;
constexpr int NCMP = 255;
constexpr int NEXP = 32, EH = 512, LCAP = 32768;
constexpr float DN_ALPHA = 1.41421356237f;
constexpr float LN_EPS = 1e-5f;
constexpr int NWAVES = 8, NTHREADS = 512;

constexpr size_t MiB = 1u << 20;
constexpr size_t WS_CTL = 0;
constexpr size_t WS_CMPB = 1 * MiB;
constexpr size_t WS_MSEL = 1 * MiB + 65536;
constexpr size_t WS_KCMP = 2 * MiB;
constexpr size_t WS_VCMP = 3 * MiB;
constexpr size_t WS_PK = 4 * MiB;
constexpr size_t WS_PV = 12 * MiB;
constexpr size_t WS_LIST = 20 * MiB;
constexpr size_t WS_GATE = 24 * MiB;
constexpr size_t WS_MEMB = 25 * MiB;
constexpr size_t WS_MEMK = 29 * MiB;
constexpr size_t WS_MEMV = 33 * MiB;
constexpr size_t WS_W_IN = 40 * MiB;
constexpr size_t WS_W_OUT = 45 * MiB;
constexpr size_t WS_OD_IN = 47 * MiB;
constexpr size_t WS_OD_OUT = 53 * MiB;
constexpr size_t WS_WQ = 55 * MiB;
constexpr size_t WS_WO = 59 * MiB;
constexpr size_t WS_WK = 63 * MiB;
constexpr size_t WS_WV = 65 * MiB;
constexpr size_t WS_CW1 = 67 * MiB;
constexpr size_t WS_W13 = 72 * MiB;
constexpr size_t WS_W2 = 136 * MiB;
constexpr size_t WS_XA = 168 * MiB;
constexpr size_t WS_XB = 232 * MiB;
constexpr size_t WS_SCR = 296 * MiB;
constexpr size_t WS_END = 520 * MiB;
constexpr size_t SC_Y0 = WS_SCR;
constexpr size_t SC_CAT = WS_SCR + 160 * MiB;
constexpr size_t SC_Z = WS_SCR;
constexpr size_t SC_Q = WS_SCR;
constexpr size_t SC_P = WS_SCR + 64 * MiB;
constexpr size_t SC_CTX = WS_SCR + 128 * MiB;
constexpr size_t SC_H = WS_SCR;
constexpr size_t SC_Y = WS_SCR + 80 * MiB;

DEV float bf2f(bf16_t b) { return __uint_as_float(((unsigned)b) << 16); }
DEV unsigned f2bf(float f) { unsigned u = __float_as_uint(f); return (u + 0x7fffu + ((u >> 16) & 1u)) >> 16; }
DEV unsigned pk2(float lo, float hi) { return f2bf(lo) | (f2bf(hi) << 16); }
DEV float wsum(float v) {
#pragma unroll
    for (int o = 1; o < 64; o <<= 1) v += __shfl_xor(v, o);
    return v;
}
DEV float gsum16(float v) { v += __shfl_xor(v, 1); v += __shfl_xor(v, 2); v += __shfl_xor(v, 4); v += __shfl_xor(v, 8); return v; }
DEV float sigmoidf_(float x) { return 1.f / (1.f + __expf(-x)); }
DEV float siluf_(float x) { return x / (1.f + __expf(-x)); }
DEV float gelu_tanh(float x) { const float u = 0.7978845608028654f * (x + 0.044715f * x * x * x); return 0.5f * x * (1.f + tanhf(u)); }
#define LDS_WAIT() asm volatile("s_waitcnt lgkmcnt(0)" ::: "memory")
DEV void ld4bf(const bf16_t* p, float* o) { const u32x2 w = *(const u32x2*)p; o[0] = __uint_as_float(w.x << 16); o[1] = __uint_as_float(w.x & 0xffff0000u); o[2] = __uint_as_float(w.y << 16); o[3] = __uint_as_float(w.y & 0xffff0000u); }
DEV void st4bf(bf16_t* p, float a, float b, float c, float d) { u32x2 w; w.x = pk2(a, b); w.y = pk2(c, d); *(u32x2*)p = w; }

struct Params {
    const float* in[34];
    float* out;
    unsigned char* ws;
    int ph_lo, ph_hi;
};
struct Ctx {
    const Params* p;
    unsigned char* ws;
    float* lds;
    int tid, lane, wave, gw, ngw;
};

template <class AF, class BF, class EF>
DEV void ngemm(const Ctx& c, int mtiles, int ntiles, int K, AF af, BF bf, EF ef) {
    const int fr = c.lane & 15, fq = c.lane >> 4;
    for (int it = c.gw; it < mtiles * ntiles; it += c.ngw) {
        const int mt = it / ntiles, nt = it % ntiles;
        f32x4 acc[4][4];
#pragma unroll
        for (int i = 0; i < 4; ++i)
#pragma unroll
            for (int j = 0; j < 4; ++j) acc[i][j] = (f32x4){0.f, 0.f, 0.f, 0.f};
        const bf16_t* bp[4];
#pragma unroll
        for (int j = 0; j < 4; ++j) bp[j] = bf(nt * 64 + j * 16 + fr, mt) + fq * 8;
        for (int k0 = 0; k0 < K; k0 += 32) {
            bf16x8 a[4], b[4];
#pragma unroll
            for (int i = 0; i < 4; ++i) a[i] = *(const bf16x8*)(af(mt * 64 + i * 16 + fr, k0) + fq * 8);
#pragma unroll
            for (int j = 0; j < 4; ++j) b[j] = *(const bf16x8*)(bp[j] + k0);
#pragma unroll
            for (int i = 0; i < 4; ++i)
#pragma unroll
                for (int j = 0; j < 4; ++j) acc[i][j] = __builtin_amdgcn_mfma_f32_16x16x32_bf16(b[j], a[i], acc[i][j], 0, 0, 0);
        }
#pragma unroll
        for (int i = 0; i < 4; ++i)
#pragma unroll
            for (int j = 0; j < 4; ++j) ef(mt * 64 + i * 16 + fr, nt * 64 + j * 16 + 4 * fq, acc[i][j]);
    }
}

namespace pg8 {
#define PG8_LAS __attribute__((address_space(3)))
constexpr int BM = 256, BK = 64, HALF = 128, HTB = HALF * BK * 2, STAGE_BYTES = 8 * HTB, NXCD = 8, WGM = 8;
DEV int lds_byte(int r, int c) { const int st = (r >> 4) * 2 + (c >> 5), rr = r & 15, cc = c & 31, ob = rr * 64 + cc * 2; return st * 1024 + (ob ^ (((ob >> 9) & 1) << 5)); }
DEV void stage_rc(int b, int& R, int& C) { const int st = b / 1024, sb = b % 1024, swz = sb ^ (((sb >> 9) & 1) << 5); R = (st >> 1) * 16 + swz / 64; C = (st & 1) * 32 + (swz % 64) / 2; }
DEV int perm32(int rho) { const int n = rho >> 4, i = rho & 15; return 8 * (i >> 2) + 4 * n + (i & 3); }
struct Unit { int pm, pn, aux; };
struct StaticOrder {
    int nM, nN, nwg, G, c;
    DEV void init(int M, int N, int G_, int c_) { nM = M / BM; nN = N / BM; nwg = nM * nN; G = G_; c = c_; }
    DEV bool next(int i, Unit& u) const {
        const long L = (long)i * G + c; if (L >= nwg) return false;
        int wgid = (int)L; { const int q = nwg / NXCD, r = nwg % NXCD, xcd = wgid % NXCD, off = wgid / NXCD; wgid = (xcd < r ? xcd * (q + 1) : r * (q + 1) + (xcd - r) * q) + off; }
        const int nig = WGM * nN, gid = wgid / nig, fm = gid * WGM, gsz = (nM - fm) < WGM ? (nM - fm) : WGM;
        u.pm = fm + ((wgid % nig) % gsz); u.pn = (wgid % nig) / gsz; u.aux = 0; return true;
    }
};
DEV unsigned cvt_pk_bf16(float lo, float hi) { unsigned r; asm volatile("v_cvt_pk_bf16_f32 %0, %1, %2" : "=v"(r) : "v"(lo), "v"(hi)); return r; }
typedef f32x4 Acc[2][2][4][2];

template <class Task>
DEV void gemm_phase(PG8_LAS unsigned char* lds, const Task& T) {
    const int tid = threadIdx.x, wid = __builtin_amdgcn_readfirstlane(tid >> 6), lane = tid & 63, wr = wid >> 2, wc = wid & 3, fr = lane & 15, fq = lane >> 4;
    const int nt = T.K / BK;
    int R[2], C[2]; unsigned voffB[2];
#pragma unroll
    for (int i = 0; i < 2; ++i) { stage_rc(tid * 16 + i * 8192, R[i], C[i]); const int Rb = Task::PERM ? ((R[i] & ~31) + perm32(R[i] & 31)) : R[i]; voffB[i] = (unsigned)(Rb * T.ldb() + C[i]) * 2u; }
    const size_t kstepB = (size_t)(BK * 2);
    const size_t hstepB = (size_t)HALF * T.ldb() * 2;
    const unsigned ldsw = (unsigned)wid * 1024u;
    const int aoff = lds_byte(wr * 64 + fr, fq * 8), boff = lds_byte(wc * 32 + fr, fq * 8);
#define PG8_SA(b, h) (((b) * 2 + (h)) * HTB)
#define PG8_SB(b, h) ((4 + (b) * 2 + (h)) * HTB)
#define PG8_STAGE(bufoff, gbase, voff) do { _Pragma("unroll") for (int _i = 0; _i < 2; ++_i) \
        __builtin_amdgcn_global_load_lds((const unsigned*)((const char*)(gbase) + (voff)[_i]), (PG8_LAS unsigned*)(lds + (bufoff) + ldsw + _i * 8192), 16, 0, 0); } while (0)
#define PG8_LDA(dst, b, h) do { _Pragma("unroll") for (int m = 0; m < 4; ++m) _Pragma("unroll") for (int k = 0; k < 2; ++k) dst[m][k] = *(const PG8_LAS bf16x8*)(lds + PG8_SA(b, h) + aoff + m * 2048 + k * 1024); } while (0)
#define PG8_LDB(dst, b, h) do { _Pragma("unroll") for (int n = 0; n < 2; ++n) _Pragma("unroll") for (int k = 0; k < 2; ++k) dst[n][k] = *(const PG8_LAS bf16x8*)(lds + PG8_SB(b, h) + boff + n * 2048 + k * 1024); } while (0)
#define PG8_MMA(ai, bj, At, Bt) do { __builtin_amdgcn_s_setprio(1); _Pragma("unroll") for (int m = 0; m < 4; ++m) _Pragma("unroll") for (int n = 0; n < 2; ++n) _Pragma("unroll") for (int k = 0; k < 2; ++k) \
        acc[ai][bj][m][n] = __builtin_amdgcn_mfma_f32_16x16x32_bf16(Bt[n][k], At[m][k], acc[ai][bj][m][n], 0, 0, 0); __builtin_amdgcn_s_setprio(0); } while (0)
#define PG8_WAIT_V(n) asm volatile("s_waitcnt vmcnt(" #n ")" ::: "memory")
#define PG8_WAIT_L(n) asm volatile("s_waitcnt lgkmcnt(" #n ")" ::: "memory")
#define PG8_BAR __builtin_amdgcn_s_barrier()
#define PG8_SCHED __builtin_amdgcn_sched_barrier(0)
    Unit cur, nxt; int ui = 0;
    if (!T.next(0, cur)) return;
    Acc acc;
#pragma unroll
    for (int a = 0; a < 2; ++a)
#pragma unroll
        for (int b = 0; b < 2; ++b)
#pragma unroll
            for (int m = 0; m < 4; ++m)
#pragma unroll
                for (int n = 0; n < 2; ++n) acc[a][b][m][n] = (f32x4){0.f, 0.f, 0.f, 0.f};
    bf16x8 At[4][2], B0[2][2], B1[2][2];
    unsigned va[2][2], na[2][2];
    T.a_offs(cur, R, C, va);
    const char* cA = T.a_base(cur); const char* cB = T.b_base(cur); size_t kstepA = T.a_kstep(cur), kstepN = kstepA;
    PG8_STAGE(PG8_SB(0, 0), cB, voffB); PG8_STAGE(PG8_SB(0, 1), cB + hstepB, voffB); PG8_STAGE(PG8_SA(0, 0), cA, va[0]); PG8_STAGE(PG8_SA(0, 1), cA, va[1]);
    if (wr == 1) PG8_BAR;
    PG8_WAIT_V(2); PG8_BAR;
    PG8_STAGE(PG8_SB(1, 0), cB + kstepB, voffB); PG8_STAGE(PG8_SA(1, 0), cA + kstepA, va[0]); PG8_STAGE(PG8_SB(1, 1), cB + hstepB + kstepB, voffB);
    PG8_WAIT_V(6); PG8_BAR;
    for (;;) {
        const bool has_next = T.next(ui + 1, nxt);
        const char* nA = cA; const char* nB = cB;
#pragma unroll
        for (int h = 0; h < 2; ++h)
#pragma unroll
            for (int i = 0; i < 2; ++i) na[h][i] = va[h][i];
        kstepN = kstepA;
        if (has_next) { nA = T.a_base(nxt); nB = T.b_base(nxt); T.a_offs(nxt, R, C, na); kstepN = T.a_kstep(nxt); }
        for (int t = 0; t < nt; t += 2) {
            const bool last = (t == nt - 2);
            const char* a1 = cA + (size_t)(t + 1) * kstepA;
            const char* a2 = last ? nA : cA + (size_t)(t + 2) * kstepA; const char* b2 = last ? nB : cB + (size_t)(t + 2) * kstepB;
            const char* a3 = a2 + (last ? kstepN : kstepA); const char* b3 = b2 + kstepB;
            unsigned w2[2][2];
#pragma unroll
            for (int h = 0; h < 2; ++h)
#pragma unroll
                for (int i = 0; i < 2; ++i) w2[h][i] = last ? na[h][i] : va[h][i];
            PG8_LDB(B0, 0, 0); PG8_LDB(B1, 0, 1); PG8_SCHED; PG8_LDA(At, 0, 0); PG8_STAGE(PG8_SA(1, 1), a1, va[1]);
            PG8_WAIT_V(8); PG8_WAIT_L(0); PG8_BAR; PG8_MMA(0, 0, At, B0); PG8_MMA(0, 1, At, B1); PG8_BAR; PG8_SCHED;
            PG8_LDA(At, 0, 1); PG8_STAGE(PG8_SB(0, 0), b2, voffB); PG8_STAGE(PG8_SB(0, 1), b2 + hstepB, voffB); PG8_STAGE(PG8_SA(0, 0), a2, w2[0]);
            PG8_WAIT_V(8); PG8_WAIT_L(0); PG8_BAR; PG8_MMA(1, 0, At, B0); PG8_MMA(1, 1, At, B1); PG8_BAR; PG8_SCHED;
            PG8_LDB(B0, 1, 0); PG8_LDB(B1, 1, 1); PG8_SCHED; PG8_LDA(At, 1, 0); PG8_STAGE(PG8_SA(0, 1), a2, w2[1]);
            PG8_WAIT_V(8); PG8_WAIT_L(0); PG8_BAR; PG8_MMA(0, 0, At, B0); PG8_MMA(0, 1, At, B1); PG8_BAR; PG8_SCHED;
            PG8_LDA(At, 1, 1); PG8_STAGE(PG8_SB(1, 0), b3, voffB); PG8_STAGE(PG8_SB(1, 1), b3 + hstepB, voffB); PG8_STAGE(PG8_SA(1, 0), a3, w2[0]);
            PG8_WAIT_V(8); PG8_WAIT_L(0); PG8_BAR; PG8_MMA(1, 0, At, B0); PG8_MMA(1, 1, At, B1); PG8_BAR; PG8_SCHED;
        }
        if (wr == 0) PG8_BAR;
        T.epi(acc, cur, wr, wc, fr, fq);
        if (!has_next) break;
#pragma unroll
        for (int a = 0; a < 2; ++a)
#pragma unroll
            for (int b = 0; b < 2; ++b)
#pragma unroll
                for (int m = 0; m < 4; ++m)
#pragma unroll
                    for (int n = 0; n < 2; ++n) acc[a][b][m][n] = (f32x4){0.f, 0.f, 0.f, 0.f};
        cur = nxt; cA = nA; cB = nB; kstepA = kstepN; ++ui;
#pragma unroll
        for (int h = 0; h < 2; ++h)
#pragma unroll
            for (int i = 0; i < 2; ++i) va[h][i] = na[h][i];
        if (wr == 1) PG8_BAR;
    }
    PG8_WAIT_V(0);
    PG8_BAR;
#undef PG8_SA
#undef PG8_SB
#undef PG8_STAGE
#undef PG8_LDA
#undef PG8_LDB
#undef PG8_MMA
#undef PG8_WAIT_V
#undef PG8_WAIT_L
#undef PG8_BAR
#undef PG8_SCHED
}

DEV void store_tile_bf16(const Acc& acc, bf16_t* base, int ldc, int wr, int wc, int fr, int fq) {
#pragma unroll
    for (int ai = 0; ai < 2; ++ai)
#pragma unroll
        for (int m = 0; m < 4; ++m) { bf16_t* rowp = base + (size_t)(ai * HALF + wr * 64 + m * 16 + fr) * ldc + wc * 32 + 8 * fq;
#pragma unroll
            for (int bj = 0; bj < 2; ++bj) { const f32x4 v0 = acc[ai][bj][m][0], v1 = acc[ai][bj][m][1];
                u32x4 w; w.x = cvt_pk_bf16(v0[0], v0[1]); w.y = cvt_pk_bf16(v0[2], v0[3]); w.z = cvt_pk_bf16(v1[0], v1[1]); w.w = cvt_pk_bf16(v1[2], v1[3]);
                *(u32x4*)(rowp + bj * HALF) = w; } }
}
template <class Epi, bool PERM_>
struct PlainTask {
    static constexpr bool PERM = PERM_;
    const bf16_t* A; int lda; const bf16_t* Bt; int ldb_; int K; StaticOrder S; Epi E;
    DEV bool next(int i, Unit& u) const { return S.next(i, u); }
    DEV const char* a_base(const Unit& u) const { return (const char*)(A + (size_t)u.pm * BM * lda); }
    DEV void a_offs(const Unit&, const int (&R)[2], const int (&C)[2], unsigned (&v)[2][2]) const {
#pragma unroll
        for (int h = 0; h < 2; ++h)
#pragma unroll
            for (int i = 0; i < 2; ++i) v[h][i] = (unsigned)((h * HALF + R[i]) * lda + C[i]) * 2u;
    }
    DEV size_t a_kstep(const Unit&) const { return (size_t)(BK * 2); }
    DEV const char* b_base(const Unit& u) const { return (const char*)(Bt + (size_t)u.pn * BM * ldb_); }
    DEV int ldb() const { return ldb_; }
    DEV void epi(Acc& acc, const Unit& u, int wr, int wc, int fr, int fq) const { E(acc, u, wr, wc, fr, fq); }
};
struct EpiBf16 {
    bf16_t* Cc; int ldc;
    DEV void operator()(Acc& acc, const Unit& u, int wr, int wc, int fr, int fq) const { store_tile_bf16(acc, Cc + (size_t)u.pm * BM * ldc + u.pn * BM, ldc, wr, wc, fr, fq); }
};
struct EpiInproj {
    bf16_t* Cc;
    DEV void operator()(Acc& acc, const Unit& u, int wr, int wc, int fr, int fq) const {
        if (u.pn == 4 || u.pn == 5) {
#pragma unroll
            for (int a = 0; a < 2; ++a)
#pragma unroll
                for (int b = 0; b < 2; ++b)
#pragma unroll
                    for (int m = 0; m < 4; ++m)
#pragma unroll
                        for (int n = 0; n < 2; ++n) acc[a][b][m][n] = acc[a][b][m][n] * (0.125f * 1.4426950408889634f);
        }
        store_tile_bf16(acc, Cc + (size_t)u.pm * BM * EINP + u.pn * BM, EINP, wr, wc, fr, fq); }
};
struct EpiBf16S {
    bf16_t* Cc; int ldc; float scale;
    DEV void operator()(Acc& acc, const Unit& u, int wr, int wc, int fr, int fq) const {
#pragma unroll
        for (int a = 0; a < 2; ++a)
#pragma unroll
            for (int b = 0; b < 2; ++b)
#pragma unroll
                for (int m = 0; m < 4; ++m)
#pragma unroll
                    for (int n = 0; n < 2; ++n) acc[a][b][m][n] = acc[a][b][m][n] * scale;
        store_tile_bf16(acc, Cc + (size_t)u.pm * BM * ldc + u.pn * BM, ldc, wr, wc, fr, fq); }
};
template <bool RES_F32>
struct EpiRes {
    float* Z; const void* res;
    DEV void operator()(Acc& acc, const Unit& u, int wr, int wc, int fr, int fq) const {
#pragma unroll
        for (int ai = 0; ai < 2; ++ai)
#pragma unroll
            for (int m = 0; m < 4; ++m) { const size_t roff = (size_t)(u.pm * BM + ai * HALF + wr * 64 + m * 16 + fr) * DM + u.pn * BM + wc * 32 + 4 * fq;
#pragma unroll
                for (int bj = 0; bj < 2; ++bj)
#pragma unroll
                    for (int n = 0; n < 2; ++n) { const size_t off = roff + bj * HALF + n * 16; f32x4 r;
                        if (RES_F32) r = *(const f32x4*)((const float*)res + off); else { float t[4]; ld4bf((const bf16_t*)res + off, t); r = (f32x4){t[0], t[1], t[2], t[3]}; }
                        *(f32x4*)(Z + off) = r * DN_ALPHA + acc[ai][bj][m][n]; } }
    }
};
}

namespace pg8 {
constexpr int LDS_SPARE = STAGE_BYTES;
DEV void store_tile_f32_perm(const Acc& acc, float* base, int ldc, int wr, int wc, int fr, int fq) {
#pragma unroll
    for (int ai = 0; ai < 2; ++ai)
#pragma unroll
        for (int m = 0; m < 4; ++m) { float* rowp = base + (size_t)(ai * HALF + wr * 64 + m * 16 + fr) * ldc + wc * 32 + 8 * fq;
#pragma unroll
            for (int bj = 0; bj < 2; ++bj) { *(f32x4*)(rowp + bj * HALF) = acc[ai][bj][m][0]; *(f32x4*)(rowp + bj * HALF + 4) = acc[ai][bj][m][1]; } }
}
struct CmpTask {
    static constexpr bool PERM = true;
    int K; unsigned char* ws; int id;
    DEV bool next(int i, Unit& u) const { if (i > 0 || id >= 64) return false; u.aux = id >> 5; u.pm = (id >> 1) & 15; u.pn = id & 1; return true; }
    DEV const char* a_base(const Unit& u) const { return (const char*)(ws + SC_Y0) + (u.aux ? C_VC : C_KC) * 2; }
    DEV void a_offs(const Unit& u, const int (&R)[2], const int (&C)[2], unsigned (&v)[2][2]) const {
#pragma unroll
        for (int h = 0; h < 2; ++h)
#pragma unroll
            for (int i = 0; i < 2; ++i) { const int m = u.pm * BM + h * HALF + R[i], g = m & 1, bj = m >> 1; v[h][i] = (unsigned)(((size_t)bj * 16 * EINP + g * 64 + C[i]) * 2); } }
    DEV size_t a_kstep(const Unit&) const { return (size_t)EINP * 2; }
    DEV const char* b_base(const Unit& u) const { return (const char*)(ws + WS_CW1) + ((size_t)u.aux * 512 + (size_t)u.pn * BM) * DM * 2; }
    DEV int ldb() const { return DM; }
    DEV void epi(Acc& acc, const Unit& u, int wr, int wc, int fr, int fq) const { store_tile_f32_perm(acc, (float*)(ws + (u.aux ? WS_PV : WS_PK)) + (size_t)u.pm * BM * 512 + u.pn * BM, 512, wr, wc, fr, fq); }
};
struct OneUnitTask {
    static constexpr bool PERM = true;
    int K; const bf16_t* A; const bf16_t* Bt; bf16_t* Cc; int ldc; size_t cm, cn; int pm, pn; bool on;
    DEV bool next(int i, Unit& u) const { if (i > 0 || !on) return false; u.pm = pm; u.pn = pn; u.aux = 0; return true; }
    DEV const char* a_base(const Unit& u) const { return (const char*)(A + (size_t)u.pm * BM * DM); }
    DEV void a_offs(const Unit&, const int (&R)[2], const int (&C)[2], unsigned (&v)[2][2]) const {
#pragma unroll
        for (int h = 0; h < 2; ++h)
#pragma unroll
            for (int i = 0; i < 2; ++i) v[h][i] = (unsigned)((h * HALF + R[i]) * DM + C[i]) * 2u; }
    DEV size_t a_kstep(const Unit&) const { return (size_t)(BK * 2); }
    DEV const char* b_base(const Unit& u) const { return (const char*)(Bt + (size_t)u.pn * BM * DM); }
    DEV int ldb() const { return DM; }
    DEV void epi(Acc& acc, const Unit& u, int wr, int wc, int fr, int fq) const { store_tile_bf16(acc, Cc + (size_t)u.pm * cm + (size_t)u.pn * cn, ldc, wr, wc, fr, fq); }
};
struct XaSTask {
    static constexpr bool PERM = true;
    int K; const bf16_t* Q; const bf16_t* MK; bf16_t* P; PG8_LAS unsigned char* lds; StaticOrder S;
    DEV bool next(int i, Unit& u) const { return S.next(i, u); }
    DEV const char* a_base(const Unit& u) const { return (const char*)(Q + (size_t)u.pm * BM * DM + u.pn * 256); }
    DEV void a_offs(const Unit&, const int (&R)[2], const int (&C)[2], unsigned (&v)[2][2]) const {
#pragma unroll
        for (int h = 0; h < 2; ++h)
#pragma unroll
            for (int i = 0; i < 2; ++i) v[h][i] = (unsigned)((h * HALF + R[i]) * DM + C[i]) * 2u; }
    DEV size_t a_kstep(const Unit&) const { return (size_t)(BK * 2); }
    DEV const char* b_base(const Unit& u) const { return (const char*)(MK + (size_t)(u.pm >> 4) * MEML * DM + u.pn * 256); }
    DEV int ldb() const { return DM; }
    DEV void epi(Acc& acc, const Unit& u, int wr, int wc, int fr, int fq) const {
        PG8_LAS float* smax = (PG8_LAS float*)(lds + LDS_SPARE); PG8_LAS float* ssum = smax + 1024;
#pragma unroll
        for (int ai = 0; ai < 2; ++ai)
#pragma unroll
            for (int m = 0; m < 4; ++m) { float v = -INFINITY;
#pragma unroll
                for (int bj = 0; bj < 2; ++bj)
#pragma unroll
                    for (int n = 0; n < 2; ++n) { const f32x4 x = acc[ai][bj][m][n]; v = fmaxf(v, fmaxf(fmaxf(x[0], x[1]), fmaxf(x[2], x[3]))); }
                v = fmaxf(v, __shfl_xor(v, 16)); v = fmaxf(v, __shfl_xor(v, 32));
                if (fq == 0) smax[(ai * HALF + wr * 64 + m * 16 + fr) * 4 + wc] = v; }
        asm volatile("s_waitcnt lgkmcnt(0)" ::: "memory"); __builtin_amdgcn_s_barrier(); asm volatile("" ::: "memory");
#pragma unroll
        for (int ai = 0; ai < 2; ++ai)
#pragma unroll
            for (int m = 0; m < 4; ++m) { const int row = ai * HALF + wr * 64 + m * 16 + fr;
                const f32x4 t = *(const PG8_LAS f32x4*)(smax + row * 4); const float M = fmaxf(fmaxf(t[0], t[1]), fmaxf(t[2], t[3])); float s = 0.f;
#pragma unroll
                for (int bj = 0; bj < 2; ++bj)
#pragma unroll
                    for (int n = 0; n < 2; ++n) { f32x4 x = acc[ai][bj][m][n];
#pragma unroll
                        for (int j = 0; j < 4; ++j) { x[j] = __builtin_amdgcn_exp2f(x[j] - M); s += x[j]; }
                        acc[ai][bj][m][n] = x; }
                s += __shfl_xor(s, 16); s += __shfl_xor(s, 32);
                if (fq == 0) ssum[row * 4 + wc] = s; }
        asm volatile("s_waitcnt lgkmcnt(0)" ::: "memory"); __builtin_amdgcn_s_barrier(); asm volatile("" ::: "memory");
#pragma unroll
        for (int ai = 0; ai < 2; ++ai)
#pragma unroll
            for (int m = 0; m < 4; ++m) { const int row = ai * HALF + wr * 64 + m * 16 + fr;
                const f32x4 t = *(const PG8_LAS f32x4*)(ssum + row * 4); const float inv = 1.f / ((t[0] + t[1]) + (t[2] + t[3]));
#pragma unroll
                for (int bj = 0; bj < 2; ++bj)
#pragma unroll
                    for (int n = 0; n < 2; ++n) acc[ai][bj][m][n] = acc[ai][bj][m][n] * inv; }
        store_tile_bf16(acc, P + (size_t)u.pm * BM * DM + u.pn * 256, DM, wr, wc, fr, fq);
        asm volatile("s_waitcnt lgkmcnt(0)" ::: "memory"); __builtin_amdgcn_s_barrier(); asm volatile("" ::: "memory");
    }
};
struct XaPVTask {
    static constexpr bool PERM = true;
    int K; const bf16_t* P; const bf16_t* VT; bf16_t* O; StaticOrder S;
    DEV bool next(int i, Unit& u) const { return S.next(i, u); }
    DEV const char* a_base(const Unit& u) const { return (const char*)(P + (size_t)u.pm * BM * DM + u.pn * 256); }
    DEV void a_offs(const Unit&, const int (&R)[2], const int (&C)[2], unsigned (&v)[2][2]) const {
#pragma unroll
        for (int h = 0; h < 2; ++h)
#pragma unroll
            for (int i = 0; i < 2; ++i) v[h][i] = (unsigned)((h * HALF + R[i]) * DM + C[i]) * 2u; }
    DEV size_t a_kstep(const Unit&) const { return (size_t)(BK * 2); }
    DEV const char* b_base(const Unit& u) const { return (const char*)(VT + ((size_t)(u.pm >> 4) * DM + u.pn * 256) * MEML); }
    DEV int ldb() const { return MEML; }
    DEV void epi(Acc& acc, const Unit& u, int wr, int wc, int fr, int fq) const { store_tile_bf16(acc, O + (size_t)u.pm * BM * DM + u.pn * 256, DM, wr, wc, fr, fq); }
};
DEV void moe_build_tab(const int* cnt, PG8_LAS int* tab) {
    if (threadIdx.x == 0) { int nb = 0; for (int e = 0; e < NEXP; ++e) { const int k = (cnt[e] + 255) >> 8; for (int j = 0; j < k; ++j) tab[1 + nb + j] = (e << 16) | j; nb += k; } tab[0] = nb; }
    asm volatile("s_waitcnt lgkmcnt(0)" ::: "memory"); __syncthreads();
}
struct Moe1Task {
    static constexpr bool PERM = true;
    int K; const bf16_t* X; const bf16_t* W13; bf16_t* H; const int* cnt; const int* list; const PG8_LAS int* tab; int G, c;
    DEV bool next(int i, Unit& u) const { const int id = i * G + c, rb = id >> 2; if (rb >= tab[0]) return false; u.pm = rb; u.pn = id & 3; u.aux = tab[1 + rb]; return true; }
    DEV const char* a_base(const Unit&) const { return (const char*)X; }
    DEV void a_offs(const Unit& u, const int (&R)[2], const int (&C)[2], unsigned (&v)[2][2]) const {
        const int e = u.aux >> 16, lb = u.aux & 0xffff, ce = cnt[e];
#pragma unroll
        for (int h = 0; h < 2; ++h)
#pragma unroll
            for (int i = 0; i < 2; ++i) { const int r = lb * BM + h * HALF + R[i]; const int tok = (r < ce) ? (list[e * LCAP + r] >> 1) : 0; v[h][i] = (unsigned)(tok * DM + C[i]) * 2u; } }
    DEV size_t a_kstep(const Unit&) const { return (size_t)(BK * 2); }
    DEV const char* b_base(const Unit& u) const { return (const char*)(W13 + ((size_t)(u.aux >> 16) * DM + (size_t)u.pn * BM) * DM); }
    DEV int ldb() const { return DM; }
    DEV void epi(Acc& acc, const Unit& u, int wr, int wc, int fr, int fq) const {
#pragma unroll
        for (int ai = 0; ai < 2; ++ai)
#pragma unroll
            for (int m = 0; m < 4; ++m) { bf16_t* rowp = H + (size_t)(u.pm * BM + ai * HALF + wr * 64 + m * 16 + fr) * EH + u.pn * HALF + wc * 32 + 8 * fq;
                f32x4 h0, h1;
#pragma unroll
                for (int j = 0; j < 4; ++j) { const float a = acc[ai][0][m][0][j], b = acc[ai][0][m][1][j]; h0[j] = a / (1.f + __expf(-a)) * acc[ai][1][m][0][j]; h1[j] = b / (1.f + __expf(-b)) * acc[ai][1][m][1][j]; }
                u32x4 w; w.x = cvt_pk_bf16(h0[0], h0[1]); w.y = cvt_pk_bf16(h0[2], h0[3]); w.z = cvt_pk_bf16(h1[0], h1[1]); w.w = cvt_pk_bf16(h1[2], h1[3]);
                *(u32x4*)rowp = w; }
    }
};
struct Moe2Task {
    static constexpr bool PERM = true;
    int K; const bf16_t* H; const bf16_t* W2; bf16_t* Y; const int* cnt; const int* list; const float* gate; const PG8_LAS int* tab; int G, c;
    DEV bool next(int i, Unit& u) const { const int id = i * G + c, rb = id >> 2; if (rb >= tab[0]) return false; u.pm = rb; u.pn = id & 3; u.aux = tab[1 + rb]; return true; }
    DEV const char* a_base(const Unit& u) const { return (const char*)(H + (size_t)u.pm * BM * EH); }
    DEV void a_offs(const Unit&, const int (&R)[2], const int (&C)[2], unsigned (&v)[2][2]) const {
#pragma unroll
        for (int h = 0; h < 2; ++h)
#pragma unroll
            for (int i = 0; i < 2; ++i) v[h][i] = (unsigned)((h * HALF + R[i]) * EH + C[i]) * 2u; }
    DEV size_t a_kstep(const Unit&) const { return (size_t)(BK * 2); }
    DEV const char* b_base(const Unit& u) const { return (const char*)(W2 + ((size_t)(u.aux >> 16) * DM + (size_t)u.pn * BM) * EH); }
    DEV int ldb() const { return EH; }
    DEV void epi(Acc& acc, const Unit& u, int wr, int wc, int fr, int fq) const {
        const int e = u.aux >> 16, lb = u.aux & 0xffff, ce = cnt[e];
#pragma unroll
        for (int ai = 0; ai < 2; ++ai)
#pragma unroll
            for (int m = 0; m < 4; ++m) { const int r = lb * BM + ai * HALF + wr * 64 + m * 16 + fr;
                if (r < ce) { const int aid = list[e * LCAP + r]; const float gt = gate[aid];
                    bf16_t* rowp = Y + (size_t)aid * DM + u.pn * BM + wc * 32 + 8 * fq;
#pragma unroll
                    for (int bj = 0; bj < 2; ++bj) { const f32x4 v0 = acc[ai][bj][m][0] * gt, v1 = acc[ai][bj][m][1] * gt;
                        u32x4 w; w.x = cvt_pk_bf16(v0[0], v0[1]); w.y = cvt_pk_bf16(v0[2], v0[3]); w.z = cvt_pk_bf16(v1[0], v1[1]); w.w = cvt_pk_bf16(v1[2], v1[3]);
                        *(u32x4*)(rowp + bj * HALF) = w; } } }
    }
};
}

template <class RM>
DEV void tr_item(const float* W, int ldw, int N, bf16_t* WT, int ldd, RM rowmap, int item, int nblk, float* scr, int lane) {
    const int kb = item / nblk, nb = item % nblk, k0 = 64 * kb, n0 = 32 * nb;
    const int n = n0 + (lane & 31);
#pragma unroll 8
    for (int i = 0; i < 32; ++i) { const int kk = 2 * i + (lane >> 5); scr[kk * 33 + (lane & 31)] = (n < N) ? W[(size_t)(k0 + kk) * ldw + n] : 0.f; }
    LDS_WAIT();
    const int ch = lane & 7;
#pragma unroll
    for (int j = 0; j < 4; ++j) {
        const int nl = (lane >> 3) + 8 * j, nn = n0 + nl;
        const float* s = scr + (8 * ch) * 33 + nl;
        u32x4 o; o.x = pk2(s[0], s[33]); o.y = pk2(s[66], s[99]); o.z = pk2(s[132], s[165]); o.w = pk2(s[198], s[231]);
        if (nn < N) *(u32x4*)(WT + (size_t)rowmap(nn) * ldd + k0 + 8 * ch) = o;
    }
    LDS_WAIT();
}
template <class RM>
DEV void tr_all(const Ctx& c, const float* W, int K, int N, bf16_t* WT, int ldd, RM rm) {
    float* scr = c.lds + c.wave * (64 * 33);
    const int nblk = (N + 31) / 32, nitems = (K / 64) * nblk;
    for (int it = c.gw; it < nitems; it += c.ngw) tr_item(W, N, N, WT, ldd, rm, it, nblk, scr, c.lane);
}
DEV void moe_weights(const Ctx& c, int layer) {
    float* scr = c.lds + c.wave * (64 * 33);
    const float* w1 = c.p->in[29] + (size_t)layer * NEXP * DM * EH;
    const float* w3 = c.p->in[30] + (size_t)layer * NEXP * DM * EH;
    const float* w2 = c.p->in[31] + (size_t)layer * NEXP * EH * DM;
    bf16_t* W13 = (bf16_t*)(c.ws + WS_W13); bf16_t* W2 = (bf16_t*)(c.ws + WS_W2);
    for (int it = c.gw; it < NEXP * 768; it += c.ngw) {
        const int e = it / 768, r = it % 768, mat = r >> 8, sub = r & 255;
        if (mat == 0) tr_item(w1 + (size_t)e * DM * EH, EH, EH, W13 + (size_t)e * DM * DM, DM, [](int n) { return (n >> 7) * 256 + (n & 127); }, sub, 16, scr, c.lane);
        else if (mat == 1) tr_item(w3 + (size_t)e * DM * EH, EH, EH, W13 + (size_t)e * DM * DM, DM, [](int n) { return (n >> 7) * 256 + 128 + (n & 127); }, sub, 16, scr, c.lane);
        else tr_item(w2 + (size_t)e * EH * DM, DM, DM, W2 + (size_t)e * DM * EH, EH, [](int n) { return n; }, sub, 32, scr, c.lane);
    }
}
DEV void cvt_rows(const Ctx& c, const float* src, bf16_t* dst, size_t n) {
    const size_t nth = (size_t)c.ngw * 64, t0 = (size_t)c.gw * 64 + c.lane;
    for (size_t i = t0; i < n / 8; i += nth) {
        const f32x4 a = *(const f32x4*)(src + i * 8), b = *(const f32x4*)(src + i * 8 + 4);
        u32x4 o; o.x = pk2(a.x, a.y); o.y = pk2(a.z, a.w); o.z = pk2(b.x, b.y); o.w = pk2(b.z, b.w);
        *(u32x4*)(dst + i * 8) = o;
    }
}
DEV void phase_prep(const Ctx& c) {
    const Params& p = *c.p; unsigned char* ws = c.ws;
    auto id = [](int n) { return n; };
    if (blockIdx.x == 0 && c.tid < 64) ((int*)(ws + WS_CTL))[c.tid] = 0;
    tr_all(c, p.in[4], DM, EIN, (bf16_t*)(ws + WS_W_IN), DM, id);
    {
        bf16_t* w = (bf16_t*)(ws + WS_W_IN) + (size_t)EIN * DM; const size_t n = (size_t)(EINP - EIN) * DM / 8;
        for (size_t i = (size_t)c.gw * 64 + c.lane; i < n; i += (size_t)c.ngw * 64) *(u32x4*)(w + i * 8) = (u32x4){0u, 0u, 0u, 0u};
    }
    tr_all(c, p.in[15], DM, DM, (bf16_t*)(ws + WS_W_OUT), DM, id);
    tr_all(c, p.in[16], DM, 3 * DM, (bf16_t*)(ws + WS_OD_IN), DM, id);
    tr_all(c, p.in[18], DM, DM, (bf16_t*)(ws + WS_OD_OUT), DM, id);
    for (int l = 0; l < 2; ++l) {
        tr_all(c, p.in[21] + (size_t)l * DM * DM, DM, DM, (bf16_t*)(ws + WS_WQ) + (size_t)l * DM * DM, DM, id);
        tr_all(c, p.in[22] + (size_t)l * DM * DM, DM, DM, (bf16_t*)(ws + WS_WO) + (size_t)l * DM * DM, DM, id);
    }
    tr_all(c, p.in[2], DM, DM, (bf16_t*)(ws + WS_WK), DM, id);
    tr_all(c, p.in[3], DM, DM, (bf16_t*)(ws + WS_WV), DM, id);
    for (int kv = 0; kv < 2; ++kv) {
        const float* w1 = p.in[kv ? 13 : 10];
        bf16_t* d = (bf16_t*)(ws + WS_CW1) + (size_t)kv * 512 * DM;
        tr_all(c, w1, 1024, 256, d, DM, id);
        tr_all(c, w1 + (size_t)1024 * 256, 1024, 256, d + (size_t)256 * DM, DM, id);
    }
    moe_weights(c, 0);
    cvt_rows(c, p.in[0], (bf16_t*)(ws + WS_XA), (size_t)NT * DM);
    cvt_rows(c, p.in[1], (bf16_t*)(ws + WS_MEMB), (size_t)NMEM * DM);
    for (int i = c.gw * 64 + c.lane; i < 256 * 64; i += c.ngw * 64) {
        const int n = i >> 6, m = i & 63; float v = 0.f;
        if (n < NCMP) { const int ov = min(16 * n + 32, 64 * m + 64) - max(16 * n, 64 * m); v = (ov > 0) ? (float)ov * (1.f / 32.f) : 0.f; }
        ((bf16_t*)(ws + WS_MSEL))[i] = (bf16_t)f2bf(v);
    }
    for (int i = c.gw * 64 + c.lane; i < 2 * 16 * 64; i += c.ngw * 64) { const int kv = i >> 10, bg = (i >> 6) & 15, d = i & 63; ((bf16_t*)(ws + (kv ? WS_VCMP : WS_KCMP)))[(size_t)(bg * 256 + 255) * 64 + d] = 0; }
    for (int it = c.gw; it < 512; it += c.ngw) {
        const int kv = it >> 8, col = it & 255;
        const float* pe = p.in[kv ? 12 : 9]; const float* w1 = p.in[kv ? 13 : 10];
        float s = 0.f;
        for (int kk = c.lane; kk < 2048; kk += 64) s += pe[kk] * w1[(size_t)kk * 256 + col];
        s = wsum(s);
        if (c.lane == 0) ((float*)(ws + WS_CMPB))[it] = s;
    }
}

struct EpiStoreBf16 { bf16_t* C; int ldc; DEV void operator()(int m, int n, f32x4 v) const { st4bf(C + (size_t)m * ldc + n, v.x, v.y, v.z, v.w); } };
struct EpiStoreF32 { float* C; int ldc; DEV void operator()(int m, int n, f32x4 v) const { *(f32x4*)(C + (size_t)m * ldc + n) = v; } };
struct EpiResF32 { float* Z; const float* res; DEV void operator()(int m, int n, f32x4 v) const { const f32x4 r = *(const f32x4*)(res + (size_t)m * DM + n); *(f32x4*)(Z + (size_t)m * DM + n) = r * DN_ALPHA + v; } };
struct EpiResBf16 { float* Z; const bf16_t* res; DEV void operator()(int m, int n, f32x4 v) const { float r[4]; ld4bf(res + (size_t)m * DM + n, r); *(f32x4*)(Z + (size_t)m * DM + n) = (f32x4){r[0] * DN_ALPHA + v.x, r[1] * DN_ALPHA + v.y, r[2] * DN_ALPHA + v.z, r[3] * DN_ALPHA + v.w}; } };

struct ARowPlain { const bf16_t* A; int lda; DEV const bf16_t* operator()(int m, int k0) const { return A + (size_t)m * lda + k0; } };
struct BRowPlain { const bf16_t* B; int ldb; DEV const bf16_t* operator()(int n, int) const { return B + (size_t)n * ldb; } };

DEV void conv_branch(const Ctx& c) {
    const Params& p = *c.p;
    const bf16_t* Y0 = (const bf16_t*)(c.ws + SC_Y0); bf16_t* CAT = (bf16_t*)(c.ws + SC_CAT);
    const float* cw = p.in[5]; const float* cb = p.in[6]; const float* g = p.in[7]; const float* bb = p.in[8];
    for (int row = c.gw; row < NT; row += c.ngw) {
        const int t = row & (SEQ - 1);
        float acc[8];
#pragma unroll
        for (int i = 0; i < 8; ++i) acc[i] = cb[c.lane + 64 * i];
        const int kmin = (t >= 30) ? 0 : 30 - t;
        for (int k = kmin; k < 31; ++k) {
            const bf16_t* yr = Y0 + (size_t)(row - 30 + k) * EINP;
#pragma unroll
            for (int i = 0; i < 8; ++i) { const int ch = c.lane + 64 * i; const float a = bf2f(yr[C_AV + ch]) * sigmoidf_(bf2f(yr[C_AG + ch])); acc[i] += cw[k * 512 + ch] * a; }
        }
        float s = 0.f;
#pragma unroll
        for (int i = 0; i < 8; ++i) s += acc[i];
        const float mean = wsum(s) * (1.f / 512.f);
        float s2 = 0.f;
#pragma unroll
        for (int i = 0; i < 8; ++i) { acc[i] -= mean; s2 += acc[i] * acc[i]; }
        const float rstd = rsqrtf(wsum(s2) * (1.f / 512.f) + LN_EPS);
#pragma unroll
        for (int i = 0; i < 8; ++i) { const int ch = c.lane + 64 * i; const float y = acc[i] * rstd * g[ch] + bb[ch]; CAT[(size_t)row * DM + ch] = (bf16_t)f2bf(siluf_(y)); }
    }
}
struct ARowCmp { const bf16_t* Y0; int coff; DEV const bf16_t* operator()(int m, int k0) const { const int g = m & 1, bj = m >> 1; return Y0 + ((size_t)bj * 16 + (k0 >> 6)) * EINP + coff + g * 64 + (k0 & 63); } };
DEV void cmp_gemm(const Ctx& c) {
    const bf16_t* Y0 = (const bf16_t*)(c.ws + SC_Y0);
    for (int kv = 0; kv < 2; ++kv) {
        ARowCmp af{Y0, kv ? C_VC : C_KC}; BRowPlain bf{(const bf16_t*)(c.ws + WS_CW1) + (size_t)kv * 512 * DM, DM};
        EpiStoreF32 ef{(float*)(c.ws + (kv ? WS_PV : WS_PK)), 512};
        ngemm(c, 4096 / 64, 512 / 64, 1024, af, bf, ef);
    }
}
DEV void cmp_finish(const Ctx& c) {
    const Params& p = *c.p;
    float* hid = c.lds + c.wave * 256;
    for (int it = c.gw; it < 2 * NB * NCMP * 2; it += c.ngw) {
        const int kv = it / (NB * NCMP * 2), r = it % (NB * NCMP * 2), g = r & 1, bn = r >> 1, b = bn / NCMP, n = bn % NCMP;
        const float* P = (const float*)(c.ws + (kv ? WS_PV : WS_PK));
        const float* cbias = (const float*)(c.ws + WS_CMPB) + kv * 256;
        const float* w2 = p.in[kv ? 14 : 11];
        const int r0 = (b * 256 + n) * 2 + g, r1 = (b * 256 + n + 1) * 2 + g;
#pragma unroll
        for (int i = 0; i < 4; ++i) { const int cc = c.lane + 64 * i; hid[cc] = gelu_tanh(P[(size_t)r0 * 512 + cc] + P[(size_t)r1 * 512 + 256 + cc] + cbias[cc]); }
        LDS_WAIT();
        float o = 0.f;
        for (int cc = 0; cc < 256; ++cc) o += hid[cc] * w2[cc * 64 + c.lane];
        ((bf16_t*)(c.ws + (kv ? WS_VCMP : WS_KCMP)))[(size_t)((b * 2 + g) * 256 + n) * 64 + c.lane] = (bf16_t)f2bf(o);
        LDS_WAIT();
    }
}

DEV void nsa_naive(const Ctx& c) {
    const bf16_t* Y0 = (const bf16_t*)(c.ws + SC_Y0); bf16_t* CAT = (bf16_t*)(c.ws + SC_CAT);
    const float* KC = (const float*)(c.ws + WS_KCMP); const float* VC = (const float*)(c.ws + WS_VCMP);
    float* pc = c.lds + c.wave * 1024;
    const int hh = c.lane >> 4, dq = c.lane & 15;
    for (int it = c.gw; it < NT * 2; it += c.ngw) {
        const int g = it & 1, row = it >> 1, b = row >> 12, t = row & (SEQ - 1);
        const int h = g * 4 + hh;
        const bf16_t* yrow = Y0 + (size_t)row * EINP;
        float q[4]; ld4bf(yrow + C_Q + h * 64 + dq * 4, q);
#pragma unroll
        for (int i = 0; i < 4; ++i) q[i] *= 0.125f;
        const int ncv = (t >= 31) ? min(NCMP, (t - 31) / 16 + 1) : 0;
        float oc[4] = {0.f, 0.f, 0.f, 0.f};
        float mx = -INFINITY;
        for (int n = 0; n < ncv; ++n) {
            const f32x4 k4 = *(const f32x4*)(KC + (size_t)((b * NCMP + n) * 2 + g) * 64 + dq * 4);
            float s = q[0] * k4.x + q[1] * k4.y + q[2] * k4.z + q[3] * k4.w; s = gsum16(s);
            if (dq == 0) pc[hh * 256 + n] = s;
            mx = fmaxf(mx, s);
        }
        LDS_WAIT();
        float l = 0.f;
        for (int n = 0; n < ncv; ++n) l += __expf(pc[hh * 256 + n] - mx);
        const float inv = (ncv > 0) ? 1.f / l : 0.f;
        for (int n = 0; n < ncv; ++n) {
            const float pr = __expf(pc[hh * 256 + n] - mx) * inv;
            const f32x4 v4 = *(const f32x4*)(VC + (size_t)((b * NCMP + n) * 2 + g) * 64 + dq * 4);
            oc[0] += pr * v4.x; oc[1] += pr * v4.y; oc[2] += pr * v4.z; oc[3] += pr * v4.w;
            LDS_WAIT();
            if (dq == 0) pc[hh * 256 + n] = pr;
        }
        LDS_WAIT();
        const int m = c.lane, cur = t >> 6;
        float imp = 0.f;
#pragma unroll
        for (int h2 = 0; h2 < 4; ++h2)
#pragma unroll
            for (int dn = -1; dn <= 3; ++dn) { const int n = 4 * m + dn; if (n >= 0 && n < ncv) imp += pc[h2 * 256 + n] * ((dn == -1 || dn == 3) ? 0.5f : 1.f); }
        const bool causal = m <= cur, forced = (m == 0) || (m == cur) || (m == cur - 1);
        const float score = causal ? (forced ? 1e4f : imp) : -1e30f;
        int rank = 0;
        for (int m2 = 0; m2 < 64; ++m2) { const float s2 = __shfl(score, m2); rank += ((s2 > score) || (s2 == score && m2 < m)) ? 1 : 0; }
        unsigned long long selmask = __ballot(causal && rank < 16);
        LDS_WAIT();
        float ms = -INFINITY, ls = 0.f, os[4] = {0.f, 0.f, 0.f, 0.f};
        while (selmask) {
            const int mb = __builtin_ctzll(selmask); selmask &= selmask - 1;
            const int jmax = min(63, t - 64 * mb);
            const bf16_t* kb = Y0 + (size_t)(b * SEQ + 64 * mb) * EINP + g * 64 + dq * 4;
            for (int j = 0; j <= jmax; ++j) {
                float k4[4], v4[4]; ld4bf(kb + (size_t)j * EINP + C_KS, k4); ld4bf(kb + (size_t)j * EINP + C_VS, v4);
                float s = q[0] * k4[0] + q[1] * k4[1] + q[2] * k4[2] + q[3] * k4[3]; s = gsum16(s);
                const float mn = fmaxf(ms, s), cf = __expf(ms - mn), pp = __expf(s - mn);
                ls = ls * cf + pp;
#pragma unroll
                for (int i = 0; i < 4; ++i) os[i] = os[i] * cf + pp * v4[i];
                ms = mn;
            }
        }
        float mw = -INFINITY, lw = 0.f, ow[4] = {0.f, 0.f, 0.f, 0.f};
        {
            const int k0 = max(0, t - 511);
            const bf16_t* kb = Y0 + (size_t)(b * SEQ) * EINP + g * 64 + dq * 4;
            for (int kp = k0; kp <= t; ++kp) {
                float k4[4], v4[4]; ld4bf(kb + (size_t)kp * EINP + C_KW, k4); ld4bf(kb + (size_t)kp * EINP + C_VW, v4);
                float s = q[0] * k4[0] + q[1] * k4[1] + q[2] * k4[2] + q[3] * k4[3]; s = gsum16(s);
                const float mn = fmaxf(mw, s), cf = __expf(mw - mn), pp = __expf(s - mn);
                lw = lw * cf + pp;
#pragma unroll
                for (int i = 0; i < 4; ++i) ow[i] = ow[i] * cf + pp * v4[i];
                mw = mn;
            }
        }
        const float gc = sigmoidf_(bf2f(yrow[C_GL + h * 3 + 0])), gs = sigmoidf_(bf2f(yrow[C_GL + h * 3 + 1])) / ls, gwn = sigmoidf_(bf2f(yrow[C_GL + h * 3 + 2])) / lw;
        st4bf(CAT + (size_t)row * DM + 512 + h * 64 + dq * 4, gc * oc[0] + gs * os[0] + gwn * ow[0], gc * oc[1] + gs * os[1] + gwn * ow[1], gc * oc[2] + gs * os[2] + gwn * ow[2], gc * oc[3] + gs * os[3] + gwn * ow[3]);
    }
}

namespace nsa {
typedef float f32x16 __attribute__((ext_vector_type(16)));
typedef short s16x4 __attribute__((ext_vector_type(4)));
typedef __attribute__((address_space(3))) unsigned char lds_u8;
constexpr int SLOT = 8192, NSLOT = 3;
constexpr int L_K = 0, L_V = NSLOT * SLOT, L_IMP = 2 * NSLOT * SLOT  , L_SEL = L_IMP + 65536  ;
constexpr float NEGB = -1e30f;
DEV int crow(int r, int hi) { return (r & 3) + 8 * (r >> 2) + 4 * hi; }
DEV s16x4 vtr(const lds_u8* p) { typedef short v4i16_t __attribute__((ext_vector_type(4))); return __builtin_bit_cast(s16x4, __builtin_amdgcn_ds_read_tr16_b64_v4i16((__attribute__((address_space(3))) v4i16_t*)p)); }
DEV unsigned cvtpk(float lo, float hi) { typedef float f2 __attribute__((ext_vector_type(2))); typedef __bf16 b2 __attribute__((ext_vector_type(2))); f2 v = {lo, hi}; b2 b = __builtin_convertvector(v, b2); return __builtin_bit_cast(unsigned, b); }
DEV void glds16(const void* gsrc, unsigned lds_dst) { unsigned keep;
    asm volatile("s_mov_b32 %0, m0\n\ts_mov_b32 m0, %2\n\ts_nop 0\n\tglobal_load_lds_dwordx4 %1, off\n\ts_mov_b32 m0, %0" : "=&s"(keep) : "v"(gsrc), "s"(lds_dst) : "memory"); }
#define NSA_WAITV(n) asm volatile("s_waitcnt vmcnt(" #n ")" ::: "memory")
#define NSA_BAR() do { asm volatile("s_waitcnt lgkmcnt(0)" ::: "memory"); __builtin_amdgcn_s_barrier(); asm volatile("" ::: "memory"); } while (0)

DEV void flash_pass(lds_u8* lds, const bf16_t* Kg, int pk, const bf16_t* Vg, int pv, int t0, int nt, const bf16x8 (&qr)[4],
                    int lo, int hi_b, unsigned long long rowmask, int lo_max, int hi_min, f32x16 (&o)[2], float& l_out) {
    const int tid = threadIdx.x, lane = tid & 63, r32 = lane & 31, hi = lane >> 5; const int wid = __builtin_amdgcn_readfirstlane(tid >> 6);
    o[0] = f32x16{}; o[1] = f32x16{}; float l = 0.f, mhat = 0.f;
    if (nt <= 0) { l_out = 0.f; return; }
    const bf16_t* ksrc = Kg + (size_t)(t0 * 64 + lane) * pk + wid * 8;
    const bf16_t* vsrc = Vg + (size_t)(t0 * 64 + 16 * (wid & 3) + (lane >> 2)) * pv + (wid >> 2) * 32 + (lane & 3) * 8;
    const size_t kstep = (size_t)64 * pk, vstep = (size_t)64 * pv;
    const unsigned lds0 = (unsigned)(uintptr_t)lds;
#define NSA_DMA(t, slot) do { glds16(ksrc + (size_t)(t) * kstep, (unsigned)__builtin_amdgcn_readfirstlane(lds0 + L_K + (slot) * SLOT + wid * 1024)); \
                               glds16(vsrc + (size_t)(t) * vstep, (unsigned)__builtin_amdgcn_readfirstlane(lds0 + L_V + (slot) * SLOT + wid * 1024)); } while (0)
    const lds_u8* kp0 = lds + L_K + hi * 1024 + r32 * 16;
    const lds_u8* vp0 = lds + L_V + ((lane >> 4) & 1) * 32 + (lane & 3) * 8 + (4 * hi + ((lane & 15) >> 2)) * 64;
    NSA_DMA(0, 0);
    if (nt > 1) NSA_DMA(1, 1);
    int slot = 0;
    for (int t = 0; t < nt; ++t) {
        if (t + 1 < nt) NSA_WAITV(2); else NSA_WAITV(0);
        NSA_BAR();
        if (t + 2 < nt) { const int s2 = (slot >= 1) ? slot - 1 : 2; NSA_DMA(t + 2, s2); }
        const int gt = t0 + t;
        const bool rowok = (rowmask >> gt) & 1ull;
        const float ci = rowok ? -mhat : NEGB;
        f32x16 c0, c1;
#pragma unroll
        for (int r = 0; r < 16; ++r) { c0[r] = ci; c1[r] = ci; }
        const lds_u8* kp = kp0 + slot * SLOT;
#pragma unroll
        for (int d0 = 0; d0 < 4; ++d0) {
            const bf16x8 k0 = *(const __attribute__((address_space(3))) bf16x8*)(kp + d0 * 2048);
            const bf16x8 k1 = *(const __attribute__((address_space(3))) bf16x8*)(kp + d0 * 2048 + 512);
            c0 = __builtin_amdgcn_mfma_f32_32x32x16_bf16(k0, qr[d0], c0, 0, 0, 0);
            c1 = __builtin_amdgcn_mfma_f32_32x32x16_bf16(k1, qr[d0], c1, 0, 0, 0);
        }
        if ((64 * gt + 63 > hi_min) || (64 * gt <= lo_max)) {
            const int kb = 64 * gt + 4 * hi;
#pragma unroll
            for (int r = 0; r < 16; ++r) { const int kv = kb + (r & 3) + 8 * (r >> 2);
                if (!(kv > lo && kv <= hi_b)) c0[r] = NEGB;
                if (!(kv + 32 > lo && kv + 32 <= hi_b)) c1[r] = NEGB; }
        }
        float rm = fmaxf(c0[0], c1[0]);
#pragma unroll
        for (int r = 1; r < 16; ++r) rm = fmaxf(rm, fmaxf(c0[r], c1[r]));
        { auto rr = __builtin_amdgcn_permlane32_swap(__float_as_uint(rm), __float_as_uint(rm), false, false); rm = fmaxf(__uint_as_float(rr[0]), __uint_as_float(rr[1])); }
        if (__any(rm > 6.0f)) {
            const float dl = fmaxf(rm, 0.f), f = __builtin_amdgcn_exp2f(-dl);
            mhat += dl; l *= f;
#pragma unroll
            for (int r = 0; r < 16; ++r) { c0[r] -= dl; c1[r] -= dl; o[0][r] *= f; o[1][r] *= f; }
        }
        float ps = 0.f;
#pragma unroll
        for (int r = 0; r < 16; ++r) { c0[r] = __builtin_amdgcn_exp2f(c0[r]); c1[r] = __builtin_amdgcn_exp2f(c1[r]); ps += c0[r] + c1[r]; }
        l += ps;
        u32x4 pw[4];
#pragma unroll
        for (int s = 0; s < 2; ++s)
#pragma unroll
            for (int j = 0; j < 4; ++j) { pw[s][j] = cvtpk(c0[8 * s + 2 * j], c0[8 * s + 2 * j + 1]); pw[2 + s][j] = cvtpk(c1[8 * s + 2 * j], c1[8 * s + 2 * j + 1]); }
        const lds_u8* vp = vp0 + slot * SLOT;
#pragma unroll
        for (int dh = 0; dh < 2; ++dh)
#pragma unroll
            for (int ks = 0; ks < 4; ++ks) {
                const s16x4 vl = vtr(vp + dh * 4096 + ks * 1024), vh = vtr(vp + dh * 4096 + ks * 1024 + 512);
                const bf16x8 vf = (bf16x8){vl[0], vl[1], vl[2], vl[3], vh[0], vh[1], vh[2], vh[3]};
                o[dh] = __builtin_amdgcn_mfma_f32_32x32x16_bf16(vf, __builtin_bit_cast(bf16x8, pw[ks]), o[dh], 0, 0, 0);
            }
        slot = (slot == 2) ? 0 : slot + 1;
    }
    NSA_BAR();
    { auto rr = __builtin_amdgcn_permlane32_swap(__float_as_uint(l), __float_as_uint(l), false, false); l = __uint_as_float(rr[0]) + __uint_as_float(rr[1]); }
    l_out = l;
#undef NSA_DMA
}

DEV void nsa_unit(lds_u8* lds, unsigned char* ws, int b, int g, int qt) {
    const int tid = threadIdx.x, lane = tid & 63, r32 = lane & 31, hi = lane >> 5; const int wid = __builtin_amdgcn_readfirstlane(tid >> 6);
    const int hh = wid >> 1, h = 4 * g + hh, ql = 32 * (wid & 1) + r32, t = 64 * qt + ql;
    const bf16_t* Y0 = (const bf16_t*)(ws + SC_Y0);
    const bf16_t* yrow = Y0 + (size_t)(b * SEQ + t) * EINP;
    bf16x8 qr[4];
#pragma unroll
    for (int d0 = 0; d0 < 4; ++d0) qr[d0] = *(const bf16x8*)(yrow + C_Q + h * 64 + d0 * 16 + hi * 8);
#pragma unroll
    for (int d0 = 0; d0 < 4; ++d0) asm volatile("" : "+v"(qr[d0]));
    const float g_c = sigmoidf_(bf2f(yrow[C_GL + h * 3 + 0])), g_s = sigmoidf_(bf2f(yrow[C_GL + h * 3 + 1])), g_w = sigmoidf_(bf2f(yrow[C_GL + h * 3 + 2]));
    const bf16_t* Ybg = Y0 + (size_t)(b * SEQ) * EINP + g * 64;
    f32x16 acc[2], o[2]; float l;
    const int nmax = (t >= 31) ? (t - 31) >> 4 : -1;
    const int tmaxu = 64 * qt + 63, nmax_u = (tmaxu - 31) >> 4, nct = (nmax_u >> 6) + 1;
    const int nmin_u = (64 * qt >= 31) ? (64 * qt - 31) >> 4 : -1;
    const bf16_t* KC = (const bf16_t*)(ws + WS_KCMP) + (size_t)(b * 2 + g) * 256 * 64;
    const bf16_t* VC = (const bf16_t*)(ws + WS_VCMP) + (size_t)(b * 2 + g) * 256 * 64;
    const bf16_t* MS = (const bf16_t*)(ws + WS_MSEL);
    flash_pass(lds, KC, 64, VC, 64, 0, nct, qr, -1, nmax, ~0ull, -1, nmin_u, o, l);
    { const float sc = (l > 0.f) ? g_c / l : 0.f;
#pragma unroll
      for (int dh = 0; dh < 2; ++dh)
#pragma unroll
          for (int r = 0; r < 16; ++r) acc[dh][r] = o[dh][r] * sc; }
    flash_pass(lds, KC, 64, MS, 64, 0, nct, qr, -1, nmax, ~0ull, -1, nmin_u, o, l);
    { const float sc = (l > 0.f) ? 1.f / l : 0.f;
      __attribute__((address_space(3))) float* imp = (__attribute__((address_space(3))) float*)(lds + L_IMP) + (hh * 64 + ql) * 64;
#pragma unroll
      for (int dh = 0; dh < 2; ++dh)
#pragma unroll
          for (int r = 0; r < 16; ++r) imp[32 * dh + crow(r, hi)] = o[dh][r] * sc; }
    NSA_BAR();
    {
        __attribute__((address_space(3))) const float* impb = (__attribute__((address_space(3))) const float*)(lds + L_IMP);
        __attribute__((address_space(3))) unsigned long long* selp = (__attribute__((address_space(3))) unsigned long long*)(lds + L_SEL);
        const int m = lane, cur = qt;
        for (int qq = 8 * wid; qq < 8 * wid + 8; ++qq) {
            unsigned long long sel;
            if (cur < 16) sel = (2ull << cur) - 1ull;
            else {
                const float iv = ((impb[(0 * 64 + qq) * 64 + m] + impb[(1 * 64 + qq) * 64 + m]) + impb[(2 * 64 + qq) * 64 + m]) + impb[(3 * 64 + qq) * 64 + m];
                const bool cand = (m >= 1) && (m <= cur - 2);
                const unsigned bits = __float_as_uint(fmaxf(iv, 0.f));
                unsigned T = 0u;
                for (int bit = 30; bit >= 0; --bit) { const unsigned trial = T | (1u << bit); if (__popcll(__ballot(cand && bits >= trial)) >= 13) T = trial; }
                const unsigned long long gtm = __ballot(cand && bits > T); unsigned long long eqm = __ballot(cand && bits == T);
                int need = 13 - __popcll(gtm); unsigned long long tie = 0ull;
                while (need > 0 && eqm) { const unsigned long long lowb = eqm & (~eqm + 1ull); tie |= lowb; eqm ^= lowb; --need; }
                sel = gtm | tie | 1ull | (1ull << cur) | (1ull << (cur - 1));
            }
            if (lane == 0) selp[qq] = sel;
        }
    }
    NSA_BAR();
    const unsigned long long selmask = ((__attribute__((address_space(3))) const unsigned long long*)(lds + L_SEL))[ql];
    flash_pass(lds, Ybg + C_KS, EINP, Ybg + C_VS, EINP, 0, qt + 1, qr, -1, t, selmask, -1, 64 * qt, o, l);
    { const float sc = g_s / l;
#pragma unroll
      for (int dh = 0; dh < 2; ++dh)
#pragma unroll
          for (int r = 0; r < 16; ++r) acc[dh][r] += o[dh][r] * sc; }
    { const int wt0 = (qt >= 8) ? qt - 8 : 0;
      flash_pass(lds, Ybg + C_KW, EINP, Ybg + C_VW, EINP, wt0, qt - wt0 + 1, qr, t - 512, t, ~0ull, 64 * qt + 63 - 512, 64 * qt, o, l);
      const float sc = g_w / l;
#pragma unroll
      for (int dh = 0; dh < 2; ++dh)
#pragma unroll
          for (int r = 0; r < 16; ++r) acc[dh][r] += o[dh][r] * sc; }
    bf16_t* orow = (bf16_t*)(ws + SC_CAT) + (size_t)(b * SEQ + t) * DM + 512 + h * 64;
#pragma unroll
    for (int dh = 0; dh < 2; ++dh)
#pragma unroll
        for (int j = 0; j < 4; ++j) { u32x2 w; w.x = cvtpk(acc[dh][4 * j], acc[dh][4 * j + 1]); w.y = cvtpk(acc[dh][4 * j + 2], acc[dh][4 * j + 3]); *(u32x2*)(orow + 32 * dh + 8 * j + 4 * hi) = w; }
    NSA_WAITV(0);
}
DEV void nsa_phase(unsigned char* lds_raw, unsigned char* ws) {
    lds_u8* lds = (lds_u8*)lds_raw;
    const int G = gridDim.x, bx = blockIdx.x;
    const int vcu = (G % 8 == 0) ? (bx % 8) * (G / 8) + bx / 8 : bx;
    for (int p = vcu; p < 512; p += G) {
        const int bg = p >> 5, s = p & 31;
        nsa_unit(lds, ws, bg >> 1, bg & 1, 63 - s);
        nsa_unit(lds, ws, bg >> 1, bg & 1, s);
    }
}
#undef NSA_WAITV
#undef NSA_BAR
}

template <bool ROUTER>
DEV void ln_pass(const Ctx& c, const float* Z, const float* g, const float* b, bf16_t* X, int layer) {
    const Params& p = *c.p;
    const float* wg = p.in[25] + (size_t)layer * DM * 4; const float* bg = p.in[26] + layer * 4;
    const float* we = p.in[27] + (size_t)layer * DM * 32; const float* be = p.in[28] + layer * 32;
    int* cnt = (int*)(c.ws + WS_CTL) + layer * 32; int* list = (int*)(c.ws + WS_LIST); float* gate = (float*)(c.ws + WS_GATE);
    for (int row = c.gw; row < NT; row += c.ngw) {
        f32x4 v[4]; float s = 0.f;
#pragma unroll
        for (int j = 0; j < 4; ++j) { v[j] = *(const f32x4*)(Z + (size_t)row * DM + 256 * j + 4 * c.lane); s += (v[j].x + v[j].y) + (v[j].z + v[j].w); }
        const float mean = wsum(s) * (1.f / DM); float s2 = 0.f;
#pragma unroll
        for (int j = 0; j < 4; ++j) { v[j] = v[j] - mean; s2 += (v[j].x * v[j].x + v[j].y * v[j].y) + (v[j].z * v[j].z + v[j].w * v[j].w); }
        const float rstd = rsqrtf(wsum(s2) * (1.f / DM) + LN_EPS);
#pragma unroll
        for (int j = 0; j < 4; ++j) {
            const f32x4 gg = *(const f32x4*)(g + 256 * j + 4 * c.lane), bb = *(const f32x4*)(b + 256 * j + 4 * c.lane);
            v[j] = v[j] * rstd * gg + bb;
            st4bf(X + (size_t)row * DM + 256 * j + 4 * c.lane, v[j].x, v[j].y, v[j].z, v[j].w);
        }
        if (ROUTER) {
            float* xs = c.lds + c.wave * 1024;
#pragma unroll
            for (int j = 0; j < 4; ++j) *(f32x4*)(xs + 256 * j + 4 * c.lane) = v[j];
            LDS_WAIT();
            float lgt = 0.f;
            if (c.lane < 36) {
                const int o = c.lane;
                const float* wp = (o < 4) ? (wg + o) : (we + (o - 4));
                const int st = (o < 4) ? 4 : 32;
#pragma unroll 8
                for (int k = 0; k < DM; ++k) lgt += xs[k] * wp[(size_t)k * st];
                lgt += (o < 4) ? bg[o] : be[o - 4];
            }
            LDS_WAIT();
            float gl[4]; int gs = 0;
#pragma unroll
            for (int o = 0; o < 4; ++o) gl[o] = __shfl(lgt, o);
            float gm = gl[0];
#pragma unroll
            for (int o = 1; o < 4; ++o) if (gl[o] > gm) { gm = gl[o]; gs = o; }
            float den = 0.f;
#pragma unroll
            for (int o = 0; o < 4; ++o) den += __expf(gl[o] - gm);
            const float pgroup = 1.f / den;
            float el[8];
#pragma unroll
            for (int o = 0; o < 8; ++o) el[o] = __shfl(lgt, 4 + gs * 8 + o);
            int i0 = 0; float v0 = el[0];
#pragma unroll
            for (int o = 1; o < 8; ++o) if (el[o] > v0) { v0 = el[o]; i0 = o; }
            int i1 = -1; float v1 = -INFINITY;
#pragma unroll
            for (int o = 0; o < 8; ++o) if (o != i0 && el[o] > v1) { v1 = el[o]; i1 = o; }
            const float e1 = __expf(v1 - v0), g0 = pgroup / (1.f + e1), g1 = pgroup * e1 / (1.f + e1);
            if (c.lane < 2) {
                const int ex = gs * 8 + (c.lane == 0 ? i0 : i1);
                const int pos = atomicAdd(cnt + ex, 1);
                list[ex * LCAP + pos] = row * 2 + c.lane;
                gate[row * 2 + c.lane] = (c.lane == 0) ? g0 : g1;
            }
        }
    }
}

DEV void xattn_naive(const Ctx& c) {
    const bf16_t* Q = (const bf16_t*)(c.ws + SC_Q); bf16_t* CTXo = (bf16_t*)(c.ws + SC_CTX);
    const bf16_t* MK = (const bf16_t*)(c.ws + WS_MEMK); const bf16_t* MV = (const bf16_t*)(c.ws + WS_MEMV);
    for (int it = c.gw; it < NT * 4; it += c.ngw) {
        const int h = it & 3, row = it >> 2, b = row >> 12;
        float q[4]; ld4bf(Q + (size_t)row * DM + h * 256 + 4 * c.lane, q);
#pragma unroll
        for (int i = 0; i < 4; ++i) q[i] *= 0.0625f;
        float ms = -INFINITY, ls = 0.f, o[4] = {0.f, 0.f, 0.f, 0.f};
        for (int m = 0; m < MEML; ++m) {
            float k4[4], v4[4]; ld4bf(MK + (size_t)(b * MEML + m) * DM + h * 256 + 4 * c.lane, k4); ld4bf(MV + (size_t)(b * MEML + m) * DM + h * 256 + 4 * c.lane, v4);
            float s = q[0] * k4[0] + q[1] * k4[1] + q[2] * k4[2] + q[3] * k4[3]; s = wsum(s);
            const float mn = fmaxf(ms, s), cf = __expf(ms - mn), pp = __expf(s - mn);
            ls = ls * cf + pp;
#pragma unroll
            for (int i = 0; i < 4; ++i) o[i] = o[i] * cf + pp * v4[i];
            ms = mn;
        }
        const float inv = 1.f / ls;
        st4bf(CTXo + (size_t)row * DM + h * 256 + 4 * c.lane, o[0] * inv, o[1] * inv, o[2] * inv, o[3] * inv);
    }
}

DEV int moe_nblk(const int* cnt) { int nb = 0; for (int e = 0; e < NEXP; ++e) nb += (cnt[e] + 255) >> 8; return nb; }
DEV void moe_find(const int* cnt, int pr, int& e, int& r) { int base = 0; e = 0; r = 0; for (int x = 0; x < NEXP; ++x) { const int nb = (cnt[x] + 255) >> 8; if (pr < (base + nb) * 256) { e = x; r = pr - base * 256; return; } base += nb; } e = NEXP - 1; r = 1 << 30; }
DEV void moe_gemm1(const Ctx& c, const bf16_t* X, int layer) {
    const int* cnt = (const int*)(c.ws + WS_CTL) + layer * 32; const int* list = (const int*)(c.ws + WS_LIST);
    const bf16_t* W13 = (const bf16_t*)(c.ws + WS_W13); bf16_t* H = (bf16_t*)(c.ws + SC_H);
    const int nblk = moe_nblk(cnt), mtiles = nblk * 4, ntiles = EH / 32;
    const int fr = c.lane & 15, fq = c.lane >> 4;
    for (int it = c.gw; it < mtiles * ntiles; it += c.ngw) {
        const int mt = it / ntiles, nt = it % ntiles;
        int e, r0; moe_find(cnt, mt * 64, e, r0);
        const int ce = cnt[e];
        const bf16_t* ap[4];
#pragma unroll
        for (int i = 0; i < 4; ++i) { const int r = r0 + i * 16 + fr; const int tok = (r < ce) ? (list[e * LCAP + r] >> 1) : 0; ap[i] = X + (size_t)tok * DM + fq * 8; }
        const bf16_t* b1[2]; const bf16_t* b3[2];
#pragma unroll
        for (int j = 0; j < 2; ++j) { const int n = nt * 32 + j * 16 + fr; b1[j] = W13 + (size_t)e * DM * DM + (size_t)((n >> 7) * 256 + (n & 127)) * DM + fq * 8; b3[j] = b1[j] + (size_t)128 * DM; }
        f32x4 a1[4][2], a3[4][2];
#pragma unroll
        for (int i = 0; i < 4; ++i)
#pragma unroll
            for (int j = 0; j < 2; ++j) { a1[i][j] = (f32x4){0.f, 0.f, 0.f, 0.f}; a3[i][j] = (f32x4){0.f, 0.f, 0.f, 0.f}; }
        for (int k0 = 0; k0 < DM; k0 += 32) {
            bf16x8 a[4], w1[2], w3[2];
#pragma unroll
            for (int i = 0; i < 4; ++i) a[i] = *(const bf16x8*)(ap[i] + k0);
#pragma unroll
            for (int j = 0; j < 2; ++j) { w1[j] = *(const bf16x8*)(b1[j] + k0); w3[j] = *(const bf16x8*)(b3[j] + k0); }
#pragma unroll
            for (int i = 0; i < 4; ++i)
#pragma unroll
                for (int j = 0; j < 2; ++j) { a1[i][j] = __builtin_amdgcn_mfma_f32_16x16x32_bf16(w1[j], a[i], a1[i][j], 0, 0, 0); a3[i][j] = __builtin_amdgcn_mfma_f32_16x16x32_bf16(w3[j], a[i], a3[i][j], 0, 0, 0); }
        }
#pragma unroll
        for (int i = 0; i < 4; ++i)
#pragma unroll
            for (int j = 0; j < 2; ++j) {
                const int pr = mt * 64 + i * 16 + fr, n = nt * 32 + j * 16 + 4 * fq;
                const f32x4 x1 = a1[i][j], x3 = a3[i][j];
                st4bf(H + (size_t)pr * EH + n, siluf_(x1.x) * x3.x, siluf_(x1.y) * x3.y, siluf_(x1.z) * x3.z, siluf_(x1.w) * x3.w);
            }
    }
}
struct BRowMoe2 { const bf16_t* W2; const int* cnt; DEV const bf16_t* operator()(int n, int mt) const { int e, r; moe_find(cnt, mt * 64, e, r); return W2 + (size_t)e * DM * EH + (size_t)n * EH; } };
struct EpiMoe2 { bf16_t* Y; const int* cnt; const int* list; const float* gate;
    DEV void operator()(int m, int n, f32x4 v) const { int e, r; moe_find(cnt, m, e, r); if (r < cnt[e]) { const int aid = list[e * LCAP + r]; const float gt = gate[aid]; st4bf(Y + (size_t)aid * DM + n, v.x * gt, v.y * gt, v.z * gt, v.w * gt); } } };
DEV void moe_gemm2(const Ctx& c, int layer) {
    const int* cnt = (const int*)(c.ws + WS_CTL) + layer * 32;
    const int nblk = moe_nblk(cnt);
    ARowPlain af{(const bf16_t*)(c.ws + SC_H), EH}; BRowMoe2 bf{(const bf16_t*)(c.ws + WS_W2), cnt};
    EpiMoe2 ef{(bf16_t*)(c.ws + SC_Y), cnt, (const int*)(c.ws + WS_LIST), (const float*)(c.ws + WS_GATE)};
    ngemm(c, nblk * 4, DM / 64, EH, af, bf, ef);
}
DEV void moe_combine(const Ctx& c, const bf16_t* Xin, const float* g, const float* b, bf16_t* Xo, float* outf) {
    const bf16_t* Y = (const bf16_t*)(c.ws + SC_Y);
    for (int row = c.gw; row < NT; row += c.ngw) {
        f32x4 v[4]; float s = 0.f;
#pragma unroll
        for (int j = 0; j < 4; ++j) {
            float x[4], y0[4], y1[4]; const int col = 256 * j + 4 * c.lane;
            ld4bf(Xin + (size_t)row * DM + col, x); ld4bf(Y + (size_t)(2 * row) * DM + col, y0); ld4bf(Y + (size_t)(2 * row + 1) * DM + col, y1);
            v[j] = (f32x4){x[0] * DN_ALPHA + (y0[0] + y1[0]), x[1] * DN_ALPHA + (y0[1] + y1[1]), x[2] * DN_ALPHA + (y0[2] + y1[2]), x[3] * DN_ALPHA + (y0[3] + y1[3])};
            s += (v[j].x + v[j].y) + (v[j].z + v[j].w);
        }
        const float mean = wsum(s) * (1.f / DM); float s2 = 0.f;
#pragma unroll
        for (int j = 0; j < 4; ++j) { v[j] = v[j] - mean; s2 += (v[j].x * v[j].x + v[j].y * v[j].y) + (v[j].z * v[j].z + v[j].w * v[j].w); }
        const float rstd = rsqrtf(wsum(s2) * (1.f / DM) + LN_EPS);
#pragma unroll
        for (int j = 0; j < 4; ++j) {
            const int col = 256 * j + 4 * c.lane;
            const f32x4 gg = *(const f32x4*)(g + col), bb = *(const f32x4*)(b + col);
            v[j] = v[j] * rstd * gg + bb;
            if (Xo) st4bf(Xo + (size_t)row * DM + col, v[j].x, v[j].y, v[j].z, v[j].w);
            if (outf) *(f32x4*)(outf + (size_t)row * DM + col) = v[j];
        }
    }
}

DEV void odd_conv(const Ctx& c) {
    const bf16_t* Y1 = (const bf16_t*)(c.ws + SC_Y0); bf16_t* V = (bf16_t*)(c.ws + WS_XA);
    const float* cw = c.p->in[17];
    for (int row = c.gw; row < NT; row += c.ngw) {
        const int t = row & (SEQ - 1);
#pragma unroll
        for (int j = 0; j < 4; ++j) {
            const int col = 256 * j + 4 * c.lane;
            float acc[4] = {0.f, 0.f, 0.f, 0.f};
#pragma unroll
            for (int k = 0; k < 3; ++k) {
                if (t - 2 + k >= 0) {
                    const bf16_t* yr = Y1 + (size_t)(row - 2 + k) * 3072;
                    float gcv[4], hv[4]; ld4bf(yr + 1024 + col, gcv); ld4bf(yr + 2048 + col, hv);
                    const f32x4 w = *(const f32x4*)(cw + k * DM + col);
                    acc[0] += w.x * gcv[0] * hv[0]; acc[1] += w.y * gcv[1] * hv[1]; acc[2] += w.z * gcv[2] * hv[2]; acc[3] += w.w * gcv[3] * hv[3];
                }
            }
            float gb[4]; ld4bf(Y1 + (size_t)row * 3072 + col, gb);
            st4bf(V + (size_t)row * DM + col, gb[0] * acc[0], gb[1] * acc[1], gb[2] * acc[2], gb[3] * acc[3]);
        }
    }
}

constexpr int N_PHASES = 27;
constexpr int LDS_BYTES = 147456;
__global__ void __launch_bounds__(NTHREADS, 2) fwd_kernel(Params prm) {
    extern __shared__ __attribute__((aligned(16))) unsigned char lds_raw[];
    Ctx c; c.p = &prm; c.ws = prm.ws; c.lds = (float*)lds_raw;
    c.tid = threadIdx.x; c.lane = c.tid & 63; c.wave = __builtin_amdgcn_readfirstlane(c.tid >> 6);
    c.gw = blockIdx.x * NWAVES + c.wave; c.ngw = gridDim.x * NWAVES;
    unsigned char* ws = prm.ws;
    PG8_LAS unsigned char* ldsp = (PG8_LAS unsigned char*)lds_raw;
    bf16_t* XA = (bf16_t*)(ws + WS_XA); bf16_t* XB = (bf16_t*)(ws + WS_XB);
    float* Z = (float*)(ws + SC_Z);
    const float* const* in = prm.in;
#ifndef ONLY_PHASE
#define ONLY_PHASE -1
#endif
#define PHASE(k, ...) if ((ONLY_PHASE < 0 || ONLY_PHASE == (k)) && prm.ph_lo <= (k) && (k) < prm.ph_hi) { __VA_ARGS__; if ((k) + 1 < prm.ph_hi) { __threadfence(); cg::this_grid().sync(); } }
    PHASE(0, phase_prep(c))
    PHASE(1, { pg8::PlainTask<pg8::EpiInproj, true> T{XA, DM, (const bf16_t*)(ws + WS_W_IN), DM, DM, {}, {(bf16_t*)(ws + SC_Y0)}}; T.S.init(NT, EINP, gridDim.x, blockIdx.x); pg8::gemm_phase(ldsp, T); })
    PHASE(2, {
        const int bx = blockIdx.x;
        if (bx < 64) { pg8::CmpTask T{DM, ws, bx}; pg8::gemm_phase(ldsp, T); }
        else if (bx < 128) {
            const int j = (bx - 64) & 31; const bool isv = bx >= 96;
            pg8::OneUnitTask T{DM, (const bf16_t*)(ws + (isv ? WS_WV : WS_MEMB)), (const bf16_t*)(ws + (isv ? WS_MEMB : WS_WK)), (bf16_t*)(ws + (isv ? WS_MEMV : WS_MEMK)), isv ? MEML : DM,
                               isv ? (size_t)256 * MEML : (size_t)256 * DM, isv ? (size_t)DM * MEML : (size_t)256, isv ? (j >> 3) : (j >> 2), isv ? (j & 7) : (j & 3), true};
            pg8::gemm_phase(ldsp, T); }
        } conv_branch(c))
    PHASE(3, cmp_finish(c))
    PHASE(4, nsa::nsa_phase(lds_raw, ws))
    PHASE(5, { pg8::PlainTask<pg8::EpiRes<true>, false> T{(const bf16_t*)(ws + SC_CAT), DM, (const bf16_t*)(ws + WS_W_OUT), DM, DM, {}, {Z, in[0]}}; T.S.init(NT, DM, gridDim.x, blockIdx.x); pg8::gemm_phase(ldsp, T); })
    PHASE(6, ln_pass<false>(c, Z, in[19], in[20], XB, 0))
    PHASE(7, { pg8::PlainTask<pg8::EpiBf16S, true> T{XB, DM, (const bf16_t*)(ws + WS_WQ), DM, DM, {}, {(bf16_t*)(ws + SC_Q), DM, 0.0625f * 1.4426950408889634f}}; T.S.init(NT, DM, gridDim.x, blockIdx.x); pg8::gemm_phase(ldsp, T); })
    PHASE(8, { pg8::XaSTask T{256, (const bf16_t*)(ws + SC_Q), (const bf16_t*)(ws + WS_MEMK), (bf16_t*)(ws + SC_P), ldsp, {}}; T.S.init(NT, DM, gridDim.x, blockIdx.x); pg8::gemm_phase(ldsp, T); })
    PHASE(9, { pg8::XaPVTask T{256, (const bf16_t*)(ws + SC_P), (const bf16_t*)(ws + WS_MEMV), (bf16_t*)(ws + SC_CTX), {}}; T.S.init(NT, DM, gridDim.x, blockIdx.x); pg8::gemm_phase(ldsp, T); })
    PHASE(10, { pg8::PlainTask<pg8::EpiRes<false>, false> T{(const bf16_t*)(ws + SC_CTX), DM, (const bf16_t*)(ws + WS_WO), DM, DM, {}, {Z, XB}}; T.S.init(NT, DM, gridDim.x, blockIdx.x); pg8::gemm_phase(ldsp, T); })
    PHASE(11, ln_pass<true>(c, Z, in[23], in[24], XA, 0))
    PHASE(12, { const int* cnt = (const int*)(ws + WS_CTL) + 0 * 32; PG8_LAS int* tab = (PG8_LAS int*)(ldsp + pg8::LDS_SPARE); pg8::moe_build_tab(cnt, tab);
        pg8::Moe1Task T{DM, XA, (const bf16_t*)(ws + WS_W13), (bf16_t*)(ws + SC_H), cnt, (const int*)(ws + WS_LIST), tab, (int)gridDim.x, (int)blockIdx.x}; pg8::gemm_phase(ldsp, T); })
    PHASE(13, { const int* cnt = (const int*)(ws + WS_CTL) + 0 * 32; PG8_LAS int* tab = (PG8_LAS int*)(ldsp + pg8::LDS_SPARE); pg8::moe_build_tab(cnt, tab);
        pg8::Moe2Task T{EH, (const bf16_t*)(ws + SC_H), (const bf16_t*)(ws + WS_W2), (bf16_t*)(ws + SC_Y), cnt, (const int*)(ws + WS_LIST), (const float*)(ws + WS_GATE), tab, (int)gridDim.x, (int)blockIdx.x}; pg8::gemm_phase(ldsp, T); })
    PHASE(14, moe_combine(c, XA, in[32], in[33], XB, nullptr); moe_weights(c, 1))
    PHASE(15, { pg8::PlainTask<pg8::EpiBf16, true> T{XB, DM, (const bf16_t*)(ws + WS_OD_IN), DM, DM, {}, {(bf16_t*)(ws + SC_Y0), 3 * DM}}; T.S.init(NT, 3 * DM, gridDim.x, blockIdx.x); pg8::gemm_phase(ldsp, T); })
    PHASE(16, odd_conv(c))
    PHASE(17, { pg8::PlainTask<pg8::EpiRes<false>, false> T{XA, DM, (const bf16_t*)(ws + WS_OD_OUT), DM, DM, {}, {Z, XB}}; T.S.init(NT, DM, gridDim.x, blockIdx.x); pg8::gemm_phase(ldsp, T); })
    PHASE(18, ln_pass<false>(c, Z, in[19] + DM, in[20] + DM, XA, 1))
    PHASE(19, { pg8::PlainTask<pg8::EpiBf16S, true> T{XA, DM, (const bf16_t*)(ws + WS_WQ) + (size_t)DM * DM, DM, DM, {}, {(bf16_t*)(ws + SC_Q), DM, 0.0625f * 1.4426950408889634f}}; T.S.init(NT, DM, gridDim.x, blockIdx.x); pg8::gemm_phase(ldsp, T); })
    PHASE(20, { pg8::XaSTask T{256, (const bf16_t*)(ws + SC_Q), (const bf16_t*)(ws + WS_MEMK), (bf16_t*)(ws + SC_P), ldsp, {}}; T.S.init(NT, DM, gridDim.x, blockIdx.x); pg8::gemm_phase(ldsp, T); })
    PHASE(21, { pg8::XaPVTask T{256, (const bf16_t*)(ws + SC_P), (const bf16_t*)(ws + WS_MEMV), (bf16_t*)(ws + SC_CTX), {}}; T.S.init(NT, DM, gridDim.x, blockIdx.x); pg8::gemm_phase(ldsp, T); })
    PHASE(22, { pg8::PlainTask<pg8::EpiRes<false>, false> T{(const bf16_t*)(ws + SC_CTX), DM, (const bf16_t*)(ws + WS_WO) + (size_t)DM * DM, DM, DM, {}, {Z, XA}}; T.S.init(NT, DM, gridDim.x, blockIdx.x); pg8::gemm_phase(ldsp, T); })
    PHASE(23, ln_pass<true>(c, Z, in[23] + DM, in[24] + DM, XB, 1))
    PHASE(24, { const int* cnt = (const int*)(ws + WS_CTL) + 1 * 32; PG8_LAS int* tab = (PG8_LAS int*)(ldsp + pg8::LDS_SPARE); pg8::moe_build_tab(cnt, tab);
        pg8::Moe1Task T{DM, XB, (const bf16_t*)(ws + WS_W13), (bf16_t*)(ws + SC_H), cnt, (const int*)(ws + WS_LIST), tab, (int)gridDim.x, (int)blockIdx.x}; pg8::gemm_phase(ldsp, T); })
    PHASE(25, { const int* cnt = (const int*)(ws + WS_CTL) + 1 * 32; PG8_LAS int* tab = (PG8_LAS int*)(ldsp + pg8::LDS_SPARE); pg8::moe_build_tab(cnt, tab);
        pg8::Moe2Task T{EH, (const bf16_t*)(ws + SC_H), (const bf16_t*)(ws + WS_W2), (bf16_t*)(ws + SC_Y), cnt, (const int*)(ws + WS_LIST), (const float*)(ws + WS_GATE), tab, (int)gridDim.x, (int)blockIdx.x}; pg8::gemm_phase(ldsp, T); })
    PHASE(26, moe_combine(c, XB, in[32] + DM, in[33] + DM, nullptr, prm.out))
}

extern "C" void kernel_launch(void* const* d_in, const int* in_sizes, int n_in, void* d_out, int out_size, void* d_ws, size_t ws_size, hipStream_t stream) {
    static int grid = 0;
    if (grid == 0) {
        if (n_in != 34 || ws_size < WS_END) { fprintf(stderr, "kernel_launch: unexpected n_in %d or ws_size %zu\n", n_in, ws_size); grid = -1; return; }
        int dev = 0, cus = 0, per_cu = 0;
        (void)hipGetDevice(&dev);
        (void)hipDeviceGetAttribute(&cus, hipDeviceAttributeMultiprocessorCount, dev);
        (void)hipFuncSetAttribute((const void*)fwd_kernel, hipFuncAttributeMaxDynamicSharedMemorySize, LDS_BYTES);
        (void)hipOccupancyMaxActiveBlocksPerMultiprocessor(&per_cu, (const void*)fwd_kernel, NTHREADS, LDS_BYTES);
        if (per_cu < 1) { fprintf(stderr, "kernel_launch: occupancy query says %d blocks/CU\n", per_cu); per_cu = 1; }
        grid = cus * per_cu;
    }
    if (grid < 0) return;
    Params prm{};
    for (int i = 0; i < 34; ++i) prm.in[i] = (const float*)d_in[i];
    prm.out = (float*)d_out; prm.ws = (unsigned char*)d_ws;
#if N_LAUNCH_MODE == 1
    for (int ph = 0; ph < N_PHASES; ++ph) {
        prm.ph_lo = ph; prm.ph_hi = ph + 1;
        hipLaunchKernelGGL(fwd_kernel, dim3(grid), dim3(NTHREADS), LDS_BYTES, stream, prm);
    }
#else
    prm.ph_lo = 0; prm.ph_hi = N_PHASES;
    void* args[] = {&prm};
    hipError_t e = hipLaunchCooperativeKernel((const void*)fwd_kernel, dim3(grid), dim3(NTHREADS), args, LDS_BYTES, stream);
    if (e != hipSuccess) fprintf(stderr, "cooperative launch failed: %s (grid %d)\n", hipGetErrorString(e), grid);
#endif
}
```

```cpp
#include <hip/hip_runtime.h>
#include <hip/hip_cooperative_groups.h>
#include <cstdint>
#include <cstdio>
namespace cg = cooperative_groups;

#ifndef N_LAUNCH_MODE
#define N_LAUNCH_MODE 0
#endif

typedef unsigned short bf16_t;
typedef short bf16x8 __attribute__((ext_vector_type(8)));
typedef float f32x4 __attribute__((ext_vector_type(4)));
typedef unsigned u32x4 __attribute__((ext_vector_type(4)));
typedef unsigned u32x2 __attribute__((ext_vector_type(2)));
#define DEV __device__ __forceinline__

constexpr int NB = 8, SEQ = 4096, DM = 1024, NT = NB * SEQ;
constexpr int MEML = 256, NMEM = NB * MEML;
constexpr int EIN = 2328, EINP = 2560;
constexpr int C_AV = 0, C_AG = 512, C_Q = 1024, C_KC = 1536, C_VC = 1664, C_KS = 1792, C_VS = 1920, C_KW = 2048, C_VW = 2176, C_GL = 2304;
constexpr int NCMP = 255;
constexpr int NEXP = 32, EH = 512, LCAP = 32768;
constexpr float DN_ALPHA = 1.41421356237f;
constexpr float LN_EPS = 1e-5f;
constexpr int NWAVES = 8, NTHREADS = 512;

constexpr size_t MiB = 1u << 20;
constexpr size_t WS_CTL = 0;
constexpr size_t WS_CMPB = 1 * MiB;
constexpr size_t WS_MSEL = 1 * MiB + 65536;
constexpr size_t WS_RW = 1 * MiB + 131072;
constexpr size_t WS_KCMP = 2 * MiB;
constexpr size_t WS_VCMP = 3 * MiB;
constexpr size_t WS_PK = 4 * MiB;
constexpr size_t WS_PV = 12 * MiB;
constexpr size_t WS_LIST = 20 * MiB;
constexpr size_t WS_GATE = 24 * MiB;
constexpr size_t WS_MEMB = 25 * MiB;
constexpr size_t WS_MEMK = 29 * MiB;
constexpr size_t WS_MEMV = 33 * MiB;
constexpr size_t WS_W_IN = 40 * MiB;
constexpr size_t WS_W_OUT = 45 * MiB;
constexpr size_t WS_OD_IN = 47 * MiB;
constexpr size_t WS_OD_OUT = 53 * MiB;
constexpr size_t WS_WQ = 55 * MiB;
constexpr size_t WS_WO = 59 * MiB;
constexpr size_t WS_WK = 63 * MiB;
constexpr size_t WS_WV = 65 * MiB;
constexpr size_t WS_CW1 = 67 * MiB;
constexpr size_t WS_W13 = 72 * MiB;
constexpr size_t WS_W2 = 136 * MiB;
constexpr size_t WS_XA = 168 * MiB;
constexpr size_t WS_XB = 232 * MiB;
constexpr size_t WS_SCR = 296 * MiB;
constexpr size_t WS_END = 520 * MiB;
constexpr size_t SC_Y0 = WS_SCR;
constexpr size_t SC_CAT = WS_SCR + 160 * MiB;
constexpr size_t SC_Z = WS_SCR;
constexpr size_t SC_Q = WS_SCR;
constexpr size_t SC_P = WS_SCR + 64 * MiB;
constexpr size_t SC_CTX = WS_SCR + 128 * MiB;
constexpr size_t SC_H = WS_SCR;
constexpr size_t SC_Y = WS_SCR + 80 * MiB;

DEV float bf2f(bf16_t b) { return __uint_as_float(((unsigned)b) << 16); }
DEV unsigned f2bf(float f) { unsigned u = __float_as_uint(f); return (u + 0x7fffu + ((u >> 16) & 1u)) >> 16; }
DEV unsigned pk2(float lo, float hi) { return f2bf(lo) | (f2bf(hi) << 16); }
DEV float wsum(float v) {
#pragma unroll
    for (int o = 1; o < 64; o <<= 1) v += __shfl_xor(v, o);
    return v;
}
DEV float gsum16(float v) { v += __shfl_xor(v, 1); v += __shfl_xor(v, 2); v += __shfl_xor(v, 4); v += __shfl_xor(v, 8); return v; }
DEV float sigmoidf_(float x) { return 1.f / (1.f + __expf(-x)); }
DEV float siluf_(float x) { return x / (1.f + __expf(-x)); }
DEV float gelu_tanh(float x) { const float u = 0.7978845608028654f * (x + 0.044715f * x * x * x); return 0.5f * x * (1.f + tanhf(u)); }
#define LDS_WAIT() asm volatile("s_waitcnt lgkmcnt(0)" ::: "memory")
DEV void ld4bf(const bf16_t* p, float* o) { const u32x2 w = *(const u32x2*)p; o[0] = __uint_as_float(w.x << 16); o[1] = __uint_as_float(w.x & 0xffff0000u); o[2] = __uint_as_float(w.y << 16); o[3] = __uint_as_float(w.y & 0xffff0000u); }
DEV void st4bf(bf16_t* p, float a, float b, float c, float d) { u32x2 w; w.x = pk2(a, b); w.y = pk2(c, d); *(u32x2*)p = w; }

struct Params {
    const float* in[34];
    float* out;
    unsigned char* ws;
    int ph_lo, ph_hi;
};
struct Ctx {
    const Params* p;
    unsigned char* ws;
    float* lds;
    int tid, lane, wave, gw, ngw;
};

template <class AF, class BF, class EF>
DEV void ngemm(const Ctx& c, int mtiles, int ntiles, int K, AF af, BF bf, EF ef) {
    const int fr = c.lane & 15, fq = c.lane >> 4;
    for (int it = c.gw; it < mtiles * ntiles; it += c.ngw) {
        const int mt = it / ntiles, nt = it % ntiles;
        f32x4 acc[4][4];
#pragma unroll
        for (int i = 0; i < 4; ++i)
#pragma unroll
            for (int j = 0; j < 4; ++j) acc[i][j] = (f32x4){0.f, 0.f, 0.f, 0.f};
        const bf16_t* bp[4];
#pragma unroll
        for (int j = 0; j < 4; ++j) bp[j] = bf(nt * 64 + j * 16 + fr, mt) + fq * 8;
        for (int k0 = 0; k0 < K; k0 += 32) {
            bf16x8 a[4], b[4];
#pragma unroll
            for (int i = 0; i < 4; ++i) a[i] = *(const bf16x8*)(af(mt * 64 + i * 16 + fr, k0) + fq * 8);
#pragma unroll
            for (int j = 0; j < 4; ++j) b[j] = *(const bf16x8*)(bp[j] + k0);
#pragma unroll
            for (int i = 0; i < 4; ++i)
#pragma unroll
                for (int j = 0; j < 4; ++j) acc[i][j] = __builtin_amdgcn_mfma_f32_16x16x32_bf16(b[j], a[i], acc[i][j], 0, 0, 0);
        }
#pragma unroll
        for (int i = 0; i < 4; ++i)
#pragma unroll
            for (int j = 0; j < 4; ++j) ef(mt * 64 + i * 16 + fr, nt * 64 + j * 16 + 4 * fq, acc[i][j]);
    }
}

namespace pg8 {
#define PG8_LAS __attribute__((address_space(3)))
constexpr int BM = 256, BK = 64, HALF = 128, HTB = HALF * BK * 2, STAGE_BYTES = 8 * HTB, NXCD = 8, WGM = 8;
DEV int lds_byte(int r, int c) { const int st = (r >> 4) * 2 + (c >> 5), rr = r & 15, cc = c & 31, ob = rr * 64 + cc * 2; return st * 1024 + (ob ^ (((ob >> 9) & 1) << 5)); }
DEV void stage_rc(int b, int& R, int& C) { const int st = b / 1024, sb = b % 1024, swz = sb ^ (((sb >> 9) & 1) << 5); R = (st >> 1) * 16 + swz / 64; C = (st & 1) * 32 + (swz % 64) / 2; }
DEV int perm32(int rho) { const int n = rho >> 4, i = rho & 15; return 8 * (i >> 2) + 4 * n + (i & 3); }
struct Unit { int pm, pn, aux; };
struct StaticOrder {
    int nM, nN, nwg, G, c;
    DEV void init(int M, int N, int G_, int c_) { nM = M / BM; nN = N / BM; nwg = nM * nN; G = G_; c = c_; }
    DEV bool next(int i, Unit& u) const {
        const long L = (long)i * G + c; if (L >= nwg) return false;
        int wgid = (int)L; { const int q = nwg / NXCD, r = nwg % NXCD, xcd = wgid % NXCD, off = wgid / NXCD; wgid = (xcd < r ? xcd * (q + 1) : r * (q + 1) + (xcd - r) * q) + off; }
        const int nig = WGM * nN, gid = wgid / nig, fm = gid * WGM, gsz = (nM - fm) < WGM ? (nM - fm) : WGM;
        u.pm = fm + ((wgid % nig) % gsz); u.pn = (wgid % nig) / gsz; u.aux = 0; return true;
    }
};
DEV unsigned cvt_pk_bf16(float lo, float hi) { unsigned r; asm volatile("v_cvt_pk_bf16_f32 %0, %1, %2" : "=v"(r) : "v"(lo), "v"(hi)); return r; }
typedef f32x4 Acc[2][2][4][2];

template <class Task>
DEV void gemm_phase(PG8_LAS unsigned char* lds, const Task& T) {
    const int tid = threadIdx.x, wid = __builtin_amdgcn_readfirstlane(tid >> 6), lane = tid & 63, wr = wid >> 2, wc = wid & 3, fr = lane & 15, fq = lane >> 4;
    const int nt = T.K / BK;
    int R[2], C[2]; unsigned voffB[2];
#pragma unroll
    for (int i = 0; i < 2; ++i) { stage_rc(tid * 16 + i * 8192, R[i], C[i]); const int Rb = Task::PERM ? ((R[i] & ~31) + perm32(R[i] & 31)) : R[i]; voffB[i] = (unsigned)(Rb * T.ldb() + C[i]) * 2u; }
    const size_t kstepB = (size_t)(BK * 2);
    const size_t hstepB = (size_t)HALF * T.ldb() * 2;
    const unsigned ldsw = (unsigned)wid * 1024u;
    const int aoff = lds_byte(wr * 64 + fr, fq * 8), boff = lds_byte(wc * 32 + fr, fq * 8);
#define PG8_SA(b, h) (((b) * 2 + (h)) * HTB)
#define PG8_SB(b, h) ((4 + (b) * 2 + (h)) * HTB)
#define PG8_STAGE(bufoff, gbase, voff) do { _Pragma("unroll") for (int _i = 0; _i < 2; ++_i) \
        __builtin_amdgcn_global_load_lds((const unsigned*)((const char*)(gbase) + (voff)[_i]), (PG8_LAS unsigned*)(lds + (bufoff) + ldsw + _i * 8192), 16, 0, 0); } while (0)
#define PG8_LDA(dst, b, h) do { _Pragma("unroll") for (int m = 0; m < 4; ++m) _Pragma("unroll") for (int k = 0; k < 2; ++k) dst[m][k] = *(const PG8_LAS bf16x8*)(lds + PG8_SA(b, h) + aoff + m * 2048 + k * 1024); } while (0)
#define PG8_LDB(dst, b, h) do { _Pragma("unroll") for (int n = 0; n < 2; ++n) _Pragma("unroll") for (int k = 0; k < 2; ++k) dst[n][k] = *(const PG8_LAS bf16x8*)(lds + PG8_SB(b, h) + boff + n * 2048 + k * 1024); } while (0)
#define PG8_MMA(ai, bj, At, Bt) do { __builtin_amdgcn_s_setprio(1); _Pragma("unroll") for (int m = 0; m < 4; ++m) _Pragma("unroll") for (int n = 0; n < 2; ++n) _Pragma("unroll") for (int k = 0; k < 2; ++k) \
        acc[ai][bj][m][n] = __builtin_amdgcn_mfma_f32_16x16x32_bf16(Bt[n][k], At[m][k], acc[ai][bj][m][n], 0, 0, 0); __builtin_amdgcn_s_setprio(0); } while (0)
#define PG8_WAIT_V(n) asm volatile("s_waitcnt vmcnt(" #n ")" ::: "memory")
#define PG8_WAIT_L(n) asm volatile("s_waitcnt lgkmcnt(" #n ")" ::: "memory")
#define PG8_BAR __builtin_amdgcn_s_barrier()
#define PG8_SCHED __builtin_amdgcn_sched_barrier(0)
    Unit cur, nxt; int ui = 0;
    if (!T.next(0, cur)) return;
    Acc acc;
#pragma unroll
    for (int a = 0; a < 2; ++a)
#pragma unroll
        for (int b = 0; b < 2; ++b)
#pragma unroll
            for (int m = 0; m < 4; ++m)
#pragma unroll
                for (int n = 0; n < 2; ++n) acc[a][b][m][n] = (f32x4){0.f, 0.f, 0.f, 0.f};
    bf16x8 At[4][2], B0[2][2], B1[2][2];
    unsigned va[2][2], na[2][2];
    T.a_offs(cur, R, C, va);
    const char* cA = T.a_base(cur); const char* cB = T.b_base(cur); size_t kstepA = T.a_kstep(cur), kstepN = kstepA;
    PG8_STAGE(PG8_SB(0, 0), cB, voffB); PG8_STAGE(PG8_SB(0, 1), cB + hstepB, voffB); PG8_STAGE(PG8_SA(0, 0), cA, va[0]); PG8_STAGE(PG8_SA(0, 1), cA, va[1]);
    if (wr == 1) PG8_BAR;
    PG8_WAIT_V(2); PG8_BAR;
    PG8_STAGE(PG8_SB(1, 0), cB + kstepB, voffB); PG8_STAGE(PG8_SA(1, 0), cA + kstepA, va[0]); PG8_STAGE(PG8_SB(1, 1), cB + hstepB + kstepB, voffB);
    PG8_WAIT_V(6); PG8_BAR;
    for (;;) {
        const bool has_next = T.next(ui + 1, nxt);
        const char* nA = cA; const char* nB = cB;
#pragma unroll
        for (int h = 0; h < 2; ++h)
#pragma unroll
            for (int i = 0; i < 2; ++i) na[h][i] = va[h][i];
        kstepN = kstepA;
        if (has_next) { nA = T.a_base(nxt); nB = T.b_base(nxt); T.a_offs(nxt, R, C, na); kstepN = T.a_kstep(nxt); }
        for (int t = 0; t < nt; t += 2) {
            const bool last = (t == nt - 2);
            const char* a1 = cA + (size_t)(t + 1) * kstepA;
            const char* a2 = last ? nA : cA + (size_t)(t + 2) * kstepA; const char* b2 = last ? nB : cB + (size_t)(t + 2) * kstepB;
            const char* a3 = a2 + (last ? kstepN : kstepA); const char* b3 = b2 + kstepB;
            unsigned w2[2][2];
#pragma unroll
            for (int h = 0; h < 2; ++h)
#pragma unroll
                for (int i = 0; i < 2; ++i) w2[h][i] = last ? na[h][i] : va[h][i];
            PG8_LDB(B0, 0, 0); PG8_LDB(B1, 0, 1); PG8_SCHED; PG8_LDA(At, 0, 0); PG8_STAGE(PG8_SA(1, 1), a1, va[1]);
            PG8_WAIT_V(8); PG8_WAIT_L(0); PG8_BAR; PG8_MMA(0, 0, At, B0); PG8_MMA(0, 1, At, B1); PG8_BAR; PG8_SCHED;
            PG8_LDA(At, 0, 1); PG8_STAGE(PG8_SB(0, 0), b2, voffB); PG8_STAGE(PG8_SB(0, 1), b2 + hstepB, voffB); PG8_STAGE(PG8_SA(0, 0), a2, w2[0]);
            PG8_WAIT_V(8); PG8_WAIT_L(0); PG8_BAR; PG8_MMA(1, 0, At, B0); PG8_MMA(1, 1, At, B1); PG8_BAR; PG8_SCHED;
            PG8_LDB(B0, 1, 0); PG8_LDB(B1, 1, 1); PG8_SCHED; PG8_LDA(At, 1, 0); PG8_STAGE(PG8_SA(0, 1), a2, w2[1]);
            PG8_WAIT_V(8); PG8_WAIT_L(0); PG8_BAR; PG8_MMA(0, 0, At, B0); PG8_MMA(0, 1, At, B1); PG8_BAR; PG8_SCHED;
            PG8_LDA(At, 1, 1); PG8_STAGE(PG8_SB(1, 0), b3, voffB); PG8_STAGE(PG8_SB(1, 1), b3 + hstepB, voffB); PG8_STAGE(PG8_SA(1, 0), a3, w2[0]);
            PG8_WAIT_V(8); PG8_WAIT_L(0); PG8_BAR; PG8_MMA(1, 0, At, B0); PG8_MMA(1, 1, At, B1); PG8_BAR; PG8_SCHED;
        }
        if (wr == 0) PG8_BAR;
        T.epi(acc, cur, wr, wc, fr, fq);
        if (!has_next) break;
#pragma unroll
        for (int a = 0; a < 2; ++a)
#pragma unroll
            for (int b = 0; b < 2; ++b)
#pragma unroll
                for (int m = 0; m < 4; ++m)
#pragma unroll
                    for (int n = 0; n < 2; ++n) acc[a][b][m][n] = (f32x4){0.f, 0.f, 0.f, 0.f};
        cur = nxt; cA = nA; cB = nB; kstepA = kstepN; ++ui;
#pragma unroll
        for (int h = 0; h < 2; ++h)
#pragma unroll
            for (int i = 0; i < 2; ++i) va[h][i] = na[h][i];
        if (wr == 1) PG8_BAR;
    }
    PG8_WAIT_V(0);
    PG8_BAR;
#undef PG8_SA
#undef PG8_SB
#undef PG8_STAGE
#undef PG8_LDA
#undef PG8_LDB
#undef PG8_MMA
#undef PG8_WAIT_V
#undef PG8_WAIT_L
#undef PG8_BAR
#undef PG8_SCHED
}

DEV void store_tile_bf16(const Acc& acc, bf16_t* base, int ldc, int wr, int wc, int fr, int fq) {
#pragma unroll
    for (int ai = 0; ai < 2; ++ai)
#pragma unroll
        for (int m = 0; m < 4; ++m) { bf16_t* rowp = base + (size_t)(ai * HALF + wr * 64 + m * 16 + fr) * ldc + wc * 32 + 8 * fq;
#pragma unroll
            for (int bj = 0; bj < 2; ++bj) { const f32x4 v0 = acc[ai][bj][m][0], v1 = acc[ai][bj][m][1];
                u32x4 w; w.x = cvt_pk_bf16(v0[0], v0[1]); w.y = cvt_pk_bf16(v0[2], v0[3]); w.z = cvt_pk_bf16(v1[0], v1[1]); w.w = cvt_pk_bf16(v1[2], v1[3]);
                *(u32x4*)(rowp + bj * HALF) = w; } }
}
template <class Epi, bool PERM_>
struct PlainTask {
    static constexpr bool PERM = PERM_;
    const bf16_t* A; int lda; const bf16_t* Bt; int ldb_; int K; StaticOrder S; Epi E;
    DEV bool next(int i, Unit& u) const { return S.next(i, u); }
    DEV const char* a_base(const Unit& u) const { return (const char*)(A + (size_t)u.pm * BM * lda); }
    DEV void a_offs(const Unit&, const int (&R)[2], const int (&C)[2], unsigned (&v)[2][2]) const {
#pragma unroll
        for (int h = 0; h < 2; ++h)
#pragma unroll
            for (int i = 0; i < 2; ++i) v[h][i] = (unsigned)((h * HALF + R[i]) * lda + C[i]) * 2u;
    }
    DEV size_t a_kstep(const Unit&) const { return (size_t)(BK * 2); }
    DEV const char* b_base(const Unit& u) const { return (const char*)(Bt + (size_t)u.pn * BM * ldb_); }
    DEV int ldb() const { return ldb_; }
    DEV void epi(Acc& acc, const Unit& u, int wr, int wc, int fr, int fq) const { E(acc, u, wr, wc, fr, fq); }
};
struct EpiBf16 {
    bf16_t* Cc; int ldc;
    DEV void operator()(Acc& acc, const Unit& u, int wr, int wc, int fr, int fq) const { store_tile_bf16(acc, Cc + (size_t)u.pm * BM * ldc + u.pn * BM, ldc, wr, wc, fr, fq); }
};
struct EpiInproj {
    bf16_t* Cc;
    DEV void operator()(Acc& acc, const Unit& u, int wr, int wc, int fr, int fq) const {
        if (u.pn == 4 || u.pn == 5) {
#pragma unroll
            for (int a = 0; a < 2; ++a)
#pragma unroll
                for (int b = 0; b < 2; ++b)
#pragma unroll
                    for (int m = 0; m < 4; ++m)
#pragma unroll
                        for (int n = 0; n < 2; ++n) acc[a][b][m][n] = acc[a][b][m][n] * (0.125f * 1.4426950408889634f);
        }
        store_tile_bf16(acc, Cc + (size_t)u.pm * BM * EINP + u.pn * BM, EINP, wr, wc, fr, fq); }
};
struct EpiBf16S {
    bf16_t* Cc; int ldc; float scale;
    DEV void operator()(Acc& acc, const Unit& u, int wr, int wc, int fr, int fq) const {
#pragma unroll
        for (int a = 0; a < 2; ++a)
#pragma unroll
            for (int b = 0; b < 2; ++b)
#pragma unroll
                for (int m = 0; m < 4; ++m)
#pragma unroll
                    for (int n = 0; n < 2; ++n) acc[a][b][m][n] = acc[a][b][m][n] * scale;
        store_tile_bf16(acc, Cc + (size_t)u.pm * BM * ldc + u.pn * BM, ldc, wr, wc, fr, fq); }
};
template <bool RES_F32>
struct EpiRes {
    float* Z; const void* res;
    DEV void operator()(Acc& acc, const Unit& u, int wr, int wc, int fr, int fq) const {
#pragma unroll
        for (int ai = 0; ai < 2; ++ai)
#pragma unroll
            for (int m = 0; m < 4; ++m) { const size_t roff = (size_t)(u.pm * BM + ai * HALF + wr * 64 + m * 16 + fr) * DM + u.pn * BM + wc * 32 + 4 * fq;
#pragma unroll
                for (int bj = 0; bj < 2; ++bj)
#pragma unroll
                    for (int n = 0; n < 2; ++n) { const size_t off = roff + bj * HALF + n * 16; f32x4 r;
                        if (RES_F32) r = *(const f32x4*)((const float*)res + off); else { float t[4]; ld4bf((const bf16_t*)res + off, t); r = (f32x4){t[0], t[1], t[2], t[3]}; }
                        *(f32x4*)(Z + off) = r * DN_ALPHA + acc[ai][bj][m][n]; } }
    }
};
}

namespace pg8 {
constexpr int LDS_SPARE = STAGE_BYTES;
DEV void store_tile_f32_perm(const Acc& acc, float* base, int ldc, int wr, int wc, int fr, int fq) {
#pragma unroll
    for (int ai = 0; ai < 2; ++ai)
#pragma unroll
        for (int m = 0; m < 4; ++m) { float* rowp = base + (size_t)(ai * HALF + wr * 64 + m * 16 + fr) * ldc + wc * 32 + 8 * fq;
#pragma unroll
            for (int bj = 0; bj < 2; ++bj) { *(f32x4*)(rowp + bj * HALF) = acc[ai][bj][m][0]; *(f32x4*)(rowp + bj * HALF + 4) = acc[ai][bj][m][1]; } }
}
struct CmpTask {
    static constexpr bool PERM = true;
    int K; unsigned char* ws; int id;
    DEV bool next(int i, Unit& u) const { if (i > 0 || id >= 64) return false; u.aux = id >> 5; u.pm = (id >> 1) & 15; u.pn = id & 1; return true; }
    DEV const char* a_base(const Unit& u) const { return (const char*)(ws + SC_Y0) + (u.aux ? C_VC : C_KC) * 2; }
    DEV void a_offs(const Unit& u, const int (&R)[2], const int (&C)[2], unsigned (&v)[2][2]) const {
#pragma unroll
        for (int h = 0; h < 2; ++h)
#pragma unroll
            for (int i = 0; i < 2; ++i) { const int m = u.pm * BM + h * HALF + R[i], g = m & 1, bj = m >> 1; v[h][i] = (unsigned)(((size_t)bj * 16 * EINP + g * 64 + C[i]) * 2); } }
    DEV size_t a_kstep(const Unit&) const { return (size_t)EINP * 2; }
    DEV const char* b_base(const Unit& u) const { return (const char*)(ws + WS_CW1) + ((size_t)u.aux * 512 + (size_t)u.pn * BM) * DM * 2; }
    DEV int ldb() const { return DM; }
    DEV void epi(Acc& acc, const Unit& u, int wr, int wc, int fr, int fq) const { store_tile_f32_perm(acc, (float*)(ws + (u.aux ? WS_PV : WS_PK)) + (size_t)u.pm * BM * 512 + u.pn * BM, 512, wr, wc, fr, fq); }
};
struct OneUnitTask {
    static constexpr bool PERM = true;
    int K; const bf16_t* A; const bf16_t* Bt; bf16_t* Cc; int ldc; size_t cm, cn; int pm, pn; bool on;
    DEV bool next(int i, Unit& u) const { if (i > 0 || !on) return false; u.pm = pm; u.pn = pn; u.aux = 0; return true; }
    DEV const char* a_base(const Unit& u) const { return (const char*)(A + (size_t)u.pm * BM * DM); }
    DEV void a_offs(const Unit&, const int (&R)[2], const int (&C)[2], unsigned (&v)[2][2]) const {
#pragma unroll
        for (int h = 0; h < 2; ++h)
#pragma unroll
            for (int i = 0; i < 2; ++i) v[h][i] = (unsigned)((h * HALF + R[i]) * DM + C[i]) * 2u; }
    DEV size_t a_kstep(const Unit&) const { return (size_t)(BK * 2); }
    DEV const char* b_base(const Unit& u) const { return (const char*)(Bt + (size_t)u.pn * BM * DM); }
    DEV int ldb() const { return DM; }
    DEV void epi(Acc& acc, const Unit& u, int wr, int wc, int fr, int fq) const { store_tile_bf16(acc, Cc + (size_t)u.pm * cm + (size_t)u.pn * cn, ldc, wr, wc, fr, fq); }
};
struct XaSTask {
    static constexpr bool PERM = true;
    int K; const bf16_t* Q; const bf16_t* MK; bf16_t* P; PG8_LAS unsigned char* lds; StaticOrder S;
    DEV bool next(int i, Unit& u) const { return S.next(i, u); }
    DEV const char* a_base(const Unit& u) const { return (const char*)(Q + (size_t)u.pm * BM * DM + u.pn * 256); }
    DEV void a_offs(const Unit&, const int (&R)[2], const int (&C)[2], unsigned (&v)[2][2]) const {
#pragma unroll
        for (int h = 0; h < 2; ++h)
#pragma unroll
            for (int i = 0; i < 2; ++i) v[h][i] = (unsigned)((h * HALF + R[i]) * DM + C[i]) * 2u; }
    DEV size_t a_kstep(const Unit&) const { return (size_t)(BK * 2); }
    DEV const char* b_base(const Unit& u) const { return (const char*)(MK + (size_t)(u.pm >> 4) * MEML * DM + u.pn * 256); }
    DEV int ldb() const { return DM; }
    DEV void epi(Acc& acc, const Unit& u, int wr, int wc, int fr, int fq) const {
        PG8_LAS float* smax = (PG8_LAS float*)(lds + LDS_SPARE); PG8_LAS float* ssum = smax + 1024;
#pragma unroll
        for (int ai = 0; ai < 2; ++ai)
#pragma unroll
            for (int m = 0; m < 4; ++m) { float v = -INFINITY;
#pragma unroll
                for (int bj = 0; bj < 2; ++bj)
#pragma unroll
                    for (int n = 0; n < 2; ++n) { const f32x4 x = acc[ai][bj][m][n]; v = fmaxf(v, fmaxf(fmaxf(x[0], x[1]), fmaxf(x[2], x[3]))); }
                v = fmaxf(v, __shfl_xor(v, 16)); v = fmaxf(v, __shfl_xor(v, 32));
                if (fq == 0) smax[(ai * HALF + wr * 64 + m * 16 + fr) * 4 + wc] = v; }
        asm volatile("s_waitcnt lgkmcnt(0)" ::: "memory"); __builtin_amdgcn_s_barrier(); asm volatile("" ::: "memory");
#pragma unroll
        for (int ai = 0; ai < 2; ++ai)
#pragma unroll
            for (int m = 0; m < 4; ++m) { const int row = ai * HALF + wr * 64 + m * 16 + fr;
                const f32x4 t = *(const PG8_LAS f32x4*)(smax + row * 4); const float M = fmaxf(fmaxf(t[0], t[1]), fmaxf(t[2], t[3])); float s = 0.f;
#pragma unroll
                for (int bj = 0; bj < 2; ++bj)
#pragma unroll
                    for (int n = 0; n < 2; ++n) { f32x4 x = acc[ai][bj][m][n];
#pragma unroll
                        for (int j = 0; j < 4; ++j) { x[j] = __builtin_amdgcn_exp2f(x[j] - M); s += x[j]; }
                        acc[ai][bj][m][n] = x; }
                s += __shfl_xor(s, 16); s += __shfl_xor(s, 32);
                if (fq == 0) ssum[row * 4 + wc] = s; }
        asm volatile("s_waitcnt lgkmcnt(0)" ::: "memory"); __builtin_amdgcn_s_barrier(); asm volatile("" ::: "memory");
#pragma unroll
        for (int ai = 0; ai < 2; ++ai)
#pragma unroll
            for (int m = 0; m < 4; ++m) { const int row = ai * HALF + wr * 64 + m * 16 + fr;
                const f32x4 t = *(const PG8_LAS f32x4*)(ssum + row * 4); const float inv = 1.f / ((t[0] + t[1]) + (t[2] + t[3]));
#pragma unroll
                for (int bj = 0; bj < 2; ++bj)
#pragma unroll
                    for (int n = 0; n < 2; ++n) acc[ai][bj][m][n] = acc[ai][bj][m][n] * inv; }
        store_tile_bf16(acc, P + (size_t)u.pm * BM * DM + u.pn * 256, DM, wr, wc, fr, fq);
        asm volatile("s_waitcnt lgkmcnt(0)" ::: "memory"); __builtin_amdgcn_s_barrier(); asm volatile("" ::: "memory");
    }
};
struct XaPVTask {
    static constexpr bool PERM = true;
    int K; const bf16_t* P; const bf16_t* VT; bf16_t* O; StaticOrder S;
    DEV bool next(int i, Unit& u) const { return S.next(i, u); }
    DEV const char* a_base(const Unit& u) const { return (const char*)(P + (size_t)u.pm * BM * DM + u.pn * 256); }
    DEV void a_offs(const Unit&, const int (&R)[2], const int (&C)[2], unsigned (&v)[2][2]) const {
#pragma unroll
        for (int h = 0; h < 2; ++h)
#pragma unroll
            for (int i = 0; i < 2; ++i) v[h][i] = (unsigned)((h * HALF + R[i]) * DM + C[i]) * 2u; }
    DEV size_t a_kstep(const Unit&) const { return (size_t)(BK * 2); }
    DEV const char* b_base(const Unit& u) const { return (const char*)(VT + ((size_t)(u.pm >> 4) * DM + u.pn * 256) * MEML); }
    DEV int ldb() const { return MEML; }
    DEV void epi(Acc& acc, const Unit& u, int wr, int wc, int fr, int fq) const { store_tile_bf16(acc, O + (size_t)u.pm * BM * DM + u.pn * 256, DM, wr, wc, fr, fq); }
};
DEV void moe_build_tab(const int* cnt, PG8_LAS int* tab) {
    if (threadIdx.x == 0) { int nb = 0; for (int e = 0; e < NEXP; ++e) { const int k = (cnt[e] + 255) >> 8; for (int j = 0; j < k; ++j) tab[1 + nb + j] = (e << 16) | j; nb += k; } tab[0] = nb; }
    asm volatile("s_waitcnt lgkmcnt(0)" ::: "memory"); __syncthreads();
}
struct Moe1Task {
    static constexpr bool PERM = true;
    int K; const bf16_t* X; const bf16_t* W13; bf16_t* H; const int* cnt; const int* list; const PG8_LAS int* tab; int G, c;
    DEV bool next(int i, Unit& u) const { const int id = i * G + c, rb = id >> 2; if (rb >= tab[0]) return false; u.pm = rb; u.pn = id & 3; u.aux = tab[1 + rb]; return true; }
    DEV const char* a_base(const Unit&) const { return (const char*)X; }
    DEV void a_offs(const Unit& u, const int (&R)[2], const int (&C)[2], unsigned (&v)[2][2]) const {
        const int e = u.aux >> 16, lb = u.aux & 0xffff, ce = cnt[e];
#pragma unroll
        for (int h = 0; h < 2; ++h)
#pragma unroll
            for (int i = 0; i < 2; ++i) { const int r = lb * BM + h * HALF + R[i]; const int tok = (r < ce) ? (list[e * LCAP + r] >> 1) : 0; v[h][i] = (unsigned)(tok * DM + C[i]) * 2u; } }
    DEV size_t a_kstep(const Unit&) const { return (size_t)(BK * 2); }
    DEV const char* b_base(const Unit& u) const { return (const char*)(W13 + ((size_t)(u.aux >> 16) * DM + (size_t)u.pn * BM) * DM); }
    DEV int ldb() const { return DM; }
    DEV void epi(Acc& acc, const Unit& u, int wr, int wc, int fr, int fq) const {
#pragma unroll
        for (int ai = 0; ai < 2; ++ai)
#pragma unroll
            for (int m = 0; m < 4; ++m) { bf16_t* rowp = H + (size_t)(u.pm * BM + ai * HALF + wr * 64 + m * 16 + fr) * EH + u.pn * HALF + wc * 32 + 8 * fq;
                f32x4 h0, h1;
#pragma unroll
                for (int j = 0; j < 4; ++j) { const float a = acc[ai][0][m][0][j], b = acc[ai][0][m][1][j]; h0[j] = a / (1.f + __expf(-a)) * acc[ai][1][m][0][j]; h1[j] = b / (1.f + __expf(-b)) * acc[ai][1][m][1][j]; }
                u32x4 w; w.x = cvt_pk_bf16(h0[0], h0[1]); w.y = cvt_pk_bf16(h0[2], h0[3]); w.z = cvt_pk_bf16(h1[0], h1[1]); w.w = cvt_pk_bf16(h1[2], h1[3]);
                *(u32x4*)rowp = w; }
    }
};
struct Moe2Task {
    static constexpr bool PERM = true;
    int K; const bf16_t* H; const bf16_t* W2; bf16_t* Y; const int* cnt; const int* list; const float* gate; const PG8_LAS int* tab; int G, c;
    DEV bool next(int i, Unit& u) const { const int id = i * G + c, rb = id >> 2; if (rb >= tab[0]) return false; u.pm = rb; u.pn = id & 3; u.aux = tab[1 + rb]; return true; }
    DEV const char* a_base(const Unit& u) const { return (const char*)(H + (size_t)u.pm * BM * EH); }
    DEV void a_offs(const Unit&, const int (&R)[2], const int (&C)[2], unsigned (&v)[2][2]) const {
#pragma unroll
        for (int h = 0; h < 2; ++h)
#pragma unroll
            for (int i = 0; i < 2; ++i) v[h][i] = (unsigned)((h * HALF + R[i]) * EH + C[i]) * 2u; }
    DEV size_t a_kstep(const Unit&) const { return (size_t)(BK * 2); }
    DEV const char* b_base(const Unit& u) const { return (const char*)(W2 + ((size_t)(u.aux >> 16) * DM + (size_t)u.pn * BM) * EH); }
    DEV int ldb() const { return EH; }
    DEV void epi(Acc& acc, const Unit& u, int wr, int wc, int fr, int fq) const {
        const int e = u.aux >> 16, lb = u.aux & 0xffff, ce = cnt[e];
#pragma unroll
        for (int ai = 0; ai < 2; ++ai)
#pragma unroll
            for (int m = 0; m < 4; ++m) { const int r = lb * BM + ai * HALF + wr * 64 + m * 16 + fr;
                if (r < ce) { const int aid = list[e * LCAP + r]; const float gt = gate[aid];
                    bf16_t* rowp = Y + (size_t)aid * DM + u.pn * BM + wc * 32 + 8 * fq;
#pragma unroll
                    for (int bj = 0; bj < 2; ++bj) { const f32x4 v0 = acc[ai][bj][m][0] * gt, v1 = acc[ai][bj][m][1] * gt;
                        u32x4 w; w.x = cvt_pk_bf16(v0[0], v0[1]); w.y = cvt_pk_bf16(v0[2], v0[3]); w.z = cvt_pk_bf16(v1[0], v1[1]); w.w = cvt_pk_bf16(v1[2], v1[3]);
                        *(u32x4*)(rowp + bj * HALF) = w; } } }
    }
};
}

template <class RM>
DEV void tr_item(const float* W, int ldw, int N, bf16_t* WT, int ldd, RM rowmap, int item, int nblk, float* scr, int lane) {
    const int kb = item / nblk, nb = item % nblk, k0 = 64 * kb, n0 = 32 * nb;
    const int n = n0 + (lane & 31);
#pragma unroll 8
    for (int i = 0; i < 32; ++i) { const int kk = 2 * i + (lane >> 5); scr[kk * 33 + (lane & 31)] = (n < N) ? W[(size_t)(k0 + kk) * ldw + n] : 0.f; }
    LDS_WAIT();
    const int ch = lane & 7;
#pragma unroll
    for (int j = 0; j < 4; ++j) {
        const int nl = (lane >> 3) + 8 * j, nn = n0 + nl;
        const float* s = scr + (8 * ch) * 33 + nl;
        u32x4 o; o.x = pk2(s[0], s[33]); o.y = pk2(s[66], s[99]); o.z = pk2(s[132], s[165]); o.w = pk2(s[198], s[231]);
        if (nn < N) *(u32x4*)(WT + (size_t)rowmap(nn) * ldd + k0 + 8 * ch) = o;
    }
    LDS_WAIT();
}
template <class RM>
DEV void tr_all(const Ctx& c, const float* W, int K, int N, bf16_t* WT, int ldd, RM rm) {
    float* scr = c.lds + c.wave * (64 * 33);
    const int nblk = (N + 31) / 32, nitems = (K / 64) * nblk;
    for (int it = c.gw; it < nitems; it += c.ngw) tr_item(W, N, N, WT, ldd, rm, it, nblk, scr, c.lane);
}
DEV void moe_weights(const Ctx& c, int layer) {
    float* scr = c.lds + c.wave * (64 * 33);
    const float* w1 = c.p->in[29] + (size_t)layer * NEXP * DM * EH;
    const float* w3 = c.p->in[30] + (size_t)layer * NEXP * DM * EH;
    const float* w2 = c.p->in[31] + (size_t)layer * NEXP * EH * DM;
    bf16_t* W13 = (bf16_t*)(c.ws + WS_W13); bf16_t* W2 = (bf16_t*)(c.ws + WS_W2);
    for (int it = c.gw; it < NEXP * 768; it += c.ngw) {
        const int e = it / 768, r = it % 768, mat = r >> 8, sub = r & 255;
        if (mat == 0) tr_item(w1 + (size_t)e * DM * EH, EH, EH, W13 + (size_t)e * DM * DM, DM, [](int n) { return (n >> 7) * 256 + (n & 127); }, sub, 16, scr, c.lane);
        else if (mat == 1) tr_item(w3 + (size_t)e * DM * EH, EH, EH, W13 + (size_t)e * DM * DM, DM, [](int n) { return (n >> 7) * 256 + 128 + (n & 127); }, sub, 16, scr, c.lane);
        else tr_item(w2 + (size_t)e * EH * DM, DM, DM, W2 + (size_t)e * DM * EH, EH, [](int n) { return n; }, sub, 32, scr, c.lane);
    }
}
DEV void cvt_rows(const Ctx& c, const float* src, bf16_t* dst, size_t n) {
    const size_t nth = (size_t)c.ngw * 64, t0 = (size_t)c.gw * 64 + c.lane;
    for (size_t i = t0; i < n / 8; i += nth) {
        const f32x4 a = *(const f32x4*)(src + i * 8), b = *(const f32x4*)(src + i * 8 + 4);
        u32x4 o; o.x = pk2(a.x, a.y); o.y = pk2(a.z, a.w); o.z = pk2(b.x, b.y); o.w = pk2(b.z, b.w);
        *(u32x4*)(dst + i * 8) = o;
    }
}
DEV void phase_prep(const Ctx& c) {
    const Params& p = *c.p; unsigned char* ws = c.ws;
    auto id = [](int n) { return n; };
    if (blockIdx.x == 0 && c.tid < 64) ((int*)(ws + WS_CTL))[c.tid] = 0;
    tr_all(c, p.in[4], DM, EIN, (bf16_t*)(ws + WS_W_IN), DM, id);
    {
        bf16_t* w = (bf16_t*)(ws + WS_W_IN) + (size_t)EIN * DM; const size_t n = (size_t)(EINP - EIN) * DM / 8;
        for (size_t i = (size_t)c.gw * 64 + c.lane; i < n; i += (size_t)c.ngw * 64) *(u32x4*)(w + i * 8) = (u32x4){0u, 0u, 0u, 0u};
    }
    tr_all(c, p.in[15], DM, DM, (bf16_t*)(ws + WS_W_OUT), DM, id);
    tr_all(c, p.in[16], DM, 3 * DM, (bf16_t*)(ws + WS_OD_IN), DM, id);
    tr_all(c, p.in[18], DM, DM, (bf16_t*)(ws + WS_OD_OUT), DM, id);
    for (int l = 0; l < 2; ++l) {
        tr_all(c, p.in[21] + (size_t)l * DM * DM, DM, DM, (bf16_t*)(ws + WS_WQ) + (size_t)l * DM * DM, DM, id);
        tr_all(c, p.in[22] + (size_t)l * DM * DM, DM, DM, (bf16_t*)(ws + WS_WO) + (size_t)l * DM * DM, DM, id);
    }
    tr_all(c, p.in[2], DM, DM, (bf16_t*)(ws + WS_WK), DM, id);
    tr_all(c, p.in[3], DM, DM, (bf16_t*)(ws + WS_WV), DM, id);
    for (int kv = 0; kv < 2; ++kv) {
        const float* w1 = p.in[kv ? 13 : 10];
        bf16_t* d = (bf16_t*)(ws + WS_CW1) + (size_t)kv * 512 * DM;
        tr_all(c, w1, 1024, 256, d, DM, id);
        tr_all(c, w1 + (size_t)1024 * 256, 1024, 256, d + (size_t)256 * DM, DM, id);
    }
    moe_weights(c, 0);
    cvt_rows(c, p.in[0], (bf16_t*)(ws + WS_XA), (size_t)NT * DM);
    cvt_rows(c, p.in[1], (bf16_t*)(ws + WS_MEMB), (size_t)NMEM * DM);
    for (int i = c.gw * 64 + c.lane; i < 256 * 64; i += c.ngw * 64) {
        const int n = i >> 6, m = i & 63; float v = 0.f;
        if (n < NCMP) { const int ov = min(16 * n + 32, 64 * m + 64) - max(16 * n, 64 * m); v = (ov > 0) ? (float)ov * (1.f / 32.f) : 0.f; }
        ((bf16_t*)(ws + WS_MSEL))[i] = (bf16_t)f2bf(v);
    }
    for (int i = c.gw * 64 + c.lane; i < 2 * 16 * 64; i += c.ngw * 64) { const int kv = i >> 10, bg = (i >> 6) & 15, d = i & 63; ((bf16_t*)(ws + (kv ? WS_VCMP : WS_KCMP)))[(size_t)(bg * 256 + 255) * 64 + d] = 0; }
    for (int i = c.gw * 64 + c.lane; i < 2 * 36 * DM; i += c.ngw * 64) {
        const int l = i / (36 * DM), o = (i / DM) % 36, k = i % DM;
        ((float*)(ws + WS_RW))[i] = (o < 4) ? p.in[25][((size_t)l * DM + k) * 4 + o] : p.in[27][((size_t)l * DM + k) * 32 + (o - 4)];
    }
    for (int it = c.gw; it < 512; it += c.ngw) {
        const int kv = it >> 8, col = it & 255;
        const float* pe = p.in[kv ? 12 : 9]; const float* w1 = p.in[kv ? 13 : 10];
        float s = 0.f;
        for (int kk = c.lane; kk < 2048; kk += 64) s += pe[kk] * w1[(size_t)kk * 256 + col];
        s = wsum(s);
        if (c.lane == 0) ((float*)(ws + WS_CMPB))[it] = s;
    }
}

struct EpiStoreBf16 { bf16_t* C; int ldc; DEV void operator()(int m, int n, f32x4 v) const { st4bf(C + (size_t)m * ldc + n, v.x, v.y, v.z, v.w); } };
struct EpiStoreF32 { float* C; int ldc; DEV void operator()(int m, int n, f32x4 v) const { *(f32x4*)(C + (size_t)m * ldc + n) = v; } };
struct EpiResF32 { float* Z; const float* res; DEV void operator()(int m, int n, f32x4 v) const { const f32x4 r = *(const f32x4*)(res + (size_t)m * DM + n); *(f32x4*)(Z + (size_t)m * DM + n) = r * DN_ALPHA + v; } };
struct EpiResBf16 { float* Z; const bf16_t* res; DEV void operator()(int m, int n, f32x4 v) const { float r[4]; ld4bf(res + (size_t)m * DM + n, r); *(f32x4*)(Z + (size_t)m * DM + n) = (f32x4){r[0] * DN_ALPHA + v.x, r[1] * DN_ALPHA + v.y, r[2] * DN_ALPHA + v.z, r[3] * DN_ALPHA + v.w}; } };

struct ARowPlain { const bf16_t* A; int lda; DEV const bf16_t* operator()(int m, int k0) const { return A + (size_t)m * lda + k0; } };
struct BRowPlain { const bf16_t* B; int ldb; DEV const bf16_t* operator()(int n, int) const { return B + (size_t)n * ldb; } };

DEV void conv_branch(const Ctx& c) {
    const Params& p = *c.p;
    const bf16_t* Y0 = (const bf16_t*)(c.ws + SC_Y0); bf16_t* CAT = (bf16_t*)(c.ws + SC_CAT);
    const float* cw = p.in[5]; const float* cb = p.in[6]; const float* g = p.in[7]; const float* bb = p.in[8];
    for (int row = c.gw; row < NT; row += c.ngw) {
        const int t = row & (SEQ - 1);
        float acc[8];
#pragma unroll
        for (int i = 0; i < 8; ++i) acc[i] = cb[c.lane + 64 * i];
        const int kmin = (t >= 30) ? 0 : 30 - t;
        for (int k = kmin; k < 31; ++k) {
            const bf16_t* yr = Y0 + (size_t)(row - 30 + k) * EINP;
#pragma unroll
            for (int i = 0; i < 8; ++i) { const int ch = c.lane + 64 * i; const float a = bf2f(yr[C_AV + ch]) * sigmoidf_(bf2f(yr[C_AG + ch])); acc[i] += cw[k * 512 + ch] * a; }
        }
        float s = 0.f;
#pragma unroll
        for (int i = 0; i < 8; ++i) s += acc[i];
        const float mean = wsum(s) * (1.f / 512.f);
        float s2 = 0.f;
#pragma unroll
        for (int i = 0; i < 8; ++i) { acc[i] -= mean; s2 += acc[i] * acc[i]; }
        const float rstd = rsqrtf(wsum(s2) * (1.f / 512.f) + LN_EPS);
#pragma unroll
        for (int i = 0; i < 8; ++i) { const int ch = c.lane + 64 * i; const float y = acc[i] * rstd * g[ch] + bb[ch]; CAT[(size_t)row * DM + ch] = (bf16_t)f2bf(siluf_(y)); }
    }
}
struct ARowCmp { const bf16_t* Y0; int coff; DEV const bf16_t* operator()(int m, int k0) const { const int g = m & 1, bj = m >> 1; return Y0 + ((size_t)bj * 16 + (k0 >> 6)) * EINP + coff + g * 64 + (k0 & 63); } };
DEV void cmp_gemm(const Ctx& c) {
    const bf16_t* Y0 = (const bf16_t*)(c.ws + SC_Y0);
    for (int kv = 0; kv < 2; ++kv) {
        ARowCmp af{Y0, kv ? C_VC : C_KC}; BRowPlain bf{(const bf16_t*)(c.ws + WS_CW1) + (size_t)kv * 512 * DM, DM};
        EpiStoreF32 ef{(float*)(c.ws + (kv ? WS_PV : WS_PK)), 512};
        ngemm(c, 4096 / 64, 512 / 64, 1024, af, bf, ef);
    }
}
DEV void cmp_finish(const Ctx& c) {
    const Params& p = *c.p;
    float* hid = c.lds + c.wave * 256;
    for (int it = c.gw; it < 2 * NB * NCMP * 2; it += c.ngw) {
        const int kv = it / (NB * NCMP * 2), r = it % (NB * NCMP * 2), g = r & 1, bn = r >> 1, b = bn / NCMP, n = bn % NCMP;
        const float* P = (const float*)(c.ws + (kv ? WS_PV : WS_PK));
        const float* cbias = (const float*)(c.ws + WS_CMPB) + kv * 256;
        const float* w2 = p.in[kv ? 14 : 11];
        const int r0 = (b * 256 + n) * 2 + g, r1 = (b * 256 + n + 1) * 2 + g;
#pragma unroll
        for (int i = 0; i < 4; ++i) { const int cc = c.lane + 64 * i; hid[cc] = gelu_tanh(P[(size_t)r0 * 512 + cc] + P[(size_t)r1 * 512 + 256 + cc] + cbias[cc]); }
        LDS_WAIT();
        float o = 0.f;
        for (int cc = 0; cc < 256; ++cc) o += hid[cc] * w2[cc * 64 + c.lane];
        ((bf16_t*)(c.ws + (kv ? WS_VCMP : WS_KCMP)))[(size_t)((b * 2 + g) * 256 + n) * 64 + c.lane] = (bf16_t)f2bf(o);
        LDS_WAIT();
    }
}

DEV void nsa_naive(const Ctx& c) {
    const bf16_t* Y0 = (const bf16_t*)(c.ws + SC_Y0); bf16_t* CAT = (bf16_t*)(c.ws + SC_CAT);
    const float* KC = (const float*)(c.ws + WS_KCMP); const float* VC = (const float*)(c.ws + WS_VCMP);
    float* pc = c.lds + c.wave * 1024;
    const int hh = c.lane >> 4, dq = c.lane & 15;
    for (int it = c.gw; it < NT * 2; it += c.ngw) {
        const int g = it & 1, row = it >> 1, b = row >> 12, t = row & (SEQ - 1);
        const int h = g * 4 + hh;
        const bf16_t* yrow = Y0 + (size_t)row * EINP;
        float q[4]; ld4bf(yrow + C_Q + h * 64 + dq * 4, q);
#pragma unroll
        for (int i = 0; i < 4; ++i) q[i] *= 0.125f;
        const int ncv = (t >= 31) ? min(NCMP, (t - 31) / 16 + 1) : 0;
        float oc[4] = {0.f, 0.f, 0.f, 0.f};
        float mx = -INFINITY;
        for (int n = 0; n < ncv; ++n) {
            const f32x4 k4 = *(const f32x4*)(KC + (size_t)((b * NCMP + n) * 2 + g) * 64 + dq * 4);
            float s = q[0] * k4.x + q[1] * k4.y + q[2] * k4.z + q[3] * k4.w; s = gsum16(s);
            if (dq == 0) pc[hh * 256 + n] = s;
            mx = fmaxf(mx, s);
        }
        LDS_WAIT();
        float l = 0.f;
        for (int n = 0; n < ncv; ++n) l += __expf(pc[hh * 256 + n] - mx);
        const float inv = (ncv > 0) ? 1.f / l : 0.f;
        for (int n = 0; n < ncv; ++n) {
            const float pr = __expf(pc[hh * 256 + n] - mx) * inv;
            const f32x4 v4 = *(const f32x4*)(VC + (size_t)((b * NCMP + n) * 2 + g) * 64 + dq * 4);
            oc[0] += pr * v4.x; oc[1] += pr * v4.y; oc[2] += pr * v4.z; oc[3] += pr * v4.w;
            LDS_WAIT();
            if (dq == 0) pc[hh * 256 + n] = pr;
        }
        LDS_WAIT();
        const int m = c.lane, cur = t >> 6;
        float imp = 0.f;
#pragma unroll
        for (int h2 = 0; h2 < 4; ++h2)
#pragma unroll
            for (int dn = -1; dn <= 3; ++dn) { const int n = 4 * m + dn; if (n >= 0 && n < ncv) imp += pc[h2 * 256 + n] * ((dn == -1 || dn == 3) ? 0.5f : 1.f); }
        const bool causal = m <= cur, forced = (m == 0) || (m == cur) || (m == cur - 1);
        const float score = causal ? (forced ? 1e4f : imp) : -1e30f;
        int rank = 0;
        for (int m2 = 0; m2 < 64; ++m2) { const float s2 = __shfl(score, m2); rank += ((s2 > score) || (s2 == score && m2 < m)) ? 1 : 0; }
        unsigned long long selmask = __ballot(causal && rank < 16);
        LDS_WAIT();
        float ms = -INFINITY, ls = 0.f, os[4] = {0.f, 0.f, 0.f, 0.f};
        while (selmask) {
            const int mb = __builtin_ctzll(selmask); selmask &= selmask - 1;
            const int jmax = min(63, t - 64 * mb);
            const bf16_t* kb = Y0 + (size_t)(b * SEQ + 64 * mb) * EINP + g * 64 + dq * 4;
            for (int j = 0; j <= jmax; ++j) {
                float k4[4], v4[4]; ld4bf(kb + (size_t)j * EINP + C_KS, k4); ld4bf(kb + (size_t)j * EINP + C_VS, v4);
                float s = q[0] * k4[0] + q[1] * k4[1] + q[2] * k4[2] + q[3] * k4[3]; s = gsum16(s);
                const float mn = fmaxf(ms, s), cf = __expf(ms - mn), pp = __expf(s - mn);
                ls = ls * cf + pp;
#pragma unroll
                for (int i = 0; i < 4; ++i) os[i] = os[i] * cf + pp * v4[i];
                ms = mn;
            }
        }
        float mw = -INFINITY, lw = 0.f, ow[4] = {0.f, 0.f, 0.f, 0.f};
        {
            const int k0 = max(0, t - 511);
            const bf16_t* kb = Y0 + (size_t)(b * SEQ) * EINP + g * 64 + dq * 4;
            for (int kp = k0; kp <= t; ++kp) {
                float k4[4], v4[4]; ld4bf(kb + (size_t)kp * EINP + C_KW, k4); ld4bf(kb + (size_t)kp * EINP + C_VW, v4);
                float s = q[0] * k4[0] + q[1] * k4[1] + q[2] * k4[2] + q[3] * k4[3]; s = gsum16(s);
                const float mn = fmaxf(mw, s), cf = __expf(mw - mn), pp = __expf(s - mn);
                lw = lw * cf + pp;
#pragma unroll
                for (int i = 0; i < 4; ++i) ow[i] = ow[i] * cf + pp * v4[i];
                mw = mn;
            }
        }
        const float gc = sigmoidf_(bf2f(yrow[C_GL + h * 3 + 0])), gs = sigmoidf_(bf2f(yrow[C_GL + h * 3 + 1])) / ls, gwn = sigmoidf_(bf2f(yrow[C_GL + h * 3 + 2])) / lw;
        st4bf(CAT + (size_t)row * DM + 512 + h * 64 + dq * 4, gc * oc[0] + gs * os[0] + gwn * ow[0], gc * oc[1] + gs * os[1] + gwn * ow[1], gc * oc[2] + gs * os[2] + gwn * ow[2], gc * oc[3] + gs * os[3] + gwn * ow[3]);
    }
}

namespace nsa {
typedef float f32x16 __attribute__((ext_vector_type(16)));
typedef short s16x4 __attribute__((ext_vector_type(4)));
typedef __attribute__((address_space(3))) unsigned char lds_u8;
constexpr int SLOT = 8192, NSLOT = 3;
constexpr int L_K = 0, L_V = NSLOT * SLOT, L_IMP = 2 * NSLOT * SLOT  , L_SEL = L_IMP + 65536  ;
constexpr float NEGB = -1e30f;
DEV int crow(int r, int hi) { return (r & 3) + 8 * (r >> 2) + 4 * hi; }
DEV s16x4 vtr(const lds_u8* p) { typedef short v4i16_t __attribute__((ext_vector_type(4))); return __builtin_bit_cast(s16x4, __builtin_amdgcn_ds_read_tr16_b64_v4i16((__attribute__((address_space(3))) v4i16_t*)p)); }
DEV unsigned cvtpk(float lo, float hi) { typedef float f2 __attribute__((ext_vector_type(2))); typedef __bf16 b2 __attribute__((ext_vector_type(2))); f2 v = {lo, hi}; b2 b = __builtin_convertvector(v, b2); return __builtin_bit_cast(unsigned, b); }
DEV void glds16(const void* gsrc, unsigned lds_dst) { unsigned keep;
    asm volatile("s_mov_b32 %0, m0\n\ts_mov_b32 m0, %2\n\ts_nop 0\n\tglobal_load_lds_dwordx4 %1, off\n\ts_mov_b32 m0, %0" : "=&s"(keep) : "v"(gsrc), "s"(lds_dst) : "memory"); }
#define NSA_WAITV(n) asm volatile("s_waitcnt vmcnt(" #n ")" ::: "memory")
#define NSA_BAR() do { asm volatile("s_waitcnt lgkmcnt(0)" ::: "memory"); __builtin_amdgcn_s_barrier(); asm volatile("" ::: "memory"); } while (0)

DEV void flash_pass(lds_u8* lds, const bf16_t* Kg, int pk, const bf16_t* Vg, int pv, int t0, int nt, const bf16x8 (&qr)[4],
                    int lo, int hi_b, unsigned long long rowmask, int lo_max, int hi_min, f32x16 (&o)[2], float& l_out) {
    const int tid = threadIdx.x, lane = tid & 63, r32 = lane & 31, hi = lane >> 5; const int wid = __builtin_amdgcn_readfirstlane(tid >> 6);
    o[0] = f32x16{}; o[1] = f32x16{}; float l = 0.f, mhat = 0.f;
    if (nt <= 0) { l_out = 0.f; return; }
    const bf16_t* ksrc = Kg + (size_t)(t0 * 64 + lane) * pk + wid * 8;
    const bf16_t* vsrc = Vg + (size_t)(t0 * 64 + 16 * (wid & 3) + (lane >> 2)) * pv + (wid >> 2) * 32 + (lane & 3) * 8;
    const size_t kstep = (size_t)64 * pk, vstep = (size_t)64 * pv;
    const unsigned lds0 = (unsigned)(uintptr_t)lds;
#define NSA_DMA(t, slot) do { glds16(ksrc + (size_t)(t) * kstep, (unsigned)__builtin_amdgcn_readfirstlane(lds0 + L_K + (slot) * SLOT + wid * 1024)); \
                               glds16(vsrc + (size_t)(t) * vstep, (unsigned)__builtin_amdgcn_readfirstlane(lds0 + L_V + (slot) * SLOT + wid * 1024)); } while (0)
    const lds_u8* kp0 = lds + L_K + hi * 1024 + r32 * 16;
    const lds_u8* vp0 = lds + L_V + ((lane >> 4) & 1) * 32 + (lane & 3) * 8 + (4 * hi + ((lane & 15) >> 2)) * 64;
    NSA_DMA(0, 0);
    if (nt > 1) NSA_DMA(1, 1);
    int slot = 0;
    for (int t = 0; t < nt; ++t) {
        if (t + 1 < nt) NSA_WAITV(2); else NSA_WAITV(0);
        NSA_BAR();
        if (t + 2 < nt) { const int s2 = (slot >= 1) ? slot - 1 : 2; NSA_DMA(t + 2, s2); }
        const int gt = t0 + t;
        const bool rowok = (rowmask >> gt) & 1ull;
        const float ci = rowok ? -mhat : NEGB;
        f32x16 c0, c1;
#pragma unroll
        for (int r = 0; r < 16; ++r) { c0[r] = ci; c1[r] = ci; }
        const lds_u8* kp = kp0 + slot * SLOT;
#pragma unroll
        for (int d0 = 0; d0 < 4; ++d0) {
            const bf16x8 k0 = *(const __attribute__((address_space(3))) bf16x8*)(kp + d0 * 2048);
            const bf16x8 k1 = *(const __attribute__((address_space(3))) bf16x8*)(kp + d0 * 2048 + 512);
            c0 = __builtin_amdgcn_mfma_f32_32x32x16_bf16(k0, qr[d0], c0, 0, 0, 0);
            c1 = __builtin_amdgcn_mfma_f32_32x32x16_bf16(k1, qr[d0], c1, 0, 0, 0);
        }
        if ((64 * gt + 63 > hi_min) || (64 * gt <= lo_max)) {
            const int kb = 64 * gt + 4 * hi;
#pragma unroll
            for (int r = 0; r < 16; ++r) { const int kv = kb + (r & 3) + 8 * (r >> 2);
                if (!(kv > lo && kv <= hi_b)) c0[r] = NEGB;
                if (!(kv + 32 > lo && kv + 32 <= hi_b)) c1[r] = NEGB; }
        }
        float rm = fmaxf(c0[0], c1[0]);
#pragma unroll
        for (int r = 1; r < 16; ++r) rm = fmaxf(rm, fmaxf(c0[r], c1[r]));
        { auto rr = __builtin_amdgcn_permlane32_swap(__float_as_uint(rm), __float_as_uint(rm), false, false); rm = fmaxf(__uint_as_float(rr[0]), __uint_as_float(rr[1])); }
        if (__any(rm > 6.0f)) {
            const float dl = fmaxf(rm, 0.f), f = __builtin_amdgcn_exp2f(-dl);
            mhat += dl; l *= f;
#pragma unroll
            for (int r = 0; r < 16; ++r) { c0[r] -= dl; c1[r] -= dl; o[0][r] *= f; o[1][r] *= f; }
        }
        float ps = 0.f;
#pragma unroll
        for (int r = 0; r < 16; ++r) { c0[r] = __builtin_amdgcn_exp2f(c0[r]); c1[r] = __builtin_amdgcn_exp2f(c1[r]); ps += c0[r] + c1[r]; }
        l += ps;
        u32x4 pw[4];
#pragma unroll
        for (int s = 0; s < 2; ++s)
#pragma unroll
            for (int j = 0; j < 4; ++j) { pw[s][j] = cvtpk(c0[8 * s + 2 * j], c0[8 * s + 2 * j + 1]); pw[2 + s][j] = cvtpk(c1[8 * s + 2 * j], c1[8 * s + 2 * j + 1]); }
        const lds_u8* vp = vp0 + slot * SLOT;
#pragma unroll
        for (int dh = 0; dh < 2; ++dh)
#pragma unroll
            for (int ks = 0; ks < 4; ++ks) {
                const s16x4 vl = vtr(vp + dh * 4096 + ks * 1024), vh = vtr(vp + dh * 4096 + ks * 1024 + 512);
                const bf16x8 vf = (bf16x8){vl[0], vl[1], vl[2], vl[3], vh[0], vh[1], vh[2], vh[3]};
                o[dh] = __builtin_amdgcn_mfma_f32_32x32x16_bf16(vf, __builtin_bit_cast(bf16x8, pw[ks]), o[dh], 0, 0, 0);
            }
        slot = (slot == 2) ? 0 : slot + 1;
    }
    NSA_BAR();
    { auto rr = __builtin_amdgcn_permlane32_swap(__float_as_uint(l), __float_as_uint(l), false, false); l = __uint_as_float(rr[0]) + __uint_as_float(rr[1]); }
    l_out = l;
#undef NSA_DMA
}

DEV void nsa_unit(lds_u8* lds, unsigned char* ws, int b, int g, int qt) {
    const int tid = threadIdx.x, lane = tid & 63, r32 = lane & 31, hi = lane >> 5; const int wid = __builtin_amdgcn_readfirstlane(tid >> 6);
    const int hh = wid >> 1, h = 4 * g + hh, ql = 32 * (wid & 1) + r32, t = 64 * qt + ql;
    const bf16_t* Y0 = (const bf16_t*)(ws + SC_Y0);
    const bf16_t* yrow = Y0 + (size_t)(b * SEQ + t) * EINP;
    bf16x8 qr[4];
#pragma unroll
    for (int d0 = 0; d0 < 4; ++d0) qr[d0] = *(const bf16x8*)(yrow + C_Q + h * 64 + d0 * 16 + hi * 8);
#pragma unroll
    for (int d0 = 0; d0 < 4; ++d0) asm volatile("" : "+v"(qr[d0]));
    const float g_c = sigmoidf_(bf2f(yrow[C_GL + h * 3 + 0])), g_s = sigmoidf_(bf2f(yrow[C_GL + h * 3 + 1])), g_w = sigmoidf_(bf2f(yrow[C_GL + h * 3 + 2]));
    const bf16_t* Ybg = Y0 + (size_t)(b * SEQ) * EINP + g * 64;
    f32x16 acc[2], o[2]; float l;
    const int nmax = (t >= 31) ? (t - 31) >> 4 : -1;
    const int tmaxu = 64 * qt + 63, nmax_u = (tmaxu - 31) >> 4, nct = (nmax_u >> 6) + 1;
    const int nmin_u = (64 * qt >= 31) ? (64 * qt - 31) >> 4 : -1;
    const bf16_t* KC = (const bf16_t*)(ws + WS_KCMP) + (size_t)(b * 2 + g) * 256 * 64;
    const bf16_t* VC = (const bf16_t*)(ws + WS_VCMP) + (size_t)(b * 2 + g) * 256 * 64;
    const bf16_t* MS = (const bf16_t*)(ws + WS_MSEL);
    flash_pass(lds, KC, 64, VC, 64, 0, nct, qr, -1, nmax, ~0ull, -1, nmin_u, o, l);
    { const float sc = (l > 0.f) ? g_c / l : 0.f;
#pragma unroll
      for (int dh = 0; dh < 2; ++dh)
#pragma unroll
          for (int r = 0; r < 16; ++r) acc[dh][r] = o[dh][r] * sc; }
    flash_pass(lds, KC, 64, MS, 64, 0, nct, qr, -1, nmax, ~0ull, -1, nmin_u, o, l);
    { const float sc = (l > 0.f) ? 1.f / l : 0.f;
      __attribute__((address_space(3))) float* imp = (__attribute__((address_space(3))) float*)(lds + L_IMP) + (hh * 64 + ql) * 64;
#pragma unroll
      for (int dh = 0; dh < 2; ++dh)
#pragma unroll
          for (int r = 0; r < 16; ++r) imp[32 * dh + crow(r, hi)] = o[dh][r] * sc; }
    NSA_BAR();
    {
        __attribute__((address_space(3))) const float* impb = (__attribute__((address_space(3))) const float*)(lds + L_IMP);
        __attribute__((address_space(3))) unsigned long long* selp = (__attribute__((address_space(3))) unsigned long long*)(lds + L_SEL);
        const int m = lane, cur = qt;
        for (int qq = 8 * wid; qq < 8 * wid + 8; ++qq) {
            unsigned long long sel;
            if (cur < 16) sel = (2ull << cur) - 1ull;
            else {
                const float iv = ((impb[(0 * 64 + qq) * 64 + m] + impb[(1 * 64 + qq) * 64 + m]) + impb[(2 * 64 + qq) * 64 + m]) + impb[(3 * 64 + qq) * 64 + m];
                const bool cand = (m >= 1) && (m <= cur - 2);
                const unsigned bits = __float_as_uint(fmaxf(iv, 0.f));
                unsigned T = 0u;
                for (int bit = 30; bit >= 0; --bit) { const unsigned trial = T | (1u << bit); if (__popcll(__ballot(cand && bits >= trial)) >= 13) T = trial; }
                const unsigned long long gtm = __ballot(cand && bits > T); unsigned long long eqm = __ballot(cand && bits == T);
                int need = 13 - __popcll(gtm); unsigned long long tie = 0ull;
                while (need > 0 && eqm) { const unsigned long long lowb = eqm & (~eqm + 1ull); tie |= lowb; eqm ^= lowb; --need; }
                sel = gtm | tie | 1ull | (1ull << cur) | (1ull << (cur - 1));
            }
            if (lane == 0) selp[qq] = sel;
        }
    }
    NSA_BAR();
    const unsigned long long selmask = ((__attribute__((address_space(3))) const unsigned long long*)(lds + L_SEL))[ql];
    flash_pass(lds, Ybg + C_KS, EINP, Ybg + C_VS, EINP, 0, qt + 1, qr, -1, t, selmask, -1, 64 * qt, o, l);
    { const float sc = g_s / l;
#pragma unroll
      for (int dh = 0; dh < 2; ++dh)
#pragma unroll
          for (int r = 0; r < 16; ++r) acc[dh][r] += o[dh][r] * sc; }
    { const int wt0 = (qt >= 8) ? qt - 8 : 0;
      flash_pass(lds, Ybg + C_KW, EINP, Ybg + C_VW, EINP, wt0, qt - wt0 + 1, qr, t - 512, t, ~0ull, 64 * qt + 63 - 512, 64 * qt, o, l);
      const float sc = g_w / l;
#pragma unroll
      for (int dh = 0; dh < 2; ++dh)
#pragma unroll
          for (int r = 0; r < 16; ++r) acc[dh][r] += o[dh][r] * sc; }
    bf16_t* orow = (bf16_t*)(ws + SC_CAT) + (size_t)(b * SEQ + t) * DM + 512 + h * 64;
#pragma unroll
    for (int dh = 0; dh < 2; ++dh)
#pragma unroll
        for (int j = 0; j < 4; ++j) { u32x2 w; w.x = cvtpk(acc[dh][4 * j], acc[dh][4 * j + 1]); w.y = cvtpk(acc[dh][4 * j + 2], acc[dh][4 * j + 3]); *(u32x2*)(orow + 32 * dh + 8 * j + 4 * hi) = w; }
    NSA_WAITV(0);
}
DEV void nsa_phase(unsigned char* lds_raw, unsigned char* ws) {
    lds_u8* lds = (lds_u8*)lds_raw;
    const int G = gridDim.x, bx = blockIdx.x;
    const int vcu = (G % 8 == 0) ? (bx % 8) * (G / 8) + bx / 8 : bx;
    for (int p = vcu; p < 512; p += G) {
        const int bg = p >> 5, s = p & 31;
        nsa_unit(lds, ws, bg >> 1, bg & 1, 63 - s);
        nsa_unit(lds, ws, bg >> 1, bg & 1, s);
    }
}
#undef NSA_WAITV
#undef NSA_BAR
}

template <bool ROUTER>
DEV void ln_pass(const Ctx& c, const float* Z, const float* g, const float* b, bf16_t* X, int layer) {
    const Params& p = *c.p;
    const float* wg = p.in[25] + (size_t)layer * DM * 4; const float* bg = p.in[26] + layer * 4;
    const float* we = p.in[27] + (size_t)layer * DM * 32; const float* be = p.in[28] + layer * 32;
    int* cnt = (int*)(c.ws + WS_CTL) + layer * 32; int* list = (int*)(c.ws + WS_LIST); float* gate = (float*)(c.ws + WS_GATE);
    for (int row = c.gw; row < NT; row += c.ngw) {
        f32x4 v[4]; float s = 0.f;
#pragma unroll
        for (int j = 0; j < 4; ++j) { v[j] = *(const f32x4*)(Z + (size_t)row * DM + 256 * j + 4 * c.lane); s += (v[j].x + v[j].y) + (v[j].z + v[j].w); }
        const float mean = wsum(s) * (1.f / DM); float s2 = 0.f;
#pragma unroll
        for (int j = 0; j < 4; ++j) { v[j] = v[j] - mean; s2 += (v[j].x * v[j].x + v[j].y * v[j].y) + (v[j].z * v[j].z + v[j].w * v[j].w); }
        const float rstd = rsqrtf(wsum(s2) * (1.f / DM) + LN_EPS);
#pragma unroll
        for (int j = 0; j < 4; ++j) {
            const f32x4 gg = *(const f32x4*)(g + 256 * j + 4 * c.lane), bb = *(const f32x4*)(b + 256 * j + 4 * c.lane);
            v[j] = v[j] * rstd * gg + bb;
            st4bf(X + (size_t)row * DM + 256 * j + 4 * c.lane, v[j].x, v[j].y, v[j].z, v[j].w);
        }
        if (ROUTER) {
            float* xs = c.lds + c.wave * 1024;
#pragma unroll
            for (int j = 0; j < 4; ++j) *(f32x4*)(xs + 256 * j + 4 * c.lane) = v[j];
            LDS_WAIT();
            float lgt = 0.f;
            if (c.lane < 36) {
                const int o = c.lane;
                const float* wp = (o < 4) ? (wg + o) : (we + (o - 4));
                const int st = (o < 4) ? 4 : 32;
#pragma unroll 8
                for (int k = 0; k < DM; ++k) lgt += xs[k] * wp[(size_t)k * st];
                lgt += (o < 4) ? bg[o] : be[o - 4];
            }
            LDS_WAIT();
            float gl[4]; int gs = 0;
#pragma unroll
            for (int o = 0; o < 4; ++o) gl[o] = __shfl(lgt, o);
            float gm = gl[0];
#pragma unroll
            for (int o = 1; o < 4; ++o) if (gl[o] > gm) { gm = gl[o]; gs = o; }
            float den = 0.f;
#pragma unroll
            for (int o = 0; o < 4; ++o) den += __expf(gl[o] - gm);
            const float pgroup = 1.f / den;
            float el[8];
#pragma unroll
            for (int o = 0; o < 8; ++o) el[o] = __shfl(lgt, 4 + gs * 8 + o);
            int i0 = 0; float v0 = el[0];
#pragma unroll
            for (int o = 1; o < 8; ++o) if (el[o] > v0) { v0 = el[o]; i0 = o; }
            int i1 = -1; float v1 = -INFINITY;
#pragma unroll
            for (int o = 0; o < 8; ++o) if (o != i0 && el[o] > v1) { v1 = el[o]; i1 = o; }
            const float e1 = __expf(v1 - v0), g0 = pgroup / (1.f + e1), g1 = pgroup * e1 / (1.f + e1);
            if (c.lane < 2) {
                const int ex = gs * 8 + (c.lane == 0 ? i0 : i1);
                const int pos = atomicAdd(cnt + ex, 1);
                list[ex * LCAP + pos] = row * 2 + c.lane;
                gate[row * 2 + c.lane] = (c.lane == 0) ? g0 : g1;
            }
        }
    }
}

DEV void ln_router_pass(const Ctx& c, const float* Z, const float* g, const float* b, bf16_t* X, int layer) {
    const Params& p = *c.p;
    const float* bg = p.in[26] + layer * 4; const float* be = p.in[28] + layer * 32;
    const float* WT = (const float*)(c.ws + WS_RW) + (size_t)layer * 36 * DM;
    int* cnt = (int*)(c.ws + WS_CTL) + layer * 32; int* list = (int*)(c.ws + WS_LIST); float* gate = (float*)(c.ws + WS_GATE);
    int* lcnt = (int*)c.lds; int* lbase = lcnt + 32; int* asg = lcnt + 64;
    const int rpw = NT / gridDim.x, rows_per_wave = rpw / NWAVES;
    if (c.tid < 32) lcnt[c.tid] = 0;
    __syncthreads();
    constexpr int R = 8;
    for (int rr = 0; rr < rows_per_wave; rr += R) {
        const int lrow0 = c.wave * rows_per_wave + rr, row0 = blockIdx.x * rpw + lrow0;
        f32x4 v[R][4];
#pragma unroll
        for (int r = 0; r < R; ++r)
#pragma unroll
            for (int j = 0; j < 4; ++j) v[r][j] = *(const f32x4*)(Z + (size_t)(row0 + r) * DM + 256 * j + 4 * c.lane);
        f32x4 gg[4], bb[4];
#pragma unroll
        for (int j = 0; j < 4; ++j) { gg[j] = *(const f32x4*)(g + 256 * j + 4 * c.lane); bb[j] = *(const f32x4*)(b + 256 * j + 4 * c.lane); }
#pragma unroll
        for (int r = 0; r < R; ++r) {
            float s = 0.f;
#pragma unroll
            for (int j = 0; j < 4; ++j) s += (v[r][j].x + v[r][j].y) + (v[r][j].z + v[r][j].w);
            const float mean = wsum(s) * (1.f / DM); float s2 = 0.f;
#pragma unroll
            for (int j = 0; j < 4; ++j) { v[r][j] = v[r][j] - mean; s2 += (v[r][j].x * v[r][j].x + v[r][j].y * v[r][j].y) + (v[r][j].z * v[r][j].z + v[r][j].w * v[r][j].w); }
            const float rstd = rsqrtf(wsum(s2) * (1.f / DM) + LN_EPS);
#pragma unroll
            for (int j = 0; j < 4; ++j) { v[r][j] = v[r][j] * rstd * gg[j] + bb[j]; st4bf(X + (size_t)(row0 + r) * DM + 256 * j + 4 * c.lane, v[r][j].x, v[r][j].y, v[r][j].z, v[r][j].w); }
        }
        float mylg[R];
#pragma unroll
        for (int r = 0; r < R; ++r) mylg[r] = 0.f;
        for (int o = 0; o < 36; ++o) {
            f32x4 w[4];
#pragma unroll
            for (int j = 0; j < 4; ++j) w[j] = *(const f32x4*)(WT + (size_t)o * DM + 256 * j + 4 * c.lane);
#pragma unroll
            for (int r = 0; r < R; ++r) {
                float d = 0.f;
#pragma unroll
                for (int j = 0; j < 4; ++j) d += (v[r][j].x * w[j].x + v[r][j].y * w[j].y) + (v[r][j].z * w[j].z + v[r][j].w * w[j].w);
                d = wsum(d);
                mylg[r] = (c.lane == o) ? d : mylg[r];
            }
        }
        const float mybias = (c.lane < 4) ? bg[c.lane] : ((c.lane < 36) ? be[c.lane - 4] : 0.f);
#pragma unroll
        for (int r = 0; r < R; ++r) {
            const float lgt = mylg[r] + mybias;
            float gl[4]; int gs = 0;
#pragma unroll
            for (int o = 0; o < 4; ++o) gl[o] = __shfl(lgt, o);
            float gm = gl[0];
#pragma unroll
            for (int o = 1; o < 4; ++o) if (gl[o] > gm) { gm = gl[o]; gs = o; }
            float den = 0.f;
#pragma unroll
            for (int o = 0; o < 4; ++o) den += __expf(gl[o] - gm);
            const float pgroup = 1.f / den;
            float el[8];
#pragma unroll
            for (int o = 0; o < 8; ++o) el[o] = __shfl(lgt, 4 + gs * 8 + o);
            int i0 = 0; float v0 = el[0];
#pragma unroll
            for (int o = 1; o < 8; ++o) if (el[o] > v0) { v0 = el[o]; i0 = o; }
            int i1 = -1; float v1 = -INFINITY;
#pragma unroll
            for (int o = 0; o < 8; ++o) if (o != i0 && el[o] > v1) { v1 = el[o]; i1 = o; }
            const float e1 = __expf(v1 - v0), g0 = pgroup / (1.f + e1), g1 = pgroup * e1 / (1.f + e1);
            if (c.lane < 2) {
                const int ex = gs * 8 + (c.lane == 0 ? i0 : i1);
                const int lpos = atomicAdd(lcnt + ex, 1);
                asg[(lrow0 + r) * 2 + c.lane] = (ex << 16) | lpos;
                gate[(row0 + r) * 2 + c.lane] = (c.lane == 0) ? g0 : g1;
            }
        }
    }
    __syncthreads();
    if (c.tid < 32) lbase[c.tid] = atomicAdd(cnt + c.tid, lcnt[c.tid]);
    __syncthreads();
    for (int i = c.tid; i < 2 * rpw; i += NTHREADS) { const int a = asg[i], ex = a >> 16, lpos = a & 0xffff; list[ex * LCAP + lbase[ex] + lpos] = (blockIdx.x * rpw) * 2 + i; }
    __syncthreads();
}

DEV void xattn_naive(const Ctx& c) {
    const bf16_t* Q = (const bf16_t*)(c.ws + SC_Q); bf16_t* CTXo = (bf16_t*)(c.ws + SC_CTX);
    const bf16_t* MK = (const bf16_t*)(c.ws + WS_MEMK); const bf16_t* MV = (const bf16_t*)(c.ws + WS_MEMV);
    for (int it = c.gw; it < NT * 4; it += c.ngw) {
        const int h = it & 3, row = it >> 2, b = row >> 12;
        float q[4]; ld4bf(Q + (size_t)row * DM + h * 256 + 4 * c.lane, q);
#pragma unroll
        for (int i = 0; i < 4; ++i) q[i] *= 0.0625f;
        float ms = -INFINITY, ls = 0.f, o[4] = {0.f, 0.f, 0.f, 0.f};
        for (int m = 0; m < MEML; ++m) {
            float k4[4], v4[4]; ld4bf(MK + (size_t)(b * MEML + m) * DM + h * 256 + 4 * c.lane, k4); ld4bf(MV + (size_t)(b * MEML + m) * DM + h * 256 + 4 * c.lane, v4);
            float s = q[0] * k4[0] + q[1] * k4[1] + q[2] * k4[2] + q[3] * k4[3]; s = wsum(s);
            const float mn = fmaxf(ms, s), cf = __expf(ms - mn), pp = __expf(s - mn);
            ls = ls * cf + pp;
#pragma unroll
            for (int i = 0; i < 4; ++i) o[i] = o[i] * cf + pp * v4[i];
            ms = mn;
        }
        const float inv = 1.f / ls;
        st4bf(CTXo + (size_t)row * DM + h * 256 + 4 * c.lane, o[0] * inv, o[1] * inv, o[2] * inv, o[3] * inv);
    }
}

DEV int moe_nblk(const int* cnt) { int nb = 0; for (int e = 0; e < NEXP; ++e) nb += (cnt[e] + 255) >> 8; return nb; }
DEV void moe_find(const int* cnt, int pr, int& e, int& r) { int base = 0; e = 0; r = 0; for (int x = 0; x < NEXP; ++x) { const int nb = (cnt[x] + 255) >> 8; if (pr < (base + nb) * 256) { e = x; r = pr - base * 256; return; } base += nb; } e = NEXP - 1; r = 1 << 30; }
DEV void moe_gemm1(const Ctx& c, const bf16_t* X, int layer) {
    const int* cnt = (const int*)(c.ws + WS_CTL) + layer * 32; const int* list = (const int*)(c.ws + WS_LIST);
    const bf16_t* W13 = (const bf16_t*)(c.ws + WS_W13); bf16_t* H = (bf16_t*)(c.ws + SC_H);
    const int nblk = moe_nblk(cnt), mtiles = nblk * 4, ntiles = EH / 32;
    const int fr = c.lane & 15, fq = c.lane >> 4;
    for (int it = c.gw; it < mtiles * ntiles; it += c.ngw) {
        const int mt = it / ntiles, nt = it % ntiles;
        int e, r0; moe_find(cnt, mt * 64, e, r0);
        const int ce = cnt[e];
        const bf16_t* ap[4];
#pragma unroll
        for (int i = 0; i < 4; ++i) { const int r = r0 + i * 16 + fr; const int tok = (r < ce) ? (list[e * LCAP + r] >> 1) : 0; ap[i] = X + (size_t)tok * DM + fq * 8; }
        const bf16_t* b1[2]; const bf16_t* b3[2];
#pragma unroll
        for (int j = 0; j < 2; ++j) { const int n = nt * 32 + j * 16 + fr; b1[j] = W13 + (size_t)e * DM * DM + (size_t)((n >> 7) * 256 + (n & 127)) * DM + fq * 8; b3[j] = b1[j] + (size_t)128 * DM; }
        f32x4 a1[4][2], a3[4][2];
#pragma unroll
        for (int i = 0; i < 4; ++i)
#pragma unroll
            for (int j = 0; j < 2; ++j) { a1[i][j] = (f32x4){0.f, 0.f, 0.f, 0.f}; a3[i][j] = (f32x4){0.f, 0.f, 0.f, 0.f}; }
        for (int k0 = 0; k0 < DM; k0 += 32) {
            bf16x8 a[4], w1[2], w3[2];
#pragma unroll
            for (int i = 0; i < 4; ++i) a[i] = *(const bf16x8*)(ap[i] + k0);
#pragma unroll
            for (int j = 0; j < 2; ++j) { w1[j] = *(const bf16x8*)(b1[j] + k0); w3[j] = *(const bf16x8*)(b3[j] + k0); }
#pragma unroll
            for (int i = 0; i < 4; ++i)
#pragma unroll
                for (int j = 0; j < 2; ++j) { a1[i][j] = __builtin_amdgcn_mfma_f32_16x16x32_bf16(w1[j], a[i], a1[i][j], 0, 0, 0); a3[i][j] = __builtin_amdgcn_mfma_f32_16x16x32_bf16(w3[j], a[i], a3[i][j], 0, 0, 0); }
        }
#pragma unroll
        for (int i = 0; i < 4; ++i)
#pragma unroll
            for (int j = 0; j < 2; ++j) {
                const int pr = mt * 64 + i * 16 + fr, n = nt * 32 + j * 16 + 4 * fq;
                const f32x4 x1 = a1[i][j], x3 = a3[i][j];
                st4bf(H + (size_t)pr * EH + n, siluf_(x1.x) * x3.x, siluf_(x1.y) * x3.y, siluf_(x1.z) * x3.z, siluf_(x1.w) * x3.w);
            }
    }
}
struct BRowMoe2 { const bf16_t* W2; const int* cnt; DEV const bf16_t* operator()(int n, int mt) const { int e, r; moe_find(cnt, mt * 64, e, r); return W2 + (size_t)e * DM * EH + (size_t)n * EH; } };
struct EpiMoe2 { bf16_t* Y; const int* cnt; const int* list; const float* gate;
    DEV void operator()(int m, int n, f32x4 v) const { int e, r; moe_find(cnt, m, e, r); if (r < cnt[e]) { const int aid = list[e * LCAP + r]; const float gt = gate[aid]; st4bf(Y + (size_t)aid * DM + n, v.x * gt, v.y * gt, v.z * gt, v.w * gt); } } };
DEV void moe_gemm2(const Ctx& c, int layer) {
    const int* cnt = (const int*)(c.ws + WS_CTL) + layer * 32;
    const int nblk = moe_nblk(cnt);
    ARowPlain af{(const bf16_t*)(c.ws + SC_H), EH}; BRowMoe2 bf{(const bf16_t*)(c.ws + WS_W2), cnt};
    EpiMoe2 ef{(bf16_t*)(c.ws + SC_Y), cnt, (const int*)(c.ws + WS_LIST), (const float*)(c.ws + WS_GATE)};
    ngemm(c, nblk * 4, DM / 64, EH, af, bf, ef);
}
DEV void moe_combine(const Ctx& c, const bf16_t* Xin, const float* g, const float* b, bf16_t* Xo, float* outf) {
    const bf16_t* Y = (const bf16_t*)(c.ws + SC_Y);
    for (int row = c.gw; row < NT; row += c.ngw) {
        f32x4 v[4]; float s = 0.f;
#pragma unroll
        for (int j = 0; j < 4; ++j) {
            float x[4], y0[4], y1[4]; const int col = 256 * j + 4 * c.lane;
            ld4bf(Xin + (size_t)row * DM + col, x); ld4bf(Y + (size_t)(2 * row) * DM + col, y0); ld4bf(Y + (size_t)(2 * row + 1) * DM + col, y1);
            v[j] = (f32x4){x[0] * DN_ALPHA + (y0[0] + y1[0]), x[1] * DN_ALPHA + (y0[1] + y1[1]), x[2] * DN_ALPHA + (y0[2] + y1[2]), x[3] * DN_ALPHA + (y0[3] + y1[3])};
            s += (v[j].x + v[j].y) + (v[j].z + v[j].w);
        }
        const float mean = wsum(s) * (1.f / DM); float s2 = 0.f;
#pragma unroll
        for (int j = 0; j < 4; ++j) { v[j] = v[j] - mean; s2 += (v[j].x * v[j].x + v[j].y * v[j].y) + (v[j].z * v[j].z + v[j].w * v[j].w); }
        const float rstd = rsqrtf(wsum(s2) * (1.f / DM) + LN_EPS);
#pragma unroll
        for (int j = 0; j < 4; ++j) {
            const int col = 256 * j + 4 * c.lane;
            const f32x4 gg = *(const f32x4*)(g + col), bb = *(const f32x4*)(b + col);
            v[j] = v[j] * rstd * gg + bb;
            if (Xo) st4bf(Xo + (size_t)row * DM + col, v[j].x, v[j].y, v[j].z, v[j].w);
            if (outf) *(f32x4*)(outf + (size_t)row * DM + col) = v[j];
        }
    }
}

DEV void odd_conv(const Ctx& c) {
    const bf16_t* Y1 = (const bf16_t*)(c.ws + SC_Y0); bf16_t* V = (bf16_t*)(c.ws + WS_XA);
    const float* cw = c.p->in[17];
    for (int row = c.gw; row < NT; row += c.ngw) {
        const int t = row & (SEQ - 1);
#pragma unroll
        for (int j = 0; j < 4; ++j) {
            const int col = 256 * j + 4 * c.lane;
            float acc[4] = {0.f, 0.f, 0.f, 0.f};
#pragma unroll
            for (int k = 0; k < 3; ++k) {
                if (t - 2 + k >= 0) {
                    const bf16_t* yr = Y1 + (size_t)(row - 2 + k) * 3072;
                    float gcv[4], hv[4]; ld4bf(yr + 1024 + col, gcv); ld4bf(yr + 2048 + col, hv);
                    const f32x4 w = *(const f32x4*)(cw + k * DM + col);
                    acc[0] += w.x * gcv[0] * hv[0]; acc[1] += w.y * gcv[1] * hv[1]; acc[2] += w.z * gcv[2] * hv[2]; acc[3] += w.w * gcv[3] * hv[3];
                }
            }
            float gb[4]; ld4bf(Y1 + (size_t)row * 3072 + col, gb);
            st4bf(V + (size_t)row * DM + col, gb[0] * acc[0], gb[1] * acc[1], gb[2] * acc[2], gb[3] * acc[3]);
        }
    }
}

#define XB_TMO      128
#define XB_XCNT(j)  (256  + 64 * (j))
#define XB_XSUB(j)  (1280 + 64 * (j))
#define XB_XGEN(j)  (2304 + 64 * (j))
#define XB_TOP      3328
#define XB_TOPGEN   3392
#define XCD_BAR_WORDS 3456
#define XB_SPIN_CAP (1u << 22)
DEV unsigned xb_ld(unsigned* p)              { return __hip_atomic_load(p, __ATOMIC_RELAXED, __HIP_MEMORY_SCOPE_AGENT); }
DEV unsigned xb_add(unsigned* p, unsigned v) { return __hip_atomic_fetch_add(p, v, __ATOMIC_RELAXED, __HIP_MEMORY_SCOPE_AGENT); }
DEV unsigned xb_xcc_id() { return (unsigned)__builtin_amdgcn_s_getreg((3 << 11) | 20) & 0xFu; }
#define XB_SPIN(cond, bar) do { unsigned _sp = 0; while (cond) { __builtin_amdgcn_s_sleep(1); \
    if ((++_sp & 255u) == 0u) { if (xb_ld(&(bar)[XB_TMO])) break; if (_sp > XB_SPIN_CAP) { atomicAdd(&(bar)[XB_TMO], 1u); break; } } } } while (0)
struct XcdBarrier { unsigned* bar; unsigned x; volatile __attribute__((address_space(3))) unsigned* st; };
DEV XcdBarrier xcd_barrier_post(unsigned* bar, volatile __attribute__((address_space(3))) unsigned* st) {
    XcdBarrier b; b.bar = bar; b.x = xb_xcc_id(); b.st = st;
    if (threadIdx.x == 0) (void)xb_add(&bar[XB_XCNT(b.x)], 1u);
    return b;
}
DEV void xcd_barrier_complete(unsigned* bar, unsigned x, unsigned& nloc, unsigned& nx) {
    const unsigned G = gridDim.x * gridDim.y * gridDim.z;
    unsigned sum, cnt, mine, sp = 0u;
    for (;;) {
        sum = 0u; cnt = 0u; mine = 0u;
#pragma unroll
        for (unsigned j = 0; j < 16; ++j) { const unsigned cc = xb_ld(&bar[XB_XCNT(j)]); sum += cc; cnt += (cc > 0u) ? 1u : 0u; mine = (j == x) ? cc : mine; }
        if (sum == G) break;
        __builtin_amdgcn_s_sleep(1);
        if ((++sp & 255u) == 0u) { if (xb_ld(&bar[XB_TMO])) break; if (sp > XB_SPIN_CAP) { atomicAdd(&bar[XB_TMO], 1u); break; } }
    }
    nloc = mine > 0u ? mine : 1u; nx = cnt > 0u ? cnt : 1u;
}
DEV void xcd_barrier(const XcdBarrier& b) {
    asm volatile("s_waitcnt vmcnt(0)" ::: "memory");
    __syncthreads();
    if (threadIdx.x == 0) {
        unsigned* bar = b.bar;
        __builtin_amdgcn_s_waitcnt(0);
        unsigned nloc = b.st[0], nx = b.st[1];
        if (nloc == 0u) { xcd_barrier_complete(bar, b.x, nloc, nx); b.st[0] = nloc; b.st[1] = nx; }
        const unsigned old = xb_add(&bar[XB_XSUB(b.x)], 1u);
        const unsigned gen = old / nloc;
        if (old + 1u == (gen + 1u) * nloc) {
            __builtin_amdgcn_fence(__ATOMIC_RELEASE, "agent");
            asm volatile("s_waitcnt vmcnt(0)" ::: "memory");
            const unsigned og = xb_add(&bar[XB_TOP], 1u);
            const unsigned tg = og / nx;
            if (og + 1u == (tg + 1u) * nx) xb_add(&bar[XB_TOPGEN], 1u);
            else XB_SPIN(xb_ld(&bar[XB_TOPGEN]) == tg, bar);
            __builtin_amdgcn_fence(__ATOMIC_ACQUIRE, "agent");
            xb_add(&bar[XB_XGEN(b.x)], 1u);
            asm volatile("s_waitcnt vmcnt(0)" ::: "memory");
        } else {
            XB_SPIN(xb_ld(&bar[XB_XGEN(b.x)]) == gen, bar);
            __builtin_amdgcn_fence(__ATOMIC_ACQUIRE, "agent");
            asm volatile("s_waitcnt vmcnt(0)" ::: "memory");
        }
    }
    __syncthreads();
}

constexpr int N_PHASES = 27;
constexpr int LDS_BYTES = 147456;
__global__ void __launch_bounds__(NTHREADS, 2) fwd_kernel(Params prm) {
    extern __shared__ __attribute__((aligned(16))) unsigned char lds_raw[];
    volatile __attribute__((address_space(3))) unsigned* bst = (volatile __attribute__((address_space(3))) unsigned*)((__attribute__((address_space(3))) unsigned char*)lds_raw + LDS_BYTES - 16);
    if (threadIdx.x < 4) bst[threadIdx.x] = 0u;
    __syncthreads();
    XcdBarrier xbar; xbar.bar = (unsigned*)(prm.ws + WS_CTL) + 1024; xbar.x = 0; xbar.st = bst;
    if (prm.ph_hi - prm.ph_lo > 1) xbar = xcd_barrier_post((unsigned*)(prm.ws + WS_CTL) + 1024, bst);
    Ctx c; c.p = &prm; c.ws = prm.ws; c.lds = (float*)lds_raw;
    c.tid = threadIdx.x; c.lane = c.tid & 63; c.wave = __builtin_amdgcn_readfirstlane(c.tid >> 6);
    c.gw = blockIdx.x * NWAVES + c.wave; c.ngw = gridDim.x * NWAVES;
    unsigned char* ws = prm.ws;
    PG8_LAS unsigned char* ldsp = (PG8_LAS unsigned char*)lds_raw;
#define XA ((bf16_t*)(ws + WS_XA))
#define XB ((bf16_t*)(ws + WS_XB))
#define Z ((float*)(ws + SC_Z))
    const float* const* in = prm.in;
#ifndef ONLY_PHASE
#define ONLY_PHASE -1
#endif
#ifndef PROBE_MASK
#define PROBE_MASK 0ull
#endif
#define PHASE(k, ...) if ((ONLY_PHASE < 0 || ONLY_PHASE == (k)) && prm.ph_lo <= (k) && (k) < prm.ph_hi) { asm volatile("" : "+s"(ws)); for (int rep_ = 0; rep_ < 1 + (int)((PROBE_MASK >> (k)) & 1ull); ++rep_) { __VA_ARGS__; } if ((k) + 1 < prm.ph_hi) { if ((k) == 0) { __threadfence(); cg::this_grid().sync(); } else xcd_barrier(xbar); } }
    PHASE(0, phase_prep(c))
    PHASE(1, { pg8::PlainTask<pg8::EpiInproj, true> T{XA, DM, (const bf16_t*)(ws + WS_W_IN), DM, DM, {}, {(bf16_t*)(ws + SC_Y0)}}; T.S.init(NT, EINP, gridDim.x, blockIdx.x); pg8::gemm_phase(ldsp, T); })
    PHASE(2, {
        const int bx = blockIdx.x;
        if (bx < 64) { pg8::CmpTask T{DM, ws, bx}; pg8::gemm_phase(ldsp, T); }
        else if (bx < 128) {
            const int j = (bx - 64) & 31; const bool isv = bx >= 96;
            pg8::OneUnitTask T{DM, (const bf16_t*)(ws + (isv ? WS_WV : WS_MEMB)), (const bf16_t*)(ws + (isv ? WS_MEMB : WS_WK)), (bf16_t*)(ws + (isv ? WS_MEMV : WS_MEMK)), isv ? MEML : DM,
                               isv ? (size_t)256 * MEML : (size_t)256 * DM, isv ? (size_t)DM * MEML : (size_t)256, isv ? (j >> 3) : (j >> 2), isv ? (j & 7) : (j & 3), true};
            pg8::gemm_phase(ldsp, T); }
        } conv_branch(c))
    PHASE(3, cmp_finish(c))
    PHASE(4, nsa::nsa_phase(lds_raw, ws))
    PHASE(5, { pg8::PlainTask<pg8::EpiRes<true>, false> T{(const bf16_t*)(ws + SC_CAT), DM, (const bf16_t*)(ws + WS_W_OUT), DM, DM, {}, {Z, in[0]}}; T.S.init(NT, DM, gridDim.x, blockIdx.x); pg8::gemm_phase(ldsp, T); })
    PHASE(6, ln_pass<false>(c, Z, in[19], in[20], XB, 0))
    PHASE(7, { pg8::PlainTask<pg8::EpiBf16S, true> T{XB, DM, (const bf16_t*)(ws + WS_WQ), DM, DM, {}, {(bf16_t*)(ws + SC_Q), DM, 0.0625f * 1.4426950408889634f}}; T.S.init(NT, DM, gridDim.x, blockIdx.x); pg8::gemm_phase(ldsp, T); })
    PHASE(8, { pg8::XaSTask T{256, (const bf16_t*)(ws + SC_Q), (const bf16_t*)(ws + WS_MEMK), (bf16_t*)(ws + SC_P), ldsp, {}}; T.S.init(NT, DM, gridDim.x, blockIdx.x); pg8::gemm_phase(ldsp, T); })
    PHASE(9, { pg8::XaPVTask T{256, (const bf16_t*)(ws + SC_P), (const bf16_t*)(ws + WS_MEMV), (bf16_t*)(ws + SC_CTX), {}}; T.S.init(NT, DM, gridDim.x, blockIdx.x); pg8::gemm_phase(ldsp, T); })
    PHASE(10, { pg8::PlainTask<pg8::EpiRes<false>, false> T{(const bf16_t*)(ws + SC_CTX), DM, (const bf16_t*)(ws + WS_WO), DM, DM, {}, {Z, XB}}; T.S.init(NT, DM, gridDim.x, blockIdx.x); pg8::gemm_phase(ldsp, T); })
    PHASE(11, ln_router_pass(c, Z, in[23], in[24], XA, 0))
    PHASE(12, { const int* cnt = (const int*)(ws + WS_CTL) + 0 * 32; PG8_LAS int* tab = (PG8_LAS int*)(ldsp + pg8::LDS_SPARE); pg8::moe_build_tab(cnt, tab);
        pg8::Moe1Task T{DM, XA, (const bf16_t*)(ws + WS_W13), (bf16_t*)(ws + SC_H), cnt, (const int*)(ws + WS_LIST), tab, (int)gridDim.x, (int)blockIdx.x}; pg8::gemm_phase(ldsp, T); })
    PHASE(13, { const int* cnt = (const int*)(ws + WS_CTL) + 0 * 32; PG8_LAS int* tab = (PG8_LAS int*)(ldsp + pg8::LDS_SPARE); pg8::moe_build_tab(cnt, tab);
        pg8::Moe2Task T{EH, (const bf16_t*)(ws + SC_H), (const bf16_t*)(ws + WS_W2), (bf16_t*)(ws + SC_Y), cnt, (const int*)(ws + WS_LIST), (const float*)(ws + WS_GATE), tab, (int)gridDim.x, (int)blockIdx.x}; pg8::gemm_phase(ldsp, T); })
    PHASE(14, moe_combine(c, XA, in[32], in[33], XB, nullptr); moe_weights(c, 1))
    PHASE(15, { pg8::PlainTask<pg8::EpiBf16, true> T{XB, DM, (const bf16_t*)(ws + WS_OD_IN), DM, DM, {}, {(bf16_t*)(ws + SC_Y0), 3 * DM}}; T.S.init(NT, 3 * DM, gridDim.x, blockIdx.x); pg8::gemm_phase(ldsp, T); })
    PHASE(16, odd_conv(c))
    PHASE(17, { pg8::PlainTask<pg8::EpiRes<false>, false> T{XA, DM, (const bf16_t*)(ws + WS_OD_OUT), DM, DM, {}, {Z, XB}}; T.S.init(NT, DM, gridDim.x, blockIdx.x); pg8::gemm_phase(ldsp, T); })
    PHASE(18, ln_pass<false>(c, Z, in[19] + DM, in[20] + DM, XA, 1))
    PHASE(19, { pg8::PlainTask<pg8::EpiBf16S, true> T{XA, DM, (const bf16_t*)(ws + WS_WQ) + (size_t)DM * DM, DM, DM, {}, {(bf16_t*)(ws + SC_Q), DM, 0.0625f * 1.4426950408889634f}}; T.S.init(NT, DM, gridDim.x, blockIdx.x); pg8::gemm_phase(ldsp, T); })
    PHASE(20, { pg8::XaSTask T{256, (const bf16_t*)(ws + SC_Q), (const bf16_t*)(ws + WS_MEMK), (bf16_t*)(ws + SC_P), ldsp, {}}; T.S.init(NT, DM, gridDim.x, blockIdx.x); pg8::gemm_phase(ldsp, T); })
    PHASE(21, { pg8::XaPVTask T{256, (const bf16_t*)(ws + SC_P), (const bf16_t*)(ws + WS_MEMV), (bf16_t*)(ws + SC_CTX), {}}; T.S.init(NT, DM, gridDim.x, blockIdx.x); pg8::gemm_phase(ldsp, T); })
    PHASE(22, { pg8::PlainTask<pg8::EpiRes<false>, false> T{(const bf16_t*)(ws + SC_CTX), DM, (const bf16_t*)(ws + WS_WO) + (size_t)DM * DM, DM, DM, {}, {Z, XA}}; T.S.init(NT, DM, gridDim.x, blockIdx.x); pg8::gemm_phase(ldsp, T); })
    PHASE(23, ln_router_pass(c, Z, in[23] + DM, in[24] + DM, XB, 1))
    PHASE(24, { const int* cnt = (const int*)(ws + WS_CTL) + 1 * 32; PG8_LAS int* tab = (PG8_LAS int*)(ldsp + pg8::LDS_SPARE); pg8::moe_build_tab(cnt, tab);
        pg8::Moe1Task T{DM, XB, (const bf16_t*)(ws + WS_W13), (bf16_t*)(ws + SC_H), cnt, (const int*)(ws + WS_LIST), tab, (int)gridDim.x, (int)blockIdx.x}; pg8::gemm_phase(ldsp, T); })
    PHASE(25, { const int* cnt = (const int*)(ws + WS_CTL) + 1 * 32; PG8_LAS int* tab = (PG8_LAS int*)(ldsp + pg8::LDS_SPARE); pg8::moe_build_tab(cnt, tab);
        pg8::Moe2Task T{EH, (const bf16_t*)(ws + SC_H), (const bf16_t*)(ws + WS_W2), (bf16_t*)(ws + SC_Y), cnt, (const int*)(ws + WS_LIST), (const float*)(ws + WS_GATE), tab, (int)gridDim.x, (int)blockIdx.x}; pg8::gemm_phase(ldsp, T); })
    PHASE(26, moe_combine(c, XB, in[32] + DM, in[33] + DM, nullptr, prm.out))
}

extern "C" void kernel_launch(void* const* d_in, const int* in_sizes, int n_in, void* d_out, int out_size, void* d_ws, size_t ws_size, hipStream_t stream) {
    static int grid = 0;
    if (grid == 0) {
        if (n_in != 34 || ws_size < WS_END) { fprintf(stderr, "kernel_launch: unexpected n_in %d or ws_size %zu\n", n_in, ws_size); grid = -1; return; }
        int dev = 0, cus = 0, per_cu = 0;
        (void)hipGetDevice(&dev);
        (void)hipDeviceGetAttribute(&cus, hipDeviceAttributeMultiprocessorCount, dev);
        (void)hipFuncSetAttribute((const void*)fwd_kernel, hipFuncAttributeMaxDynamicSharedMemorySize, LDS_BYTES);
        (void)hipOccupancyMaxActiveBlocksPerMultiprocessor(&per_cu, (const void*)fwd_kernel, NTHREADS, LDS_BYTES);
        if (per_cu < 1) { fprintf(stderr, "kernel_launch: occupancy query says %d blocks/CU\n", per_cu); per_cu = 1; }
        grid = cus * per_cu;
    }
    if (grid < 0) return;
    (void)hipMemsetAsync(d_ws, 0, 65536, stream);
    Params prm{};
    for (int i = 0; i < 34; ++i) prm.in[i] = (const float*)d_in[i];
    prm.out = (float*)d_out; prm.ws = (unsigned char*)d_ws;
#if N_LAUNCH_MODE == 1
    for (int ph = 0; ph < N_PHASES; ++ph) {
        prm.ph_lo = ph; prm.ph_hi = ph + 1;
        hipLaunchKernelGGL(fwd_kernel, dim3(grid), dim3(NTHREADS), LDS_BYTES, stream, prm);
    }
#else
    prm.ph_lo = 0; prm.ph_hi = N_PHASES;
    void* args[] = {&prm};
    hipError_t e = hipLaunchCooperativeKernel((const void*)fwd_kernel, dim3(grid), dim3(NTHREADS), args, LDS_BYTES, stream);
    if (e != hipSuccess) fprintf(stderr, "cooperative launch failed: %s (grid %d)\n", hipGetErrorString(e), grid);
#ifdef PROBE_PHASES
    {
        static const int pl[] = PROBE_PHASES;
        for (unsigned i = 0; i < sizeof(pl) / sizeof(pl[0]); ++i) { prm.ph_lo = pl[i]; prm.ph_hi = pl[i] + 1; hipLaunchKernelGGL(fwd_kernel, dim3(grid), dim3(NTHREADS), LDS_BYTES, stream, prm); }
    }
#endif
#endif
}
```

```cpp
#include <hip/hip_runtime.h>
#include <hip/hip_cooperative_groups.h>
#include <cstdint>
#include <cstdio>
namespace cg = cooperative_groups;

#ifndef N_LAUNCH_MODE
#define N_LAUNCH_MODE 0
#endif

typedef unsigned short bf16_t;
typedef short bf16x8 __attribute__((ext_vector_type(8)));
typedef float f32x4 __attribute__((ext_vector_type(4)));
typedef unsigned u32x4 __attribute__((ext_vector_type(4)));
typedef unsigned u32x2 __attribute__((ext_vector_type(2)));
#define DEV __device__ __forceinline__

constexpr int NB = 8, SEQ = 4096, DM = 1024, NT = NB * SEQ;
constexpr int MEML = 256, NMEM = NB * MEML;
constexpr int EIN = 2328, EINP = 2560;
constexpr int C_AV = 0, C_AG = 512, C_Q = 1024, C_KC = 1536, C_VC = 1664, C_KS = 1792, C_VS = 1920, C_KW = 2048, C_VW = 2176, C_GL = 2304;
constexpr int NCMP = 255;
constexpr int NEXP = 32, EH = 512, LCAP = 32768;
constexpr float DN_ALPHA = 1.41421356237f;
constexpr float LN_EPS = 1e-5f;
constexpr int NWAVES = 8, NTHREADS = 512;

constexpr size_t MiB = 1u << 20;
constexpr size_t WS_CTL = 0;
constexpr size_t WS_CMPB = 1 * MiB;
constexpr size_t WS_CMPP = 1 * MiB + 393216;
constexpr size_t WS_MSEL = 1 * MiB + 65536;
constexpr size_t WS_RWB = 1 * MiB + 524288;
constexpr size_t WS_KCMP = 2 * MiB;
constexpr size_t WS_VCMP = 3 * MiB;
constexpr size_t WS_PK = 4 * MiB;
constexpr size_t WS_PV = 12 * MiB;
constexpr size_t WS_LIST = 20 * MiB;
constexpr size_t WS_GATE = 24 * MiB;
constexpr size_t WS_APOS = 24 * MiB + 262144;
constexpr size_t WS_MEMB = 25 * MiB;
constexpr size_t WS_MEMK = 29 * MiB;
constexpr size_t WS_MEMV = 33 * MiB;
constexpr size_t WS_XBUF = 37 * MiB;
constexpr size_t WS_W_IN = 40 * MiB;
constexpr size_t WS_W_OUT = 45 * MiB;
constexpr size_t WS_OD_IN = 47 * MiB;
constexpr size_t WS_OD_OUT = 53 * MiB;
constexpr size_t WS_WQ = 55 * MiB;
constexpr size_t WS_WO = 59 * MiB;
constexpr size_t WS_WK = 63 * MiB;
constexpr size_t WS_WV = 65 * MiB;
constexpr size_t WS_CW1 = 67 * MiB;
constexpr size_t WS_W13 = 72 * MiB;
constexpr size_t WS_W2 = 136 * MiB;
constexpr size_t WS_XA = 168 * MiB;
constexpr size_t WS_XB = 232 * MiB;
constexpr size_t WS_SCR = 296 * MiB;
constexpr size_t WS_MT = 520 * MiB;
constexpr size_t WS_NT = 536 * MiB;
constexpr size_t WS_W2B = 552 * MiB;
constexpr size_t WS_END = 568 * MiB;
constexpr size_t SC_Y0 = WS_SCR;
constexpr size_t SC_CAT = WS_SCR + 160 * MiB;
constexpr size_t SC_Z = WS_SCR;
constexpr size_t SC_Q = WS_SCR;
constexpr size_t SC_P = WS_SCR + 64 * MiB;
constexpr size_t SC_CTX = WS_SCR + 128 * MiB;
constexpr size_t SC_H = WS_SCR;
constexpr size_t SC_Y = WS_SCR + 80 * MiB;

DEV float bf2f(bf16_t b) { return __uint_as_float(((unsigned)b) << 16); }
DEV unsigned f2bf(float f) { unsigned u = __float_as_uint(f); return (u + 0x7fffu + ((u >> 16) & 1u)) >> 16; }
DEV unsigned pk2(float lo, float hi) { typedef float f2_t __attribute__((ext_vector_type(2))); typedef __bf16 b2_t __attribute__((ext_vector_type(2))); f2_t v = {lo, hi}; b2_t b = __builtin_convertvector(v, b2_t); return __builtin_bit_cast(unsigned, b); }
DEV float wsum(float v) {
#pragma unroll
    for (int o = 1; o < 64; o <<= 1) v += __shfl_xor(v, o);
    return v;
}
DEV float wsum_dpp(float v) {
#define DPP_ADD(ctrl, rmask) v += __builtin_bit_cast(float, __builtin_amdgcn_update_dpp(0, __builtin_bit_cast(int, v), ctrl, rmask, 0xF, false))
    DPP_ADD(0xB1, 0xF);
    DPP_ADD(0x4E, 0xF);
    DPP_ADD(0x141, 0xF);
    DPP_ADD(0x140, 0xF);
    DPP_ADD(0x142, 0xA);
    DPP_ADD(0x143, 0xC);
#undef DPP_ADD
    return __builtin_bit_cast(float, __builtin_amdgcn_readlane(__builtin_bit_cast(int, v), 63));
}
DEV float gsum16(float v) { v += __shfl_xor(v, 1); v += __shfl_xor(v, 2); v += __shfl_xor(v, 4); v += __shfl_xor(v, 8); return v; }
DEV float frcp(float x) { return __builtin_amdgcn_rcpf(x); }
DEV float sigmoidf_(float x) { return frcp(1.f + __expf(-x)); }
DEV float siluf_(float x) { return x * frcp(1.f + __expf(-x)); }
DEV float gelu_tanh(float x) { const float u = 0.7978845608028654f * (x + 0.044715f * x * x * x); return 0.5f * x * (1.f + tanhf(u)); }
#define LDS_WAIT() asm volatile("s_waitcnt lgkmcnt(0)" ::: "memory")
DEV void ld4bf(const bf16_t* p, float* o) { const u32x2 w = *(const u32x2*)p; o[0] = __uint_as_float(w.x << 16); o[1] = __uint_as_float(w.x & 0xffff0000u); o[2] = __uint_as_float(w.y << 16); o[3] = __uint_as_float(w.y & 0xffff0000u); }
DEV void st4bf(bf16_t* p, float a, float b, float c, float d) { u32x2 w; w.x = pk2(a, b); w.y = pk2(c, d); *(u32x2*)p = w; }

DEV const float* gptr(const float* x) { return (const float*)(const __attribute__((address_space(1))) float*)x; }
struct Params {
    const float* in[34];
    float* out;
    unsigned char* ws;
    int ph_lo, ph_hi;
};
typedef const __attribute__((address_space(4))) Params* KParams;
struct Ctx {
    KParams p;
    unsigned char* ws;
    float* lds;
    int tid, lane, wave, gw, ngw;
};

namespace pg8 {
#define PG8_LAS __attribute__((address_space(3)))
constexpr int BM = 256, BK = 64, HALF = 128, HTB = HALF * BK * 2, STAGE_BYTES = 8 * HTB, NXCD = 8, WGM = 8;
DEV int lds_byte(int r, int c) { const int st = (r >> 4) * 2 + (c >> 5), rr = r & 15, cc = c & 31, ob = rr * 64 + cc * 2; return st * 1024 + (ob ^ (((ob >> 9) & 1) << 5)); }
DEV void stage_rc(int b, int& R, int& C) { const int st = b / 1024, sb = b % 1024, swz = sb ^ (((sb >> 9) & 1) << 5); R = (st >> 1) * 16 + swz / 64; C = (st & 1) * 32 + (swz % 64) / 2; }
DEV int perm32(int rho) { const int n = rho >> 4, i = rho & 15; return 8 * (i >> 2) + 4 * n + (i & 3); }
struct Unit { int pm, pn, aux; };
struct StaticOrder {
    int nM, nN, nwg, G, c;
    DEV void init(int M, int N, int G_, int c_) { nM = M / BM; nN = N / BM; nwg = nM * nN; G = G_; c = c_; }
    DEV bool next(int i, Unit& u) const {
        const long L = (long)i * G + c; if (L >= nwg) return false;
        int wgid = (int)L; { const int q = nwg / NXCD, r = nwg % NXCD, xcd = wgid % NXCD, off = wgid / NXCD; wgid = (xcd < r ? xcd * (q + 1) : r * (q + 1) + (xcd - r) * q) + off; }
        const int nig = WGM * nN, gid = wgid / nig, fm = gid * WGM, gsz = (nM - fm) < WGM ? (nM - fm) : WGM;
        u.pm = fm + ((wgid % nig) % gsz); u.pn = (wgid % nig) / gsz; u.aux = 0; return true;
    }
};
DEV unsigned cvt_pk_bf16(float lo, float hi) { unsigned r; asm volatile("v_cvt_pk_bf16_f32 %0, %1, %2" : "=v"(r) : "v"(lo), "v"(hi)); return r; }
typedef f32x4 Acc[2][2][4][2];

template <class Task, bool DRAINED = false>
DEV void gemm_phase(PG8_LAS unsigned char* lds, const Task& T) {
    const int tid = threadIdx.x, wid = __builtin_amdgcn_readfirstlane(tid >> 6), lane = tid & 63, wr = wid >> 2, wc = wid & 3, fr = lane & 15, fq = lane >> 4;
    const int nt = T.K / BK;
    int R[2], C[2]; unsigned voffB[2];
#pragma unroll
    for (int i = 0; i < 2; ++i) { stage_rc(tid * 16 + i * 8192, R[i], C[i]); const int Rb = Task::PERM ? ((R[i] & ~31) + perm32(R[i] & 31)) : R[i]; voffB[i] = (unsigned)(Rb * T.ldb() + C[i]) * 2u; }
    const size_t kstepB = (size_t)(BK * 2);
    const size_t hstepB = (size_t)HALF * T.ldb() * 2;
    const unsigned ldsw = (unsigned)wid * 1024u;
    const int aoff = lds_byte(wr * 64 + fr, fq * 8), boff = lds_byte(wc * 32 + fr, fq * 8);
#define PG8_SA(b, h) (((b) * 2 + (h)) * HTB)
#define PG8_SB(b, h) ((4 + (b) * 2 + (h)) * HTB)
#define PG8_STAGE(bufoff, gbase, voff) do { _Pragma("unroll") for (int _i = 0; _i < 2; ++_i) \
        __builtin_amdgcn_global_load_lds((const unsigned*)((const char*)(gbase) + (voff)[_i]), (PG8_LAS unsigned*)(lds + (bufoff) + ldsw + _i * 8192), 16, 0, 0); } while (0)
#define PG8_LDA(dst, b, h) do { _Pragma("unroll") for (int m = 0; m < 4; ++m) _Pragma("unroll") for (int k = 0; k < 2; ++k) dst[m][k] = *(const PG8_LAS bf16x8*)(lds + PG8_SA(b, h) + aoff + m * 2048 + k * 1024); } while (0)
#define PG8_LDB(dst, b, h) do { _Pragma("unroll") for (int n = 0; n < 2; ++n) _Pragma("unroll") for (int k = 0; k < 2; ++k) dst[n][k] = *(const PG8_LAS bf16x8*)(lds + PG8_SB(b, h) + boff + n * 2048 + k * 1024); } while (0)
#define PG8_MMA(ai, bj, At, Bt) do { __builtin_amdgcn_s_setprio(1); _Pragma("unroll") for (int m = 0; m < 4; ++m) _Pragma("unroll") for (int n = 0; n < 2; ++n) _Pragma("unroll") for (int k = 0; k < 2; ++k) \
        acc[ai][bj][m][n] = __builtin_amdgcn_mfma_f32_16x16x32_bf16(Bt[n][k], At[m][k], acc[ai][bj][m][n], 0, 0, 0); __builtin_amdgcn_s_setprio(0); } while (0)
#define PG8_WAIT_V(n) asm volatile("s_waitcnt vmcnt(" #n ")" ::: "memory")
#define PG8_WAIT_L(n) asm volatile("s_waitcnt lgkmcnt(" #n ")" ::: "memory")
#define PG8_BAR __builtin_amdgcn_s_barrier()
#define PG8_SCHED __builtin_amdgcn_sched_barrier(0)
    Unit cur, nxt; int ui = 0;
    if (!T.next(0, cur)) return;
    Acc acc;
#pragma unroll
    for (int a = 0; a < 2; ++a)
#pragma unroll
        for (int b = 0; b < 2; ++b)
#pragma unroll
            for (int m = 0; m < 4; ++m)
#pragma unroll
                for (int n = 0; n < 2; ++n) acc[a][b][m][n] = (f32x4){0.f, 0.f, 0.f, 0.f};
    bf16x8 At[4][2], B0[2][2], B1[2][2];
    unsigned va[2][2], na[2][2];
    T.a_offs(cur, R, C, va);
    const char* cA = T.a_base(cur); const char* cB = T.b_base(cur); size_t kstepA = T.a_kstep(cur), kstepN = kstepA;
    PG8_STAGE(PG8_SB(0, 0), cB, voffB); PG8_STAGE(PG8_SB(0, 1), cB + hstepB, voffB); PG8_STAGE(PG8_SA(0, 0), cA, va[0]); PG8_STAGE(PG8_SA(0, 1), cA, va[1]);
    if (wr == 1) PG8_BAR;
    PG8_WAIT_V(2); PG8_BAR;
    PG8_STAGE(PG8_SB(1, 0), cB + kstepB, voffB); PG8_STAGE(PG8_SA(1, 0), cA + kstepA, va[0]); PG8_STAGE(PG8_SB(1, 1), cB + hstepB + kstepB, voffB);
    PG8_WAIT_V(6); PG8_BAR;
    for (;;) {
        const bool has_next = T.next(ui + 1, nxt);
        const char* nA = cA; const char* nB = cB;
#pragma unroll
        for (int h = 0; h < 2; ++h)
#pragma unroll
            for (int i = 0; i < 2; ++i) na[h][i] = va[h][i];
        kstepN = kstepA;
        if (has_next) { nA = T.a_base(nxt); nB = T.b_base(nxt); T.a_offs(nxt, R, C, na); kstepN = T.a_kstep(nxt); }
        for (int t = 0; t < nt; t += 2) {
            const bool last = (t == nt - 2);
            const char* a1 = cA + (size_t)(t + 1) * kstepA;
            const char* a2 = last ? nA : cA + (size_t)(t + 2) * kstepA; const char* b2 = last ? nB : cB + (size_t)(t + 2) * kstepB;
            const char* a3 = a2 + (last ? kstepN : kstepA); const char* b3 = b2 + kstepB;
            unsigned w2[2][2];
#pragma unroll
            for (int h = 0; h < 2; ++h)
#pragma unroll
                for (int i = 0; i < 2; ++i) w2[h][i] = last ? na[h][i] : va[h][i];
            PG8_LDB(B0, 0, 0); PG8_LDB(B1, 0, 1); PG8_SCHED; PG8_LDA(At, 0, 0); PG8_STAGE(PG8_SA(1, 1), a1, va[1]);
            PG8_WAIT_V(8); PG8_WAIT_L(0); PG8_BAR; PG8_MMA(0, 0, At, B0); PG8_MMA(0, 1, At, B1); PG8_BAR; PG8_SCHED;
            PG8_LDA(At, 0, 1); PG8_STAGE(PG8_SB(0, 0), b2, voffB); PG8_STAGE(PG8_SB(0, 1), b2 + hstepB, voffB); PG8_STAGE(PG8_SA(0, 0), a2, w2[0]);
            PG8_WAIT_V(8); PG8_WAIT_L(0); PG8_BAR; PG8_MMA(1, 0, At, B0); PG8_MMA(1, 1, At, B1); PG8_BAR; PG8_SCHED;
            PG8_LDB(B0, 1, 0); PG8_LDB(B1, 1, 1); PG8_SCHED; PG8_LDA(At, 1, 0); PG8_STAGE(PG8_SA(0, 1), a2, w2[1]);
            PG8_WAIT_V(8); PG8_WAIT_L(0); PG8_BAR; PG8_MMA(0, 0, At, B0); PG8_MMA(0, 1, At, B1); PG8_BAR; PG8_SCHED;
            PG8_LDA(At, 1, 1); PG8_STAGE(PG8_SB(1, 0), b3, voffB); PG8_STAGE(PG8_SB(1, 1), b3 + hstepB, voffB); PG8_STAGE(PG8_SA(1, 0), a3, w2[0]);
            PG8_WAIT_V(8); PG8_WAIT_L(0); PG8_BAR; PG8_MMA(1, 0, At, B0); PG8_MMA(1, 1, At, B1); PG8_BAR; PG8_SCHED;
        }
        if (wr == 0) PG8_BAR;
        if (!DRAINED || has_next) T.epi(acc, cur, wr, wc, fr, fq);
        if (!has_next) break;
#pragma unroll
        for (int a = 0; a < 2; ++a)
#pragma unroll
            for (int b = 0; b < 2; ++b)
#pragma unroll
                for (int m = 0; m < 4; ++m)
#pragma unroll
                    for (int n = 0; n < 2; ++n) acc[a][b][m][n] = (f32x4){0.f, 0.f, 0.f, 0.f};
        cur = nxt; cA = nA; cB = nB; kstepA = kstepN; ++ui;
#pragma unroll
        for (int h = 0; h < 2; ++h)
#pragma unroll
            for (int i = 0; i < 2; ++i) va[h][i] = na[h][i];
        if (wr == 1) PG8_BAR;
    }
    PG8_WAIT_V(0);
    PG8_BAR;
    if constexpr (DRAINED) T.epi_drained(acc, cur, wr, wc, fr, fq, lds, wid, lane);
#undef PG8_SA
#undef PG8_SB
#undef PG8_STAGE
#undef PG8_LDA
#undef PG8_LDB
#undef PG8_MMA
#undef PG8_WAIT_V
#undef PG8_WAIT_L
#undef PG8_BAR
#undef PG8_SCHED
}

DEV u32x4 lane_tr(u32x4 w, int src4) { w.x = (unsigned)__builtin_amdgcn_ds_bpermute(src4, (int)w.x); w.y = (unsigned)__builtin_amdgcn_ds_bpermute(src4, (int)w.y);
    w.z = (unsigned)__builtin_amdgcn_ds_bpermute(src4, (int)w.z); w.w = (unsigned)__builtin_amdgcn_ds_bpermute(src4, (int)w.w); return w; }
DEV void store_tile_bf16(const Acc& acc, bf16_t* base, int ldc, int wr, int wc, int fr, int fq) {
    const int ln = fq * 16 + fr, src4 = (((ln & 3) << 4) | (ln >> 2)) << 2;
#pragma unroll
    for (int ai = 0; ai < 2; ++ai)
#pragma unroll
        for (int m = 0; m < 4; ++m) { bf16_t* rowp = base + (size_t)(ai * HALF + wr * 64 + m * 16 + (ln >> 2)) * ldc + wc * 32 + 8 * (ln & 3);
#pragma unroll
            for (int bj = 0; bj < 2; ++bj) { const f32x4 v0 = acc[ai][bj][m][0], v1 = acc[ai][bj][m][1];
                u32x4 w; w.x = cvt_pk_bf16(v0[0], v0[1]); w.y = cvt_pk_bf16(v0[2], v0[3]); w.z = cvt_pk_bf16(v1[0], v1[1]); w.w = cvt_pk_bf16(v1[2], v1[3]);
                w.x = (unsigned)__builtin_amdgcn_ds_bpermute(src4, (int)w.x); w.y = (unsigned)__builtin_amdgcn_ds_bpermute(src4, (int)w.y);
                w.z = (unsigned)__builtin_amdgcn_ds_bpermute(src4, (int)w.z); w.w = (unsigned)__builtin_amdgcn_ds_bpermute(src4, (int)w.w);
                *(u32x4*)(rowp + bj * HALF) = w; } }
}
template <class Epi, bool PERM_>
struct PlainTask {
    static constexpr bool PERM = PERM_;
    const bf16_t* A; int lda; const bf16_t* Bt; int ldb_; int K; StaticOrder S; Epi E;
    DEV bool next(int i, Unit& u) const { return S.next(i, u); }
    DEV const char* a_base(const Unit& u) const { return (const char*)(A + (size_t)u.pm * BM * lda); }
    DEV void a_offs(const Unit&, const int (&R)[2], const int (&C)[2], unsigned (&v)[2][2]) const {
#pragma unroll
        for (int h = 0; h < 2; ++h)
#pragma unroll
            for (int i = 0; i < 2; ++i) v[h][i] = (unsigned)((h * HALF + R[i]) * lda + C[i]) * 2u;
    }
    DEV size_t a_kstep(const Unit&) const { return (size_t)(BK * 2); }
    DEV const char* b_base(const Unit& u) const { return (const char*)(Bt + (size_t)u.pn * BM * ldb_); }
    DEV int ldb() const { return ldb_; }
    DEV void epi(Acc& acc, const Unit& u, int wr, int wc, int fr, int fq) const { E(acc, u, wr, wc, fr, fq); }
};
struct EpiBf16 {
    bf16_t* Cc; int ldc;
    DEV void operator()(Acc& acc, const Unit& u, int wr, int wc, int fr, int fq) const { store_tile_bf16(acc, Cc + (size_t)u.pm * BM * ldc + u.pn * BM, ldc, wr, wc, fr, fq); }
};
struct EpiInproj {
    bf16_t* Cc;
    DEV void operator()(Acc& acc, const Unit& u, int wr, int wc, int fr, int fq) const {
        if (u.pn == 4 || u.pn == 5) {
#pragma unroll
            for (int a = 0; a < 2; ++a)
#pragma unroll
                for (int b = 0; b < 2; ++b)
#pragma unroll
                    for (int m = 0; m < 4; ++m)
#pragma unroll
                        for (int n = 0; n < 2; ++n) acc[a][b][m][n] = acc[a][b][m][n] * (0.125f * 1.4426950408889634f);
        }
        const int ln = fq * 16 + fr, src4 = (((ln & 3) << 4) | (ln >> 2)) << 2;
        if (u.pn < 4) {
#pragma unroll
            for (int ai = 0; ai < 2; ++ai)
#pragma unroll
                for (int m = 0; m < 4; ++m) { bf16_t* rowp = Cc + (size_t)(u.pm * BM + ai * HALF + wr * 64 + m * 16 + (ln >> 2)) * EINP + u.pn * HALF + wc * 32 + 8 * (ln & 3);
                    f32x4 h0, h1;
#pragma unroll
                    for (int j = 0; j < 4; ++j) { h0[j] = acc[ai][0][m][0][j] * frcp(1.f + __expf(-acc[ai][1][m][0][j])); h1[j] = acc[ai][0][m][1][j] * frcp(1.f + __expf(-acc[ai][1][m][1][j])); }
                    u32x4 w; w.x = cvt_pk_bf16(h0[0], h0[1]); w.y = cvt_pk_bf16(h0[2], h0[3]); w.z = cvt_pk_bf16(h1[0], h1[1]); w.w = cvt_pk_bf16(h1[2], h1[3]);
                    *(u32x4*)rowp = lane_tr(w, src4); }
            return;
        }
        if (u.pn == 9 && wc != 0) return;
        store_tile_bf16(acc, Cc + (size_t)u.pm * BM * EINP + u.pn * BM, EINP, wr, wc, fr, fq); }
};
struct EpiOdIn {
    bf16_t* Cc;
    DEV void operator()(Acc& acc, const Unit& u, int wr, int wc, int fr, int fq) const {
        const int ln = fq * 16 + fr, src4 = (((ln & 3) << 4) | (ln >> 2)) << 2;
#pragma unroll
        for (int ai = 0; ai < 2; ++ai)
#pragma unroll
            for (int m = 0; m < 4; ++m) { bf16_t* rowp = Cc + (size_t)(u.pm * BM + ai * HALF + wr * 64 + m * 16 + (ln >> 2)) * 2048 + 1024 + u.pn * HALF + wc * 32 + 8 * (ln & 3);
                const f32x4 h0 = acc[ai][0][m][0] * acc[ai][1][m][0], h1 = acc[ai][0][m][1] * acc[ai][1][m][1];
                u32x4 w; w.x = cvt_pk_bf16(h0[0], h0[1]); w.y = cvt_pk_bf16(h0[2], h0[3]); w.z = cvt_pk_bf16(h1[0], h1[1]); w.w = cvt_pk_bf16(h1[2], h1[3]);
                *(u32x4*)rowp = lane_tr(w, src4); }
    }
};
struct EpiBf16S {
    bf16_t* Cc; int ldc; float scale;
    DEV void operator()(Acc& acc, const Unit& u, int wr, int wc, int fr, int fq) const {
#pragma unroll
        for (int a = 0; a < 2; ++a)
#pragma unroll
            for (int b = 0; b < 2; ++b)
#pragma unroll
                for (int m = 0; m < 4; ++m)
#pragma unroll
                    for (int n = 0; n < 2; ++n) acc[a][b][m][n] = acc[a][b][m][n] * scale;
        store_tile_bf16(acc, Cc + (size_t)u.pm * BM * ldc + u.pn * BM, ldc, wr, wc, fr, fq); }
};
}

namespace pg8 {
constexpr int LDS_SPARE = STAGE_BYTES;
DEV void store_tile_f32_perm(const Acc& acc, float* base, int ldc, int wr, int wc, int fr, int fq) {
#pragma unroll
    for (int ai = 0; ai < 2; ++ai)
#pragma unroll
        for (int m = 0; m < 4; ++m) { float* rowp = base + (size_t)(ai * HALF + wr * 64 + m * 16 + fr) * ldc + wc * 32 + 8 * fq;
#pragma unroll
            for (int bj = 0; bj < 2; ++bj) { *(f32x4*)(rowp + bj * HALF) = acc[ai][bj][m][0]; *(f32x4*)(rowp + bj * HALF + 4) = acc[ai][bj][m][1]; } }
}
struct CmpTask {
    static constexpr bool PERM = true;
    int K; unsigned char* ws; int id;
    DEV bool next(int i, Unit& u) const { if (i > 0 || id >= 64) return false; u.aux = id >> 5; u.pm = (id >> 1) & 15; u.pn = id & 1; return true; }
    DEV const char* a_base(const Unit& u) const { return (const char*)(ws + SC_Y0) + (u.aux ? C_VC : C_KC) * 2; }
    DEV void a_offs(const Unit& u, const int (&R)[2], const int (&C)[2], unsigned (&v)[2][2]) const {
#pragma unroll
        for (int h = 0; h < 2; ++h)
#pragma unroll
            for (int i = 0; i < 2; ++i) { const int m = u.pm * BM + h * HALF + R[i], g = m & 1, bj = m >> 1; v[h][i] = (unsigned)(((size_t)bj * 16 * EINP + g * 64 + C[i]) * 2); } }
    DEV size_t a_kstep(const Unit&) const { return (size_t)EINP * 2; }
    DEV const char* b_base(const Unit& u) const { return (const char*)(ws + WS_CW1) + ((size_t)u.aux * 512 + (size_t)u.pn * BM) * DM * 2; }
    DEV int ldb() const { return DM; }
    DEV void epi(Acc& acc, const Unit& u, int wr, int wc, int fr, int fq) const { store_tile_f32_perm(acc, (float*)(ws + (u.aux ? WS_PV : WS_PK)) + (size_t)u.pm * BM * 512 + u.pn * BM, 512, wr, wc, fr, fq); }
};
struct OneUnitTask {
    static constexpr bool PERM = true;
    int K; const bf16_t* A; const bf16_t* Bt; bf16_t* Cc; int ldc; size_t cm, cn; int pm, pn; bool on; float scale;
    DEV bool next(int i, Unit& u) const { if (i > 0 || !on) return false; u.pm = pm; u.pn = pn; u.aux = 0; return true; }
    DEV const char* a_base(const Unit& u) const { return (const char*)(A + (size_t)u.pm * BM * DM); }
    DEV void a_offs(const Unit&, const int (&R)[2], const int (&C)[2], unsigned (&v)[2][2]) const {
#pragma unroll
        for (int h = 0; h < 2; ++h)
#pragma unroll
            for (int i = 0; i < 2; ++i) v[h][i] = (unsigned)((h * HALF + R[i]) * DM + C[i]) * 2u; }
    DEV size_t a_kstep(const Unit&) const { return (size_t)(BK * 2); }
    DEV const char* b_base(const Unit& u) const { return (const char*)(Bt + (size_t)u.pn * BM * DM); }
    DEV int ldb() const { return DM; }
    DEV void epi(Acc& acc, const Unit& u, int wr, int wc, int fr, int fq) const {
        if (scale != 1.f) {
#pragma unroll
            for (int a = 0; a < 2; ++a)
#pragma unroll
                for (int b = 0; b < 2; ++b)
#pragma unroll
                    for (int m = 0; m < 4; ++m)
#pragma unroll
                        for (int n = 0; n < 2; ++n) acc[a][b][m][n] = acc[a][b][m][n] * scale; }
        store_tile_bf16(acc, Cc + (size_t)u.pm * cm + (size_t)u.pn * cn, ldc, wr, wc, fr, fq); }
};
struct XaSTask {
    static constexpr bool PERM = true;
    int K; const bf16_t* Q; const bf16_t* MK; bf16_t* P; PG8_LAS unsigned char* lds; StaticOrder S;
    DEV bool next(int i, Unit& u) const { return S.next(i, u); }
    DEV const char* a_base(const Unit& u) const { return (const char*)(Q + (size_t)u.pm * BM * DM); }
    DEV void a_offs(const Unit&, const int (&R)[2], const int (&C)[2], unsigned (&v)[2][2]) const {
#pragma unroll
        for (int h = 0; h < 2; ++h)
#pragma unroll
            for (int i = 0; i < 2; ++i) v[h][i] = (unsigned)((h * HALF + R[i]) * DM + C[i]) * 2u; }
    DEV size_t a_kstep(const Unit&) const { return (size_t)(BK * 2); }
    DEV const char* b_base(const Unit& u) const { return (const char*)(MK + ((size_t)(u.pm >> 4) * DM + (size_t)u.pn * 256) * DM); }
    DEV int ldb() const { return DM; }
    DEV void epi(Acc& acc, const Unit& u, int wr, int wc, int fr, int fq) const {
        PG8_LAS float* smax = (PG8_LAS float*)(lds + LDS_SPARE); PG8_LAS float* ssum = smax + 1024;
#pragma unroll
        for (int ai = 0; ai < 2; ++ai)
#pragma unroll
            for (int m = 0; m < 4; ++m) { float v = -INFINITY;
#pragma unroll
                for (int bj = 0; bj < 2; ++bj)
#pragma unroll
                    for (int n = 0; n < 2; ++n) { const f32x4 x = acc[ai][bj][m][n]; v = fmaxf(v, fmaxf(fmaxf(x[0], x[1]), fmaxf(x[2], x[3]))); }
                v = fmaxf(v, __shfl_xor(v, 16)); v = fmaxf(v, __shfl_xor(v, 32));
                if (fq == 0) smax[(ai * HALF + wr * 64 + m * 16 + fr) * 4 + wc] = v; }
        asm volatile("s_waitcnt lgkmcnt(0)" ::: "memory"); __builtin_amdgcn_s_barrier(); asm volatile("" ::: "memory");
#pragma unroll
        for (int ai = 0; ai < 2; ++ai)
#pragma unroll
            for (int m = 0; m < 4; ++m) { const int row = ai * HALF + wr * 64 + m * 16 + fr;
                const f32x4 t = *(const PG8_LAS f32x4*)(smax + row * 4); const float M = fmaxf(fmaxf(t[0], t[1]), fmaxf(t[2], t[3])); float s = 0.f;
#pragma unroll
                for (int bj = 0; bj < 2; ++bj)
#pragma unroll
                    for (int n = 0; n < 2; ++n) { f32x4 x = acc[ai][bj][m][n];
#pragma unroll
                        for (int j = 0; j < 4; ++j) { x[j] = __builtin_amdgcn_exp2f(x[j] - M); s += x[j]; }
                        acc[ai][bj][m][n] = x; }
                s += __shfl_xor(s, 16); s += __shfl_xor(s, 32);
                if (fq == 0) ssum[row * 4 + wc] = s; }
        asm volatile("s_waitcnt lgkmcnt(0)" ::: "memory"); __builtin_amdgcn_s_barrier(); asm volatile("" ::: "memory");
#pragma unroll
        for (int ai = 0; ai < 2; ++ai)
#pragma unroll
            for (int m = 0; m < 4; ++m) { const int row = ai * HALF + wr * 64 + m * 16 + fr;
                const f32x4 t = *(const PG8_LAS f32x4*)(ssum + row * 4); const float inv = frcp((t[0] + t[1]) + (t[2] + t[3]));
#pragma unroll
                for (int bj = 0; bj < 2; ++bj)
#pragma unroll
                    for (int n = 0; n < 2; ++n) acc[ai][bj][m][n] = acc[ai][bj][m][n] * inv; }
        store_tile_bf16(acc, P + (size_t)u.pm * BM * DM + u.pn * 256, DM, wr, wc, fr, fq);
        asm volatile("s_waitcnt lgkmcnt(0)" ::: "memory"); __builtin_amdgcn_s_barrier(); asm volatile("" ::: "memory");
    }
};
DEV void moe_build_tab(const int* cnt, PG8_LAS int* tab) {
    if (threadIdx.x == 0) { int nb = 0; for (int e = 0; e < NEXP; ++e) { const int k = (cnt[e] + 255) >> 8; for (int j = 0; j < k; ++j) tab[1 + nb + j] = (e << 16) | j; nb += k; } tab[0] = nb; }
    asm volatile("s_waitcnt lgkmcnt(0)" ::: "memory"); __syncthreads();
}
struct Moe1Task {
    static constexpr bool PERM = true;
    int K; const bf16_t* X; const bf16_t* W13; bf16_t* H; const int* cnt; const int* list; const PG8_LAS int* tab; int G, c;
    DEV bool next(int i, Unit& u) const { const int vc = (G % 8 == 0) ? (c % 8) * (G / 8) + c / 8 : c;
        const int id = i * G + vc, rb = id >> 2; if (rb >= tab[0]) return false; u.pm = rb; u.pn = id & 3; u.aux = tab[1 + rb]; return true; }
    DEV const char* a_base(const Unit&) const { return (const char*)X; }
    DEV void a_offs(const Unit& u, const int (&R)[2], const int (&C)[2], unsigned (&v)[2][2]) const {
        const int e = u.aux >> 16, lb = u.aux & 0xffff, ce = cnt[e];
#pragma unroll
        for (int h = 0; h < 2; ++h)
#pragma unroll
            for (int i = 0; i < 2; ++i) { const int r = lb * BM + h * HALF + R[i]; const int tok = (r < ce) ? (list[e * LCAP + r] >> 1) : 0; v[h][i] = (unsigned)(tok * DM + C[i]) * 2u; } }
    DEV size_t a_kstep(const Unit&) const { return (size_t)(BK * 2); }
    DEV const char* b_base(const Unit& u) const { return (const char*)(W13 + ((size_t)(u.aux >> 16) * DM + (size_t)u.pn * BM) * DM); }
    DEV int ldb() const { return DM; }
    DEV void epi(Acc& acc, const Unit& u, int wr, int wc, int fr, int fq) const {
        const int ln = fq * 16 + fr, src4 = (((ln & 3) << 4) | (ln >> 2)) << 2;
#pragma unroll
        for (int ai = 0; ai < 2; ++ai)
#pragma unroll
            for (int m = 0; m < 4; ++m) { bf16_t* rowp = H + (size_t)(u.pm * BM + ai * HALF + wr * 64 + m * 16 + (ln >> 2)) * EH + u.pn * HALF + wc * 32 + 8 * (ln & 3);
                f32x4 h0, h1;
#pragma unroll
                for (int j = 0; j < 4; ++j) { const float a = acc[ai][0][m][0][j], b = acc[ai][0][m][1][j]; h0[j] = a * frcp(1.f + __expf(-a)) * acc[ai][1][m][0][j]; h1[j] = b * frcp(1.f + __expf(-b)) * acc[ai][1][m][1][j]; }
                u32x4 w; w.x = cvt_pk_bf16(h0[0], h0[1]); w.y = cvt_pk_bf16(h0[2], h0[3]); w.z = cvt_pk_bf16(h1[0], h1[1]); w.w = cvt_pk_bf16(h1[2], h1[3]);
                *(u32x4*)rowp = lane_tr(w, src4); }
    }
};
struct Moe2Task {
    static constexpr bool PERM = true;
    int K; const bf16_t* H; const bf16_t* W2; bf16_t* Y; const int* cnt; const int* list; const float* gate; const PG8_LAS int* tab; int G, c; const bf16_t* W2b;
    DEV bool next(int i, Unit& u) const { const int vc = (G % 8 == 0) ? (c % 8) * (G / 8) + c / 8 : c;
        const int id = i * G + vc, rb = id >> 2; if (rb >= tab[0]) return false; u.pm = rb; u.pn = id & 3; u.aux = tab[1 + rb]; return true; }
    DEV const char* a_base(const Unit& u) const { return (const char*)(H + (size_t)u.pm * BM * EH); }
    DEV void a_offs(const Unit&, const int (&R)[2], const int (&C)[2], unsigned (&v)[2][2]) const {
#pragma unroll
        for (int h = 0; h < 2; ++h)
#pragma unroll
            for (int i = 0; i < 2; ++i) v[h][i] = (unsigned)((h * HALF + R[i]) * EH + C[i]) * 2u; }
    DEV size_t a_kstep(const Unit&) const { return (size_t)(BK * 2); }
    DEV const char* b_base(const Unit& u) const { const int e = u.aux >> 16; const bf16_t* w = (W2b != nullptr && e >= 16) ? W2b + (size_t)(e - 16) * DM * EH : W2 + (size_t)e * DM * EH; return (const char*)(w + (size_t)u.pn * BM * EH); }
    DEV int ldb() const { return EH; }
    DEV void epi(Acc& acc, const Unit& u, int wr, int wc, int fr, int fq) const { store_tile_bf16(acc, Y + (size_t)u.pm * BM * DM + u.pn * BM, DM, wr, wc, fr, fq); }
};
}

namespace pg8 {
struct PanelStats {
    unsigned long long* xbuf;
    unsigned* cnt;
    DEV void run(const Acc& v, int panel, int pn, int wr, int wc, int fr, int fq, PG8_LAS unsigned char* lds, int wid, int lane) const {
        typedef float f32x2v __attribute__((ext_vector_type(2)));
        PG8_LAS f32x2v* P = (PG8_LAS f32x2v*)lds;
        PG8_LAS f32x2v* S = (PG8_LAS f32x2v*)(lds + 8192);
#pragma unroll
        for (int ai = 0; ai < 2; ++ai)
#pragma unroll
            for (int m = 0; m < 4; ++m) {
                float s = 0.f;
#pragma unroll
                for (int bj = 0; bj < 2; ++bj)
#pragma unroll
                    for (int n = 0; n < 2; ++n) { const f32x4 x = v[ai][bj][m][n]; s += (x[0] + x[1]) + (x[2] + x[3]); }
                s += __shfl_xor(s, 16); s += __shfl_xor(s, 32);
                const float mw = s * (1.0f / 64.0f); float q = 0.f;
#pragma unroll
                for (int bj = 0; bj < 2; ++bj)
#pragma unroll
                    for (int n = 0; n < 2; ++n) { const f32x4 d = v[ai][bj][m][n] - mw; q += (d[0] * d[0] + d[1] * d[1]) + (d[2] * d[2] + d[3] * d[3]); }
                q += __shfl_xor(q, 16); q += __shfl_xor(q, 32);
                if (fq == 0) P[(ai * HALF + wr * 64 + m * 16 + fr) * 4 + wc] = (f32x2v){mw, q};
            }
        asm volatile("s_waitcnt lgkmcnt(0)" ::: "memory"); __builtin_amdgcn_s_barrier(); asm volatile("" ::: "memory");
        const int row = wid * 32 + (lane & 31);
        if (lane < 32) {
            const f32x2v a = P[row * 4 + 0], b = P[row * 4 + 1], c = P[row * 4 + 2], d = P[row * 4 + 3];
            const float mt = (a.x + b.x + c.x + d.x) * 0.25f;
            const float da = a.x - mt, db = b.x - mt, dc = c.x - mt, dd = d.x - mt;
            const float m2 = (a.y + b.y) + (c.y + d.y) + 64.0f * ((da * da + db * db) + (dc * dc + dd * dd));
            unsigned long long* slot = xbuf + ((size_t)(panel * BM + row) * 4 + pn);
            __hip_atomic_store(slot, ((unsigned long long)__float_as_uint(m2) << 32) | __float_as_uint(mt), __ATOMIC_RELAXED, __HIP_MEMORY_SCOPE_AGENT);
        }
        asm volatile("s_waitcnt vmcnt(0)" ::: "memory");
        if (lane == 0) __hip_atomic_fetch_add(cnt + 64 * panel, 1u, __ATOMIC_RELAXED, __HIP_MEMORY_SCOPE_AGENT);
        if (wid == 0) {
            unsigned sp = 0;
            while ((unsigned)__builtin_amdgcn_readfirstlane(__hip_atomic_load(cnt + 64 * panel, __ATOMIC_RELAXED, __HIP_MEMORY_SCOPE_AGENT)) < 32u) { __builtin_amdgcn_s_sleep(2); if (++sp > (1u << 22)) break; }
            __builtin_amdgcn_fence(__ATOMIC_ACQUIRE, "agent");
        }
        asm volatile("s_waitcnt vmcnt(0) lgkmcnt(0)" ::: "memory"); __builtin_amdgcn_s_barrier(); asm volatile("" ::: "memory");
        if (lane < 32) {
            const unsigned long long* slot = xbuf + (size_t)(panel * BM + row) * 4; float mt[4], m2[4]; float ms = 0.f;
#pragma unroll
            for (int t = 0; t < 4; ++t) { const unsigned long long w = __hip_atomic_load(slot + t, __ATOMIC_RELAXED, __HIP_MEMORY_SCOPE_AGENT); mt[t] = __uint_as_float((unsigned)w); m2[t] = __uint_as_float((unsigned)(w >> 32)); ms += mt[t]; }
            const float mean = ms * 0.25f; float q = 0.f;
#pragma unroll
            for (int t = 0; t < 4; ++t) { const float dm = mt[t] - mean; q += m2[t] + 256.0f * dm * dm; }
            S[row] = (f32x2v){mean, rsqrtf(q * (1.0f / 1024.0f) + LN_EPS)};
        }
        asm volatile("s_waitcnt lgkmcnt(0)" ::: "memory"); __builtin_amdgcn_s_barrier(); asm volatile("" ::: "memory");
    }
};
template <bool RES_F32>
struct LnTask {
    static constexpr bool PERM = true;
    int K; const bf16_t* A; int lda; const bf16_t* Bt; const void* res; const float* g; const float* b; bf16_t* X; int row0; PanelStats st; StaticOrder S; size_t bstride;
    DEV bool next(int i, Unit& u) const { return i == 0 && S.next(0, u); }
    DEV const char* a_base(const Unit& u) const { return (const char*)(A + (size_t)(row0 + u.pm * BM) * lda); }
    DEV void a_offs(const Unit&, const int (&R)[2], const int (&C)[2], unsigned (&v)[2][2]) const {
#pragma unroll
        for (int h = 0; h < 2; ++h)
#pragma unroll
            for (int i = 0; i < 2; ++i) v[h][i] = (unsigned)((h * HALF + R[i]) * lda + C[i]) * 2u; }
    DEV size_t a_kstep(const Unit&) const { return (size_t)(BK * 2); }
    DEV const char* b_base(const Unit& u) const { return (const char*)(Bt + (size_t)((row0 / BM + u.pm) >> 4) * bstride + (size_t)u.pn * BM * DM); }
    DEV int ldb() const { return DM; }
    DEV void epi(Acc&, const Unit&, int, int, int, int) const {}
    DEV void epi_drained(Acc& acc, const Unit& u, int wr, int wc, int fr, int fq, PG8_LAS unsigned char* lds, int wid, int lane) const {
        typedef float f32x2v __attribute__((ext_vector_type(2)));
        const int colb = u.pn * BM + wc * 32 + 8 * fq;
#pragma unroll
        for (int ai = 0; ai < 2; ++ai)
#pragma unroll
            for (int m = 0; m < 4; ++m) { const size_t roff = (size_t)(row0 + u.pm * BM + ai * HALF + wr * 64 + m * 16 + fr) * DM + colb;
#pragma unroll
                for (int bj = 0; bj < 2; ++bj) { f32x4 r0, r1;
                    if (RES_F32) { r0 = *(const f32x4*)((const float*)res + roff + bj * HALF); r1 = *(const f32x4*)((const float*)res + roff + bj * HALF + 4); }
                    else { const u32x4 w = *(const u32x4*)((const bf16_t*)res + roff + bj * HALF);
                        r0 = (f32x4){__uint_as_float(w.x << 16), __uint_as_float(w.x & 0xffff0000u), __uint_as_float(w.y << 16), __uint_as_float(w.y & 0xffff0000u)};
                        r1 = (f32x4){__uint_as_float(w.z << 16), __uint_as_float(w.z & 0xffff0000u), __uint_as_float(w.w << 16), __uint_as_float(w.w & 0xffff0000u)}; }
                    acc[ai][bj][m][0] = r0 * DN_ALPHA + acc[ai][bj][m][0]; acc[ai][bj][m][1] = r1 * DN_ALPHA + acc[ai][bj][m][1]; }
                asm volatile("" : "+v"(acc[ai][0][m][0]), "+v"(acc[ai][0][m][1]), "+v"(acc[ai][1][m][0]), "+v"(acc[ai][1][m][1]));
                if (m & 1) asm volatile("" ::: "memory"); }
        st.run(acc, row0 / BM + u.pm, u.pn, wr, wc, fr, fq, lds, wid, lane);
        const PG8_LAS f32x2v* Stab = (const PG8_LAS f32x2v*)(lds + 8192);
        const int ln = fq * 16 + fr, src4 = (((ln & 3) << 4) | (ln >> 2)) << 2;
#pragma unroll
        for (int bj = 0; bj < 2; ++bj) {
            const f32x4 g0 = *(const f32x4*)(g + colb + bj * HALF), g1 = *(const f32x4*)(g + colb + bj * HALF + 4), b0 = *(const f32x4*)(b + colb + bj * HALF), b1 = *(const f32x4*)(b + colb + bj * HALF + 4);
#pragma unroll
            for (int ai = 0; ai < 2; ++ai)
#pragma unroll
                for (int m = 0; m < 4; ++m) { const int r = ai * HALF + wr * 64 + m * 16 + fr; const f32x2v sr = Stab[r];
                    const f32x4 y0 = (acc[ai][bj][m][0] - sr.x) * sr.y * g0 + b0, y1 = (acc[ai][bj][m][1] - sr.x) * sr.y * g1 + b1;
                    u32x4 w; w.x = cvt_pk_bf16(y0[0], y0[1]); w.y = cvt_pk_bf16(y0[2], y0[3]); w.z = cvt_pk_bf16(y1[0], y1[1]); w.w = cvt_pk_bf16(y1[2], y1[3]);
                    *(u32x4*)(X + (size_t)(row0 + u.pm * BM + r - fr + (ln >> 2)) * DM + u.pn * BM + wc * 32 + 8 * (ln & 3) + bj * HALF) = lane_tr(w, src4); }
        }
        asm volatile("s_waitcnt lgkmcnt(0)" ::: "memory"); __builtin_amdgcn_s_barrier(); asm volatile("" ::: "memory");
    }
};
}

DEV int tr_rowmap(int kind, int n) {
    if (kind == 1) return (n >= 1024) ? n : ((n < 512) ? ((n >> 7) * 256 + (n & 127)) : (((n - 512) >> 7) * 256 + 128 + (n & 127)));
    if (kind == 4) return (n < 1024) ? n : ((n < 2048) ? (1024 + ((n - 1024) >> 7) * 256 + (n & 127)) : (1024 + ((n - 2048) >> 7) * 256 + 128 + (n & 127)));
    if (kind == 2) return (n >> 7) * 256 + (n & 127);
    if (kind == 3) return (n >> 7) * 256 + 128 + (n & 127);
    return n;
}
struct TrItem { const float* W; int ldw, N; bf16_t* WT; int ldd, kind, kb, nb; bool on; };
DEV void tr_load(const TrItem& t, f32x4 (&v)[16], int lane) {
    const int k0 = 64 * t.kb, nn = 64 * t.nb + (lane & 15) * 4;
#pragma unroll
    for (int i = 0; i < 16; ++i) { const int kk = (lane >> 4) + 4 * i; v[i] = (t.on && nn < t.N) ? *(const f32x4*)(t.W + (size_t)(k0 + kk) * t.ldw + nn) : (f32x4){0.f, 0.f, 0.f, 0.f}; }
}
DEV void tr_store(const TrItem& t, const f32x4 (&v)[16], float* scr, int lane) {
    const int k0 = 64 * t.kb, n0 = 64 * t.nb;
#pragma unroll
    for (int i = 0; i < 16; ++i) { const int kk = (lane >> 4) + 4 * i; float* d = scr + kk * 65 + (lane & 15) * 4; d[0] = v[i].x; d[1] = v[i].y; d[2] = v[i].z; d[3] = v[i].w; }
    LDS_WAIT();
    const int kc = lane & 7;
#pragma unroll
    for (int i = 0; i < 8; ++i) {
        const int nl = (lane >> 3) + 8 * i, n = n0 + nl;
        const float* s = scr + (8 * kc) * 65 + nl;
        u32x4 o; o.x = pk2(s[0], s[65]); o.y = pk2(s[130], s[195]); o.z = pk2(s[260], s[325]); o.w = pk2(s[390], s[455]);
        if (t.on && n < t.N) *(u32x4*)(t.WT + (size_t)tr_rowmap(t.kind, n) * t.ldd + k0 + 8 * kc) = o;
    }
    LDS_WAIT();
}
constexpr int MOE_TR_ITEMS = NEXP * 384;
DEV TrItem moe_tr_decode(const Ctx& c, int layer, int it) {
    const float* w1 = gptr(c.p->in[29]) + (size_t)layer * NEXP * DM * EH;
    const float* w3 = gptr(c.p->in[30]) + (size_t)layer * NEXP * DM * EH;
    const float* w2 = gptr(c.p->in[31]) + (size_t)layer * NEXP * EH * DM;
    bf16_t* W13 = (bf16_t*)(c.ws + WS_W13); bf16_t* W2 = (bf16_t*)(c.ws + WS_W2);
    const int e = it / 384, r = it % 384, mat = r >> 7, sub = r & 127;
    if (mat == 0) return TrItem{w1 + (size_t)e * DM * EH, EH, EH, W13 + (size_t)e * DM * DM, DM, 2, sub >> 3, sub & 7, true};
    if (mat == 1) return TrItem{w3 + (size_t)e * DM * EH, EH, EH, W13 + (size_t)e * DM * DM, DM, 3, sub >> 3, sub & 7, true};
    if (layer == 1) W2 = (e < 16) ? (bf16_t*)(c.ws + WS_PK) : (bf16_t*)(c.ws + WS_W2B) - (size_t)16 * DM * EH;
    return TrItem{w2 + (size_t)e * EH * DM, DM, DM, W2 + (size_t)e * DM * EH, EH, 0, sub >> 4, sub & 15, true};
}
constexpr int MOE_E0 = 20, MOE_EARLY_ITEMS = MOE_E0 * 256, MOE_REST_ITEMS = (NEXP - MOE_E0) * 256, MOE_W2_ITEMS = NEXP * 128;
template <int MODE  >
DEV TrItem moe_tr_decode_m(const Ctx& c, int layer, int idx) {
    if (MODE == 0) return moe_tr_decode(c, layer, idx);
    if (MODE == 1) { const int e = idx >> 8, r = idx & 255; return moe_tr_decode(c, layer, e * 384 + r); }
    if (MODE == 2) { const int e = MOE_E0 + (idx >> 8), r = idx & 255; return moe_tr_decode(c, layer, e * 384 + r); }
    return moe_tr_decode(c, layer, (idx >> 7) * 384 + 256 + (idx & 127));
}
template <int MODE>
DEV void moe_weights_m(const Ctx& c, int layer, int worker, int nworkers) {
    constexpr int NIT = (MODE == 0) ? MOE_TR_ITEMS : (MODE == 1 ? MOE_EARLY_ITEMS : (MODE == 2 ? MOE_REST_ITEMS : MOE_W2_ITEMS));
    float* scr = c.lds + c.wave * (64 * 65);
    f32x4 va[16], vb[16];
    int it = worker;
    if (it >= NIT) return;
    TrItem cur = moe_tr_decode_m<MODE>(c, layer, it); tr_load(cur, va, c.lane);
    for (;;) {
        const int i1 = it + nworkers; const bool h1 = i1 < NIT; TrItem n1 = cur;
        if (h1) { n1 = moe_tr_decode_m<MODE>(c, layer, i1); tr_load(n1, vb, c.lane); }
        tr_store(cur, va, scr, c.lane);
        if (!h1) break;
        const int i2 = i1 + nworkers; const bool h2 = i2 < NIT;
        if (h2) { cur = moe_tr_decode_m<MODE>(c, layer, i2); tr_load(cur, va, c.lane); }
        tr_store(n1, vb, scr, c.lane);
        if (!h2) break;
        it = i2;
    }
}
template <int MODE>
DEV void moe_weights_in_tail(const Ctx& c, int layer, int nblk) {
    const int G = gridDim.x, bx = blockIdx.x, vc = (G % 8 == 0) ? (bx % 8) * (G / 8) + bx / 8 : bx;
    const int full = 4 * nblk - (4 * nblk / G) * G, nidle = G - full;
    if (vc < full) return;
    moe_weights_m<MODE>(c, layer, (vc - full) * NWAVES + c.wave, nidle * NWAVES);
}
DEV void cvt_rows(const Ctx& c, const float* src, bf16_t* dst, size_t n, int gw, int ngw) {
    const size_t nth = (size_t)ngw * 64, t0 = (size_t)gw * 64 + c.lane, nch = n / 8;
    for (size_t i = t0; i < nch; i += 4 * nth) {
        f32x4 a[4], b[4];
#pragma unroll
        for (int u = 0; u < 4; ++u) { const size_t j = i + u * nth; if (j < nch) { a[u] = *(const f32x4*)(src + j * 8); b[u] = *(const f32x4*)(src + j * 8 + 4); } }
#pragma unroll
        for (int u = 0; u < 4; ++u) { const size_t j = i + u * nth; if (j < nch) { u32x4 o; o.x = pk2(a[u].x, a[u].y); o.y = pk2(a[u].z, a[u].w); o.z = pk2(b[u].x, b[u].y); o.w = pk2(b[u].z, b[u].w); *(u32x4*)(dst + j * 8) = o; } }
    }
}
template <int PART>
DEV void phase_prep(const Ctx& c) {
    const __attribute__((address_space(4))) Params& p = *c.p; unsigned char* ws = c.ws;
    float* scr = c.lds + c.wave * (64 * 65);
    if (PART == 0 && blockIdx.x == 0 && c.tid < 64) ((int*)(ws + WS_CTL))[c.tid] = 0;
    constexpr int I_IN = 16 * 37, I_SQ = 16 * 16, I_OD = 16 * 48, I_CW = 16 * 4;
    constexpr int NA = I_IN + I_SQ + I_OD + I_SQ + 4 * I_SQ + 2 * I_SQ + 4 * I_CW;
    {
        const int bx = blockIdx.x; int g_ = 0, ng_ = 1;
        auto sub = [&](int w0, int nw) { g_ = (bx - w0) * NWAVES + c.wave; ng_ = nw * NWAVES; return bx >= w0 && bx < w0 + nw; };
        if (PART == 1 && sub(0, 64)) {
            for (int i = g_ * 64 + c.lane; i < 2 * 96 * DM; i += ng_ * 64) {
                const int l = i / (96 * DM), rr = (i / DM) % 96, k = i % DM, part = rr / 48, o = rr % 48;
                float w = 0.f;
                if (o < 32) w = gptr(p.in[27])[((size_t)l * DM + k) * 32 + o]; else if (o < 36) w = gptr(p.in[25])[((size_t)l * DM + k) * 4 + (o - 32)];
                const unsigned hi = f2bf(w); const float lo = w - __uint_as_float(hi << 16);
                ((bf16_t*)(ws + WS_RWB))[i] = (bf16_t)(part ? f2bf(lo) : hi);
            }
        }
        if (PART == 1 && sub(64, 32)) {
            for (int i = g_ * 64 + c.lane; i < 8 * 256 * 64; i += ng_ * 64) {
                const int n = (i >> 6) & 255, m = i & 63; float v = 0.f;
                if (n < NCMP) { const int ov = min(16 * n + 32, 64 * m + 64) - max(16 * n, 64 * m); v = (ov > 0) ? (float)ov * (1.f / 32.f) : 0.f; }
                ((bf16_t*)(ws + WS_MSEL))[i] = (bf16_t)f2bf(v);
            }
            for (int i = g_ * 64 + c.lane; i < 2 * 16 * 64; i += ng_ * 64) { const int kv = i >> 10, bg = (i >> 6) & 15, d = i & 63; ((bf16_t*)(ws + (kv ? WS_VCMP : WS_KCMP)))[(size_t)(bg * 256 + 255) * 64 + d] = 0; }
        }
        if (PART == 1 && sub(96, 64)) cvt_rows(c, gptr(p.in[1]), (bf16_t*)(ws + WS_MEMB), (size_t)NMEM * DM, g_, ng_);
        if (PART == 1 && sub(160, 64)) cvt_rows(c, gptr(p.in[21]), (bf16_t*)(ws + WS_WQ), (size_t)2 * DM * DM, g_, ng_);
        if (PART == 0 && sub(224, 24)) {
            bf16_t* w = (bf16_t*)(ws + WS_W_IN) + (size_t)EIN * DM; const size_t n = (size_t)(EINP - EIN) * DM / 8;
            for (size_t i = (size_t)g_ * 64 + c.lane; i < n; i += (size_t)ng_ * 64) *(u32x4*)(w + i * 8) = (u32x4){0u, 0u, 0u, 0u};
        }
        if (PART == 1 && sub(248, 8)) {
            for (int it = g_; it < 64; it += ng_) {
                const int kv = it >> 5, blk = it & 31;
                const float* pe = gptr(p.in[kv ? 12 : 9]); const float* w1 = gptr(p.in[kv ? 13 : 10]);
                f32x4 sacc = {0.f, 0.f, 0.f, 0.f};
#pragma unroll 8
                for (int r = 0; r < 64; ++r) { const int kk = blk * 64 + r; sacc = sacc + *(const f32x4*)(w1 + (size_t)kk * 256 + 4 * c.lane) * pe[kk]; }
                *(f32x4*)((float*)(ws + WS_CMPP) + (size_t)it * 256 + 4 * c.lane) = sacc;
            }
        }
    }
    auto decode = [&](int it) -> TrItem {
        int r = it;
        if (r >= NA) return moe_tr_decode(c, 0, r - NA);
        if (r < I_IN) return TrItem{gptr(p.in[4]), EIN, EIN, (bf16_t*)(ws + WS_W_IN), DM, 1, r / 37, r % 37, true}; r -= I_IN;
        if (r < I_SQ) return TrItem{gptr(p.in[15]), DM, DM, (bf16_t*)(ws + WS_W_OUT), DM, 0, r >> 4, r & 15, true}; r -= I_SQ;
        if (r < I_OD) return TrItem{gptr(p.in[16]), 3 * DM, 3 * DM, (bf16_t*)(ws + WS_OD_IN), DM, 4, r / 48, r % 48, true}; r -= I_OD;
        if (r < I_SQ) return TrItem{gptr(p.in[18]), DM, DM, (bf16_t*)(ws + WS_OD_OUT), DM, 0, r >> 4, r & 15, true}; r -= I_SQ;
        if (r < 4 * I_SQ) { const int m = r >> 8, l = m & 1, q = r & 255;
            return TrItem{gptr(p.in[22]) + (size_t)l * DM * DM, DM, DM, (bf16_t*)(ws + WS_WO) + (size_t)l * DM * DM, DM, 0, q >> 4, q & 15, m >= 2}; } r -= 4 * I_SQ;
        if (r < 2 * I_SQ) { const int m = r >> 8, q = r & 255; return TrItem{gptr(p.in[m ? 3 : 2]), DM, DM, (bf16_t*)(ws + (m ? WS_WV : WS_WK)), DM, 0, q >> 4, q & 15, true}; } r -= 2 * I_SQ;
        const int m = r >> 6, kv = m >> 1, half = m & 1, q = r & 63;
        return TrItem{gptr(p.in[kv ? 13 : 10]) + (size_t)half * 1024 * 256, 256, 256, (bf16_t*)(ws + WS_CW1) + ((size_t)kv * 512 + half * 256) * DM, DM, 0, q >> 2, q & 3, true};
    };
    {   constexpr int ILO = (PART == 0) ? 0 : I_IN, NTOT = (PART == 0) ? I_IN : NA;
        f32x4 va[16], vb[16];
        int it = ILO + c.gw;
        if (it < NTOT) {
            TrItem cur = decode(it); tr_load(cur, va, c.lane);
            for (;;) {
                const int i1 = it + c.ngw; const bool h1 = i1 < NTOT; TrItem n1 = cur;
                if (h1) { n1 = decode(i1); tr_load(n1, vb, c.lane); }
                tr_store(cur, va, scr, c.lane);
                if (!h1) break;
                const int i2 = i1 + c.ngw; const bool h2 = i2 < NTOT;
                if (h2) { cur = decode(i2); tr_load(cur, va, c.lane); }
                tr_store(n1, vb, scr, c.lane);
                if (!h2) break;
                it = i2;
            }
        }
    }
    if (PART == 0) cvt_rows(c, gptr(p.in[0]), (bf16_t*)(ws + WS_XA), (size_t)NT * DM, c.gw, c.ngw);
}

constexpr int CONV_LW = 63488;
typedef float f32x2 __attribute__((ext_vector_type(2)));
DEV void conv_stage_w(const Ctx& c) {
    __attribute__((address_space(3))) float* LW = (__attribute__((address_space(3))) float*)((__attribute__((address_space(3))) unsigned char*)c.lds + CONV_LW);
    const float* cw = gptr(c.p->in[5]);
    for (int i = c.tid; i < 37 * 512; i += NTHREADS) { const int row = i >> 9, ch = i & 511, k = row - 3;
        LW[row * 512 + ((ch & 4) ? 256 : 0) + (ch >> 3) * 4 + (ch & 3)] = (k >= 0 && k <= 30) ? cw[k * 512 + ch] : 0.f; }
}
DEV void conv_tile(const Ctx& c, int tile, const float (&bias)[8], const float (&gam)[8], const float (&bet)[8]) {
    typedef __attribute__((address_space(3))) unsigned char lds8;
    lds8* L = (lds8*)c.lds; lds8* LW = L + CONV_LW;
    const bf16_t* Y0 = (const bf16_t*)(c.ws + SC_Y0); bf16_t* CAT = (bf16_t*)(c.ws + SC_CAT);
    const int tok0 = tile * 32, t0 = tok0 & (SEQ - 1);
    __syncthreads();
    {   u32x4 v[8];
#pragma unroll
        for (int u = 0; u < 8; ++u) { const int i = c.tid + u * NTHREADS, r = i >> 6, ch = i & 63; v[u] = (u32x4){0u, 0u, 0u, 0u};
            if (i < 62 * 64 && t0 - 30 + r >= 0) v[u] = *(const u32x4*)(Y0 + (size_t)(tok0 - 30 + r) * EINP + ch * 8); }
#pragma unroll
        for (int u = 0; u < 8; ++u) { const int i = c.tid + u * NTHREADS, r = i >> 6, ch = i & 63;
            if (i < 62 * 64) *(__attribute__((address_space(3))) u32x4*)(L + r * 1024 + ch * 16) = v[u]; }
    }
    __syncthreads();
    const int ch0 = c.lane * 8, j0 = c.wave * 4;
    f32x2 acc[4][4];
#pragma unroll
    for (int j = 0; j < 4; ++j) { const f32x2 bq = {bias[2 * j], bias[2 * j + 1]};
#pragma unroll
        for (int m = 0; m < 4; ++m) acc[m][j] = bq; }
    f32x2 w[4][4];
#pragma unroll
    for (int d = 0; d < 4; ++d)
#pragma unroll
        for (int j = 0; j < 4; ++j) w[d][j] = (f32x2){0.f, 0.f};
#define CONV_STEP(s, u) do { \
        const u32x4 ra_ = *(const __attribute__((address_space(3))) u32x4*)(L + (j0 + (s)) * 1024 + c.lane * 16); \
        const f32x4 wa_ = *(const __attribute__((address_space(3))) f32x4*)(LW + ((s) + 3) * 2048 + c.lane * 16), wb_ = *(const __attribute__((address_space(3))) f32x4*)(LW + ((s) + 3) * 2048 + 1024 + c.lane * 16); \
        w[(u)][0] = (f32x2){wa_[0], wa_[1]}; w[(u)][1] = (f32x2){wa_[2], wa_[3]}; w[(u)][2] = (f32x2){wb_[0], wb_[1]}; w[(u)][3] = (f32x2){wb_[2], wb_[3]}; \
        f32x2 a_[4]; \
        _Pragma("unroll") for (int j = 0; j < 4; ++j) a_[j] = (f32x2){__uint_as_float(ra_[j] << 16), __uint_as_float(ra_[j] & 0xffff0000u)}; \
        _Pragma("unroll") for (int m = 0; m < 4; ++m) _Pragma("unroll") for (int j = 0; j < 4; ++j) acc[m][j] = __builtin_elementwise_fma(a_[j], w[((u) - m) & 3][j], acc[m][j]); } while (0)
    for (int s4 = 0; s4 < 32; s4 += 4) { CONV_STEP(s4, 0); CONV_STEP(s4 + 1, 1); CONV_STEP(s4 + 2, 2); CONV_STEP(s4 + 3, 3); }
    CONV_STEP(32, 0); CONV_STEP(33, 1);
#undef CONV_STEP
#pragma unroll
    for (int m = 0; m < 4; ++m) {
        float a8[8];
#pragma unroll
        for (int j = 0; j < 4; ++j) { a8[2 * j] = acc[m][j][0]; a8[2 * j + 1] = acc[m][j][1]; }
        float s = 0.f;
#pragma unroll
        for (int j = 0; j < 8; ++j) s += a8[j];
        const float mean = wsum_dpp(s) * (1.f / 512.f); float s2 = 0.f;
#pragma unroll
        for (int j = 0; j < 8; ++j) { a8[j] -= mean; s2 += a8[j] * a8[j]; }
        const float rstd = rsqrtf(wsum_dpp(s2) * (1.f / 512.f) + LN_EPS);
        float y[8];
#pragma unroll
        for (int j = 0; j < 8; ++j) { const float v = a8[j] * rstd * gam[j] + bet[j]; y[j] = v * frcp(1.f + __expf(-v)); }
        u32x4 o; o.x = pk2(y[0], y[1]); o.y = pk2(y[2], y[3]); o.z = pk2(y[4], y[5]); o.w = pk2(y[6], y[7]);
        *(u32x4*)(CAT + (size_t)(tok0 + j0 + m) * DM + ch0) = o;
    }
}
DEV void conv_phase(const Ctx& c) {
    conv_stage_w(c);
    const int bx = blockIdx.x;
    if (bx == gridDim.x - 1) {
        const float* part = (const float*)(c.ws + WS_CMPP); float sum = 0.f;
        for (int blk = 0; blk < 32; ++blk) sum += part[(size_t)((c.tid >> 8) * 32 + blk) * 256 + (c.tid & 255)];
        ((float*)(c.ws + WS_CMPB))[c.tid] = sum;
    }
    float bias[8], gam[8], bet[8];
#pragma unroll
    for (int j = 0; j < 8; ++j) { bias[j] = gptr(c.p->in[6])[c.lane * 8 + j]; gam[j] = gptr(c.p->in[7])[c.lane * 8 + j]; bet[j] = gptr(c.p->in[8])[c.lane * 8 + j]; }
    if (bx < 128) { for (int i = 0; i < 3; ++i) conv_tile(c, 3 * bx + i, bias, gam, bet); }
    else for (int i = 0; i < 5; ++i) conv_tile(c, 384 + (bx - 128) * 5 + i, bias, gam, bet);
    __syncthreads();
}

DEV float gelu_tanh_fast(float x) { const float u = 0.7978845608028654f * (x + 0.044715f * x * x * x); const float t = 1.f - 2.f * frcp(1.f + __expf(2.f * u)); return 0.5f * x * (1.f + t); }
DEV void cmp_finish(const Ctx& c) {
    const __attribute__((address_space(4))) Params& p = *c.p;
    const int kv = (blockIdx.x >= gridDim.x / 2) ? 1 : 0, half = gridDim.x / 2, bxl = blockIdx.x - kv * half;
    float* w2l = c.lds;
    float* hid = c.lds + 16384 + c.wave * 256;
    { const float* w2 = gptr(p.in[kv ? 14 : 11]); for (int i = c.tid; i < 4096; i += NTHREADS) *(f32x4*)(w2l + 4 * i) = *(const f32x4*)(w2 + 4 * i); }
    __syncthreads();
    const float* P = (const float*)(c.ws + (kv ? WS_PV : WS_PK));
    const float* cbias = (const float*)(c.ws + WS_CMPB) + kv * 256;
    float cb[4];
#pragma unroll
    for (int i = 0; i < 4; ++i) cb[i] = cbias[c.lane + 64 * i];
    for (int r = bxl * NWAVES + c.wave; r < NB * NCMP * 2; r += half * NWAVES) {
        const int g = r & 1, bn = r >> 1, b = bn / NCMP, n = bn % NCMP;
        const int r0 = (b * 256 + n) * 2 + g, r1 = (b * 256 + n + 1) * 2 + g;
#pragma unroll
        for (int i = 0; i < 4; ++i) { const int cc = c.lane + 64 * i; hid[cc] = gelu_tanh_fast(P[(size_t)r0 * 512 + cc] + P[(size_t)r1 * 512 + 256 + cc] + cb[i]); }
        LDS_WAIT();
        float o0 = 0.f, o1 = 0.f, o2 = 0.f, o3 = 0.f;
#pragma unroll 4
        for (int cc = 0; cc < 256; cc += 4) { const f32x4 hv = *(const f32x4*)(hid + cc);
            o0 += hv.x * w2l[(cc + 0) * 64 + c.lane]; o1 += hv.y * w2l[(cc + 1) * 64 + c.lane]; o2 += hv.z * w2l[(cc + 2) * 64 + c.lane]; o3 += hv.w * w2l[(cc + 3) * 64 + c.lane]; }
        ((bf16_t*)(c.ws + (kv ? WS_VCMP : WS_KCMP)))[(size_t)((b * 2 + g) * 256 + n) * 64 + c.lane] = (bf16_t)f2bf((o0 + o1) + (o2 + o3));
        LDS_WAIT();
    }
}

DEV void nsa_naive(const Ctx& c) {
    const bf16_t* Y0 = (const bf16_t*)(c.ws + SC_Y0); bf16_t* CAT = (bf16_t*)(c.ws + WS_XB);
    const bf16_t* KC = (const bf16_t*)(c.ws + WS_KCMP); const bf16_t* VC = (const bf16_t*)(c.ws + WS_VCMP);
    float* pc = c.lds + c.wave * 1024;
    const int hh = c.lane >> 4, dq = c.lane & 15;
    for (int it = c.gw; it < NT * 2; it += c.ngw) {
        const int g = it & 1, row = it >> 1, b = row >> 12, t = row & (SEQ - 1);
        const int h = g * 4 + hh;
        const bf16_t* yrow = Y0 + (size_t)row * EINP;
        float q[4]; ld4bf(yrow + C_Q + h * 64 + dq * 4, q);
        const int ncv = (t >= 31) ? min(NCMP, (t - 31) / 16 + 1) : 0;
        float oc[4] = {0.f, 0.f, 0.f, 0.f};
        float mx = -INFINITY;
        for (int n = 0; n < ncv; ++n) {
            float kk4[4]; ld4bf(KC + (size_t)((b * 2 + g) * 256 + n) * 64 + dq * 4, kk4); const f32x4 k4 = {kk4[0], kk4[1], kk4[2], kk4[3]};
            float s = q[0] * k4.x + q[1] * k4.y + q[2] * k4.z + q[3] * k4.w; s = gsum16(s);
            if (dq == 0) pc[hh * 256 + n] = s;
            mx = fmaxf(mx, s);
        }
        LDS_WAIT();
        float l = 0.f;
        for (int n = 0; n < ncv; ++n) l += exp2f(pc[hh * 256 + n] - mx);
        const float inv = (ncv > 0) ? 1.f / l : 0.f;
        for (int n = 0; n < ncv; ++n) {
            const float pr = exp2f(pc[hh * 256 + n] - mx) * inv;
            float vv4[4]; ld4bf(VC + (size_t)((b * 2 + g) * 256 + n) * 64 + dq * 4, vv4); const f32x4 v4 = {vv4[0], vv4[1], vv4[2], vv4[3]};
            oc[0] += pr * v4.x; oc[1] += pr * v4.y; oc[2] += pr * v4.z; oc[3] += pr * v4.w;
            LDS_WAIT();
            if (dq == 0) pc[hh * 256 + n] = pr;
        }
        LDS_WAIT();
        const int m = c.lane, cur = t >> 6;
        float imp = 0.f;
#pragma unroll
        for (int h2 = 0; h2 < 4; ++h2)
#pragma unroll
            for (int dn = -1; dn <= 3; ++dn) { const int n = 4 * m + dn; if (n >= 0 && n < ncv) imp += pc[h2 * 256 + n] * ((dn == -1 || dn == 3) ? 0.5f : 1.f); }
        const bool causal = m <= cur, forced = (m == 0) || (m == cur) || (m == cur - 1);
        const float score = causal ? (forced ? 1e4f : imp) : -1e30f;
        int rank = 0;
        for (int m2 = 0; m2 < 64; ++m2) { const float s2 = __shfl(score, m2); rank += ((s2 > score) || (s2 == score && m2 < m)) ? 1 : 0; }
        unsigned long long selmask = __ballot(causal && rank < 16);
        LDS_WAIT();
        float ms = -INFINITY, ls = 0.f, os[4] = {0.f, 0.f, 0.f, 0.f};
        while (selmask) {
            const int mb = __builtin_ctzll(selmask); selmask &= selmask - 1;
            const int jmax = min(63, t - 64 * mb);
            const bf16_t* kb = Y0 + (size_t)(b * SEQ + 64 * mb) * EINP + g * 64 + dq * 4;
            for (int j = 0; j <= jmax; ++j) {
                float k4[4], v4[4]; ld4bf(kb + (size_t)j * EINP + C_KS, k4); ld4bf(kb + (size_t)j * EINP + C_VS, v4);
                float s = q[0] * k4[0] + q[1] * k4[1] + q[2] * k4[2] + q[3] * k4[3]; s = gsum16(s);
                const float mn = fmaxf(ms, s), cf = exp2f(ms - mn), pp = exp2f(s - mn);
                ls = ls * cf + pp;
#pragma unroll
                for (int i = 0; i < 4; ++i) os[i] = os[i] * cf + pp * v4[i];
                ms = mn;
            }
        }
        float mw = -INFINITY, lw = 0.f, ow[4] = {0.f, 0.f, 0.f, 0.f};
        {
            const int k0 = max(0, t - 511);
            const bf16_t* kb = Y0 + (size_t)(b * SEQ) * EINP + g * 64 + dq * 4;
            for (int kp = k0; kp <= t; ++kp) {
                float k4[4], v4[4]; ld4bf(kb + (size_t)kp * EINP + C_KW, k4); ld4bf(kb + (size_t)kp * EINP + C_VW, v4);
                float s = q[0] * k4[0] + q[1] * k4[1] + q[2] * k4[2] + q[3] * k4[3]; s = gsum16(s);
                const float mn = fmaxf(mw, s), cf = exp2f(mw - mn), pp = exp2f(s - mn);
                lw = lw * cf + pp;
#pragma unroll
                for (int i = 0; i < 4; ++i) ow[i] = ow[i] * cf + pp * v4[i];
                mw = mn;
            }
        }
        const float gc = sigmoidf_(bf2f(yrow[C_GL + h * 3 + 0])), gs = sigmoidf_(bf2f(yrow[C_GL + h * 3 + 1])) / ls, gwn = sigmoidf_(bf2f(yrow[C_GL + h * 3 + 2])) / lw;
        st4bf(CAT + (size_t)row * DM + 512 + h * 64 + dq * 4, gc * oc[0] + gs * os[0] + gwn * ow[0], gc * oc[1] + gs * os[1] + gwn * ow[1], gc * oc[2] + gs * os[2] + gwn * ow[2], gc * oc[3] + gs * os[3] + gwn * ow[3]);
    }
}

namespace nsa {
typedef float f32x16 __attribute__((ext_vector_type(16)));
typedef short s16x4 __attribute__((ext_vector_type(4)));
typedef __attribute__((address_space(3))) unsigned char lds_u8;
constexpr int SLOT = 8192, NSLOT = 3;
constexpr int IMPP = 65;
constexpr int L_K = 0, L_V = NSLOT * SLOT, L_IMP = 2 * NSLOT * SLOT  , L_SEL = L_IMP + 4 * 64 * IMPP * 4  ;
constexpr float NEGB = -1e30f;
DEV int crow(int r, int hi) { return (r & 3) + 8 * (r >> 2) + 4 * hi; }
DEV s16x4 vtr(const lds_u8* p) { typedef short v4i16_t __attribute__((ext_vector_type(4))); return __builtin_bit_cast(s16x4, __builtin_amdgcn_ds_read_tr16_b64_v4i16((__attribute__((address_space(3))) v4i16_t*)p)); }
DEV unsigned cvtpk(float lo, float hi) { typedef float f2 __attribute__((ext_vector_type(2))); typedef __bf16 b2 __attribute__((ext_vector_type(2))); f2 v = {lo, hi}; b2 b = __builtin_convertvector(v, b2); return __builtin_bit_cast(unsigned, b); }
DEV void glds16(const void* gsrc, unsigned lds_dst) { unsigned keep;
    asm volatile("s_mov_b32 %0, m0\n\ts_mov_b32 m0, %2\n\ts_nop 0\n\tglobal_load_lds_dwordx4 %1, off\n\ts_mov_b32 m0, %0" : "=&s"(keep) : "v"(gsrc), "s"(lds_dst) : "memory"); }
#define NSA_WAITV(n) asm volatile("s_waitcnt vmcnt(" #n ")" ::: "memory")
#define NSA_BAR() do { asm volatile("s_waitcnt lgkmcnt(0)" ::: "memory"); __builtin_amdgcn_s_barrier(); asm volatile("" ::: "memory"); } while (0)

DEV void flash_pass(lds_u8* lds, const bf16_t* Kg, int pk, const bf16_t* Vg, int pv, int t0, int nt, const bf16x8 (&qr)[4],
                    int lo, int hi_b, unsigned long long rowmask, int lo_max, int hi_min, f32x16 (&o)[2], float& l_out) {
    const int tid = threadIdx.x, lane = tid & 63, r32 = lane & 31, hi = lane >> 5; const int wid = __builtin_amdgcn_readfirstlane(tid >> 6);
    o[0] = f32x16{}; o[1] = f32x16{}; float l = 0.f, mhat = 0.f;
    if (nt <= 0) { l_out = 0.f; return; }
    const bf16_t* ksrc = Kg + (size_t)(t0 * 64 + lane) * pk + wid * 8;
    const bf16_t* vsrc = Vg + (size_t)(t0 * 64 + 16 * (wid & 3) + (lane >> 2)) * pv + (wid >> 2) * 32 + (lane & 3) * 8;
    const size_t kstep = (size_t)64 * pk, vstep = (size_t)64 * pv;
    const unsigned lds0 = (unsigned)(uintptr_t)lds;
#define NSA_DMA(t, slot) do { glds16(ksrc + (size_t)(t) * kstep, (unsigned)__builtin_amdgcn_readfirstlane(lds0 + L_K + (slot) * SLOT + wid * 1024)); \
                               glds16(vsrc + (size_t)(t) * vstep, (unsigned)__builtin_amdgcn_readfirstlane(lds0 + L_V + (slot) * SLOT + wid * 1024)); } while (0)
    const lds_u8* kp0 = lds + L_K + hi * 1024 + r32 * 16;
    const lds_u8* vp0 = lds + L_V + ((lane >> 4) & 1) * 32 + (lane & 3) * 8 + (4 * hi + ((lane & 15) >> 2)) * 64;
    NSA_DMA(0, 0);
    if (nt > 1) NSA_DMA(1, 1);
    int slot = 0;
    for (int t = 0; t < nt; ++t) {
        if (t + 1 < nt) NSA_WAITV(2); else NSA_WAITV(0);
        NSA_BAR();
        if (t + 2 < nt) { const int s2 = (slot >= 1) ? slot - 1 : 2; NSA_DMA(t + 2, s2); }
        const int gt = t0 + t;
        const bool rowok = (rowmask >> gt) & 1ull;
        const float ci = rowok ? -mhat : NEGB;
        f32x16 c0, c1;
#pragma unroll
        for (int r = 0; r < 16; ++r) { c0[r] = ci; c1[r] = ci; }
        const lds_u8* kp = kp0 + slot * SLOT;
        bf16x8 kf[8];
#pragma unroll
        for (int d0 = 0; d0 < 4; ++d0) { kf[2 * d0] = *(const __attribute__((address_space(3))) bf16x8*)(kp + d0 * 2048); kf[2 * d0 + 1] = *(const __attribute__((address_space(3))) bf16x8*)(kp + d0 * 2048 + 512); }
        __builtin_amdgcn_s_setprio(1);
#pragma unroll
        for (int d0 = 0; d0 < 4; ++d0) {
            c0 = __builtin_amdgcn_mfma_f32_32x32x16_bf16(kf[2 * d0], qr[d0], c0, 0, 0, 0);
            c1 = __builtin_amdgcn_mfma_f32_32x32x16_bf16(kf[2 * d0 + 1], qr[d0], c1, 0, 0, 0);
        }
        __builtin_amdgcn_s_setprio(0);
        if ((64 * gt + 63 > hi_min) || (64 * gt <= lo_max)) {
            const int kb = 64 * gt + 4 * hi;
#pragma unroll
            for (int r = 0; r < 16; ++r) { const int kv = kb + (r & 3) + 8 * (r >> 2);
                if (!(kv > lo && kv <= hi_b)) c0[r] = NEGB;
                if (!(kv + 32 > lo && kv + 32 <= hi_b)) c1[r] = NEGB; }
        }
#define NSA_MX3(a, b, c) __builtin_fmaxf(__builtin_fmaxf((a), (b)), (c))
        float rm, rm2;
        { float a = NSA_MX3(c0[0], c0[1], c1[0]), b = NSA_MX3(c0[2], c0[3], c1[1]); a = NSA_MX3(a, c1[2], c1[3]);
#pragma unroll
          for (int r = 4; r < 16; r += 4) { a = NSA_MX3(a, c0[r], c0[r + 1]); b = NSA_MX3(b, c0[r + 2], c0[r + 3]); a = NSA_MX3(a, c1[r], c1[r + 1]); b = NSA_MX3(b, c1[r + 2], c1[r + 3]); }
          rm = __builtin_fmaxf(a, b); rm2 = rm; }
#undef NSA_MX3
        { auto rr = __builtin_amdgcn_permlane32_swap(__float_as_uint(rm), __float_as_uint(rm2), false, false); rm = __builtin_fmaxf(__uint_as_float(rr[0]), __uint_as_float(rr[1])); }
        if (__any(rm > 6.0f)) {
            const float dl = fmaxf(rm, 0.f), f = __builtin_amdgcn_exp2f(-dl);
            mhat += dl; l *= f;
#pragma unroll
            for (int r = 0; r < 16; ++r) { c0[r] -= dl; c1[r] -= dl; o[0][r] *= f; o[1][r] *= f; }
        }
        float ps = 0.f;
#pragma unroll
        for (int r = 0; r < 16; ++r) { c0[r] = __builtin_amdgcn_exp2f(c0[r]); c1[r] = __builtin_amdgcn_exp2f(c1[r]); ps += c0[r] + c1[r]; }
        l += ps;
        u32x4 pw[4];
#pragma unroll
        for (int s = 0; s < 2; ++s)
#pragma unroll
            for (int j = 0; j < 4; ++j) { pw[s][j] = cvtpk(c0[8 * s + 2 * j], c0[8 * s + 2 * j + 1]); pw[2 + s][j] = cvtpk(c1[8 * s + 2 * j], c1[8 * s + 2 * j + 1]); }
        const lds_u8* vp = vp0 + slot * SLOT;
        bf16x8 vf[8];
#pragma unroll
        for (int dh = 0; dh < 2; ++dh)
#pragma unroll
            for (int ks = 0; ks < 4; ++ks) {
                const s16x4 vl = vtr(vp + dh * 4096 + ks * 1024), vh = vtr(vp + dh * 4096 + ks * 1024 + 512);
                vf[dh * 4 + ks] = (bf16x8){vl[0], vl[1], vl[2], vl[3], vh[0], vh[1], vh[2], vh[3]};
            }
        __builtin_amdgcn_s_setprio(1);
#pragma unroll
        for (int ks = 0; ks < 4; ++ks) {
            o[0] = __builtin_amdgcn_mfma_f32_32x32x16_bf16(vf[ks], __builtin_bit_cast(bf16x8, pw[ks]), o[0], 0, 0, 0);
            o[1] = __builtin_amdgcn_mfma_f32_32x32x16_bf16(vf[4 + ks], __builtin_bit_cast(bf16x8, pw[ks]), o[1], 0, 0, 0);
        }
        __builtin_amdgcn_s_setprio(0);
        slot = (slot == 2) ? 0 : slot + 1;
    }
    NSA_BAR();
    { auto rr = __builtin_amdgcn_permlane32_swap(__float_as_uint(l), __float_as_uint(l), false, false); l = __uint_as_float(rr[0]) + __uint_as_float(rr[1]); }
    l_out = l;
#undef NSA_DMA
}

DEV void nsa_unit(lds_u8* lds, unsigned char* ws, int b, int g, int qt) {
    const int tid = threadIdx.x, lane = tid & 63, r32 = lane & 31, hi = lane >> 5; const int wid = __builtin_amdgcn_readfirstlane(tid >> 6);
    const int hh = wid >> 1, h = 4 * g + hh, ql = 32 * (wid & 1) + r32, t = 64 * qt + ql;
    const bf16_t* Y0 = (const bf16_t*)(ws + SC_Y0);
    const bf16_t* yrow = Y0 + (size_t)(b * SEQ + t) * EINP;
    bf16x8 qr[4];
#pragma unroll
    for (int d0 = 0; d0 < 4; ++d0) qr[d0] = *(const bf16x8*)(yrow + C_Q + h * 64 + d0 * 16 + hi * 8);
#pragma unroll
    for (int d0 = 0; d0 < 4; ++d0) asm volatile("" : "+v"(qr[d0]));
    const float g_c = sigmoidf_(bf2f(yrow[C_GL + h * 3 + 0])), g_s = sigmoidf_(bf2f(yrow[C_GL + h * 3 + 1])), g_w = sigmoidf_(bf2f(yrow[C_GL + h * 3 + 2]));
    const bf16_t* Ybg = Y0 + (size_t)(b * SEQ) * EINP + g * 64;
    f32x16 acc[2], o[2]; float l;
    const int nmax = (t >= 31) ? (t - 31) >> 4 : -1;
    const int tmaxu = 64 * qt + 63, nmax_u = (tmaxu - 31) >> 4, nct = (nmax_u >> 6) + 1;
    const int nmin_u = (64 * qt >= 31) ? (64 * qt - 31) >> 4 : -1;
    const bf16_t* KC = (const bf16_t*)(ws + WS_KCMP) + (size_t)(b * 2 + g) * 256 * 64;
    const bf16_t* VC = (const bf16_t*)(ws + WS_VCMP) + (size_t)(b * 2 + g) * 256 * 64;
    const bf16_t* MS = (const bf16_t*)(ws + WS_MSEL) + (size_t)((b * 2 + g) & 7) * 256 * 64;
    flash_pass(lds, KC, 64, VC, 64, 0, nct, qr, -1, nmax, ~0ull, -1, nmin_u, o, l);
    { const float sc = (l > 0.f) ? g_c * frcp(l) : 0.f;
#pragma unroll
      for (int dh = 0; dh < 2; ++dh)
#pragma unroll
          for (int r = 0; r < 16; ++r) acc[dh][r] = o[dh][r] * sc; }
    unsigned long long selmask = (2ull << qt) - 1ull;
    if (qt >= 16) {
    flash_pass(lds, KC, 64, MS, 64, 0, nct, qr, -1, nmax, ~0ull, -1, nmin_u, o, l);
    { const float sc = (l > 0.f) ? frcp(l) : 0.f;
      __attribute__((address_space(3))) float* imp = (__attribute__((address_space(3))) float*)(lds + L_IMP) + (hh * 64 + ql) * IMPP;
#pragma unroll
      for (int dh = 0; dh < 2; ++dh)
#pragma unroll
          for (int r = 0; r < 16; ++r) imp[32 * dh + crow(r, hi)] = o[dh][r] * sc; }
    NSA_BAR();
    {
        __attribute__((address_space(3))) const float* impb = (__attribute__((address_space(3))) const float*)(lds + L_IMP);
        __attribute__((address_space(3))) unsigned long long* selp = (__attribute__((address_space(3))) unsigned long long*)(lds + L_SEL);
        const int m = lane, cur = qt;
        for (int qq = 8 * wid; qq < 8 * wid + 8; ++qq) {
            unsigned long long sel;
            if (cur < 16) sel = (2ull << cur) - 1ull;
            else {
                const float iv = ((impb[(0 * 64 + qq) * IMPP + m] + impb[(1 * 64 + qq) * IMPP + m]) + impb[(2 * 64 + qq) * IMPP + m]) + impb[(3 * 64 + qq) * IMPP + m];
                const bool cand = (m >= 1) && (m <= cur - 2);
                const unsigned bits = __float_as_uint(fmaxf(iv, 0.f));
                unsigned T = 0u;
                for (int bit = 30; bit >= 0; --bit) { const unsigned trial = T | (1u << bit); if (__popcll(__ballot(cand && bits >= trial)) >= 13) T = trial; }
                const unsigned long long gtm = __ballot(cand && bits > T); unsigned long long eqm = __ballot(cand && bits == T);
                int need = 13 - __popcll(gtm); unsigned long long tie = 0ull;
                while (need > 0 && eqm) { const unsigned long long lowb = eqm & (~eqm + 1ull); tie |= lowb; eqm ^= lowb; --need; }
                sel = gtm | tie | 1ull | (1ull << cur) | (1ull << (cur - 1));
            }
            if (lane == 0) selp[qq] = sel;
        }
    }
    NSA_BAR();
    selmask = ((__attribute__((address_space(3))) const unsigned long long*)(lds + L_SEL))[ql];
    }
    flash_pass(lds, Ybg + C_KS, EINP, Ybg + C_VS, EINP, 0, qt + 1, qr, -1, t, selmask, -1, 64 * qt, o, l);
    { const float sc = g_s * frcp(l);
#pragma unroll
      for (int dh = 0; dh < 2; ++dh)
#pragma unroll
          for (int r = 0; r < 16; ++r) acc[dh][r] += o[dh][r] * sc; }
    { const int wt0 = (qt >= 8) ? qt - 8 : 0;
      flash_pass(lds, Ybg + C_KW, EINP, Ybg + C_VW, EINP, wt0, qt - wt0 + 1, qr, t - 512, t, ~0ull, 64 * qt + 63 - 512, 64 * qt, o, l);
      const float sc = g_w * frcp(l);
#pragma unroll
      for (int dh = 0; dh < 2; ++dh)
#pragma unroll
          for (int r = 0; r < 16; ++r) acc[dh][r] += o[dh][r] * sc; }
    bf16_t* orow = (bf16_t*)(ws + SC_CAT) + (size_t)(b * SEQ + t) * DM + 512 + h * 64;
#pragma unroll
    for (int dh = 0; dh < 2; ++dh)
#pragma unroll
        for (int j = 0; j < 4; ++j) { u32x2 w; w.x = cvtpk(acc[dh][4 * j], acc[dh][4 * j + 1]); w.y = cvtpk(acc[dh][4 * j + 2], acc[dh][4 * j + 3]); *(u32x2*)(orow + 32 * dh + 8 * j + 4 * hi) = w; }
    NSA_WAITV(0);
}
DEV void nsa_phase(unsigned char* lds_raw, unsigned char* ws) {
    lds_u8* lds = (lds_u8*)lds_raw;
    const int G = gridDim.x, bx = blockIdx.x;
    const int vcu = (G % 8 == 0) ? (bx % 8) * (G / 8) + bx / 8 : bx;
    for (int p = vcu; p < 512; p += G) {
        const int bg = p >> 5, s = p & 31;
        nsa_unit(lds, ws, bg >> 1, bg & 1, 63 - s);
        nsa_unit(lds, ws, bg >> 1, bg & 1, s);
    }
}
#undef NSA_WAITV
#undef NSA_BAR
}

DEV void router_mfma(const Ctx& c, const bf16_t* X, int layer) {
    const __attribute__((address_space(4))) Params& p = *c.p;
    const float* bg = gptr(p.in[26]) + layer * 4; const float* be = gptr(p.in[28]) + layer * 32;
    const bf16_t* WB = (const bf16_t*)(c.ws + WS_RWB) + (size_t)layer * 96 * DM;
    int* cnt = (int*)(c.ws + WS_CTL) + layer * 32; int* list = (int*)(c.ws + WS_LIST); float* gate = (float*)(c.ws + WS_GATE);
    int* lcnt = (int*)c.lds; int* lbase = lcnt + 32; int* asg = lcnt + 64;
    float* lgs = c.lds + 1024 + c.wave * 640;
    constexpr int rpw = NT / 256;
    if (c.tid < 32) lcnt[c.tid] = 0;
    __syncthreads();
    const int fr = c.lane & 15, kg = c.lane >> 4;
    static_assert(rpw == NWAVES * 16, "one 16-row block per wave");
    {
        const int lrow0 = c.wave * 16;
        const int row0 = blockIdx.x * rpw + lrow0;
        const bf16_t* ap = X + (size_t)(row0 + fr) * DM + kg * 8;
        f32x4 aE0 = {0.f, 0.f, 0.f, 0.f}, aE1 = aE0, aG = aE0;
        typedef __attribute__((address_space(3))) unsigned char lds8;
        lds8* LB = (lds8*)c.lds + 32768;
        for (int half = 0; half < 2; ++half) {
            __syncthreads();
#pragma unroll 4
            for (int i = c.tid; i < 96 * 64; i += NTHREADS) { const int row = i >> 6, ch = i & 63;
                *(__attribute__((address_space(3))) u32x4*)(LB + row * 1040 + ch * 16) = *(const u32x4*)(WB + (size_t)row * DM + half * 512 + ch * 8); }
            __syncthreads();
            const lds8* bp = LB + fr * 1040 + kg * 16;
#pragma unroll 4
            for (int s = 0; s < 16; ++s) {
                const bf16x8 a = *(const bf16x8*)(ap + half * 512 + 32 * s);
#define RB(blk) (*(const __attribute__((address_space(3))) bf16x8*)(bp + (blk) * 16 * 1040 + s * 64))
                const bf16x8 b0 = RB(0), b1 = RB(1), b2 = RB(2), b3 = RB(3), b4 = RB(4), b5 = RB(5);
#undef RB
                aE0 = __builtin_amdgcn_mfma_f32_16x16x32_bf16(a, b0, aE0, 0, 0, 0); aE0 = __builtin_amdgcn_mfma_f32_16x16x32_bf16(a, b3, aE0, 0, 0, 0);
                aE1 = __builtin_amdgcn_mfma_f32_16x16x32_bf16(a, b1, aE1, 0, 0, 0); aE1 = __builtin_amdgcn_mfma_f32_16x16x32_bf16(a, b4, aE1, 0, 0, 0);
                aG = __builtin_amdgcn_mfma_f32_16x16x32_bf16(a, b2, aG, 0, 0, 0); aG = __builtin_amdgcn_mfma_f32_16x16x32_bf16(a, b5, aG, 0, 0, 0);
            }
        }
#pragma unroll
        for (int r = 0; r < 4; ++r) { float* lr = lgs + (4 * kg + r) * 40; lr[4 + fr] = aE0[r]; lr[20 + fr] = aE1[r]; if (fr < 4) lr[fr] = aG[r]; }
        LDS_WAIT();
        if (c.lane < 16) {
            const float* lr = lgs + c.lane * 40;
            float gl[4]; int gs = 0;
#pragma unroll
            for (int o = 0; o < 4; ++o) gl[o] = lr[o] + bg[o];
            float gm = gl[0];
#pragma unroll
            for (int o = 1; o < 4; ++o) if (gl[o] > gm) { gm = gl[o]; gs = o; }
            float den = 0.f;
#pragma unroll
            for (int o = 0; o < 4; ++o) den += __expf(gl[o] - gm);
            const float pgroup = frcp(den);
            int i0 = 0, i1 = -1; float v0 = -INFINITY, v1 = -INFINITY;
#pragma unroll
            for (int o = 0; o < 8; ++o) { const float e = lr[4 + gs * 8 + o] + be[gs * 8 + o];
                if (e > v0) { v1 = v0; i1 = i0; v0 = e; i0 = o; } else if (e > v1) { v1 = e; i1 = o; } }
            const float e1 = __expf(v1 - v0), g0 = pgroup * frcp(1.f + e1), g1 = g0 * e1;
            const int ex0 = gs * 8 + i0, ex1 = gs * 8 + i1;
            const int lp0 = atomicAdd(lcnt + ex0, 1), lp1 = atomicAdd(lcnt + ex1, 1);
            asg[(lrow0 + c.lane) * 2] = (ex0 << 16) | lp0; asg[(lrow0 + c.lane) * 2 + 1] = (ex1 << 16) | lp1;
            gate[(row0 + c.lane) * 2] = g0; gate[(row0 + c.lane) * 2 + 1] = g1;
        }
        LDS_WAIT();
    }
    __syncthreads();
    if (c.tid < 32) lbase[c.tid] = atomicAdd(cnt + c.tid, lcnt[c.tid]);
    __syncthreads();
    for (int i = c.tid; i < 2 * rpw; i += NTHREADS) { const int a = asg[i], ex = a >> 16, lpos = a & 0xffff; const int aid_ = (blockIdx.x * rpw) * 2 + i, slot_ = lbase[ex] + lpos; list[ex * LCAP + slot_] = aid_; ((int*)(c.ws + WS_APOS))[aid_] = (ex << 16) | slot_; }
    __syncthreads();
}

DEV void bf8_to_f32(const u32x4 w, float* o) {
#pragma unroll
    for (int j = 0; j < 4; ++j) { o[2 * j] = __uint_as_float(w[j] << 16); o[2 * j + 1] = __uint_as_float(w[j] & 0xffff0000u); }
}
DEV void moe_combine(const Ctx& c, const bf16_t* Xin, const float* g, const float* b, bf16_t* Xo, float* outf, const int* cnt) {
    const bf16_t* Y = (const bf16_t*)(c.ws + SC_Y);
    const int* apos = (const int*)(c.ws + WS_APOS); const float* gate = (const float*)(c.ws + WS_GATE);
    int pref;
    { const int nb = (c.lane < NEXP) ? (cnt[c.lane] + 255) >> 8 : 0; int incl = nb;
#pragma unroll
      for (int o = 1; o < 32; o <<= 1) { const int t = __shfl_up(incl, o); if ((c.lane & 63) >= o) incl += t; }
      pref = incl - nb; }
    float gg[16], bb[16];
#pragma unroll
    for (int hf = 0; hf < 2; ++hf)
#pragma unroll
        for (int j = 0; j < 8; ++j) { gg[hf * 8 + j] = g[hf * 512 + 8 * c.lane + j]; bb[hf * 8 + j] = b[hf * 512 + 8 * c.lane + j]; }
    for (int row0 = c.gw * 2; row0 < NT; row0 += c.ngw * 2) {
        u32x4 xr[2][2], y0r[2][2], y1r[2][2];
#pragma unroll
        for (int r = 0; r < 2; ++r)
#pragma unroll
            for (int hf = 0; hf < 2; ++hf) { const size_t row = row0 + r; const int col = hf * 512 + 8 * c.lane;
                const int a0 = apos[2 * row], a1 = apos[2 * row + 1];
                const size_t p0 = (size_t)__shfl(pref, a0 >> 16) * 256 + (a0 & 0xffff), p1 = (size_t)__shfl(pref, a1 >> 16) * 256 + (a1 & 0xffff);
                xr[r][hf] = *(const u32x4*)(Xin + row * DM + col); y0r[r][hf] = *(const u32x4*)(Y + p0 * DM + col); y1r[r][hf] = *(const u32x4*)(Y + p1 * DM + col); }
#pragma unroll
        for (int r = 0; r < 2; ++r) {
            float v[16]; float s = 0.f; const float g0 = gate[2 * (row0 + r)], g1 = gate[2 * (row0 + r) + 1];
#pragma unroll
            for (int hf = 0; hf < 2; ++hf) { float x[8], a[8], bq[8]; bf8_to_f32(xr[r][hf], x); bf8_to_f32(y0r[r][hf], a); bf8_to_f32(y1r[r][hf], bq);
#pragma unroll
                for (int j = 0; j < 8; ++j) { v[hf * 8 + j] = x[j] * DN_ALPHA + (g0 * a[j] + g1 * bq[j]); s += v[hf * 8 + j]; } }
            const float mean = wsum_dpp(s) * (1.f / DM); float s2 = 0.f;
#pragma unroll
            for (int j = 0; j < 16; ++j) { v[j] -= mean; s2 += v[j] * v[j]; }
            const float rstd = rsqrtf(wsum_dpp(s2) * (1.f / DM) + LN_EPS);
#pragma unroll
            for (int j = 0; j < 16; ++j) v[j] = v[j] * rstd * gg[j] + bb[j];
            const size_t row = row0 + r;
#pragma unroll
            for (int hf = 0; hf < 2; ++hf) { const int col = hf * 512 + 8 * c.lane;
                if (Xo) { u32x4 o; o.x = pk2(v[hf * 8], v[hf * 8 + 1]); o.y = pk2(v[hf * 8 + 2], v[hf * 8 + 3]); o.z = pk2(v[hf * 8 + 4], v[hf * 8 + 5]); o.w = pk2(v[hf * 8 + 6], v[hf * 8 + 7]); *(u32x4*)(Xo + row * DM + col) = o; }
                if (outf) { *(f32x4*)(outf + row * DM + col) = (f32x4){v[hf * 8], v[hf * 8 + 1], v[hf * 8 + 2], v[hf * 8 + 3]}; *(f32x4*)(outf + row * DM + col + 4) = (f32x4){v[hf * 8 + 4], v[hf * 8 + 5], v[hf * 8 + 6], v[hf * 8 + 7]}; }
            }
        }
    }
}

DEV void odd_conv(const Ctx& c) {
    const bf16_t* Y1 = (const bf16_t*)(c.ws + SC_Y0); bf16_t* V = (bf16_t*)(c.ws + WS_XA);
    const float* cw = gptr(c.p->in[17]);
    float w0[8], w1[8], w2[8];
    { const int col = (c.gw & 1) * 512 + 8 * c.lane;
#pragma unroll
      for (int j = 0; j < 8; ++j) { w0[j] = cw[col + j]; w1[j] = cw[DM + col + j]; w2[j] = cw[2 * DM + col + j]; } }
    for (int it = c.gw; it < (NT / 16) * 2; it += c.ngw) {
        const int half = it & 1, tok0 = (it >> 1) * 16, col = half * 512 + 8 * c.lane, t0 = tok0 & (SEQ - 1);
        float um2[8], um1[8];
        if (t0 >= 2) { bf8_to_f32(*(const u32x4*)(Y1 + (size_t)(tok0 - 2) * 2048 + 1024 + col), um2); bf8_to_f32(*(const u32x4*)(Y1 + (size_t)(tok0 - 1) * 2048 + 1024 + col), um1); }
        else {
#pragma unroll
            for (int j = 0; j < 8; ++j) { um2[j] = 0.f; um1[j] = 0.f; } }
#pragma unroll 4
        for (int i = 0; i < 16; ++i) {
            float u0[8], gb[8];
            bf8_to_f32(*(const u32x4*)(Y1 + (size_t)(tok0 + i) * 2048 + 1024 + col), u0);
            bf8_to_f32(*(const u32x4*)(Y1 + (size_t)(tok0 + i) * 2048 + col), gb);
            float y[8];
#pragma unroll
            for (int j = 0; j < 8; ++j) { y[j] = gb[j] * (w0[j] * um2[j] + w1[j] * um1[j] + w2[j] * u0[j]); um2[j] = um1[j]; um1[j] = u0[j]; }
            u32x4 o; o.x = pk2(y[0], y[1]); o.y = pk2(y[2], y[3]); o.z = pk2(y[4], y[5]); o.w = pk2(y[6], y[7]);
            *(u32x4*)(V + (size_t)(tok0 + i) * DM + col) = o;
        }
    }
}

#define XB_TMO      128
#define XB_XCNT(j)  (256  + 64 * (j))
#define XB_XSUB(j)  (1280 + 64 * (j))
#define XB_XGEN(j)  (2304 + 64 * (j))
#define XB_TOP      3328
#define XB_TOPGEN   3392
#define XCD_BAR_WORDS 3456
#define XB_SPIN_CAP (1u << 22)
DEV unsigned xb_ld(unsigned* p)              { return __hip_atomic_load(p, __ATOMIC_RELAXED, __HIP_MEMORY_SCOPE_AGENT); }
DEV unsigned xb_add(unsigned* p, unsigned v) { return __hip_atomic_fetch_add(p, v, __ATOMIC_RELAXED, __HIP_MEMORY_SCOPE_AGENT); }
DEV unsigned xb_xcc_id() { return (unsigned)__builtin_amdgcn_s_getreg((3 << 11) | 20) & 0xFu; }
#define XB_SPIN(cond, bar) do { unsigned _sp = 0; while (cond) { __builtin_amdgcn_s_sleep(1); \
    if ((++_sp & 255u) == 0u) { if (xb_ld(&(bar)[XB_TMO])) break; if (_sp > XB_SPIN_CAP) { atomicAdd(&(bar)[XB_TMO], 1u); break; } } } } while (0)
struct XcdBarrier { unsigned* bar; unsigned x; volatile __attribute__((address_space(3))) unsigned* st; };
DEV XcdBarrier xcd_barrier_post(unsigned* bar, volatile __attribute__((address_space(3))) unsigned* st) {
    XcdBarrier b; b.bar = bar; b.x = xb_xcc_id(); b.st = st;
    if (threadIdx.x == 0) (void)xb_add(&bar[XB_XCNT(b.x)], 1u);
    return b;
}
DEV void xcd_barrier_complete(unsigned* bar, unsigned x, unsigned& nloc, unsigned& nx) {
    const unsigned G = gridDim.x * gridDim.y * gridDim.z;
    unsigned sum, cnt, mine, sp = 0u;
    for (;;) {
        sum = 0u; cnt = 0u; mine = 0u;
#pragma unroll
        for (unsigned j = 0; j < 16; ++j) { const unsigned cc = xb_ld(&bar[XB_XCNT(j)]); sum += cc; cnt += (cc > 0u) ? 1u : 0u; mine = (j == x) ? cc : mine; }
        if (sum == G) break;
        __builtin_amdgcn_s_sleep(1);
        if ((++sp & 255u) == 0u) { if (xb_ld(&bar[XB_TMO])) break; if (sp > XB_SPIN_CAP) { atomicAdd(&bar[XB_TMO], 1u); break; } }
    }
    nloc = mine > 0u ? mine : 1u; nx = cnt > 0u ? cnt : 1u;
}
DEV void xcd_barrier(const XcdBarrier& b) {
    asm volatile("s_waitcnt vmcnt(0)" ::: "memory");
    __syncthreads();
    if (threadIdx.x == 0) {
        unsigned* bar = b.bar;
        __builtin_amdgcn_s_waitcnt(0);
        unsigned nloc = b.st[0], nx = b.st[1];
        if (nloc == 0u) { xcd_barrier_complete(bar, b.x, nloc, nx); b.st[0] = nloc; b.st[1] = nx; }
        const unsigned old = xb_add(&bar[XB_XSUB(b.x)], 1u);
        const unsigned gen = old / nloc;
        if (old + 1u == (gen + 1u) * nloc) {
            __builtin_amdgcn_fence(__ATOMIC_RELEASE, "agent");
            asm volatile("s_waitcnt vmcnt(0)" ::: "memory");
            const unsigned og = xb_add(&bar[XB_TOP], 1u);
            const unsigned tg = og / nx;
            if (og + 1u == (tg + 1u) * nx) xb_add(&bar[XB_TOPGEN], 1u);
            else XB_SPIN(xb_ld(&bar[XB_TOPGEN]) == tg, bar);
            __builtin_amdgcn_fence(__ATOMIC_ACQUIRE, "agent");
            xb_add(&bar[XB_XGEN(b.x)], 1u);
            asm volatile("s_waitcnt vmcnt(0)" ::: "memory");
        } else {
            XB_SPIN(xb_ld(&bar[XB_XGEN(b.x)]) == gen, bar);
            __builtin_amdgcn_fence(__ATOMIC_ACQUIRE, "agent");
            asm volatile("s_waitcnt vmcnt(0)" ::: "memory");
        }
    }
    __syncthreads();
}

DEV void xa_fold_unit(PG8_LAS unsigned char* ldsp, unsigned char* ws, int layer, int fid) {
    const int id = fid & 127, b = id >> 4, h = (id >> 2) & 3, q = id & 3; const bool isn = fid >= 128;
    const bf16_t* MK = (const bf16_t*)(ws + WS_MEMK) + (size_t)(b * MEML) * DM + h * 256;
    const bf16_t* MV = (const bf16_t*)(ws + WS_MEMV) + (size_t)(b * MEML) * DM + h * 256;
    const bf16_t* WQP = (const bf16_t*)(ws + WS_WQ) + (size_t)layer * DM * DM + (size_t)(q * 256) * DM + h * 256;
    const bf16_t* WOT = (const bf16_t*)(ws + WS_WO) + (size_t)layer * DM * DM + (size_t)(q * 256) * DM + h * 256;
    bf16_t* MT = (bf16_t*)(ws + WS_MT) + ((size_t)b * DM + h * 256) * DM + q * 256;
    bf16_t* NT_ = (bf16_t*)(ws + WS_NT) + ((size_t)b * DM + q * 256) * DM + h * 256;
    pg8::OneUnitTask T{256, isn ? WOT : MK, isn ? MV : WQP, isn ? NT_ : MT, DM, 0, 0, 0, 0, fid < 256, isn ? 1.f : 0.0625f * 1.4426950408889634f};
    pg8::gemm_phase(ldsp, T);
}
DEV void xa_fold(PG8_LAS unsigned char* ldsp, unsigned char* ws, int layer) { xa_fold_unit(ldsp, ws, layer, blockIdx.x); }
DEV void xa_fold_in_moe_tail(PG8_LAS unsigned char* ldsp, unsigned char* ws, int layer, int nblk) {
    const int G = gridDim.x, bx = blockIdx.x, vc = (G % 8 == 0) ? (bx % 8) * (G / 8) + bx / 8 : bx;
    const int full = 4 * nblk - (4 * nblk / G) * G;
    const int nidle = G - full;
    if (vc < full) return;
    for (int fid = vc - full; fid < 256; fid += nidle) xa_fold_unit(ldsp, ws, layer, fid);
}

constexpr int N_PHASES = 25;
constexpr int LDS_BYTES = 147456;
__global__ void __launch_bounds__(NTHREADS, 2) fwd_kernel(Params prm) {
    extern __shared__ __attribute__((aligned(16))) unsigned char lds_raw[];
    volatile __attribute__((address_space(3))) unsigned* bst = (volatile __attribute__((address_space(3))) unsigned*)((__attribute__((address_space(3))) unsigned char*)lds_raw + LDS_BYTES - 16);
    if (threadIdx.x < 4) bst[threadIdx.x] = 0u;
    __syncthreads();
    XcdBarrier xbar; xbar.bar = (unsigned*)(prm.ws + WS_CTL) + 1024; xbar.x = 0; xbar.st = bst;
    if (prm.ph_hi - prm.ph_lo > 1) xbar = xcd_barrier_post((unsigned*)(prm.ws + WS_CTL) + 1024, bst);
    KParams kp = (KParams)__builtin_amdgcn_kernarg_segment_ptr();
    Ctx c; c.p = kp; c.ws = prm.ws; c.lds = (float*)lds_raw;
    c.tid = threadIdx.x; c.lane = c.tid & 63; c.wave = __builtin_amdgcn_readfirstlane(c.tid >> 6);
    c.gw = blockIdx.x * NWAVES + c.wave; c.ngw = gridDim.x * NWAVES;
    typedef __attribute__((address_space(1))) unsigned char gu8_t;
    gu8_t* wsg = (gu8_t*)prm.ws;
    unsigned char* ws = (unsigned char*)wsg;
    PG8_LAS unsigned char* ldsp = (PG8_LAS unsigned char*)lds_raw;
#define XA ((bf16_t*)(ws + WS_XA))
#define XB ((bf16_t*)(ws + WS_XB))
#define Z ((float*)(ws + SC_Z))
    typedef const float* cfptr_t;
    const __attribute__((address_space(4))) cfptr_t* in = (const __attribute__((address_space(4))) cfptr_t*)kp;
#ifndef ONLY_PHASE
#define ONLY_PHASE -1
#endif
#ifndef TPROBE_PHASE
#define TPROBE_PHASE -1
#endif
#define PHASE(k, ...) if (TPROBE_PHASE == (k)) tp0_ = __builtin_amdgcn_s_memrealtime(); if ((ONLY_PHASE < 0 || ONLY_PHASE == (k)) && prm.ph_lo <= (k) && (k) < prm.ph_hi) { asm volatile("" : "+s"(wsg)); ws = (unsigned char*)wsg; asm volatile("" : "+s"(kp)); c.p = kp; c.ws = ws; c.tid = threadIdx.x; asm volatile("" : "+v"(c.tid)); c.lane = c.tid & 63; in = (const __attribute__((address_space(4))) cfptr_t*)kp; { __VA_ARGS__; } if ((k) + 1 < prm.ph_hi) { xcd_barrier(xbar); } if (TPROBE_PHASE == (k)) tp1_ = __builtin_amdgcn_s_memrealtime(); }
    unsigned long long tp0_ = 0, tp1_ = 0;
    if (prm.ph_hi > N_PHASES) { __threadfence(); cg::this_grid().sync(); }
    PHASE(0, phase_prep<0>(c))
    PHASE(1, { const bool early = ((blockIdx.x >> 3) & 1) == 0; if (early) { phase_prep<1>(c); __syncthreads(); }
        pg8::PlainTask<pg8::EpiInproj, true> T{XA, DM, (const bf16_t*)(ws + WS_W_IN), DM, DM, {}, {(bf16_t*)(ws + SC_Y0)}}; T.S.init(NT, EINP, gridDim.x, blockIdx.x); pg8::gemm_phase(ldsp, T);
        if (!early) { __syncthreads(); c.tid = threadIdx.x; asm volatile("" : "+v"(c.tid)); c.lane = c.tid & 63; phase_prep<1>(c); } })
    PHASE(2, {
        const int bx = blockIdx.x;
        if (bx < 64) { pg8::CmpTask T{DM, ws, bx}; pg8::gemm_phase(ldsp, T); }
        else if (bx < 128) {
            const int j = (bx - 64) & 31; const bool isv = bx >= 96;
            pg8::OneUnitTask T{DM, (const bf16_t*)(ws + WS_MEMB), (const bf16_t*)(ws + (isv ? WS_WV : WS_WK)), (bf16_t*)(ws + (isv ? WS_MEMV : WS_MEMK)), DM,
                               (size_t)256 * DM, (size_t)256, j >> 2, j & 3, true, 1.f};
            pg8::gemm_phase(ldsp, T); }
        } conv_phase(c))
    PHASE(3, cmp_finish(c); __syncthreads(); xa_fold(ldsp, ws, 0))
#ifdef NSA_CHECK
    PHASE(4, nsa::nsa_phase(lds_raw, ws); nsa_naive(c);
        __syncthreads(); if (c.tid == 0) __threadfence(); )
#else
    PHASE(4, { const bool early = ((blockIdx.x >> 3) & 1) == 0;
        if (early) { moe_weights_m<0>(c, 0, c.gw, c.ngw); __syncthreads(); }
        nsa::nsa_phase(lds_raw, ws);
        if (!early) { __syncthreads(); moe_weights_m<0>(c, 0, c.gw, c.ngw); } })
#endif
#ifdef NSA_CHECK
    if (prm.ph_lo <= 5 && 5 < prm.ph_hi) {
        const bf16_t* A_ = (const bf16_t*)(ws + SC_CAT); const bf16_t* B_ = (const bf16_t*)(ws + WS_XB); float d2 = 0.f, a2 = 0.f;
        for (size_t i = (size_t)c.gw * 64 + c.lane; i < (size_t)NT * 512; i += (size_t)c.ngw * 64) { const size_t r = i >> 9, cc = 512 + (i & 511); const float a = bf2f(A_[r * DM + cc]), b = bf2f(B_[r * DM + cc]); d2 += (a - b) * (a - b); a2 += b * b; }
        d2 = wsum(d2); a2 = wsum(a2);
        if (c.lane == 0) { atomicAdd((float*)(ws + WS_CTL) + 60000, d2); atomicAdd((float*)(ws + WS_CTL) + 60001, a2); }
        xcd_barrier(xbar);
    }
#endif
    PHASE(5, { for (int half = 0; half < 2; ++half) { pg8::LnTask<true> T{DM, (const bf16_t*)(ws + SC_CAT), DM, (const bf16_t*)(ws + WS_W_OUT), gptr(in[0]), gptr(in[19]), gptr(in[20]), XB, half * 16384, {(unsigned long long*)(ws + WS_XBUF), (unsigned*)(ws + WS_CTL) + 8192 + 0 * 8192}, {}, 0}; T.S.init(16384, DM, gridDim.x, blockIdx.x); pg8::gemm_phase<pg8::LnTask<true>, true>(ldsp, T); } })
    PHASE(6, { pg8::XaSTask T{DM, XB, (const bf16_t*)(ws + WS_MT), (bf16_t*)(ws + SC_P), ldsp, {}}; T.S.init(NT, DM, gridDim.x, blockIdx.x); pg8::gemm_phase(ldsp, T); })
    PHASE(9, { for (int half = 0; half < 2; ++half) { pg8::LnTask<false> T{DM, (const bf16_t*)(ws + SC_P), DM, (const bf16_t*)(ws + WS_NT), XB, gptr(in[23]), gptr(in[24]), XA, half * 16384, {(unsigned long long*)(ws + WS_XBUF), (unsigned*)(ws + WS_CTL) + 8192 + 1 * 8192}, {}, (size_t)DM * DM}; T.S.init(16384, DM, gridDim.x, blockIdx.x); pg8::gemm_phase<pg8::LnTask<false>, true>(ldsp, T); } })
    PHASE(10, router_mfma(c, XA, 0))
    PHASE(11, { const int* cnt = (const int*)(ws + WS_CTL) + 0 * 32; PG8_LAS int* tab = (PG8_LAS int*)(ldsp + pg8::LDS_SPARE); pg8::moe_build_tab(cnt, tab);
        pg8::Moe1Task T{DM, XA, (const bf16_t*)(ws + WS_W13), (bf16_t*)(ws + SC_H), cnt, (const int*)(ws + WS_LIST), tab, (int)gridDim.x, (int)blockIdx.x}; pg8::gemm_phase(ldsp, T); const int nblk_ = tab[0]; __syncthreads(); xa_fold_in_moe_tail(ldsp, ws, 1, nblk_); __syncthreads(); moe_weights_in_tail<3>(c, 1, nblk_); })
    PHASE(12, { const int* cnt = (const int*)(ws + WS_CTL) + 0 * 32; PG8_LAS int* tab = (PG8_LAS int*)(ldsp + pg8::LDS_SPARE); pg8::moe_build_tab(cnt, tab);
        pg8::Moe2Task T{EH, (const bf16_t*)(ws + SC_H), (const bf16_t*)(ws + WS_W2), (bf16_t*)(ws + SC_Y), cnt, (const int*)(ws + WS_LIST), (const float*)(ws + WS_GATE), tab, (int)gridDim.x, (int)blockIdx.x, nullptr}; pg8::gemm_phase(ldsp, T); const int nblk_ = tab[0]; __syncthreads(); moe_weights_in_tail<1>(c, 1, nblk_); })
    PHASE(13, moe_combine(c, XA, gptr(in[32]), gptr(in[33]), XB, nullptr, (const int*)(ws + WS_CTL)); moe_weights_m<2>(c, 1, c.gw, c.ngw))
    PHASE(14, { pg8::PlainTask<pg8::EpiBf16, true> T{XB, DM, (const bf16_t*)(ws + WS_OD_IN), DM, DM, {}, {(bf16_t*)(ws + SC_Y0), 2048}}; T.S.init(NT, DM, gridDim.x, blockIdx.x); pg8::gemm_phase(ldsp, T); }
        { pg8::PlainTask<pg8::EpiOdIn, true> T{XB, DM, (const bf16_t*)(ws + WS_OD_IN) + (size_t)DM * DM, DM, DM, {}, {(bf16_t*)(ws + SC_Y0)}}; T.S.init(NT, 2 * DM, gridDim.x, blockIdx.x); pg8::gemm_phase(ldsp, T); })
    PHASE(15, odd_conv(c))
    PHASE(16, { for (int half = 0; half < 2; ++half) { pg8::LnTask<false> T{DM, XA, DM, (const bf16_t*)(ws + WS_OD_OUT), XB, gptr(in[19]) + DM, gptr(in[20]) + DM, XA, half * 16384, {(unsigned long long*)(ws + WS_XBUF), (unsigned*)(ws + WS_CTL) + 8192 + 2 * 8192}, {}, 0}; T.S.init(16384, DM, gridDim.x, blockIdx.x); pg8::gemm_phase<pg8::LnTask<false>, true>(ldsp, T); } })
    PHASE(17, { pg8::XaSTask T{DM, XA, (const bf16_t*)(ws + WS_MT), (bf16_t*)(ws + SC_P), ldsp, {}}; T.S.init(NT, DM, gridDim.x, blockIdx.x); pg8::gemm_phase(ldsp, T); })
    PHASE(20, { for (int half = 0; half < 2; ++half) { pg8::LnTask<false> T{DM, (const bf16_t*)(ws + SC_P), DM, (const bf16_t*)(ws + WS_NT), XA, gptr(in[23]) + DM, gptr(in[24]) + DM, XB, half * 16384, {(unsigned long long*)(ws + WS_XBUF), (unsigned*)(ws + WS_CTL) + 8192 + 3 * 8192}, {}, (size_t)DM * DM}; T.S.init(16384, DM, gridDim.x, blockIdx.x); pg8::gemm_phase<pg8::LnTask<false>, true>(ldsp, T); } })
    PHASE(21, router_mfma(c, XB, 1))
    PHASE(22, { const int* cnt = (const int*)(ws + WS_CTL) + 1 * 32; PG8_LAS int* tab = (PG8_LAS int*)(ldsp + pg8::LDS_SPARE); pg8::moe_build_tab(cnt, tab);
        pg8::Moe1Task T{DM, XB, (const bf16_t*)(ws + WS_W13), (bf16_t*)(ws + SC_H), cnt, (const int*)(ws + WS_LIST), tab, (int)gridDim.x, (int)blockIdx.x}; pg8::gemm_phase(ldsp, T); })
    PHASE(23, { const int* cnt = (const int*)(ws + WS_CTL) + 1 * 32; PG8_LAS int* tab = (PG8_LAS int*)(ldsp + pg8::LDS_SPARE); pg8::moe_build_tab(cnt, tab);
        pg8::Moe2Task T{EH, (const bf16_t*)(ws + SC_H), (const bf16_t*)(ws + WS_PK), (bf16_t*)(ws + SC_Y), cnt, (const int*)(ws + WS_LIST), (const float*)(ws + WS_GATE), tab, (int)gridDim.x, (int)blockIdx.x, (const bf16_t*)(ws + WS_W2B)}; pg8::gemm_phase(ldsp, T); })
    PHASE(24, moe_combine(c, XB, gptr(in[32]) + DM, gptr(in[33]) + DM, nullptr, (float*)(__attribute__((address_space(1))) float*)prm.out, (const int*)(ws + WS_CTL) + 32))
#ifdef NSA_CHECK
    {
        xcd_barrier(xbar);
        const float d2 = ((const float*)(ws + WS_CTL))[60000], a2 = ((const float*)(ws + WS_CTL))[60001];
        const float f = 1.f + 10.f * sqrtf(d2 / a2);
        for (size_t i = (size_t)c.gw * 64 + c.lane; i < (size_t)NT * DM; i += (size_t)c.ngw * 64) (float*)(__attribute__((address_space(1))) float*)prm.out[i] *= f;
    }
#endif
    if (TPROBE_PHASE >= 0) { const unsigned long long t_end = __builtin_amdgcn_s_memrealtime() + 4ull * (tp1_ - tp0_); while (__builtin_amdgcn_s_memrealtime() < t_end) __builtin_amdgcn_s_sleep(8); }
}

extern "C" void kernel_launch(void* const* d_in, const int* in_sizes, int n_in, void* d_out, int out_size, void* d_ws, size_t ws_size, hipStream_t stream) {
    static int grid = 0;
    if (grid == 0) {
        if (n_in != 34 || ws_size < WS_END) { fprintf(stderr, "kernel_launch: unexpected n_in %d or ws_size %zu\n", n_in, ws_size); grid = -1; return; }
        int dev = 0, cus = 0, per_cu = 0;
        (void)hipGetDevice(&dev);
        (void)hipDeviceGetAttribute(&cus, hipDeviceAttributeMultiprocessorCount, dev);
        (void)hipFuncSetAttribute((const void*)fwd_kernel, hipFuncAttributeMaxDynamicSharedMemorySize, LDS_BYTES);
        (void)hipOccupancyMaxActiveBlocksPerMultiprocessor(&per_cu, (const void*)fwd_kernel, NTHREADS, LDS_BYTES);
        if (per_cu < 1) { fprintf(stderr, "kernel_launch: occupancy query says %d blocks/CU\n", per_cu); per_cu = 1; }
        grid = cus * per_cu;
        if (grid != 256) { fprintf(stderr, "kernel_launch: this kernel is built for a 256-workgroup resident grid (256 CUs x 1), got %d\n", grid); grid = -1; return; }
    }
    if (grid < 0) return;
    (void)hipMemsetAsync(d_ws, 0, 262144, stream);
    Params prm{};
    for (int i = 0; i < 34; ++i) prm.in[i] = (const float*)d_in[i];
    prm.out = (float*)d_out; prm.ws = (unsigned char*)d_ws;
#if N_LAUNCH_MODE == 1
    for (int ph = 0; ph < N_PHASES; ++ph) {
        prm.ph_lo = ph; prm.ph_hi = ph + 1;
        hipLaunchKernelGGL(fwd_kernel, dim3(grid), dim3(NTHREADS), LDS_BYTES, stream, prm);
    }
#else
    prm.ph_lo = 0; prm.ph_hi = N_PHASES;
    void* args[] = {&prm};
    hipError_t e = hipLaunchCooperativeKernel((const void*)fwd_kernel, dim3(grid), dim3(NTHREADS), args, LDS_BYTES, stream);
    if (e != hipSuccess) fprintf(stderr, "cooperative launch failed: %s (grid %d)\n", hipGetErrorString(e), grid);
#endif
}
```

```cpp
#include <hip/hip_runtime.h>
#include <hip/hip_cooperative_groups.h>
#include <cstdint>
#include <cstdio>
namespace cg = cooperative_groups;

#ifndef N_LAUNCH_MODE
#define N_LAUNCH_MODE 0
#endif

typedef unsigned short bf16_t;
typedef short bf16x8 __attribute__((ext_vector_type(8)));
typedef float f32x4 __attribute__((ext_vector_type(4)));
typedef unsigned u32x4 __attribute__((ext_vector_type(4)));
typedef unsigned u32x2 __attribute__((ext_vector_type(2)));
#define DEV __device__ __forceinline__

constexpr int NB = 8, SEQ = 4096, DM = 1024, NT = NB * SEQ;
constexpr int MEML = 256, NMEM = NB * MEML;
constexpr int EIN = 2328, EINP = 2560;
constexpr int C_AV = 0, C_AG = 512, C_Q = 1024, C_KC = 1536, C_VC = 1664, C_KS = 1792, C_VS = 1920, C_KW = 2048, C_VW = 2176, C_GL = 2304;
constexpr int NCMP = 255;
constexpr int NEXP = 32, EH = 512, LCAP = 32768;
constexpr float DN_ALPHA = 1.41421356237f;
constexpr float LN_EPS = 1e-5f;
constexpr int NWAVES = 8, NTHREADS = 512;

constexpr size_t MiB = 1u << 20;
constexpr size_t WS_CTL = 0;
constexpr size_t WS_CMPB = 1 * MiB;
constexpr size_t WS_CMPP = 1 * MiB + 393216;
constexpr size_t WS_MSEL = 1 * MiB + 65536;
constexpr size_t WS_RWB = 1 * MiB + 524288;
constexpr size_t WS_KCMP = 2 * MiB;
constexpr size_t WS_VCMP = 3 * MiB;
constexpr size_t WS_PK = 4 * MiB;
constexpr size_t WS_PV = 12 * MiB;
constexpr size_t WS_LIST = 20 * MiB;
constexpr size_t WS_GATE = 24 * MiB;
constexpr size_t WS_APOS = 24 * MiB + 262144;
constexpr size_t WS_MEMB = 25 * MiB;
constexpr size_t WS_MEMK = 29 * MiB;
constexpr size_t WS_MEMV = 33 * MiB;
constexpr size_t WS_XBUF = 37 * MiB;
constexpr size_t WS_W_IN = 40 * MiB;
constexpr size_t WS_W_OUT = 45 * MiB;
constexpr size_t WS_OD_IN = 47 * MiB;
constexpr size_t WS_OD_OUT = 53 * MiB;
constexpr size_t WS_WQ = 55 * MiB;
constexpr size_t WS_WO = 59 * MiB;
constexpr size_t WS_WK = 63 * MiB;
constexpr size_t WS_WV = 65 * MiB;
constexpr size_t WS_CW1 = 67 * MiB;
constexpr size_t WS_W13 = 72 * MiB;
constexpr size_t WS_W2 = 136 * MiB;
constexpr size_t WS_XA = 168 * MiB;
constexpr size_t WS_XB = 232 * MiB;
constexpr size_t WS_SCR = 296 * MiB;
constexpr size_t WS_MT = 520 * MiB;
constexpr size_t WS_NT = 536 * MiB;
constexpr size_t WS_W2B = 552 * MiB;
constexpr size_t WS_END = 568 * MiB;
constexpr size_t SC_Y0 = WS_SCR;
constexpr size_t SC_CAT = WS_SCR + 160 * MiB;
constexpr size_t SC_Z = WS_SCR;
constexpr size_t SC_Q = WS_SCR;
constexpr size_t SC_P = WS_SCR + 64 * MiB;
constexpr size_t SC_CTX = WS_SCR + 128 * MiB;
constexpr size_t SC_H = WS_SCR;
constexpr size_t SC_Y = WS_SCR + 80 * MiB;

DEV float bf2f(bf16_t b) { return __uint_as_float(((unsigned)b) << 16); }
DEV unsigned f2bf(float f) { unsigned u = __float_as_uint(f); return (u + 0x7fffu + ((u >> 16) & 1u)) >> 16; }
DEV unsigned pk2(float lo, float hi) { typedef float f2_t __attribute__((ext_vector_type(2))); typedef __bf16 b2_t __attribute__((ext_vector_type(2))); f2_t v = {lo, hi}; b2_t b = __builtin_convertvector(v, b2_t); return __builtin_bit_cast(unsigned, b); }
DEV float wsum(float v) {
#pragma unroll
    for (int o = 1; o < 64; o <<= 1) v += __shfl_xor(v, o);
    return v;
}
DEV float wsum_dpp(float v) {
#define DPP_ADD(ctrl, rmask) v += __builtin_bit_cast(float, __builtin_amdgcn_update_dpp(0, __builtin_bit_cast(int, v), ctrl, rmask, 0xF, false))
    DPP_ADD(0xB1, 0xF);
    DPP_ADD(0x4E, 0xF);
    DPP_ADD(0x141, 0xF);
    DPP_ADD(0x140, 0xF);
    DPP_ADD(0x142, 0xA);
    DPP_ADD(0x143, 0xC);
#undef DPP_ADD
    return __builtin_bit_cast(float, __builtin_amdgcn_readlane(__builtin_bit_cast(int, v), 63));
}
DEV float gsum16(float v) { v += __shfl_xor(v, 1); v += __shfl_xor(v, 2); v += __shfl_xor(v, 4); v += __shfl_xor(v, 8); return v; }
DEV float frcp(float x) { return __builtin_amdgcn_rcpf(x); }
DEV float sigmoidf_(float x) { return frcp(1.f + __expf(-x)); }
DEV float siluf_(float x) { return x * frcp(1.f + __expf(-x)); }
DEV float gelu_tanh(float x) { const float u = 0.7978845608028654f * (x + 0.044715f * x * x * x); return 0.5f * x * (1.f + tanhf(u)); }
#define LDS_WAIT() asm volatile("s_waitcnt lgkmcnt(0)" ::: "memory")
DEV void ld4bf(const bf16_t* p, float* o) { const u32x2 w = *(const u32x2*)p; o[0] = __uint_as_float(w.x << 16); o[1] = __uint_as_float(w.x & 0xffff0000u); o[2] = __uint_as_float(w.y << 16); o[3] = __uint_as_float(w.y & 0xffff0000u); }
DEV void st4bf(bf16_t* p, float a, float b, float c, float d) { u32x2 w; w.x = pk2(a, b); w.y = pk2(c, d); *(u32x2*)p = w; }

DEV const float* gptr(const float* x) { return (const float*)(const __attribute__((address_space(1))) float*)x; }
struct Params {
    const float* in[34];
    float* out;
    unsigned char* ws;
    int ph_lo, ph_hi;
};
typedef const __attribute__((address_space(4))) Params* KParams;
struct Ctx {
    KParams p;
    unsigned char* ws;
    float* lds;
    int tid, lane, wave, gw, ngw;
};

namespace pg8 {
#define PG8_LAS __attribute__((address_space(3)))
constexpr int BM = 256, BK = 64, HALF = 128, HTB = HALF * BK * 2, STAGE_BYTES = 8 * HTB, NXCD = 8, WGM = 8;
DEV int lds_byte(int r, int c) { const int st = (r >> 4) * 2 + (c >> 5), rr = r & 15, cc = c & 31, ob = rr * 64 + cc * 2; return st * 1024 + (ob ^ (((ob >> 9) & 1) << 5)); }
DEV void stage_rc(int b, int& R, int& C) { const int st = b / 1024, sb = b % 1024, swz = sb ^ (((sb >> 9) & 1) << 5); R = (st >> 1) * 16 + swz / 64; C = (st & 1) * 32 + (swz % 64) / 2; }
DEV int perm32(int rho) { const int n = rho >> 4, i = rho & 15; return 8 * (i >> 2) + 4 * n + (i & 3); }
struct Unit { int pm, pn, aux; };
struct StaticOrder {
    int nM, nN, nwg, G, c;
    DEV void init(int M, int N, int G_, int c_) { nM = M / BM; nN = N / BM; nwg = nM * nN; G = G_; c = c_; }
    DEV bool next(int i, Unit& u) const {
        const long L = (long)i * G + c; if (L >= nwg) return false;
        int wgid = (int)L; { const int q = nwg / NXCD, r = nwg % NXCD, xcd = wgid % NXCD, off = wgid / NXCD; wgid = (xcd < r ? xcd * (q + 1) : r * (q + 1) + (xcd - r) * q) + off; }
        const int nig = WGM * nN, gid = wgid / nig, fm = gid * WGM, gsz = (nM - fm) < WGM ? (nM - fm) : WGM;
        u.pm = fm + ((wgid % nig) % gsz); u.pn = (wgid % nig) / gsz; u.aux = 0; return true;
    }
};
DEV unsigned cvt_pk_bf16(float lo, float hi) { unsigned r; asm volatile("v_cvt_pk_bf16_f32 %0, %1, %2" : "=v"(r) : "v"(lo), "v"(hi)); return r; }
typedef f32x4 Acc[2][2][4][2];

template <class T, class = void> struct has_res_lds { static constexpr bool value = false; };
template <class T> struct has_res_lds<T, decltype((void)T::RES_LDS)> { static constexpr bool value = T::RES_LDS; };
template <class Task, bool DRAINED = false>
DEV void gemm_phase(PG8_LAS unsigned char* lds, const Task& T) {
    int tid = threadIdx.x; asm volatile("" : "+v"(tid));
    const int wid = __builtin_amdgcn_readfirstlane(tid >> 6), lane = tid & 63, wr = wid >> 2, wc = wid & 3, fr = lane & 15, fq = lane >> 4;
    const int nt = T.K / BK;
    int R[2], C[2]; unsigned voffB[2];
#pragma unroll
    for (int i = 0; i < 2; ++i) { stage_rc(tid * 16 + i * 8192, R[i], C[i]); const int Rb = Task::PERM ? ((R[i] & ~31) + perm32(R[i] & 31)) : R[i]; voffB[i] = (unsigned)(Rb * T.ldb() + C[i]) * 2u; }
    const size_t kstepB = (size_t)(BK * 2);
    const size_t hstepB = (size_t)HALF * T.ldb() * 2;
    const unsigned ldsw = (unsigned)wid * 1024u;
    const int aoff = lds_byte(wr * 64 + fr, fq * 8), boff = lds_byte(wc * 32 + fr, fq * 8);
#define PG8_SA(b, h) (((b) * 2 + (h)) * HTB)
#define PG8_SB(b, h) ((4 + (b) * 2 + (h)) * HTB)
#define PG8_STAGE(bufoff, gbase, voff) do { _Pragma("unroll") for (int _i = 0; _i < 2; ++_i) \
        __builtin_amdgcn_global_load_lds((const unsigned*)((const char*)(gbase) + (voff)[_i]), (PG8_LAS unsigned*)(lds + (bufoff) + ldsw + _i * 8192), 16, 0, 0); } while (0)
#define PG8_LDA(dst, b, h) do { _Pragma("unroll") for (int m = 0; m < 4; ++m) _Pragma("unroll") for (int k = 0; k < 2; ++k) dst[m][k] = *(const PG8_LAS bf16x8*)(lds + PG8_SA(b, h) + aoff + m * 2048 + k * 1024); } while (0)
#define PG8_LDB(dst, b, h) do { _Pragma("unroll") for (int n = 0; n < 2; ++n) _Pragma("unroll") for (int k = 0; k < 2; ++k) dst[n][k] = *(const PG8_LAS bf16x8*)(lds + PG8_SB(b, h) + boff + n * 2048 + k * 1024); } while (0)
#define PG8_MMA(ai, bj, At, Bt) do { __builtin_amdgcn_s_setprio(1); _Pragma("unroll") for (int m = 0; m < 4; ++m) _Pragma("unroll") for (int n = 0; n < 2; ++n) _Pragma("unroll") for (int k = 0; k < 2; ++k) \
        acc[ai][bj][m][n] = __builtin_amdgcn_mfma_f32_16x16x32_bf16(Bt[n][k], At[m][k], acc[ai][bj][m][n], 0, 0, 0); __builtin_amdgcn_s_setprio(0); } while (0)
#define PG8_WAIT_V(n) asm volatile("s_waitcnt vmcnt(" #n ")" ::: "memory")
#define PG8_WAIT_L(n) asm volatile("s_waitcnt lgkmcnt(" #n ")" ::: "memory")
#define PG8_BAR __builtin_amdgcn_s_barrier()
#define PG8_SCHED __builtin_amdgcn_sched_barrier(0)
    Unit cur, nxt; int ui = 0;
    if (!T.next(0, cur)) return;
    Acc acc;
#pragma unroll
    for (int a = 0; a < 2; ++a)
#pragma unroll
        for (int b = 0; b < 2; ++b)
#pragma unroll
            for (int m = 0; m < 4; ++m)
#pragma unroll
                for (int n = 0; n < 2; ++n) acc[a][b][m][n] = (f32x4){0.f, 0.f, 0.f, 0.f};
    bf16x8 At[4][2], B0[2][2], B1[2][2];
    unsigned va[2][2], na[2][2];
    T.a_offs(cur, R, C, va);
    const char* cA = T.a_base(cur); const char* cB = T.b_base(cur); size_t kstepA = T.a_kstep(cur), kstepN = kstepA;
    PG8_STAGE(PG8_SB(0, 0), cB, voffB); PG8_STAGE(PG8_SB(0, 1), cB + hstepB, voffB); PG8_STAGE(PG8_SA(0, 0), cA, va[0]); PG8_STAGE(PG8_SA(0, 1), cA, va[1]);
    if (wr == 1) PG8_BAR;
    PG8_WAIT_V(2); PG8_BAR;
    PG8_STAGE(PG8_SB(1, 0), cB + kstepB, voffB); PG8_STAGE(PG8_SA(1, 0), cA + kstepA, va[0]); PG8_STAGE(PG8_SB(1, 1), cB + hstepB + kstepB, voffB);
    PG8_WAIT_V(6); PG8_BAR;
    for (;;) {
        const bool has_next = T.next(ui + 1, nxt);
        const char* nA = cA; const char* nB = cB;
#pragma unroll
        for (int h = 0; h < 2; ++h)
#pragma unroll
            for (int i = 0; i < 2; ++i) na[h][i] = va[h][i];
        kstepN = kstepA;
        if (has_next) { nA = T.a_base(nxt); nB = T.b_base(nxt); T.a_offs(nxt, R, C, na); kstepN = T.a_kstep(nxt); }
        else if constexpr (has_res_lds<Task>::value) { const unsigned long long rb = (unsigned long long)T.res_base(cur);
            nA = (const char*)(((unsigned long long)(unsigned)__builtin_amdgcn_readfirstlane((int)(rb >> 32)) << 32) | (unsigned)__builtin_amdgcn_readfirstlane((int)rb)); nB = nA + 256; kstepN = 128; }
        for (int t = 0; t < nt; t += 2) {
            const bool last = (t == nt - 2);
            const char* a1 = cA + (size_t)(t + 1) * kstepA;
            const char* nAl = nA; const char* nBl = nB;
            if constexpr (has_res_lds<Task>::value) { asm volatile("" : "+s"(nAl), "+s"(nBl)); }
            const char* a2 = last ? nAl : cA + (size_t)(t + 2) * kstepA; const char* b2 = last ? nBl : cB + (size_t)(t + 2) * kstepB;
            const char* a3 = a2 + (last ? kstepN : kstepA); const char* b3 = b2 + kstepB;
            unsigned w2[2][2];
#pragma unroll
            for (int h = 0; h < 2; ++h)
#pragma unroll
                for (int i = 0; i < 2; ++i) w2[h][i] = last ? na[h][i] : va[h][i];
            PG8_LDB(B0, 0, 0); PG8_LDB(B1, 0, 1); PG8_SCHED; PG8_LDA(At, 0, 0); PG8_STAGE(PG8_SA(1, 1), a1, va[1]);
            PG8_WAIT_V(8); PG8_WAIT_L(0); PG8_BAR; PG8_MMA(0, 0, At, B0); PG8_MMA(0, 1, At, B1); PG8_BAR; PG8_SCHED;
            PG8_LDA(At, 0, 1); PG8_STAGE(PG8_SB(0, 0), b2, voffB); PG8_STAGE(PG8_SB(0, 1), b2 + hstepB, voffB); PG8_STAGE(PG8_SA(0, 0), a2, w2[0]);
            PG8_WAIT_V(8); PG8_WAIT_L(0); PG8_BAR; PG8_MMA(1, 0, At, B0); PG8_MMA(1, 1, At, B1); PG8_BAR; PG8_SCHED;
            PG8_LDB(B0, 1, 0); PG8_LDB(B1, 1, 1); PG8_SCHED; PG8_LDA(At, 1, 0); PG8_STAGE(PG8_SA(0, 1), a2, w2[1]);
            PG8_WAIT_V(8); PG8_WAIT_L(0); PG8_BAR; PG8_MMA(0, 0, At, B0); PG8_MMA(0, 1, At, B1); PG8_BAR; PG8_SCHED;
            PG8_LDA(At, 1, 1); PG8_STAGE(PG8_SB(1, 0), b3, voffB); PG8_STAGE(PG8_SB(1, 1), b3 + hstepB, voffB); PG8_STAGE(PG8_SA(1, 0), a3, w2[0]);
            PG8_WAIT_V(8); PG8_WAIT_L(0); PG8_BAR; PG8_MMA(1, 0, At, B0); PG8_MMA(1, 1, At, B1); PG8_BAR; PG8_SCHED;
        }
        if (wr == 0) PG8_BAR;
        if constexpr (has_res_lds<Task>::value) { if (!has_next) PG8_STAGE(PG8_SA(1, 1), nA + kstepN, na[1]); }
        if (!DRAINED || has_next) T.epi(acc, cur, wr, wc, fr, fq);
        if (!has_next) break;
#pragma unroll
        for (int a = 0; a < 2; ++a)
#pragma unroll
            for (int b = 0; b < 2; ++b)
#pragma unroll
                for (int m = 0; m < 4; ++m)
#pragma unroll
                    for (int n = 0; n < 2; ++n) acc[a][b][m][n] = (f32x4){0.f, 0.f, 0.f, 0.f};
        cur = nxt; cA = nA; cB = nB; kstepA = kstepN; ++ui;
#pragma unroll
        for (int h = 0; h < 2; ++h)
#pragma unroll
            for (int i = 0; i < 2; ++i) va[h][i] = na[h][i];
        if (wr == 1) PG8_BAR;
    }
    PG8_WAIT_V(0);
    PG8_BAR;
    if constexpr (DRAINED) T.epi_drained(acc, cur, wr, wc, fr, fq, lds, wid, lane);
#undef PG8_SA
#undef PG8_SB
#undef PG8_STAGE
#undef PG8_LDA
#undef PG8_LDB
#undef PG8_MMA
#undef PG8_WAIT_V
#undef PG8_WAIT_L
#undef PG8_BAR
#undef PG8_SCHED
}

DEV u32x4 lane_tr(u32x4 w, int src4) { w.x = (unsigned)__builtin_amdgcn_ds_bpermute(src4, (int)w.x); w.y = (unsigned)__builtin_amdgcn_ds_bpermute(src4, (int)w.y);
    w.z = (unsigned)__builtin_amdgcn_ds_bpermute(src4, (int)w.z); w.w = (unsigned)__builtin_amdgcn_ds_bpermute(src4, (int)w.w); return w; }
DEV void store_tile_bf16(const Acc& acc, bf16_t* base, int ldc, int wr, int wc, int fr, int fq) {
    const int ln = fq * 16 + fr, src4 = (((ln & 3) << 4) | (ln >> 2)) << 2;
#pragma unroll
    for (int ai = 0; ai < 2; ++ai)
#pragma unroll
        for (int m = 0; m < 4; ++m) { bf16_t* rowp = base + (size_t)(ai * HALF + wr * 64 + m * 16 + (ln >> 2)) * ldc + wc * 32 + 8 * (ln & 3);
#pragma unroll
            for (int bj = 0; bj < 2; ++bj) { const f32x4 v0 = acc[ai][bj][m][0], v1 = acc[ai][bj][m][1];
                u32x4 w; w.x = cvt_pk_bf16(v0[0], v0[1]); w.y = cvt_pk_bf16(v0[2], v0[3]); w.z = cvt_pk_bf16(v1[0], v1[1]); w.w = cvt_pk_bf16(v1[2], v1[3]);
                w.x = (unsigned)__builtin_amdgcn_ds_bpermute(src4, (int)w.x); w.y = (unsigned)__builtin_amdgcn_ds_bpermute(src4, (int)w.y);
                w.z = (unsigned)__builtin_amdgcn_ds_bpermute(src4, (int)w.z); w.w = (unsigned)__builtin_amdgcn_ds_bpermute(src4, (int)w.w);
                *(u32x4*)(rowp + bj * HALF) = w; } }
}
template <class Epi, bool PERM_>
struct PlainTask {
    static constexpr bool PERM = PERM_;
    const bf16_t* A; int lda; const bf16_t* Bt; int ldb_; int K; StaticOrder S; Epi E;
    DEV bool next(int i, Unit& u) const { return S.next(i, u); }
    DEV const char* a_base(const Unit& u) const { return (const char*)(A + (size_t)u.pm * BM * lda); }
    DEV void a_offs(const Unit&, const int (&R)[2], const int (&C)[2], unsigned (&v)[2][2]) const {
#pragma unroll
        for (int h = 0; h < 2; ++h)
#pragma unroll
            for (int i = 0; i < 2; ++i) v[h][i] = (unsigned)((h * HALF + R[i]) * lda + C[i]) * 2u;
    }
    DEV size_t a_kstep(const Unit&) const { return (size_t)(BK * 2); }
    DEV const char* b_base(const Unit& u) const { return (const char*)(Bt + (size_t)u.pn * BM * ldb_); }
    DEV int ldb() const { return ldb_; }
    DEV void epi(Acc& acc, const Unit& u, int wr, int wc, int fr, int fq) const { E(acc, u, wr, wc, fr, fq); }
};
struct EpiBf16 {
    bf16_t* Cc; int ldc;
    DEV void operator()(Acc& acc, const Unit& u, int wr, int wc, int fr, int fq) const { store_tile_bf16(acc, Cc + (size_t)u.pm * BM * ldc + u.pn * BM, ldc, wr, wc, fr, fq); }
};
struct EpiInproj {
    bf16_t* Cc;
    DEV void operator()(Acc& acc, const Unit& u, int wr, int wc, int fr, int fq) const {
        if (u.pn == 4 || u.pn == 5) {
#pragma unroll
            for (int a = 0; a < 2; ++a)
#pragma unroll
                for (int b = 0; b < 2; ++b)
#pragma unroll
                    for (int m = 0; m < 4; ++m)
#pragma unroll
                        for (int n = 0; n < 2; ++n) acc[a][b][m][n] = acc[a][b][m][n] * (0.125f * 1.4426950408889634f);
        }
        const int ln = fq * 16 + fr, src4 = (((ln & 3) << 4) | (ln >> 2)) << 2;
        if (u.pn < 4) {
#pragma unroll
            for (int ai = 0; ai < 2; ++ai)
#pragma unroll
                for (int m = 0; m < 4; ++m) { bf16_t* rowp = Cc + (size_t)(u.pm * BM + ai * HALF + wr * 64 + m * 16 + (ln >> 2)) * EINP + u.pn * HALF + wc * 32 + 8 * (ln & 3);
                    f32x4 h0, h1;
#pragma unroll
                    for (int j = 0; j < 4; ++j) { h0[j] = acc[ai][0][m][0][j] * frcp(1.f + __expf(-acc[ai][1][m][0][j])); h1[j] = acc[ai][0][m][1][j] * frcp(1.f + __expf(-acc[ai][1][m][1][j])); }
                    u32x4 w; w.x = cvt_pk_bf16(h0[0], h0[1]); w.y = cvt_pk_bf16(h0[2], h0[3]); w.z = cvt_pk_bf16(h1[0], h1[1]); w.w = cvt_pk_bf16(h1[2], h1[3]);
                    *(u32x4*)rowp = lane_tr(w, src4); }
            return;
        }
        if (u.pn == 9 && wc != 0) return;
        store_tile_bf16(acc, Cc + (size_t)u.pm * BM * EINP + u.pn * BM, EINP, wr, wc, fr, fq); }
};
struct EpiOdIn {
    bf16_t* Cc;
    DEV void operator()(Acc& acc, const Unit& u, int wr, int wc, int fr, int fq) const {
        const int ln = fq * 16 + fr, src4 = (((ln & 3) << 4) | (ln >> 2)) << 2;
#pragma unroll
        for (int ai = 0; ai < 2; ++ai)
#pragma unroll
            for (int m = 0; m < 4; ++m) { bf16_t* rowp = Cc + (size_t)(u.pm * BM + ai * HALF + wr * 64 + m * 16 + (ln >> 2)) * 2048 + 1024 + u.pn * HALF + wc * 32 + 8 * (ln & 3);
                const f32x4 h0 = acc[ai][0][m][0] * acc[ai][1][m][0], h1 = acc[ai][0][m][1] * acc[ai][1][m][1];
                u32x4 w; w.x = cvt_pk_bf16(h0[0], h0[1]); w.y = cvt_pk_bf16(h0[2], h0[3]); w.z = cvt_pk_bf16(h1[0], h1[1]); w.w = cvt_pk_bf16(h1[2], h1[3]);
                *(u32x4*)rowp = lane_tr(w, src4); }
    }
};
struct EpiBf16S {
    bf16_t* Cc; int ldc; float scale;
    DEV void operator()(Acc& acc, const Unit& u, int wr, int wc, int fr, int fq) const {
#pragma unroll
        for (int a = 0; a < 2; ++a)
#pragma unroll
            for (int b = 0; b < 2; ++b)
#pragma unroll
                for (int m = 0; m < 4; ++m)
#pragma unroll
                    for (int n = 0; n < 2; ++n) acc[a][b][m][n] = acc[a][b][m][n] * scale;
        store_tile_bf16(acc, Cc + (size_t)u.pm * BM * ldc + u.pn * BM, ldc, wr, wc, fr, fq); }
};
}

namespace pg8 {
constexpr int LDS_SPARE = STAGE_BYTES;
DEV void store_tile_f32_perm(const Acc& acc, float* base, int ldc, int wr, int wc, int fr, int fq) {
#pragma unroll
    for (int ai = 0; ai < 2; ++ai)
#pragma unroll
        for (int m = 0; m < 4; ++m) { float* rowp = base + (size_t)(ai * HALF + wr * 64 + m * 16 + fr) * ldc + wc * 32 + 8 * fq;
#pragma unroll
            for (int bj = 0; bj < 2; ++bj) { *(f32x4*)(rowp + bj * HALF) = acc[ai][bj][m][0]; *(f32x4*)(rowp + bj * HALF + 4) = acc[ai][bj][m][1]; } }
}
struct CmpTask {
    static constexpr bool PERM = true;
    int K; unsigned char* ws; int id;
    DEV bool next(int i, Unit& u) const { if (i > 0 || id >= 64) return false; u.aux = id >> 5; u.pm = (id >> 1) & 15; u.pn = id & 1; return true; }
    DEV const char* a_base(const Unit& u) const { return (const char*)(ws + SC_Y0) + (u.aux ? C_VC : C_KC) * 2; }
    DEV void a_offs(const Unit& u, const int (&R)[2], const int (&C)[2], unsigned (&v)[2][2]) const {
#pragma unroll
        for (int h = 0; h < 2; ++h)
#pragma unroll
            for (int i = 0; i < 2; ++i) { const int m = u.pm * BM + h * HALF + R[i], g = m & 1, bj = m >> 1; v[h][i] = (unsigned)(((size_t)bj * 16 * EINP + g * 64 + C[i]) * 2); } }
    DEV size_t a_kstep(const Unit&) const { return (size_t)EINP * 2; }
    DEV const char* b_base(const Unit& u) const { return (const char*)(ws + WS_CW1) + ((size_t)u.aux * 512 + (size_t)u.pn * BM) * DM * 2; }
    DEV int ldb() const { return DM; }
    DEV void epi(Acc& acc, const Unit& u, int wr, int wc, int fr, int fq) const { store_tile_f32_perm(acc, (float*)(ws + (u.aux ? WS_PV : WS_PK)) + (size_t)u.pm * BM * 512 + u.pn * BM, 512, wr, wc, fr, fq); }
};
struct OneUnitTask {
    static constexpr bool PERM = true;
    int K; const bf16_t* A; const bf16_t* Bt; bf16_t* Cc; int ldc; size_t cm, cn; int pm, pn; bool on; float scale;
    DEV bool next(int i, Unit& u) const { if (i > 0 || !on) return false; u.pm = pm; u.pn = pn; u.aux = 0; return true; }
    DEV const char* a_base(const Unit& u) const { return (const char*)(A + (size_t)u.pm * BM * DM); }
    DEV void a_offs(const Unit&, const int (&R)[2], const int (&C)[2], unsigned (&v)[2][2]) const {
#pragma unroll
        for (int h = 0; h < 2; ++h)
#pragma unroll
            for (int i = 0; i < 2; ++i) v[h][i] = (unsigned)((h * HALF + R[i]) * DM + C[i]) * 2u; }
    DEV size_t a_kstep(const Unit&) const { return (size_t)(BK * 2); }
    DEV const char* b_base(const Unit& u) const { return (const char*)(Bt + (size_t)u.pn * BM * DM); }
    DEV int ldb() const { return DM; }
    DEV void epi(Acc& acc, const Unit& u, int wr, int wc, int fr, int fq) const {
        if (scale != 1.f) {
#pragma unroll
            for (int a = 0; a < 2; ++a)
#pragma unroll
                for (int b = 0; b < 2; ++b)
#pragma unroll
                    for (int m = 0; m < 4; ++m)
#pragma unroll
                        for (int n = 0; n < 2; ++n) acc[a][b][m][n] = acc[a][b][m][n] * scale; }
        store_tile_bf16(acc, Cc + (size_t)u.pm * cm + (size_t)u.pn * cn, ldc, wr, wc, fr, fq); }
};
struct XaSTask {
    static constexpr bool PERM = true;
    int K; const bf16_t* Q; const bf16_t* MK; bf16_t* P; PG8_LAS unsigned char* lds; StaticOrder S;
    DEV bool next(int i, Unit& u) const { return S.next(i, u); }
    DEV const char* a_base(const Unit& u) const { return (const char*)(Q + (size_t)u.pm * BM * DM); }
    DEV void a_offs(const Unit&, const int (&R)[2], const int (&C)[2], unsigned (&v)[2][2]) const {
#pragma unroll
        for (int h = 0; h < 2; ++h)
#pragma unroll
            for (int i = 0; i < 2; ++i) v[h][i] = (unsigned)((h * HALF + R[i]) * DM + C[i]) * 2u; }
    DEV size_t a_kstep(const Unit&) const { return (size_t)(BK * 2); }
    DEV const char* b_base(const Unit& u) const { return (const char*)(MK + ((size_t)(u.pm >> 4) * DM + (size_t)u.pn * 256) * DM); }
    DEV int ldb() const { return DM; }
    DEV void epi(Acc& acc, const Unit& u, int wr, int wc, int fr, int fq) const {
        PG8_LAS float* smax = (PG8_LAS float*)(lds + LDS_SPARE); PG8_LAS float* ssum = smax + 1024;
#pragma unroll
        for (int ai = 0; ai < 2; ++ai)
#pragma unroll
            for (int m = 0; m < 4; ++m) { float v = -INFINITY;
#pragma unroll
                for (int bj = 0; bj < 2; ++bj)
#pragma unroll
                    for (int n = 0; n < 2; ++n) { const f32x4 x = acc[ai][bj][m][n]; v = fmaxf(v, fmaxf(fmaxf(x[0], x[1]), fmaxf(x[2], x[3]))); }
                v = fmaxf(v, __shfl_xor(v, 16)); v = fmaxf(v, __shfl_xor(v, 32));
                if (fq == 0) smax[(ai * HALF + wr * 64 + m * 16 + fr) * 4 + wc] = v; }
        asm volatile("s_waitcnt lgkmcnt(0)" ::: "memory"); __builtin_amdgcn_s_barrier(); asm volatile("" ::: "memory");
#pragma unroll
        for (int ai = 0; ai < 2; ++ai)
#pragma unroll
            for (int m = 0; m < 4; ++m) { const int row = ai * HALF + wr * 64 + m * 16 + fr;
                const f32x4 t = *(const PG8_LAS f32x4*)(smax + row * 4); const float M = fmaxf(fmaxf(t[0], t[1]), fmaxf(t[2], t[3])); float s = 0.f;
#pragma unroll
                for (int bj = 0; bj < 2; ++bj)
#pragma unroll
                    for (int n = 0; n < 2; ++n) { f32x4 x = acc[ai][bj][m][n];
#pragma unroll
                        for (int j = 0; j < 4; ++j) { x[j] = __builtin_amdgcn_exp2f(x[j] - M); s += x[j]; }
                        acc[ai][bj][m][n] = x; }
                s += __shfl_xor(s, 16); s += __shfl_xor(s, 32);
                if (fq == 0) ssum[row * 4 + wc] = s; }
        asm volatile("s_waitcnt lgkmcnt(0)" ::: "memory"); __builtin_amdgcn_s_barrier(); asm volatile("" ::: "memory");
#pragma unroll
        for (int ai = 0; ai < 2; ++ai)
#pragma unroll
            for (int m = 0; m < 4; ++m) { const int row = ai * HALF + wr * 64 + m * 16 + fr;
                const f32x4 t = *(const PG8_LAS f32x4*)(ssum + row * 4); const float inv = frcp((t[0] + t[1]) + (t[2] + t[3]));
#pragma unroll
                for (int bj = 0; bj < 2; ++bj)
#pragma unroll
                    for (int n = 0; n < 2; ++n) acc[ai][bj][m][n] = acc[ai][bj][m][n] * inv; }
        store_tile_bf16(acc, P + (size_t)u.pm * BM * DM + u.pn * 256, DM, wr, wc, fr, fq);
        asm volatile("s_waitcnt lgkmcnt(0)" ::: "memory"); __builtin_amdgcn_s_barrier(); asm volatile("" ::: "memory");
    }
};
DEV void moe_build_tab(const int* cnt, PG8_LAS int* tab) {
    if (threadIdx.x == 0) { int nb = 0; for (int e = 0; e < NEXP; ++e) { const int k = (cnt[e] + 255) >> 8; for (int j = 0; j < k; ++j) tab[1 + nb + j] = (e << 16) | j; nb += k; } tab[0] = nb; }
    asm volatile("s_waitcnt lgkmcnt(0)" ::: "memory"); __syncthreads();
}
struct Moe1Task {
    static constexpr bool PERM = true;
    int K; const bf16_t* X; const bf16_t* W13; bf16_t* H; const int* cnt; const int* list; const PG8_LAS int* tab; int G, c;
    DEV bool next(int i, Unit& u) const { const int vc = (G % 8 == 0) ? (c % 8) * (G / 8) + c / 8 : c;
        const int id = i * G + vc, rb = id >> 2; if (rb >= tab[0]) return false; u.pm = rb; u.pn = id & 3; u.aux = tab[1 + rb]; return true; }
    DEV const char* a_base(const Unit&) const { return (const char*)X; }
    DEV void a_offs(const Unit& u, const int (&R)[2], const int (&C)[2], unsigned (&v)[2][2]) const {
        const int e = u.aux >> 16, lb = u.aux & 0xffff, ce = cnt[e];
#pragma unroll
        for (int h = 0; h < 2; ++h)
#pragma unroll
            for (int i = 0; i < 2; ++i) { const int r = lb * BM + h * HALF + R[i]; const int tok = (r < ce) ? (list[e * LCAP + r] >> 1) : 0; v[h][i] = (unsigned)(tok * DM + C[i]) * 2u; } }
    DEV size_t a_kstep(const Unit&) const { return (size_t)(BK * 2); }
    DEV const char* b_base(const Unit& u) const { return (const char*)(W13 + ((size_t)(u.aux >> 16) * DM + (size_t)u.pn * BM) * DM); }
    DEV int ldb() const { return DM; }
    DEV void epi(Acc& acc, const Unit& u, int wr, int wc, int fr, int fq) const {
        const int ln = fq * 16 + fr, src4 = (((ln & 3) << 4) | (ln >> 2)) << 2;
#pragma unroll
        for (int ai = 0; ai < 2; ++ai)
#pragma unroll
            for (int m = 0; m < 4; ++m) { bf16_t* rowp = H + (size_t)(u.pm * BM + ai * HALF + wr * 64 + m * 16 + (ln >> 2)) * EH + u.pn * HALF + wc * 32 + 8 * (ln & 3);
                f32x4 h0, h1;
#pragma unroll
                for (int j = 0; j < 4; ++j) { const float a = acc[ai][0][m][0][j], b = acc[ai][0][m][1][j]; h0[j] = a * frcp(1.f + __expf(-a)) * acc[ai][1][m][0][j]; h1[j] = b * frcp(1.f + __expf(-b)) * acc[ai][1][m][1][j]; }
                u32x4 w; w.x = cvt_pk_bf16(h0[0], h0[1]); w.y = cvt_pk_bf16(h0[2], h0[3]); w.z = cvt_pk_bf16(h1[0], h1[1]); w.w = cvt_pk_bf16(h1[2], h1[3]);
                *(u32x4*)rowp = lane_tr(w, src4); }
    }
};
struct Moe2Task {
    static constexpr bool PERM = true;
    int K; const bf16_t* H; const bf16_t* W2; bf16_t* Y; const int* cnt; const int* list; const float* gate; const PG8_LAS int* tab; int G, c; const bf16_t* W2b;
    DEV bool next(int i, Unit& u) const { const int vc = (G % 8 == 0) ? (c % 8) * (G / 8) + c / 8 : c;
        const int id = i * G + vc, rb = id >> 2; if (rb >= tab[0]) return false; u.pm = rb; u.pn = id & 3; u.aux = tab[1 + rb]; return true; }
    DEV const char* a_base(const Unit& u) const { return (const char*)(H + (size_t)u.pm * BM * EH); }
    DEV void a_offs(const Unit&, const int (&R)[2], const int (&C)[2], unsigned (&v)[2][2]) const {
#pragma unroll
        for (int h = 0; h < 2; ++h)
#pragma unroll
            for (int i = 0; i < 2; ++i) v[h][i] = (unsigned)((h * HALF + R[i]) * EH + C[i]) * 2u; }
    DEV size_t a_kstep(const Unit&) const { return (size_t)(BK * 2); }
    DEV const char* b_base(const Unit& u) const { const int e = u.aux >> 16; const bf16_t* w = (W2b != nullptr && e >= 16) ? W2b + (size_t)(e - 16) * DM * EH : W2 + (size_t)e * DM * EH; return (const char*)(w + (size_t)u.pn * BM * EH); }
    DEV int ldb() const { return EH; }
    DEV void epi(Acc& acc, const Unit& u, int wr, int wc, int fr, int fq) const { store_tile_bf16(acc, Y + (size_t)u.pm * BM * DM + u.pn * BM, DM, wr, wc, fr, fq); }
};
}

namespace pg8 {
struct PanelStats {
    unsigned long long* xbuf;
    unsigned* cnt;
    DEV void run(const Acc& v, int panel, int pn, int wr, int wc, int fr, int fq, PG8_LAS unsigned char* lds, int wid, int lane) const {
        typedef float f32x2v __attribute__((ext_vector_type(2)));
        PG8_LAS f32x2v* P = (PG8_LAS f32x2v*)lds;
        PG8_LAS f32x2v* S = (PG8_LAS f32x2v*)(lds + 8192);
#pragma unroll
        for (int ai = 0; ai < 2; ++ai)
#pragma unroll
            for (int m = 0; m < 4; ++m) {
                float s = 0.f;
#pragma unroll
                for (int bj = 0; bj < 2; ++bj)
#pragma unroll
                    for (int n = 0; n < 2; ++n) { const f32x4 x = v[ai][bj][m][n]; s += (x[0] + x[1]) + (x[2] + x[3]); }
                s += __shfl_xor(s, 16); s += __shfl_xor(s, 32);
                const float mw = s * (1.0f / 64.0f); float q = 0.f;
#pragma unroll
                for (int bj = 0; bj < 2; ++bj)
#pragma unroll
                    for (int n = 0; n < 2; ++n) { const f32x4 d = v[ai][bj][m][n] - mw; q += (d[0] * d[0] + d[1] * d[1]) + (d[2] * d[2] + d[3] * d[3]); }
                q += __shfl_xor(q, 16); q += __shfl_xor(q, 32);
                if (fq == 0) P[(ai * HALF + wr * 64 + m * 16 + fr) * 4 + wc] = (f32x2v){mw, q};
            }
        asm volatile("s_waitcnt lgkmcnt(0)" ::: "memory"); __builtin_amdgcn_s_barrier(); asm volatile("" ::: "memory");
        const int row = wid * 32 + (lane & 31);
        if (lane < 32) {
            const f32x2v a = P[row * 4 + 0], b = P[row * 4 + 1], c = P[row * 4 + 2], d = P[row * 4 + 3];
            const float mt = (a.x + b.x + c.x + d.x) * 0.25f;
            const float da = a.x - mt, db = b.x - mt, dc = c.x - mt, dd = d.x - mt;
            const float m2 = (a.y + b.y) + (c.y + d.y) + 64.0f * ((da * da + db * db) + (dc * dc + dd * dd));
            unsigned long long* slot = xbuf + ((size_t)(panel * BM + row) * 4 + pn);
            __hip_atomic_store(slot, ((unsigned long long)__float_as_uint(m2) << 32) | __float_as_uint(mt), __ATOMIC_RELAXED, __HIP_MEMORY_SCOPE_AGENT);
        }
        asm volatile("s_waitcnt vmcnt(0)" ::: "memory");
        if (lane == 0) __hip_atomic_fetch_add(cnt + 64 * panel, 1u, __ATOMIC_RELAXED, __HIP_MEMORY_SCOPE_AGENT);
        if (wid == 0) {
            unsigned sp = 0;
            while ((unsigned)__builtin_amdgcn_readfirstlane(__hip_atomic_load(cnt + 64 * panel, __ATOMIC_RELAXED, __HIP_MEMORY_SCOPE_AGENT)) < 32u) { __builtin_amdgcn_s_sleep(2); if (++sp > (1u << 22)) break; }
            __builtin_amdgcn_fence(__ATOMIC_ACQUIRE, "agent");
        }
        asm volatile("s_waitcnt vmcnt(0) lgkmcnt(0)" ::: "memory"); __builtin_amdgcn_s_barrier(); asm volatile("" ::: "memory");
        if (lane < 32) {
            const unsigned long long* slot = xbuf + (size_t)(panel * BM + row) * 4; float mt[4], m2[4]; float ms = 0.f;
#pragma unroll
            for (int t = 0; t < 4; ++t) { const unsigned long long w = __hip_atomic_load(slot + t, __ATOMIC_RELAXED, __HIP_MEMORY_SCOPE_AGENT); mt[t] = __uint_as_float((unsigned)w); m2[t] = __uint_as_float((unsigned)(w >> 32)); ms += mt[t]; }
            const float mean = ms * 0.25f; float q = 0.f;
#pragma unroll
            for (int t = 0; t < 4; ++t) { const float dm = mt[t] - mean; q += m2[t] + 256.0f * dm * dm; }
            S[row] = (f32x2v){mean, rsqrtf(q * (1.0f / 1024.0f) + LN_EPS)};
        }
        asm volatile("s_waitcnt lgkmcnt(0)" ::: "memory"); __builtin_amdgcn_s_barrier(); asm volatile("" ::: "memory");
    }
};
template <bool RES_F32>
struct LnTask {
    static constexpr bool PERM = true;
    int K; const bf16_t* A; int lda; const bf16_t* Bt; const void* res; const float* g; const float* b; bf16_t* X; int row0; PanelStats st; StaticOrder S; size_t bstride;
    DEV bool next(int i, Unit& u) const { return i == 0 && S.next(0, u); }
    DEV const char* a_base(const Unit& u) const { return (const char*)(A + (size_t)(row0 + u.pm * BM) * lda); }
    DEV void a_offs(const Unit&, const int (&R)[2], const int (&C)[2], unsigned (&v)[2][2]) const {
#pragma unroll
        for (int h = 0; h < 2; ++h)
#pragma unroll
            for (int i = 0; i < 2; ++i) v[h][i] = (unsigned)((h * HALF + R[i]) * lda + C[i]) * 2u; }
    DEV size_t a_kstep(const Unit&) const { return (size_t)(BK * 2); }
    DEV const char* b_base(const Unit& u) const { return (const char*)(Bt + (size_t)((row0 / BM + u.pm) >> 4) * bstride + (size_t)u.pn * BM * DM); }
    DEV int ldb() const { return DM; }
    DEV void epi(Acc&, const Unit&, int, int, int, int) const {}
    static constexpr bool RES_LDS = !RES_F32;
    DEV const char* res_base(const Unit& u) const { return (const char*)((const bf16_t*)res + (size_t)(row0 + u.pm * BM) * DM + (size_t)u.pn * BM); }
    DEV void epi_drained(Acc& acc, const Unit& u, int wr, int wc, int fr, int fq, PG8_LAS unsigned char* lds, int wid, int lane) const {
        typedef float f32x2v __attribute__((ext_vector_type(2)));
        const int colb = u.pn * BM + wc * 32 + 8 * fq;
#pragma unroll
        for (int ai = 0; ai < 2; ++ai)
#pragma unroll
            for (int m = 0; m < 4; ++m) { const size_t roff = (size_t)(row0 + u.pm * BM + ai * HALF + wr * 64 + m * 16 + fr) * DM + colb;
#pragma unroll
                for (int bj = 0; bj < 2; ++bj) { f32x4 r0, r1;
                    if (RES_F32) { r0 = *(const f32x4*)((const float*)res + roff + bj * HALF); r1 = *(const f32x4*)((const float*)res + roff + bj * HALF + 4); }
                    else { const int rl = wr * 64 + m * 16 + fr, x5 = (m & 1) * 16 + fr;
                        const int rq = bj ? ((rl & ~31) + 16 * ((x5 >> 2) & 1) + 4 * (x5 >> 3) + (x5 & 3)) : rl;
                        const u32x4 w = *(const PG8_LAS u32x4*)(lds + ((bj ? 4 : 0) + (wc >> 1) * 2 + ai) * HTB + lds_byte(rq, (wc & 1) * 32 + 8 * fq));
                        r0 = (f32x4){__uint_as_float(w.x << 16), __uint_as_float(w.x & 0xffff0000u), __uint_as_float(w.y << 16), __uint_as_float(w.y & 0xffff0000u)};
                        r1 = (f32x4){__uint_as_float(w.z << 16), __uint_as_float(w.z & 0xffff0000u), __uint_as_float(w.w << 16), __uint_as_float(w.w & 0xffff0000u)}; }
                    acc[ai][bj][m][0] = r0 * DN_ALPHA + acc[ai][bj][m][0]; acc[ai][bj][m][1] = r1 * DN_ALPHA + acc[ai][bj][m][1]; }
                asm volatile("" : "+v"(acc[ai][0][m][0]), "+v"(acc[ai][0][m][1]), "+v"(acc[ai][1][m][0]), "+v"(acc[ai][1][m][1]));
                asm volatile("" ::: "memory"); }
        st.run(acc, row0 / BM + u.pm, u.pn, wr, wc, fr, fq, lds + LDS_SPARE, wid, lane);
        const PG8_LAS f32x2v* Stab = (const PG8_LAS f32x2v*)(lds + LDS_SPARE + 8192);
        const int ln = fq * 16 + fr, src4 = (((ln & 3) << 4) | (ln >> 2)) << 2;
#pragma unroll
        for (int bj = 0; bj < 2; ++bj) {
            const f32x4 g0 = *(const f32x4*)(g + colb + bj * HALF), g1 = *(const f32x4*)(g + colb + bj * HALF + 4), b0 = *(const f32x4*)(b + colb + bj * HALF), b1 = *(const f32x4*)(b + colb + bj * HALF + 4);
#pragma unroll
            for (int ai = 0; ai < 2; ++ai)
#pragma unroll
                for (int m = 0; m < 4; ++m) { const int r = ai * HALF + wr * 64 + m * 16 + fr; const f32x2v sr = Stab[r];
                    const f32x4 y0 = (acc[ai][bj][m][0] - sr.x) * sr.y * g0 + b0, y1 = (acc[ai][bj][m][1] - sr.x) * sr.y * g1 + b1;
                    u32x4 w; w.x = cvt_pk_bf16(y0[0], y0[1]); w.y = cvt_pk_bf16(y0[2], y0[3]); w.z = cvt_pk_bf16(y1[0], y1[1]); w.w = cvt_pk_bf16(y1[2], y1[3]);
                    *(u32x4*)(X + (size_t)(row0 + u.pm * BM + r - fr + (ln >> 2)) * DM + u.pn * BM + wc * 32 + 8 * (ln & 3) + bj * HALF) = lane_tr(w, src4); }
        }
        asm volatile("s_waitcnt lgkmcnt(0)" ::: "memory"); __builtin_amdgcn_s_barrier(); asm volatile("" ::: "memory");
    }
};
}

DEV int tr_rowmap(int kind, int n) {
    if (kind == 1) return (n >= 1024) ? n : ((n < 512) ? ((n >> 7) * 256 + (n & 127)) : (((n - 512) >> 7) * 256 + 128 + (n & 127)));
    if (kind == 4) return (n < 1024) ? n : ((n < 2048) ? (1024 + ((n - 1024) >> 7) * 256 + (n & 127)) : (1024 + ((n - 2048) >> 7) * 256 + 128 + (n & 127)));
    if (kind == 2) return (n >> 7) * 256 + (n & 127);
    if (kind == 3) return (n >> 7) * 256 + 128 + (n & 127);
    return n;
}
struct TrItem { const float* W; int ldw, N; bf16_t* WT; int ldd, kind, kb, nb; bool on; };
DEV void tr_load(const TrItem& t, f32x4 (&v)[16], int lane) {
    const int k0 = 64 * t.kb, nn = 64 * t.nb + (lane & 15) * 4;
#pragma unroll
    for (int i = 0; i < 16; ++i) { const int kk = (lane >> 4) + 4 * i; v[i] = (t.on && nn < t.N) ? *(const f32x4*)(t.W + (size_t)(k0 + kk) * t.ldw + nn) : (f32x4){0.f, 0.f, 0.f, 0.f}; }
}
DEV void tr_store(const TrItem& t, const f32x4 (&v)[16], float* scr, int lane) {
    const int k0 = 64 * t.kb, n0 = 64 * t.nb;
#pragma unroll
    for (int i = 0; i < 16; ++i) { const int kk = (lane >> 4) + 4 * i; float* d = scr + kk * 65 + (lane & 15) * 4; d[0] = v[i].x; d[1] = v[i].y; d[2] = v[i].z; d[3] = v[i].w; }
    LDS_WAIT();
    const int kc = lane & 7;
#pragma unroll
    for (int i = 0; i < 8; ++i) {
        const int nl = (lane >> 3) + 8 * i, n = n0 + nl;
        const float* s = scr + (8 * kc) * 65 + nl;
        u32x4 o; o.x = pk2(s[0], s[65]); o.y = pk2(s[130], s[195]); o.z = pk2(s[260], s[325]); o.w = pk2(s[390], s[455]);
        if (t.on && n < t.N) *(u32x4*)(t.WT + (size_t)tr_rowmap(t.kind, n) * t.ldd + k0 + 8 * kc) = o;
    }
    LDS_WAIT();
}
constexpr int MOE_TR_ITEMS = NEXP * 384;
DEV TrItem moe_tr_decode(const Ctx& c, int layer, int it) {
    const float* w1 = gptr(c.p->in[29]) + (size_t)layer * NEXP * DM * EH;
    const float* w3 = gptr(c.p->in[30]) + (size_t)layer * NEXP * DM * EH;
    const float* w2 = gptr(c.p->in[31]) + (size_t)layer * NEXP * EH * DM;
    bf16_t* W13 = (bf16_t*)(c.ws + WS_W13); bf16_t* W2 = (bf16_t*)(c.ws + WS_W2);
    const int e = it / 384, r = it % 384, mat = r >> 7, sub = r & 127;
    if (mat == 0) return TrItem{w1 + (size_t)e * DM * EH, EH, EH, W13 + (size_t)e * DM * DM, DM, 2, sub >> 3, sub & 7, true};
    if (mat == 1) return TrItem{w3 + (size_t)e * DM * EH, EH, EH, W13 + (size_t)e * DM * DM, DM, 3, sub >> 3, sub & 7, true};
    if (layer == 1) W2 = (e < 16) ? (bf16_t*)(c.ws + WS_PK) : (bf16_t*)(c.ws + WS_W2B) - (size_t)16 * DM * EH;
    return TrItem{w2 + (size_t)e * EH * DM, DM, DM, W2 + (size_t)e * DM * EH, EH, 0, sub >> 4, sub & 15, true};
}
constexpr int MOE_E0 = 20, MOE_EARLY_ITEMS = MOE_E0 * 256, MOE_REST_ITEMS = (NEXP - MOE_E0) * 256, MOE_W2_ITEMS = NEXP * 128;
template <int MODE  >
DEV TrItem moe_tr_decode_m(const Ctx& c, int layer, int idx) {
    if (MODE == 0) return moe_tr_decode(c, layer, idx);
    if (MODE == 1) { const int e = idx >> 8, r = idx & 255; return moe_tr_decode(c, layer, e * 384 + r); }
    if (MODE == 2) { const int e = MOE_E0 + (idx >> 8), r = idx & 255; return moe_tr_decode(c, layer, e * 384 + r); }
    return moe_tr_decode(c, layer, (idx >> 7) * 384 + 256 + (idx & 127));
}
template <int MODE>
DEV void moe_weights_m(const Ctx& c, int layer, int worker, int nworkers) {
    constexpr int NIT = (MODE == 0) ? MOE_TR_ITEMS : (MODE == 1 ? MOE_EARLY_ITEMS : (MODE == 2 ? MOE_REST_ITEMS : MOE_W2_ITEMS));
    float* scr = c.lds + c.wave * (64 * 65);
    f32x4 va[16], vb[16];
    int it = worker;
    if (it >= NIT) return;
    TrItem cur = moe_tr_decode_m<MODE>(c, layer, it); tr_load(cur, va, c.lane);
    for (;;) {
        const int i1 = it + nworkers; const bool h1 = i1 < NIT; TrItem n1 = cur;
        if (h1) { n1 = moe_tr_decode_m<MODE>(c, layer, i1); tr_load(n1, vb, c.lane); }
        tr_store(cur, va, scr, c.lane);
        if (!h1) break;
        const int i2 = i1 + nworkers; const bool h2 = i2 < NIT;
        if (h2) { cur = moe_tr_decode_m<MODE>(c, layer, i2); tr_load(cur, va, c.lane); }
        tr_store(n1, vb, scr, c.lane);
        if (!h2) break;
        it = i2;
    }
}
template <int MODE>
DEV void moe_weights_in_tail(const Ctx& c, int layer, int nblk) {
    const int G = gridDim.x, bx = blockIdx.x, vc = (G % 8 == 0) ? (bx % 8) * (G / 8) + bx / 8 : bx;
    const int full = 4 * nblk - (4 * nblk / G) * G, nidle = G - full;
    if (vc < full) return;
    moe_weights_m<MODE>(c, layer, (vc - full) * NWAVES + c.wave, nidle * NWAVES);
}
DEV void cvt_rows(const Ctx& c, const float* src, bf16_t* dst, size_t n, int gw, int ngw) {
    const size_t nth = (size_t)ngw * 64, t0 = (size_t)gw * 64 + c.lane, nch = n / 8;
    for (size_t i = t0; i < nch; i += 4 * nth) {
        f32x4 a[4], b[4];
#pragma unroll
        for (int u = 0; u < 4; ++u) { const size_t j = i + u * nth; if (j < nch) { a[u] = *(const f32x4*)(src + j * 8); b[u] = *(const f32x4*)(src + j * 8 + 4); } }
#pragma unroll
        for (int u = 0; u < 4; ++u) { const size_t j = i + u * nth; if (j < nch) { u32x4 o; o.x = pk2(a[u].x, a[u].y); o.y = pk2(a[u].z, a[u].w); o.z = pk2(b[u].x, b[u].y); o.w = pk2(b[u].z, b[u].w); *(u32x4*)(dst + j * 8) = o; } }
    }
}
template <int PART>
DEV void phase_prep(const Ctx& c) {
    const __attribute__((address_space(4))) Params& p = *c.p; unsigned char* ws = c.ws;
    float* scr = c.lds + c.wave * (64 * 65);
    if (PART == 0 && blockIdx.x == 0 && c.tid < 64) ((int*)(ws + WS_CTL))[c.tid] = 0;
    constexpr int I_IN = 16 * 37, I_SQ = 16 * 16, I_OD = 16 * 48, I_CW = 16 * 4;
    constexpr int NA = I_IN + I_SQ + I_OD + I_SQ + 4 * I_SQ + 2 * I_SQ + 4 * I_CW;
    {
        const int bx = blockIdx.x; int g_ = 0, ng_ = 1;
        auto sub = [&](int w0, int nw) { g_ = (bx - w0) * NWAVES + c.wave; ng_ = nw * NWAVES; return bx >= w0 && bx < w0 + nw; };
        if (PART == 1 && sub(0, 64)) {
            for (int i = g_ * 64 + c.lane; i < 2 * 96 * DM; i += ng_ * 64) {
                const int l = i / (96 * DM), rr = (i / DM) % 96, k = i % DM, part = rr / 48, o = rr % 48;
                float w = 0.f;
                if (o < 32) w = gptr(p.in[27])[((size_t)l * DM + k) * 32 + o]; else if (o < 36) w = gptr(p.in[25])[((size_t)l * DM + k) * 4 + (o - 32)];
                const unsigned hi = f2bf(w); const float lo = w - __uint_as_float(hi << 16);
                ((bf16_t*)(ws + WS_RWB))[i] = (bf16_t)(part ? f2bf(lo) : hi);
            }
        }
        if (PART == 1 && sub(64, 32)) {
            for (int i = g_ * 64 + c.lane; i < 8 * 256 * 64; i += ng_ * 64) {
                const int n = (i >> 6) & 255, m = i & 63; float v = 0.f;
                if (n < NCMP) { const int ov = min(16 * n + 32, 64 * m + 64) - max(16 * n, 64 * m); v = (ov > 0) ? (float)ov * (1.f / 32.f) : 0.f; }
                ((bf16_t*)(ws + WS_MSEL))[i] = (bf16_t)f2bf(v);
            }
            for (int i = g_ * 64 + c.lane; i < 2 * 16 * 64; i += ng_ * 64) { const int kv = i >> 10, bg = (i >> 6) & 15, d = i & 63; ((bf16_t*)(ws + (kv ? WS_VCMP : WS_KCMP)))[(size_t)(bg * 256 + 255) * 64 + d] = 0; }
        }
        if (PART == 1 && sub(96, 64)) cvt_rows(c, gptr(p.in[1]), (bf16_t*)(ws + WS_MEMB), (size_t)NMEM * DM, g_, ng_);
        if (PART == 1 && sub(160, 64)) cvt_rows(c, gptr(p.in[21]), (bf16_t*)(ws + WS_WQ), (size_t)2 * DM * DM, g_, ng_);
        if (PART == 0 && sub(224, 24)) {
            bf16_t* w = (bf16_t*)(ws + WS_W_IN) + (size_t)EIN * DM; const size_t n = (size_t)(EINP - EIN) * DM / 8;
            for (size_t i = (size_t)g_ * 64 + c.lane; i < n; i += (size_t)ng_ * 64) *(u32x4*)(w + i * 8) = (u32x4){0u, 0u, 0u, 0u};
        }
        if (PART == 1 && sub(248, 8)) {
            for (int it = g_; it < 64; it += ng_) {
                const int kv = it >> 5, blk = it & 31;
                const float* pe = gptr(p.in[kv ? 12 : 9]); const float* w1 = gptr(p.in[kv ? 13 : 10]);
                f32x4 sacc = {0.f, 0.f, 0.f, 0.f};
#pragma unroll 8
                for (int r = 0; r < 64; ++r) { const int kk = blk * 64 + r; sacc = sacc + *(const f32x4*)(w1 + (size_t)kk * 256 + 4 * c.lane) * pe[kk]; }
                *(f32x4*)((float*)(ws + WS_CMPP) + (size_t)it * 256 + 4 * c.lane) = sacc;
            }
        }
    }
    auto decode = [&](int it) -> TrItem {
        int r = it;
        if (r >= NA) return moe_tr_decode(c, 0, r - NA);
        if (r < I_IN) return TrItem{gptr(p.in[4]), EIN, EIN, (bf16_t*)(ws + WS_W_IN), DM, 1, r / 37, r % 37, true}; r -= I_IN;
        if (r < I_SQ) return TrItem{gptr(p.in[15]), DM, DM, (bf16_t*)(ws + WS_W_OUT), DM, 0, r >> 4, r & 15, true}; r -= I_SQ;
        if (r < I_OD) return TrItem{gptr(p.in[16]), 3 * DM, 3 * DM, (bf16_t*)(ws + WS_OD_IN), DM, 4, r / 48, r % 48, true}; r -= I_OD;
        if (r < I_SQ) return TrItem{gptr(p.in[18]), DM, DM, (bf16_t*)(ws + WS_OD_OUT), DM, 0, r >> 4, r & 15, true}; r -= I_SQ;
        if (r < 4 * I_SQ) { const int m = r >> 8, l = m & 1, q = r & 255;
            return TrItem{gptr(p.in[22]) + (size_t)l * DM * DM, DM, DM, (bf16_t*)(ws + WS_WO) + (size_t)l * DM * DM, DM, 0, q >> 4, q & 15, m >= 2}; } r -= 4 * I_SQ;
        if (r < 2 * I_SQ) { const int m = r >> 8, q = r & 255; return TrItem{gptr(p.in[m ? 3 : 2]), DM, DM, (bf16_t*)(ws + (m ? WS_WV : WS_WK)), DM, 0, q >> 4, q & 15, true}; } r -= 2 * I_SQ;
        const int m = r >> 6, kv = m >> 1, half = m & 1, q = r & 63;
        return TrItem{gptr(p.in[kv ? 13 : 10]) + (size_t)half * 1024 * 256, 256, 256, (bf16_t*)(ws + WS_CW1) + ((size_t)kv * 512 + half * 256) * DM, DM, 0, q >> 2, q & 3, true};
    };
    {   constexpr int ILO = (PART == 0) ? 0 : I_IN, NTOT = (PART == 0) ? I_IN : NA;
        f32x4 va[16], vb[16];
        int it = ILO + c.gw;
        if (it < NTOT) {
            TrItem cur = decode(it); tr_load(cur, va, c.lane);
            for (;;) {
                const int i1 = it + c.ngw; const bool h1 = i1 < NTOT; TrItem n1 = cur;
                if (h1) { n1 = decode(i1); tr_load(n1, vb, c.lane); }
                tr_store(cur, va, scr, c.lane);
                if (!h1) break;
                const int i2 = i1 + c.ngw; const bool h2 = i2 < NTOT;
                if (h2) { cur = decode(i2); tr_load(cur, va, c.lane); }
                tr_store(n1, vb, scr, c.lane);
                if (!h2) break;
                it = i2;
            }
        }
    }
    if (PART == 0) cvt_rows(c, gptr(p.in[0]), (bf16_t*)(ws + WS_XA), (size_t)NT * DM, c.gw, c.ngw);
}

constexpr int CONV_LW = 63488;
typedef float f32x2 __attribute__((ext_vector_type(2)));
DEV void conv_stage_w(const Ctx& c) {
    __attribute__((address_space(3))) float* LW = (__attribute__((address_space(3))) float*)((__attribute__((address_space(3))) unsigned char*)c.lds + CONV_LW);
    const float* cw = gptr(c.p->in[5]);
    for (int i = c.tid; i < 37 * 512; i += NTHREADS) { const int row = i >> 9, ch = i & 511, k = row - 3;
        LW[row * 512 + ((ch & 4) ? 256 : 0) + (ch >> 3) * 4 + (ch & 3)] = (k >= 0 && k <= 30) ? cw[k * 512 + ch] : 0.f; }
}
DEV void conv_tile(const Ctx& c, int tile, const float (&bias)[8], const float (&gam)[8], const float (&bet)[8]) {
    typedef __attribute__((address_space(3))) unsigned char lds8;
    lds8* L = (lds8*)c.lds; lds8* LW = L + CONV_LW;
    const bf16_t* Y0 = (const bf16_t*)(c.ws + SC_Y0); bf16_t* CAT = (bf16_t*)(c.ws + SC_CAT);
    const int tok0 = tile * 32, t0 = tok0 & (SEQ - 1);
    __syncthreads();
    {   u32x4 v[8];
#pragma unroll
        for (int u = 0; u < 8; ++u) { const int i = c.tid + u * NTHREADS, r = i >> 6, ch = i & 63; v[u] = (u32x4){0u, 0u, 0u, 0u};
            if (i < 62 * 64 && t0 - 30 + r >= 0) v[u] = *(const u32x4*)(Y0 + (size_t)(tok0 - 30 + r) * EINP + ch * 8); }
#pragma unroll
        for (int u = 0; u < 8; ++u) { const int i = c.tid + u * NTHREADS, r = i >> 6, ch = i & 63;
            if (i < 62 * 64) *(__attribute__((address_space(3))) u32x4*)(L + r * 1024 + ch * 16) = v[u]; }
    }
    __syncthreads();
    const int ch0 = c.lane * 8, j0 = c.wave * 4;
    f32x2 acc[4][4];
#pragma unroll
    for (int j = 0; j < 4; ++j) { const f32x2 bq = {bias[2 * j], bias[2 * j + 1]};
#pragma unroll
        for (int m = 0; m < 4; ++m) acc[m][j] = bq; }
    f32x2 w[4][4];
#pragma unroll
    for (int d = 0; d < 4; ++d)
#pragma unroll
        for (int j = 0; j < 4; ++j) w[d][j] = (f32x2){0.f, 0.f};
#define CONV_STEP(s, u) do { \
        const u32x4 ra_ = *(const __attribute__((address_space(3))) u32x4*)(L + (j0 + (s)) * 1024 + c.lane * 16); \
        const f32x4 wa_ = *(const __attribute__((address_space(3))) f32x4*)(LW + ((s) + 3) * 2048 + c.lane * 16), wb_ = *(const __attribute__((address_space(3))) f32x4*)(LW + ((s) + 3) * 2048 + 1024 + c.lane * 16); \
        w[(u)][0] = (f32x2){wa_[0], wa_[1]}; w[(u)][1] = (f32x2){wa_[2], wa_[3]}; w[(u)][2] = (f32x2){wb_[0], wb_[1]}; w[(u)][3] = (f32x2){wb_[2], wb_[3]}; \
        f32x2 a_[4]; \
        _Pragma("unroll") for (int j = 0; j < 4; ++j) a_[j] = (f32x2){__uint_as_float(ra_[j] << 16), __uint_as_float(ra_[j] & 0xffff0000u)}; \
        _Pragma("unroll") for (int m = 0; m < 4; ++m) _Pragma("unroll") for (int j = 0; j < 4; ++j) acc[m][j] = __builtin_elementwise_fma(a_[j], w[((u) - m) & 3][j], acc[m][j]); } while (0)
    for (int s4 = 0; s4 < 32; s4 += 4) { CONV_STEP(s4, 0); CONV_STEP(s4 + 1, 1); CONV_STEP(s4 + 2, 2); CONV_STEP(s4 + 3, 3); }
    CONV_STEP(32, 0); CONV_STEP(33, 1);
#undef CONV_STEP
#pragma unroll
    for (int m = 0; m < 4; ++m) {
        float a8[8];
#pragma unroll
        for (int j = 0; j < 4; ++j) { a8[2 * j] = acc[m][j][0]; a8[2 * j + 1] = acc[m][j][1]; }
        float s = 0.f;
#pragma unroll
        for (int j = 0; j < 8; ++j) s += a8[j];
        const float mean = wsum_dpp(s) * (1.f / 512.f); float s2 = 0.f;
#pragma unroll
        for (int j = 0; j < 8; ++j) { a8[j] -= mean; s2 += a8[j] * a8[j]; }
        const float rstd = rsqrtf(wsum_dpp(s2) * (1.f / 512.f) + LN_EPS);
        float y[8];
#pragma unroll
        for (int j = 0; j < 8; ++j) { const float v = a8[j] * rstd * gam[j] + bet[j]; y[j] = v * frcp(1.f + __expf(-v)); }
        u32x4 o; o.x = pk2(y[0], y[1]); o.y = pk2(y[2], y[3]); o.z = pk2(y[4], y[5]); o.w = pk2(y[6], y[7]);
        *(u32x4*)(CAT + (size_t)(tok0 + j0 + m) * DM + ch0) = o;
    }
}
DEV void conv_phase(const Ctx& c) {
    conv_stage_w(c);
    const int bx = blockIdx.x;
    if (bx == gridDim.x - 1) {
        const float* part = (const float*)(c.ws + WS_CMPP); float sum = 0.f;
        for (int blk = 0; blk < 32; ++blk) sum += part[(size_t)((c.tid >> 8) * 32 + blk) * 256 + (c.tid & 255)];
        ((float*)(c.ws + WS_CMPB))[c.tid] = sum;
    }
    float bias[8], gam[8], bet[8];
#pragma unroll
    for (int j = 0; j < 8; ++j) { bias[j] = gptr(c.p->in[6])[c.lane * 8 + j]; gam[j] = gptr(c.p->in[7])[c.lane * 8 + j]; bet[j] = gptr(c.p->in[8])[c.lane * 8 + j]; }
    if (bx < 128) { for (int i = 0; i < 3; ++i) conv_tile(c, 3 * bx + i, bias, gam, bet); }
    else for (int i = 0; i < 5; ++i) conv_tile(c, 384 + (bx - 128) * 5 + i, bias, gam, bet);
    __syncthreads();
}

DEV float gelu_tanh_fast(float x) { const float u = 0.7978845608028654f * (x + 0.044715f * x * x * x); const float t = 1.f - 2.f * frcp(1.f + __expf(2.f * u)); return 0.5f * x * (1.f + t); }
DEV void cmp_finish(const Ctx& c) {
    const __attribute__((address_space(4))) Params& p = *c.p;
    const int kv = (blockIdx.x >= gridDim.x / 2) ? 1 : 0, half = gridDim.x / 2, bxl = blockIdx.x - kv * half;
    float* w2l = c.lds;
    float* hid = c.lds + 16384 + c.wave * 256;
    { const float* w2 = gptr(p.in[kv ? 14 : 11]); for (int i = c.tid; i < 4096; i += NTHREADS) *(f32x4*)(w2l + 4 * i) = *(const f32x4*)(w2 + 4 * i); }
    __syncthreads();
    const float* P = (const float*)(c.ws + (kv ? WS_PV : WS_PK));
    const float* cbias = (const float*)(c.ws + WS_CMPB) + kv * 256;
    float cb[4];
#pragma unroll
    for (int i = 0; i < 4; ++i) cb[i] = cbias[c.lane + 64 * i];
    for (int r = bxl * NWAVES + c.wave; r < NB * NCMP * 2; r += half * NWAVES) {
        const int g = r & 1, bn = r >> 1, b = bn / NCMP, n = bn % NCMP;
        const int r0 = (b * 256 + n) * 2 + g, r1 = (b * 256 + n + 1) * 2 + g;
#pragma unroll
        for (int i = 0; i < 4; ++i) { const int cc = c.lane + 64 * i; hid[cc] = gelu_tanh_fast(P[(size_t)r0 * 512 + cc] + P[(size_t)r1 * 512 + 256 + cc] + cb[i]); }
        LDS_WAIT();
        float o0 = 0.f, o1 = 0.f, o2 = 0.f, o3 = 0.f;
#pragma unroll 4
        for (int cc = 0; cc < 256; cc += 4) { const f32x4 hv = *(const f32x4*)(hid + cc);
            o0 += hv.x * w2l[(cc + 0) * 64 + c.lane]; o1 += hv.y * w2l[(cc + 1) * 64 + c.lane]; o2 += hv.z * w2l[(cc + 2) * 64 + c.lane]; o3 += hv.w * w2l[(cc + 3) * 64 + c.lane]; }
        ((bf16_t*)(c.ws + (kv ? WS_VCMP : WS_KCMP)))[(size_t)((b * 2 + g) * 256 + n) * 64 + c.lane] = (bf16_t)f2bf((o0 + o1) + (o2 + o3));
        LDS_WAIT();
    }
}

DEV void nsa_naive(const Ctx& c) {
    const bf16_t* Y0 = (const bf16_t*)(c.ws + SC_Y0); bf16_t* CAT = (bf16_t*)(c.ws + WS_XB);
    const bf16_t* KC = (const bf16_t*)(c.ws + WS_KCMP); const bf16_t* VC = (const bf16_t*)(c.ws + WS_VCMP);
    float* pc = c.lds + c.wave * 1024;
    const int hh = c.lane >> 4, dq = c.lane & 15;
    for (int it = c.gw; it < NT * 2; it += c.ngw) {
        const int g = it & 1, row = it >> 1, b = row >> 12, t = row & (SEQ - 1);
        const int h = g * 4 + hh;
        const bf16_t* yrow = Y0 + (size_t)row * EINP;
        float q[4]; ld4bf(yrow + C_Q + h * 64 + dq * 4, q);
        const int ncv = (t >= 31) ? min(NCMP, (t - 31) / 16 + 1) : 0;
        float oc[4] = {0.f, 0.f, 0.f, 0.f};
        float mx = -INFINITY;
        for (int n = 0; n < ncv; ++n) {
            float kk4[4]; ld4bf(KC + (size_t)((b * 2 + g) * 256 + n) * 64 + dq * 4, kk4); const f32x4 k4 = {kk4[0], kk4[1], kk4[2], kk4[3]};
            float s = q[0] * k4.x + q[1] * k4.y + q[2] * k4.z + q[3] * k4.w; s = gsum16(s);
            if (dq == 0) pc[hh * 256 + n] = s;
            mx = fmaxf(mx, s);
        }
        LDS_WAIT();
        float l = 0.f;
        for (int n = 0; n < ncv; ++n) l += exp2f(pc[hh * 256 + n] - mx);
        const float inv = (ncv > 0) ? 1.f / l : 0.f;
        for (int n = 0; n < ncv; ++n) {
            const float pr = exp2f(pc[hh * 256 + n] - mx) * inv;
            float vv4[4]; ld4bf(VC + (size_t)((b * 2 + g) * 256 + n) * 64 + dq * 4, vv4); const f32x4 v4 = {vv4[0], vv4[1], vv4[2], vv4[3]};
            oc[0] += pr * v4.x; oc[1] += pr * v4.y; oc[2] += pr * v4.z; oc[3] += pr * v4.w;
            LDS_WAIT();
            if (dq == 0) pc[hh * 256 + n] = pr;
        }
        LDS_WAIT();
        const int m = c.lane, cur = t >> 6;
        float imp = 0.f;
#pragma unroll
        for (int h2 = 0; h2 < 4; ++h2)
#pragma unroll
            for (int dn = -1; dn <= 3; ++dn) { const int n = 4 * m + dn; if (n >= 0 && n < ncv) imp += pc[h2 * 256 + n] * ((dn == -1 || dn == 3) ? 0.5f : 1.f); }
        const bool causal = m <= cur, forced = (m == 0) || (m == cur) || (m == cur - 1);
        const float score = causal ? (forced ? 1e4f : imp) : -1e30f;
        int rank = 0;
        for (int m2 = 0; m2 < 64; ++m2) { const float s2 = __shfl(score, m2); rank += ((s2 > score) || (s2 == score && m2 < m)) ? 1 : 0; }
        unsigned long long selmask = __ballot(causal && rank < 16);
        LDS_WAIT();
        float ms = -INFINITY, ls = 0.f, os[4] = {0.f, 0.f, 0.f, 0.f};
        while (selmask) {
            const int mb = __builtin_ctzll(selmask); selmask &= selmask - 1;
            const int jmax = min(63, t - 64 * mb);
            const bf16_t* kb = Y0 + (size_t)(b * SEQ + 64 * mb) * EINP + g * 64 + dq * 4;
            for (int j = 0; j <= jmax; ++j) {
                float k4[4], v4[4]; ld4bf(kb + (size_t)j * EINP + C_KS, k4); ld4bf(kb + (size_t)j * EINP + C_VS, v4);
                float s = q[0] * k4[0] + q[1] * k4[1] + q[2] * k4[2] + q[3] * k4[3]; s = gsum16(s);
                const float mn = fmaxf(ms, s), cf = exp2f(ms - mn), pp = exp2f(s - mn);
                ls = ls * cf + pp;
#pragma unroll
                for (int i = 0; i < 4; ++i) os[i] = os[i] * cf + pp * v4[i];
                ms = mn;
            }
        }
        float mw = -INFINITY, lw = 0.f, ow[4] = {0.f, 0.f, 0.f, 0.f};
        {
            const int k0 = max(0, t - 511);
            const bf16_t* kb = Y0 + (size_t)(b * SEQ) * EINP + g * 64 + dq * 4;
            for (int kp = k0; kp <= t; ++kp) {
                float k4[4], v4[4]; ld4bf(kb + (size_t)kp * EINP + C_KW, k4); ld4bf(kb + (size_t)kp * EINP + C_VW, v4);
                float s = q[0] * k4[0] + q[1] * k4[1] + q[2] * k4[2] + q[3] * k4[3]; s = gsum16(s);
                const float mn = fmaxf(mw, s), cf = exp2f(mw - mn), pp = exp2f(s - mn);
                lw = lw * cf + pp;
#pragma unroll
                for (int i = 0; i < 4; ++i) ow[i] = ow[i] * cf + pp * v4[i];
                mw = mn;
            }
        }
        const float gc = sigmoidf_(bf2f(yrow[C_GL + h * 3 + 0])), gs = sigmoidf_(bf2f(yrow[C_GL + h * 3 + 1])) / ls, gwn = sigmoidf_(bf2f(yrow[C_GL + h * 3 + 2])) / lw;
        st4bf(CAT + (size_t)row * DM + 512 + h * 64 + dq * 4, gc * oc[0] + gs * os[0] + gwn * ow[0], gc * oc[1] + gs * os[1] + gwn * ow[1], gc * oc[2] + gs * os[2] + gwn * ow[2], gc * oc[3] + gs * os[3] + gwn * ow[3]);
    }
}

namespace nsa {
typedef float f32x16 __attribute__((ext_vector_type(16)));
typedef short s16x4 __attribute__((ext_vector_type(4)));
typedef __attribute__((address_space(3))) unsigned char lds_u8;
constexpr int SLOT = 8192, NSLOT = 3;
constexpr int IMPP = 65;
constexpr int L_K = 0, L_V = NSLOT * SLOT, L_IMP = 2 * NSLOT * SLOT  , L_SEL = L_IMP + 4 * 64 * IMPP * 4  ;
constexpr float NEGB = -1e30f;
DEV int crow(int r, int hi) { return (r & 3) + 8 * (r >> 2) + 4 * hi; }
DEV s16x4 vtr(const lds_u8* p) { typedef short v4i16_t __attribute__((ext_vector_type(4))); return __builtin_bit_cast(s16x4, __builtin_amdgcn_ds_read_tr16_b64_v4i16((__attribute__((address_space(3))) v4i16_t*)p)); }
DEV unsigned cvtpk(float lo, float hi) { typedef float f2 __attribute__((ext_vector_type(2))); typedef __bf16 b2 __attribute__((ext_vector_type(2))); f2 v = {lo, hi}; b2 b = __builtin_convertvector(v, b2); return __builtin_bit_cast(unsigned, b); }
DEV void glds16(const void* gsrc, unsigned lds_dst) { unsigned keep;
    asm volatile("s_mov_b32 %0, m0\n\ts_mov_b32 m0, %2\n\ts_nop 0\n\tglobal_load_lds_dwordx4 %1, off\n\ts_mov_b32 m0, %0" : "=&s"(keep) : "v"(gsrc), "s"(lds_dst) : "memory"); }
#define NSA_WAITV(n) asm volatile("s_waitcnt vmcnt(" #n ")" ::: "memory")
#define NSA_BAR() do { asm volatile("s_waitcnt lgkmcnt(0)" ::: "memory"); __builtin_amdgcn_s_barrier(); asm volatile("" ::: "memory"); } while (0)

DEV void flash_pass(lds_u8* lds, const bf16_t* Kg, int pk, const bf16_t* Vg, int pv, int t0, int nt, const bf16x8 (&qr)[4],
                    int lo, int hi_b, unsigned long long rowmask, int lo_max, int hi_min, f32x16 (&o)[2], float& l_out) {
    const int tid = threadIdx.x, lane = tid & 63, r32 = lane & 31, hi = lane >> 5; const int wid = __builtin_amdgcn_readfirstlane(tid >> 6);
    o[0] = f32x16{}; o[1] = f32x16{}; float l = 0.f, mhat = 0.f;
    if (nt <= 0) { l_out = 0.f; return; }
    const bf16_t* ksrc = Kg + (size_t)(t0 * 64 + lane) * pk + wid * 8;
    const bf16_t* vsrc = Vg + (size_t)(t0 * 64 + 16 * (wid & 3) + (lane >> 2)) * pv + (wid >> 2) * 32 + (lane & 3) * 8;
    const size_t kstep = (size_t)64 * pk, vstep = (size_t)64 * pv;
    const unsigned lds0 = (unsigned)(uintptr_t)lds;
#define NSA_DMA(t, slot) do { glds16(ksrc + (size_t)(t) * kstep, (unsigned)__builtin_amdgcn_readfirstlane(lds0 + L_K + (slot) * SLOT + wid * 1024)); \
                               glds16(vsrc + (size_t)(t) * vstep, (unsigned)__builtin_amdgcn_readfirstlane(lds0 + L_V + (slot) * SLOT + wid * 1024)); } while (0)
    const lds_u8* kp0 = lds + L_K + hi * 1024 + r32 * 16;
    const lds_u8* vp0 = lds + L_V + ((lane >> 4) & 1) * 32 + (lane & 3) * 8 + (4 * hi + ((lane & 15) >> 2)) * 64;
    NSA_DMA(0, 0);
    if (nt > 1) NSA_DMA(1, 1);
    int slot = 0;
    for (int t = 0; t < nt; ++t) {
        if (t + 1 < nt) NSA_WAITV(2); else NSA_WAITV(0);
        NSA_BAR();
        if (t + 2 < nt) { const int s2 = (slot >= 1) ? slot - 1 : 2; NSA_DMA(t + 2, s2); }
        const int gt = t0 + t;
        const bool rowok = (rowmask >> gt) & 1ull;
        const float ci = rowok ? -mhat : NEGB;
        f32x16 c0, c1;
#pragma unroll
        for (int r = 0; r < 16; ++r) { c0[r] = ci; c1[r] = ci; }
        const lds_u8* kp = kp0 + slot * SLOT;
        bf16x8 kf[8];
#pragma unroll
        for (int d0 = 0; d0 < 4; ++d0) { kf[2 * d0] = *(const __attribute__((address_space(3))) bf16x8*)(kp + d0 * 2048); kf[2 * d0 + 1] = *(const __attribute__((address_space(3))) bf16x8*)(kp + d0 * 2048 + 512); }
        __builtin_amdgcn_s_setprio(1);
#pragma unroll
        for (int d0 = 0; d0 < 4; ++d0) {
            c0 = __builtin_amdgcn_mfma_f32_32x32x16_bf16(kf[2 * d0], qr[d0], c0, 0, 0, 0);
            c1 = __builtin_amdgcn_mfma_f32_32x32x16_bf16(kf[2 * d0 + 1], qr[d0], c1, 0, 0, 0);
        }
        __builtin_amdgcn_s_setprio(0);
        if ((64 * gt + 63 > hi_min) || (64 * gt <= lo_max)) {
            const int kb = 64 * gt + 4 * hi;
#pragma unroll
            for (int r = 0; r < 16; ++r) { const int kv = kb + (r & 3) + 8 * (r >> 2);
                if (!(kv > lo && kv <= hi_b)) c0[r] = NEGB;
                if (!(kv + 32 > lo && kv + 32 <= hi_b)) c1[r] = NEGB; }
        }
#define NSA_MX3(a, b, c) __builtin_fmaxf(__builtin_fmaxf((a), (b)), (c))
        float rm, rm2;
        { float a = NSA_MX3(c0[0], c0[1], c1[0]), b = NSA_MX3(c0[2], c0[3], c1[1]); a = NSA_MX3(a, c1[2], c1[3]);
#pragma unroll
          for (int r = 4; r < 16; r += 4) { a = NSA_MX3(a, c0[r], c0[r + 1]); b = NSA_MX3(b, c0[r + 2], c0[r + 3]); a = NSA_MX3(a, c1[r], c1[r + 1]); b = NSA_MX3(b, c1[r + 2], c1[r + 3]); }
          rm = __builtin_fmaxf(a, b); rm2 = rm; }
#undef NSA_MX3
        { auto rr = __builtin_amdgcn_permlane32_swap(__float_as_uint(rm), __float_as_uint(rm2), false, false); rm = __builtin_fmaxf(__uint_as_float(rr[0]), __uint_as_float(rr[1])); }
        if (__any(rm > 6.0f)) {
            const float dl = fmaxf(rm, 0.f), f = __builtin_amdgcn_exp2f(-dl);
            mhat += dl; l *= f;
#pragma unroll
            for (int r = 0; r < 16; ++r) { c0[r] -= dl; c1[r] -= dl; o[0][r] *= f; o[1][r] *= f; }
        }
        float ps = 0.f;
#pragma unroll
        for (int r = 0; r < 16; ++r) { c0[r] = __builtin_amdgcn_exp2f(c0[r]); c1[r] = __builtin_amdgcn_exp2f(c1[r]); ps += c0[r] + c1[r]; }
        l += ps;
        u32x4 pw[4];
#pragma unroll
        for (int s = 0; s < 2; ++s)
#pragma unroll
            for (int j = 0; j < 4; ++j) { pw[s][j] = cvtpk(c0[8 * s + 2 * j], c0[8 * s + 2 * j + 1]); pw[2 + s][j] = cvtpk(c1[8 * s + 2 * j], c1[8 * s + 2 * j + 1]); }
        const lds_u8* vp = vp0 + slot * SLOT;
        bf16x8 vf[8];
#pragma unroll
        for (int dh = 0; dh < 2; ++dh)
#pragma unroll
            for (int ks = 0; ks < 4; ++ks) {
                const s16x4 vl = vtr(vp + dh * 4096 + ks * 1024), vh = vtr(vp + dh * 4096 + ks * 1024 + 512);
                vf[dh * 4 + ks] = (bf16x8){vl[0], vl[1], vl[2], vl[3], vh[0], vh[1], vh[2], vh[3]};
            }
        __builtin_amdgcn_s_setprio(1);
#pragma unroll
        for (int ks = 0; ks < 4; ++ks) {
            o[0] = __builtin_amdgcn_mfma_f32_32x32x16_bf16(vf[ks], __builtin_bit_cast(bf16x8, pw[ks]), o[0], 0, 0, 0);
            o[1] = __builtin_amdgcn_mfma_f32_32x32x16_bf16(vf[4 + ks], __builtin_bit_cast(bf16x8, pw[ks]), o[1], 0, 0, 0);
        }
        __builtin_amdgcn_s_setprio(0);
        slot = (slot == 2) ? 0 : slot + 1;
    }
    NSA_BAR();
    { auto rr = __builtin_amdgcn_permlane32_swap(__float_as_uint(l), __float_as_uint(l), false, false); l = __uint_as_float(rr[0]) + __uint_as_float(rr[1]); }
    l_out = l;
#undef NSA_DMA
}

DEV void nsa_unit(lds_u8* lds, unsigned char* ws, int b, int g, int qt) {
    const int tid = threadIdx.x, lane = tid & 63, r32 = lane & 31, hi = lane >> 5; const int wid = __builtin_amdgcn_readfirstlane(tid >> 6);
    const int hh = wid >> 1, h = 4 * g + hh, ql = 32 * (wid & 1) + r32, t = 64 * qt + ql;
    const bf16_t* Y0 = (const bf16_t*)(ws + SC_Y0);
    const bf16_t* yrow = Y0 + (size_t)(b * SEQ + t) * EINP;
    bf16x8 qr[4];
#pragma unroll
    for (int d0 = 0; d0 < 4; ++d0) qr[d0] = *(const bf16x8*)(yrow + C_Q + h * 64 + d0 * 16 + hi * 8);
#pragma unroll
    for (int d0 = 0; d0 < 4; ++d0) asm volatile("" : "+v"(qr[d0]));
    const float g_c = sigmoidf_(bf2f(yrow[C_GL + h * 3 + 0])), g_s = sigmoidf_(bf2f(yrow[C_GL + h * 3 + 1])), g_w = sigmoidf_(bf2f(yrow[C_GL + h * 3 + 2]));
    const bf16_t* Ybg = Y0 + (size_t)(b * SEQ) * EINP + g * 64;
    f32x16 acc[2], o[2]; float l;
    const int nmax = (t >= 31) ? (t - 31) >> 4 : -1;
    const int tmaxu = 64 * qt + 63, nmax_u = (tmaxu - 31) >> 4, nct = (nmax_u >> 6) + 1;
    const int nmin_u = (64 * qt >= 31) ? (64 * qt - 31) >> 4 : -1;
    const bf16_t* KC = (const bf16_t*)(ws + WS_KCMP) + (size_t)(b * 2 + g) * 256 * 64;
    const bf16_t* VC = (const bf16_t*)(ws + WS_VCMP) + (size_t)(b * 2 + g) * 256 * 64;
    const bf16_t* MS = (const bf16_t*)(ws + WS_MSEL) + (size_t)((b * 2 + g) & 7) * 256 * 64;
    flash_pass(lds, KC, 64, VC, 64, 0, nct, qr, -1, nmax, ~0ull, -1, nmin_u, o, l);
    { const float sc = (l > 0.f) ? g_c * frcp(l) : 0.f;
#pragma unroll
      for (int dh = 0; dh < 2; ++dh)
#pragma unroll
          for (int r = 0; r < 16; ++r) acc[dh][r] = o[dh][r] * sc; }
    unsigned long long selmask = (2ull << qt) - 1ull;
    if (qt >= 16) {
    flash_pass(lds, KC, 64, MS, 64, 0, nct, qr, -1, nmax, ~0ull, -1, nmin_u, o, l);
    { const float sc = (l > 0.f) ? frcp(l) : 0.f;
      __attribute__((address_space(3))) float* imp = (__attribute__((address_space(3))) float*)(lds + L_IMP) + (hh * 64 + ql) * IMPP;
#pragma unroll
      for (int dh = 0; dh < 2; ++dh)
#pragma unroll
          for (int r = 0; r < 16; ++r) imp[32 * dh + crow(r, hi)] = o[dh][r] * sc; }
    NSA_BAR();
    {
        __attribute__((address_space(3))) const float* impb = (__attribute__((address_space(3))) const float*)(lds + L_IMP);
        __attribute__((address_space(3))) unsigned long long* selp = (__attribute__((address_space(3))) unsigned long long*)(lds + L_SEL);
        const int m = lane, cur = qt;
        for (int qq = 8 * wid; qq < 8 * wid + 8; ++qq) {
            unsigned long long sel;
            if (cur < 16) sel = (2ull << cur) - 1ull;
            else {
                const float iv = ((impb[(0 * 64 + qq) * IMPP + m] + impb[(1 * 64 + qq) * IMPP + m]) + impb[(2 * 64 + qq) * IMPP + m]) + impb[(3 * 64 + qq) * IMPP + m];
                const bool cand = (m >= 1) && (m <= cur - 2);
                const unsigned bits = __float_as_uint(fmaxf(iv, 0.f));
                unsigned T = 0u;
                for (int bit = 30; bit >= 0; --bit) { const unsigned trial = T | (1u << bit); if (__popcll(__ballot(cand && bits >= trial)) >= 13) T = trial; }
                const unsigned long long gtm = __ballot(cand && bits > T); unsigned long long eqm = __ballot(cand && bits == T);
                int need = 13 - __popcll(gtm); unsigned long long tie = 0ull;
                while (need > 0 && eqm) { const unsigned long long lowb = eqm & (~eqm + 1ull); tie |= lowb; eqm ^= lowb; --need; }
                sel = gtm | tie | 1ull | (1ull << cur) | (1ull << (cur - 1));
            }
            if (lane == 0) selp[qq] = sel;
        }
    }
    NSA_BAR();
    selmask = ((__attribute__((address_space(3))) const unsigned long long*)(lds + L_SEL))[ql];
    }
    flash_pass(lds, Ybg + C_KS, EINP, Ybg + C_VS, EINP, 0, qt + 1, qr, -1, t, selmask, -1, 64 * qt, o, l);
    { const float sc = g_s * frcp(l);
#pragma unroll
      for (int dh = 0; dh < 2; ++dh)
#pragma unroll
          for (int r = 0; r < 16; ++r) acc[dh][r] += o[dh][r] * sc; }
    { const int wt0 = (qt >= 8) ? qt - 8 : 0;
      flash_pass(lds, Ybg + C_KW, EINP, Ybg + C_VW, EINP, wt0, qt - wt0 + 1, qr, t - 512, t, ~0ull, 64 * qt + 63 - 512, 64 * qt, o, l);
      const float sc = g_w * frcp(l);
#pragma unroll
      for (int dh = 0; dh < 2; ++dh)
#pragma unroll
          for (int r = 0; r < 16; ++r) acc[dh][r] += o[dh][r] * sc; }
    bf16_t* orow = (bf16_t*)(ws + SC_CAT) + (size_t)(b * SEQ + t) * DM + 512 + h * 64;
#pragma unroll
    for (int dh = 0; dh < 2; ++dh)
#pragma unroll
        for (int j = 0; j < 4; ++j) { u32x2 w; w.x = cvtpk(acc[dh][4 * j], acc[dh][4 * j + 1]); w.y = cvtpk(acc[dh][4 * j + 2], acc[dh][4 * j + 3]); *(u32x2*)(orow + 32 * dh + 8 * j + 4 * hi) = w; }
    NSA_WAITV(0);
}
DEV void nsa_phase(unsigned char* lds_raw, unsigned char* ws) {
    lds_u8* lds = (lds_u8*)lds_raw;
    const int G = gridDim.x, bx = blockIdx.x;
    const int vcu = (G % 8 == 0) ? (bx % 8) * (G / 8) + bx / 8 : bx;
    for (int p = vcu; p < 512; p += G) {
        const int bg = p >> 5, s = p & 31;
        nsa_unit(lds, ws, bg >> 1, bg & 1, 63 - s);
        nsa_unit(lds, ws, bg >> 1, bg & 1, s);
    }
}
#undef NSA_WAITV
#undef NSA_BAR
}

DEV void router_mfma(const Ctx& c, const bf16_t* X, int layer) {
    const __attribute__((address_space(4))) Params& p = *c.p;
    const float* bg = gptr(p.in[26]) + layer * 4; const float* be = gptr(p.in[28]) + layer * 32;
    const bf16_t* WB = (const bf16_t*)(c.ws + WS_RWB) + (size_t)layer * 96 * DM;
    int* cnt = (int*)(c.ws + WS_CTL) + layer * 32; int* list = (int*)(c.ws + WS_LIST); float* gate = (float*)(c.ws + WS_GATE);
    int* lcnt = (int*)c.lds; int* lbase = lcnt + 32; int* asg = lcnt + 64;
    float* lgs = c.lds + 1024 + c.wave * 640;
    constexpr int rpw = NT / 256;
    if (c.tid < 32) lcnt[c.tid] = 0;
    __syncthreads();
    const int fr = c.lane & 15, kg = c.lane >> 4;
    static_assert(rpw == NWAVES * 16, "one 16-row block per wave");
    {
        const int lrow0 = c.wave * 16;
        const int row0 = blockIdx.x * rpw + lrow0;
        const bf16_t* ap = X + (size_t)(row0 + fr) * DM + kg * 8;
        f32x4 aE0 = {0.f, 0.f, 0.f, 0.f}, aE1 = aE0, aG = aE0;
        typedef __attribute__((address_space(3))) unsigned char lds8;
        lds8* LB = (lds8*)c.lds + 32768;
        for (int half = 0; half < 2; ++half) {
            __syncthreads();
#pragma unroll 4
            for (int i = c.tid; i < 96 * 64; i += NTHREADS) { const int row = i >> 6, ch = i & 63;
                *(__attribute__((address_space(3))) u32x4*)(LB + row * 1040 + ch * 16) = *(const u32x4*)(WB + (size_t)row * DM + half * 512 + ch * 8); }
            __syncthreads();
            const lds8* bp = LB + fr * 1040 + kg * 16;
#pragma unroll 4
            for (int s = 0; s < 16; ++s) {
                const bf16x8 a = *(const bf16x8*)(ap + half * 512 + 32 * s);
#define RB(blk) (*(const __attribute__((address_space(3))) bf16x8*)(bp + (blk) * 16 * 1040 + s * 64))
                const bf16x8 b0 = RB(0), b1 = RB(1), b2 = RB(2), b3 = RB(3), b4 = RB(4), b5 = RB(5);
#undef RB
                aE0 = __builtin_amdgcn_mfma_f32_16x16x32_bf16(a, b0, aE0, 0, 0, 0); aE0 = __builtin_amdgcn_mfma_f32_16x16x32_bf16(a, b3, aE0, 0, 0, 0);
                aE1 = __builtin_amdgcn_mfma_f32_16x16x32_bf16(a, b1, aE1, 0, 0, 0); aE1 = __builtin_amdgcn_mfma_f32_16x16x32_bf16(a, b4, aE1, 0, 0, 0);
                aG = __builtin_amdgcn_mfma_f32_16x16x32_bf16(a, b2, aG, 0, 0, 0); aG = __builtin_amdgcn_mfma_f32_16x16x32_bf16(a, b5, aG, 0, 0, 0);
            }
        }
#pragma unroll
        for (int r = 0; r < 4; ++r) { float* lr = lgs + (4 * kg + r) * 40; lr[4 + fr] = aE0[r]; lr[20 + fr] = aE1[r]; if (fr < 4) lr[fr] = aG[r]; }
        LDS_WAIT();
        if (c.lane < 16) {
            const float* lr = lgs + c.lane * 40;
            float gl[4]; int gs = 0;
#pragma unroll
            for (int o = 0; o < 4; ++o) gl[o] = lr[o] + bg[o];
            float gm = gl[0];
#pragma unroll
            for (int o = 1; o < 4; ++o) if (gl[o] > gm) { gm = gl[o]; gs = o; }
            float den = 0.f;
#pragma unroll
            for (int o = 0; o < 4; ++o) den += __expf(gl[o] - gm);
            const float pgroup = frcp(den);
            int i0 = 0, i1 = -1; float v0 = -INFINITY, v1 = -INFINITY;
#pragma unroll
            for (int o = 0; o < 8; ++o) { const float e = lr[4 + gs * 8 + o] + be[gs * 8 + o];
                if (e > v0) { v1 = v0; i1 = i0; v0 = e; i0 = o; } else if (e > v1) { v1 = e; i1 = o; } }
            const float e1 = __expf(v1 - v0), g0 = pgroup * frcp(1.f + e1), g1 = g0 * e1;
            const int ex0 = gs * 8 + i0, ex1 = gs * 8 + i1;
            const int lp0 = atomicAdd(lcnt + ex0, 1), lp1 = atomicAdd(lcnt + ex1, 1);
            asg[(lrow0 + c.lane) * 2] = (ex0 << 16) | lp0; asg[(lrow0 + c.lane) * 2 + 1] = (ex1 << 16) | lp1;
            gate[(row0 + c.lane) * 2] = g0; gate[(row0 + c.lane) * 2 + 1] = g1;
        }
        LDS_WAIT();
    }
    __syncthreads();
    if (c.tid < 32) lbase[c.tid] = atomicAdd(cnt + c.tid, lcnt[c.tid]);
    __syncthreads();
    for (int i = c.tid; i < 2 * rpw; i += NTHREADS) { const int a = asg[i], ex = a >> 16, lpos = a & 0xffff; const int aid_ = (blockIdx.x * rpw) * 2 + i, slot_ = lbase[ex] + lpos; list[ex * LCAP + slot_] = aid_; ((int*)(c.ws + WS_APOS))[aid_] = (ex << 16) | slot_; }
    __syncthreads();
}

DEV void bf8_to_f32(const u32x4 w, float* o) {
#pragma unroll
    for (int j = 0; j < 4; ++j) { o[2 * j] = __uint_as_float(w[j] << 16); o[2 * j + 1] = __uint_as_float(w[j] & 0xffff0000u); }
}
DEV void moe_combine(const Ctx& c, const bf16_t* Xin, const float* g, const float* b, bf16_t* Xo, float* outf, const int* cnt) {
    const bf16_t* Y = (const bf16_t*)(c.ws + SC_Y);
    const int* apos = (const int*)(c.ws + WS_APOS); const float* gate = (const float*)(c.ws + WS_GATE);
    int pref;
    { const int nb = (c.lane < NEXP) ? (cnt[c.lane] + 255) >> 8 : 0; int incl = nb;
#pragma unroll
      for (int o = 1; o < 32; o <<= 1) { const int t = __shfl_up(incl, o); if ((c.lane & 63) >= o) incl += t; }
      pref = incl - nb; }
    float gg[16], bb[16];
#pragma unroll
    for (int hf = 0; hf < 2; ++hf)
#pragma unroll
        for (int j = 0; j < 8; ++j) { gg[hf * 8 + j] = g[hf * 512 + 8 * c.lane + j]; bb[hf * 8 + j] = b[hf * 512 + 8 * c.lane + j]; }
    for (int row0 = c.gw * 2; row0 < NT; row0 += c.ngw * 2) {
        u32x4 xr[2][2], y0r[2][2], y1r[2][2];
#pragma unroll
        for (int r = 0; r < 2; ++r)
#pragma unroll
            for (int hf = 0; hf < 2; ++hf) { const size_t row = row0 + r; const int col = hf * 512 + 8 * c.lane;
                const int a0 = apos[2 * row], a1 = apos[2 * row + 1];
                const size_t p0 = (size_t)__shfl(pref, a0 >> 16) * 256 + (a0 & 0xffff), p1 = (size_t)__shfl(pref, a1 >> 16) * 256 + (a1 & 0xffff);
                xr[r][hf] = *(const u32x4*)(Xin + row * DM + col); y0r[r][hf] = *(const u32x4*)(Y + p0 * DM + col); y1r[r][hf] = *(const u32x4*)(Y + p1 * DM + col); }
#pragma unroll
        for (int r = 0; r < 2; ++r) {
            float v[16]; float s = 0.f; const float g0 = gate[2 * (row0 + r)], g1 = gate[2 * (row0 + r) + 1];
#pragma unroll
            for (int hf = 0; hf < 2; ++hf) { float x[8], a[8], bq[8]; bf8_to_f32(xr[r][hf], x); bf8_to_f32(y0r[r][hf], a); bf8_to_f32(y1r[r][hf], bq);
#pragma unroll
                for (int j = 0; j < 8; ++j) { v[hf * 8 + j] = x[j] * DN_ALPHA + (g0 * a[j] + g1 * bq[j]); s += v[hf * 8 + j]; } }
            const float mean = wsum_dpp(s) * (1.f / DM); float s2 = 0.f;
#pragma unroll
            for (int j = 0; j < 16; ++j) { v[j] -= mean; s2 += v[j] * v[j]; }
            const float rstd = rsqrtf(wsum_dpp(s2) * (1.f / DM) + LN_EPS);
#pragma unroll
            for (int j = 0; j < 16; ++j) v[j] = v[j] * rstd * gg[j] + bb[j];
            const size_t row = row0 + r;
#pragma unroll
            for (int hf = 0; hf < 2; ++hf) { const int col = hf * 512 + 8 * c.lane;
                if (Xo) { u32x4 o; o.x = pk2(v[hf * 8], v[hf * 8 + 1]); o.y = pk2(v[hf * 8 + 2], v[hf * 8 + 3]); o.z = pk2(v[hf * 8 + 4], v[hf * 8 + 5]); o.w = pk2(v[hf * 8 + 6], v[hf * 8 + 7]); *(u32x4*)(Xo + row * DM + col) = o; }
                if (outf) { *(f32x4*)(outf + row * DM + col) = (f32x4){v[hf * 8], v[hf * 8 + 1], v[hf * 8 + 2], v[hf * 8 + 3]}; *(f32x4*)(outf + row * DM + col + 4) = (f32x4){v[hf * 8 + 4], v[hf * 8 + 5], v[hf * 8 + 6], v[hf * 8 + 7]}; }
            }
        }
    }
}

DEV void odd_conv(const Ctx& c) {
    const bf16_t* Y1 = (const bf16_t*)(c.ws + SC_Y0); bf16_t* V = (bf16_t*)(c.ws + WS_XA);
    const float* cw = gptr(c.p->in[17]);
    float w0[8], w1[8], w2[8];
    { const int col = (c.gw & 1) * 512 + 8 * c.lane;
#pragma unroll
      for (int j = 0; j < 8; ++j) { w0[j] = cw[col + j]; w1[j] = cw[DM + col + j]; w2[j] = cw[2 * DM + col + j]; } }
    for (int it = c.gw; it < (NT / 16) * 2; it += c.ngw) {
        const int half = it & 1, tok0 = (it >> 1) * 16, col = half * 512 + 8 * c.lane, t0 = tok0 & (SEQ - 1);
        float um2[8], um1[8];
        if (t0 >= 2) { bf8_to_f32(*(const u32x4*)(Y1 + (size_t)(tok0 - 2) * 2048 + 1024 + col), um2); bf8_to_f32(*(const u32x4*)(Y1 + (size_t)(tok0 - 1) * 2048 + 1024 + col), um1); }
        else {
#pragma unroll
            for (int j = 0; j < 8; ++j) { um2[j] = 0.f; um1[j] = 0.f; } }
#pragma unroll 4
        for (int i = 0; i < 16; ++i) {
            float u0[8], gb[8];
            bf8_to_f32(*(const u32x4*)(Y1 + (size_t)(tok0 + i) * 2048 + 1024 + col), u0);
            bf8_to_f32(*(const u32x4*)(Y1 + (size_t)(tok0 + i) * 2048 + col), gb);
            float y[8];
#pragma unroll
            for (int j = 0; j < 8; ++j) { y[j] = gb[j] * (w0[j] * um2[j] + w1[j] * um1[j] + w2[j] * u0[j]); um2[j] = um1[j]; um1[j] = u0[j]; }
            u32x4 o; o.x = pk2(y[0], y[1]); o.y = pk2(y[2], y[3]); o.z = pk2(y[4], y[5]); o.w = pk2(y[6], y[7]);
            *(u32x4*)(V + (size_t)(tok0 + i) * DM + col) = o;
        }
    }
}

#define XB_TMO      128
#define XB_XCNT(j)  (256  + 64 * (j))
#define XB_XSUB(j)  (1280 + 64 * (j))
#define XB_XGEN(j)  (2304 + 64 * (j))
#define XB_TOP      3328
#define XB_TOPGEN   3392
#define XCD_BAR_WORDS 3456
#define XB_SPIN_CAP (1u << 22)
DEV unsigned xb_ld(unsigned* p)              { return __hip_atomic_load(p, __ATOMIC_RELAXED, __HIP_MEMORY_SCOPE_AGENT); }
DEV unsigned xb_add(unsigned* p, unsigned v) { return __hip_atomic_fetch_add(p, v, __ATOMIC_RELAXED, __HIP_MEMORY_SCOPE_AGENT); }
DEV unsigned xb_xcc_id() { return (unsigned)__builtin_amdgcn_s_getreg((3 << 11) | 20) & 0xFu; }
#define XB_SPIN(cond, bar) do { unsigned _sp = 0; while (cond) { __builtin_amdgcn_s_sleep(1); \
    if ((++_sp & 255u) == 0u) { if (xb_ld(&(bar)[XB_TMO])) break; if (_sp > XB_SPIN_CAP) { atomicAdd(&(bar)[XB_TMO], 1u); break; } } } } while (0)
struct XcdBarrier { unsigned* bar; unsigned x; volatile __attribute__((address_space(3))) unsigned* st; };
DEV XcdBarrier xcd_barrier_post(unsigned* bar, volatile __attribute__((address_space(3))) unsigned* st) {
    XcdBarrier b; b.bar = bar; b.x = xb_xcc_id(); b.st = st;
    if (threadIdx.x == 0) (void)xb_add(&bar[XB_XCNT(b.x)], 1u);
    return b;
}
DEV void xcd_barrier_complete(unsigned* bar, unsigned x, unsigned& nloc, unsigned& nx) {
    const unsigned G = gridDim.x * gridDim.y * gridDim.z;
    unsigned sum, cnt, mine, sp = 0u;
    for (;;) {
        sum = 0u; cnt = 0u; mine = 0u;
#pragma unroll
        for (unsigned j = 0; j < 16; ++j) { const unsigned cc = xb_ld(&bar[XB_XCNT(j)]); sum += cc; cnt += (cc > 0u) ? 1u : 0u; mine = (j == x) ? cc : mine; }
        if (sum == G) break;
        __builtin_amdgcn_s_sleep(1);
        if ((++sp & 255u) == 0u) { if (xb_ld(&bar[XB_TMO])) break; if (sp > XB_SPIN_CAP) { atomicAdd(&bar[XB_TMO], 1u); break; } }
    }
    nloc = mine > 0u ? mine : 1u; nx = cnt > 0u ? cnt : 1u;
}
DEV void xcd_barrier(const XcdBarrier& b) {
    asm volatile("s_waitcnt vmcnt(0)" ::: "memory");
    __syncthreads();
    if (threadIdx.x == 0) {
        unsigned* bar = b.bar;
        __builtin_amdgcn_s_waitcnt(0);
        unsigned nloc = b.st[0], nx = b.st[1];
        if (nloc == 0u) { xcd_barrier_complete(bar, b.x, nloc, nx); b.st[0] = nloc; b.st[1] = nx; }
        const unsigned old = xb_add(&bar[XB_XSUB(b.x)], 1u);
        const unsigned gen = old / nloc;
        if (old + 1u == (gen + 1u) * nloc) {
            __builtin_amdgcn_fence(__ATOMIC_RELEASE, "agent");
            asm volatile("s_waitcnt vmcnt(0)" ::: "memory");
            const unsigned og = xb_add(&bar[XB_TOP], 1u);
            const unsigned tg = og / nx;
            if (og + 1u == (tg + 1u) * nx) xb_add(&bar[XB_TOPGEN], 1u);
            else XB_SPIN(xb_ld(&bar[XB_TOPGEN]) == tg, bar);
            __builtin_amdgcn_fence(__ATOMIC_ACQUIRE, "agent");
            xb_add(&bar[XB_XGEN(b.x)], 1u);
            asm volatile("s_waitcnt vmcnt(0)" ::: "memory");
        } else {
            XB_SPIN(xb_ld(&bar[XB_XGEN(b.x)]) == gen, bar);
            __builtin_amdgcn_fence(__ATOMIC_ACQUIRE, "agent");
            asm volatile("s_waitcnt vmcnt(0)" ::: "memory");
        }
    }
    __syncthreads();
}

DEV void xa_fold_unit(PG8_LAS unsigned char* ldsp, unsigned char* ws, int layer, int fid) {
    const int id = fid & 127, b = id >> 4, h = (id >> 2) & 3, q = id & 3; const bool isn = fid >= 128;
    const bf16_t* MK = (const bf16_t*)(ws + WS_MEMK) + (size_t)(b * MEML) * DM + h * 256;
    const bf16_t* MV = (const bf16_t*)(ws + WS_MEMV) + (size_t)(b * MEML) * DM + h * 256;
    const bf16_t* WQP = (const bf16_t*)(ws + WS_WQ) + (size_t)layer * DM * DM + (size_t)(q * 256) * DM + h * 256;
    const bf16_t* WOT = (const bf16_t*)(ws + WS_WO) + (size_t)layer * DM * DM + (size_t)(q * 256) * DM + h * 256;
    bf16_t* MT = (bf16_t*)(ws + WS_MT) + ((size_t)b * DM + h * 256) * DM + q * 256;
    bf16_t* NT_ = (bf16_t*)(ws + WS_NT) + ((size_t)b * DM + q * 256) * DM + h * 256;
    pg8::OneUnitTask T{256, isn ? WOT : MK, isn ? MV : WQP, isn ? NT_ : MT, DM, 0, 0, 0, 0, fid < 256, isn ? 1.f : 0.0625f * 1.4426950408889634f};
    pg8::gemm_phase(ldsp, T);
}
DEV void xa_fold(PG8_LAS unsigned char* ldsp, unsigned char* ws, int layer) { xa_fold_unit(ldsp, ws, layer, blockIdx.x); }
DEV void xa_fold_in_moe_tail(PG8_LAS unsigned char* ldsp, unsigned char* ws, int layer, int nblk) {
    const int G = gridDim.x, bx = blockIdx.x, vc = (G % 8 == 0) ? (bx % 8) * (G / 8) + bx / 8 : bx;
    const int full = 4 * nblk - (4 * nblk / G) * G;
    const int nidle = G - full;
    if (vc < full) return;
    for (int fid = vc - full; fid < 256; fid += nidle) xa_fold_unit(ldsp, ws, layer, fid);
}

constexpr int N_PHASES = 25;
constexpr int LDS_BYTES = 147456;
__global__ void __launch_bounds__(NTHREADS, 2) fwd_kernel(Params prm) {
    extern __shared__ __attribute__((aligned(16))) unsigned char lds_raw[];
    volatile __attribute__((address_space(3))) unsigned* bst = (volatile __attribute__((address_space(3))) unsigned*)((__attribute__((address_space(3))) unsigned char*)lds_raw + LDS_BYTES - 16);
    if (threadIdx.x < 4) bst[threadIdx.x] = 0u;
    __syncthreads();
    XcdBarrier xbar; xbar.bar = (unsigned*)(prm.ws + WS_CTL) + 1024; xbar.x = 0; xbar.st = bst;
    if (prm.ph_hi - prm.ph_lo > 1) xbar = xcd_barrier_post((unsigned*)(prm.ws + WS_CTL) + 1024, bst);
    KParams kp = (KParams)__builtin_amdgcn_kernarg_segment_ptr();
    Ctx c; c.p = kp; c.ws = prm.ws; c.lds = (float*)lds_raw;
    c.tid = threadIdx.x; c.lane = c.tid & 63; c.wave = __builtin_amdgcn_readfirstlane(c.tid >> 6);
    c.gw = blockIdx.x * NWAVES + c.wave; c.ngw = gridDim.x * NWAVES;
    typedef __attribute__((address_space(1))) unsigned char gu8_t;
    gu8_t* wsg = (gu8_t*)prm.ws;
    unsigned char* ws = (unsigned char*)wsg;
    PG8_LAS unsigned char* ldsp = (PG8_LAS unsigned char*)lds_raw;
#define XA ((bf16_t*)(ws + WS_XA))
#define XB ((bf16_t*)(ws + WS_XB))
#define Z ((float*)(ws + SC_Z))
    typedef const float* cfptr_t;
    const __attribute__((address_space(4))) cfptr_t* in = (const __attribute__((address_space(4))) cfptr_t*)kp;
#ifndef ONLY_PHASE
#define ONLY_PHASE -1
#endif
#ifndef TPROBE_PHASE
#define TPROBE_PHASE -1
#endif
#define PHASE(k, ...) if (TPROBE_PHASE == (k)) tp0_ = __builtin_amdgcn_s_memrealtime(); if ((ONLY_PHASE < 0 || ONLY_PHASE == (k)) && prm.ph_lo <= (k) && (k) < prm.ph_hi) { asm volatile("" : "+s"(wsg)); ws = (unsigned char*)wsg; asm volatile("" : "+s"(kp)); c.p = kp; c.ws = ws; c.tid = threadIdx.x; asm volatile("" : "+v"(c.tid)); c.lane = c.tid & 63; in = (const __attribute__((address_space(4))) cfptr_t*)kp; { __VA_ARGS__; } if ((k) + 1 < prm.ph_hi) { xcd_barrier(xbar); } if (TPROBE_PHASE == (k)) tp1_ = __builtin_amdgcn_s_memrealtime(); }
    unsigned long long tp0_ = 0, tp1_ = 0;
    if (prm.ph_hi > N_PHASES) { __threadfence(); cg::this_grid().sync(); }
    PHASE(0, phase_prep<0>(c))
    PHASE(1, { const bool early = ((blockIdx.x >> 3) & 1) == 0; if (early) { phase_prep<1>(c); __syncthreads(); }
        pg8::PlainTask<pg8::EpiInproj, true> T{XA, DM, (const bf16_t*)(ws + WS_W_IN), DM, DM, {}, {(bf16_t*)(ws + SC_Y0)}}; T.S.init(NT, EINP, gridDim.x, blockIdx.x); pg8::gemm_phase(ldsp, T);
        if (!early) { __syncthreads(); c.tid = threadIdx.x; asm volatile("" : "+v"(c.tid)); c.lane = c.tid & 63; phase_prep<1>(c); } })
    PHASE(2, {
        const int bx = blockIdx.x;
        if (bx < 64) { pg8::CmpTask T{DM, ws, bx}; pg8::gemm_phase(ldsp, T); }
        else if (bx < 128) {
            const int j = (bx - 64) & 31; const bool isv = bx >= 96;
            pg8::OneUnitTask T{DM, (const bf16_t*)(ws + WS_MEMB), (const bf16_t*)(ws + (isv ? WS_WV : WS_WK)), (bf16_t*)(ws + (isv ? WS_MEMV : WS_MEMK)), DM,
                               (size_t)256 * DM, (size_t)256, j >> 2, j & 3, true, 1.f};
            pg8::gemm_phase(ldsp, T); }
        } conv_phase(c))
    PHASE(3, cmp_finish(c); __syncthreads(); xa_fold(ldsp, ws, 0))
#ifdef NSA_CHECK
    PHASE(4, nsa::nsa_phase(lds_raw, ws); nsa_naive(c);
        __syncthreads(); if (c.tid == 0) __threadfence(); )
#else
    PHASE(4, { const bool early = ((blockIdx.x >> 3) & 1) == 0;
        if (early) { moe_weights_m<0>(c, 0, c.gw, c.ngw); __syncthreads(); }
        nsa::nsa_phase(lds_raw, ws);
        if (!early) { __syncthreads(); moe_weights_m<0>(c, 0, c.gw, c.ngw); } })
#endif
#ifdef NSA_CHECK
    if (prm.ph_lo <= 5 && 5 < prm.ph_hi) {
        const bf16_t* A_ = (const bf16_t*)(ws + SC_CAT); const bf16_t* B_ = (const bf16_t*)(ws + WS_XB); float d2 = 0.f, a2 = 0.f;
        for (size_t i = (size_t)c.gw * 64 + c.lane; i < (size_t)NT * 512; i += (size_t)c.ngw * 64) { const size_t r = i >> 9, cc = 512 + (i & 511); const float a = bf2f(A_[r * DM + cc]), b = bf2f(B_[r * DM + cc]); d2 += (a - b) * (a - b); a2 += b * b; }
        d2 = wsum(d2); a2 = wsum(a2);
        if (c.lane == 0) { atomicAdd((float*)(ws + WS_CTL) + 60000, d2); atomicAdd((float*)(ws + WS_CTL) + 60001, a2); }
        xcd_barrier(xbar);
    }
#endif
    PHASE(5, { for (int half = 0; half < 2; ++half) { pg8::LnTask<false> T{DM, (const bf16_t*)(ws + SC_CAT), DM, (const bf16_t*)(ws + WS_W_OUT), XA, gptr(in[19]), gptr(in[20]), XB, half * 16384, {(unsigned long long*)(ws + WS_XBUF), (unsigned*)(ws + WS_CTL) + 8192 + 0 * 8192}, {}, 0}; T.S.init(16384, DM, gridDim.x, blockIdx.x); pg8::gemm_phase<pg8::LnTask<false>, true>(ldsp, T); } })
    PHASE(6, { pg8::XaSTask T{DM, XB, (const bf16_t*)(ws + WS_MT), (bf16_t*)(ws + SC_P), ldsp, {}}; T.S.init(NT, DM, gridDim.x, blockIdx.x); pg8::gemm_phase(ldsp, T); })
    PHASE(9, { for (int half = 0; half < 2; ++half) { pg8::LnTask<false> T{DM, (const bf16_t*)(ws + SC_P), DM, (const bf16_t*)(ws + WS_NT), XB, gptr(in[23]), gptr(in[24]), XA, half * 16384, {(unsigned long long*)(ws + WS_XBUF), (unsigned*)(ws + WS_CTL) + 8192 + 1 * 8192}, {}, (size_t)DM * DM}; T.S.init(16384, DM, gridDim.x, blockIdx.x); pg8::gemm_phase<pg8::LnTask<false>, true>(ldsp, T); } })
    PHASE(10, router_mfma(c, XA, 0))
    PHASE(11, { const int* cnt = (const int*)(ws + WS_CTL) + 0 * 32; PG8_LAS int* tab = (PG8_LAS int*)(ldsp + pg8::LDS_SPARE); pg8::moe_build_tab(cnt, tab);
        pg8::Moe1Task T{DM, XA, (const bf16_t*)(ws + WS_W13), (bf16_t*)(ws + SC_H), cnt, (const int*)(ws + WS_LIST), tab, (int)gridDim.x, (int)blockIdx.x}; pg8::gemm_phase(ldsp, T); const int nblk_ = tab[0]; __syncthreads(); xa_fold_in_moe_tail(ldsp, ws, 1, nblk_); __syncthreads(); moe_weights_in_tail<3>(c, 1, nblk_); })
    PHASE(12, { const int* cnt = (const int*)(ws + WS_CTL) + 0 * 32; PG8_LAS int* tab = (PG8_LAS int*)(ldsp + pg8::LDS_SPARE); pg8::moe_build_tab(cnt, tab);
        pg8::Moe2Task T{EH, (const bf16_t*)(ws + SC_H), (const bf16_t*)(ws + WS_W2), (bf16_t*)(ws + SC_Y), cnt, (const int*)(ws + WS_LIST), (const float*)(ws + WS_GATE), tab, (int)gridDim.x, (int)blockIdx.x, nullptr}; pg8::gemm_phase(ldsp, T); const int nblk_ = tab[0]; __syncthreads(); moe_weights_in_tail<1>(c, 1, nblk_); })
    PHASE(13, moe_combine(c, XA, gptr(in[32]), gptr(in[33]), XB, nullptr, (const int*)(ws + WS_CTL)); moe_weights_m<2>(c, 1, c.gw, c.ngw))
    PHASE(14, { pg8::PlainTask<pg8::EpiBf16, true> T{XB, DM, (const bf16_t*)(ws + WS_OD_IN), DM, DM, {}, {(bf16_t*)(ws + SC_Y0), 2048}}; T.S.init(NT, DM, gridDim.x, blockIdx.x); pg8::gemm_phase(ldsp, T); }
        { pg8::PlainTask<pg8::EpiOdIn, true> T{XB, DM, (const bf16_t*)(ws + WS_OD_IN) + (size_t)DM * DM, DM, DM, {}, {(bf16_t*)(ws + SC_Y0)}}; T.S.init(NT, 2 * DM, gridDim.x, blockIdx.x); pg8::gemm_phase(ldsp, T); })
    PHASE(15, odd_conv(c))
    PHASE(16, { for (int half = 0; half < 2; ++half) { pg8::LnTask<false> T{DM, XA, DM, (const bf16_t*)(ws + WS_OD_OUT), XB, gptr(in[19]) + DM, gptr(in[20]) + DM, XA, half * 16384, {(unsigned long long*)(ws + WS_XBUF), (unsigned*)(ws + WS_CTL) + 8192 + 2 * 8192}, {}, 0}; T.S.init(16384, DM, gridDim.x, blockIdx.x); pg8::gemm_phase<pg8::LnTask<false>, true>(ldsp, T); } })
    PHASE(17, { pg8::XaSTask T{DM, XA, (const bf16_t*)(ws + WS_MT), (bf16_t*)(ws + SC_P), ldsp, {}}; T.S.init(NT, DM, gridDim.x, blockIdx.x); pg8::gemm_phase(ldsp, T); })
    PHASE(20, { for (int half = 0; half < 2; ++half) { pg8::LnTask<false> T{DM, (const bf16_t*)(ws + SC_P), DM, (const bf16_t*)(ws + WS_NT), XA, gptr(in[23]) + DM, gptr(in[24]) + DM, XB, half * 16384, {(unsigned long long*)(ws + WS_XBUF), (unsigned*)(ws + WS_CTL) + 8192 + 3 * 8192}, {}, (size_t)DM * DM}; T.S.init(16384, DM, gridDim.x, blockIdx.x); pg8::gemm_phase<pg8::LnTask<false>, true>(ldsp, T); } })
    PHASE(21, router_mfma(c, XB, 1))
    PHASE(22, { const int* cnt = (const int*)(ws + WS_CTL) + 1 * 32; PG8_LAS int* tab = (PG8_LAS int*)(ldsp + pg8::LDS_SPARE); pg8::moe_build_tab(cnt, tab);
        pg8::Moe1Task T{DM, XB, (const bf16_t*)(ws + WS_W13), (bf16_t*)(ws + SC_H), cnt, (const int*)(ws + WS_LIST), tab, (int)gridDim.x, (int)blockIdx.x}; pg8::gemm_phase(ldsp, T); })
    PHASE(23, { const int* cnt = (const int*)(ws + WS_CTL) + 1 * 32; PG8_LAS int* tab = (PG8_LAS int*)(ldsp + pg8::LDS_SPARE); pg8::moe_build_tab(cnt, tab);
        pg8::Moe2Task T{EH, (const bf16_t*)(ws + SC_H), (const bf16_t*)(ws + WS_PK), (bf16_t*)(ws + SC_Y), cnt, (const int*)(ws + WS_LIST), (const float*)(ws + WS_GATE), tab, (int)gridDim.x, (int)blockIdx.x, (const bf16_t*)(ws + WS_W2B)}; pg8::gemm_phase(ldsp, T); })
    PHASE(24, moe_combine(c, XB, gptr(in[32]) + DM, gptr(in[33]) + DM, nullptr, (float*)(__attribute__((address_space(1))) float*)prm.out, (const int*)(ws + WS_CTL) + 32))
#ifdef NSA_CHECK
    {
        xcd_barrier(xbar);
        const float d2 = ((const float*)(ws + WS_CTL))[60000], a2 = ((const float*)(ws + WS_CTL))[60001];
        const float f = 1.f + 10.f * sqrtf(d2 / a2);
        for (size_t i = (size_t)c.gw * 64 + c.lane; i < (size_t)NT * DM; i += (size_t)c.ngw * 64) (float*)(__attribute__((address_space(1))) float*)prm.out[i] *= f;
    }
#endif
    if (TPROBE_PHASE >= 0) { const unsigned long long t_end = __builtin_amdgcn_s_memrealtime() + 4ull * (tp1_ - tp0_); while (__builtin_amdgcn_s_memrealtime() < t_end) __builtin_amdgcn_s_sleep(8); }
}

extern "C" void kernel_launch(void* const* d_in, const int* in_sizes, int n_in, void* d_out, int out_size, void* d_ws, size_t ws_size, hipStream_t stream) {
    static int grid = 0;
    if (grid == 0) {
        if (n_in != 34 || ws_size < WS_END) { fprintf(stderr, "kernel_launch: unexpected n_in %d or ws_size %zu\n", n_in, ws_size); grid = -1; return; }
        int dev = 0, cus = 0, per_cu = 0;
        (void)hipGetDevice(&dev);
        (void)hipDeviceGetAttribute(&cus, hipDeviceAttributeMultiprocessorCount, dev);
        (void)hipFuncSetAttribute((const void*)fwd_kernel, hipFuncAttributeMaxDynamicSharedMemorySize, LDS_BYTES);
        (void)hipOccupancyMaxActiveBlocksPerMultiprocessor(&per_cu, (const void*)fwd_kernel, NTHREADS, LDS_BYTES);
        if (per_cu < 1) { fprintf(stderr, "kernel_launch: occupancy query says %d blocks/CU\n", per_cu); per_cu = 1; }
        grid = cus * per_cu;
        if (grid != 256) { fprintf(stderr, "kernel_launch: this kernel is built for a 256-workgroup resident grid (256 CUs x 1), got %d\n", grid); grid = -1; return; }
    }
    if (grid < 0) return;
    (void)hipMemsetAsync(d_ws, 0, 262144, stream);
    Params prm{};
    for (int i = 0; i < 34; ++i) prm.in[i] = (const float*)d_in[i];
    prm.out = (float*)d_out; prm.ws = (unsigned char*)d_ws;
#if N_LAUNCH_MODE == 1
    for (int ph = 0; ph < N_PHASES; ++ph) {
        prm.ph_lo = ph; prm.ph_hi = ph + 1;
        hipLaunchKernelGGL(fwd_kernel, dim3(grid), dim3(NTHREADS), LDS_BYTES, stream, prm);
    }
#else
    prm.ph_lo = 0; prm.ph_hi = N_PHASES;
    void* args[] = {&prm};
    hipError_t e = hipLaunchCooperativeKernel((const void*)fwd_kernel, dim3(grid), dim3(NTHREADS), args, LDS_BYTES, stream);
    if (e != hipSuccess) fprintf(stderr, "cooperative launch failed: %s (grid %d)\n", hipGetErrorString(e), grid);
#endif
}
```

```cpp
#include <hip/hip_runtime.h>
#include <hip/hip_cooperative_groups.h>
#include <cstdint>
#include <cstdio>
namespace cg = cooperative_groups;

#ifndef N_LAUNCH_MODE
#define N_LAUNCH_MODE 0
#endif

typedef unsigned short bf16_t;
typedef short bf16x8 __attribute__((ext_vector_type(8)));
typedef float f32x4 __attribute__((ext_vector_type(4)));
typedef unsigned u32x4 __attribute__((ext_vector_type(4)));
typedef unsigned u32x2 __attribute__((ext_vector_type(2)));
#define DEV __device__ __forceinline__

constexpr int NB = 8, SEQ = 4096, DM = 1024, NT = NB * SEQ;
constexpr int MEML = 256, NMEM = NB * MEML;
constexpr int EIN = 2328, EINP = 2560;
constexpr int C_AV = 0, C_AG = 512, C_Q = 1024, C_KC = 1536, C_VC = 1664, C_KS = 1792, C_VS = 1920, C_KW = 2048, C_VW = 2176, C_GL = 2304;
constexpr int NCMP = 255;
constexpr int NEXP = 32, EH = 512, LCAP = 32768;
constexpr float DN_ALPHA = 1.41421356237f;
constexpr float LN_EPS = 1e-5f;
constexpr int NWAVES = 8, NTHREADS = 512;

constexpr size_t MiB = 1u << 20;
constexpr size_t WS_CTL = 0;
constexpr size_t WS_CMPB = 1 * MiB;
constexpr size_t WS_CMPP = 1 * MiB + 393216;
constexpr size_t WS_MSEL = 1 * MiB + 65536;
constexpr size_t WS_RWB = 1 * MiB + 524288;
constexpr size_t WS_KCMP = 2 * MiB;
constexpr size_t WS_VCMP = 3 * MiB;
constexpr size_t WS_PK = 4 * MiB;
constexpr size_t WS_PV = 12 * MiB;
constexpr size_t WS_LIST = 20 * MiB;
constexpr size_t WS_GATE = 24 * MiB;
constexpr size_t WS_APOS = 24 * MiB + 262144;
constexpr size_t WS_MEMB = 25 * MiB;
constexpr size_t WS_MEMK = 29 * MiB;
constexpr size_t WS_MEMV = 33 * MiB;
constexpr size_t WS_XBUF = 37 * MiB;
constexpr size_t WS_W_IN = 40 * MiB;
constexpr size_t WS_W_OUT = 45 * MiB;
constexpr size_t WS_OD_IN = 47 * MiB;
constexpr size_t WS_OD_OUT = 53 * MiB;
constexpr size_t WS_WQ = 55 * MiB;
constexpr size_t WS_WO = 59 * MiB;
constexpr size_t WS_WK = 63 * MiB;
constexpr size_t WS_WV = 65 * MiB;
constexpr size_t WS_CW1 = 67 * MiB;
constexpr size_t WS_W13 = 72 * MiB;
constexpr size_t WS_W2 = 136 * MiB;
constexpr size_t WS_XA = 168 * MiB;
constexpr size_t WS_XB = 232 * MiB;
constexpr size_t WS_SCR = 296 * MiB;
constexpr size_t WS_MT = 520 * MiB;
constexpr size_t WS_NT = 536 * MiB;
constexpr size_t WS_W2B = 552 * MiB;
constexpr size_t WS_END = 568 * MiB;
constexpr size_t SC_Y0 = WS_SCR;
constexpr size_t SC_CAT = WS_SCR + 160 * MiB;
constexpr size_t SC_Z = WS_SCR;
constexpr size_t SC_Q = WS_SCR;
constexpr size_t SC_P = WS_SCR + 64 * MiB;
constexpr size_t SC_CTX = WS_SCR + 128 * MiB;
constexpr size_t SC_H = WS_SCR;
constexpr size_t SC_Y = WS_SCR + 80 * MiB;

DEV float bf2f(bf16_t b) { return __uint_as_float(((unsigned)b) << 16); }
DEV unsigned f2bf(float f) { unsigned u = __float_as_uint(f); return (u + 0x7fffu + ((u >> 16) & 1u)) >> 16; }
DEV unsigned pk2(float lo, float hi) { typedef float f2_t __attribute__((ext_vector_type(2))); typedef __bf16 b2_t __attribute__((ext_vector_type(2))); f2_t v = {lo, hi}; b2_t b = __builtin_convertvector(v, b2_t); return __builtin_bit_cast(unsigned, b); }
DEV float wsum(float v) {
#pragma unroll
    for (int o = 1; o < 64; o <<= 1) v += __shfl_xor(v, o);
    return v;
}
DEV float wsum_dpp(float v) {
#define DPP_ADD(ctrl, rmask) v += __builtin_bit_cast(float, __builtin_amdgcn_update_dpp(0, __builtin_bit_cast(int, v), ctrl, rmask, 0xF, false))
    DPP_ADD(0xB1, 0xF);
    DPP_ADD(0x4E, 0xF);
    DPP_ADD(0x141, 0xF);
    DPP_ADD(0x140, 0xF);
    DPP_ADD(0x142, 0xA);
    DPP_ADD(0x143, 0xC);
#undef DPP_ADD
    return __builtin_bit_cast(float, __builtin_amdgcn_readlane(__builtin_bit_cast(int, v), 63));
}
DEV float gsum16(float v) { v += __shfl_xor(v, 1); v += __shfl_xor(v, 2); v += __shfl_xor(v, 4); v += __shfl_xor(v, 8); return v; }
DEV float frcp(float x) { return __builtin_amdgcn_rcpf(x); }
DEV float sigmoidf_(float x) { return frcp(1.f + __expf(-x)); }
DEV float siluf_(float x) { return x * frcp(1.f + __expf(-x)); }
DEV float gelu_tanh(float x) { const float u = 0.7978845608028654f * (x + 0.044715f * x * x * x); return 0.5f * x * (1.f + tanhf(u)); }
#define LDS_WAIT() asm volatile("s_waitcnt lgkmcnt(0)" ::: "memory")
DEV void ld4bf(const bf16_t* p, float* o) { const u32x2 w = *(const u32x2*)p; o[0] = __uint_as_float(w.x << 16); o[1] = __uint_as_float(w.x & 0xffff0000u); o[2] = __uint_as_float(w.y << 16); o[3] = __uint_as_float(w.y & 0xffff0000u); }
DEV void st4bf(bf16_t* p, float a, float b, float c, float d) { u32x2 w; w.x = pk2(a, b); w.y = pk2(c, d); *(u32x2*)p = w; }

DEV const float* gptr(const float* x) { return (const float*)(const __attribute__((address_space(1))) float*)x; }
struct Params {
    const float* in[34];
    float* out;
    unsigned char* ws;
    int ph_lo, ph_hi;
};
typedef const __attribute__((address_space(4))) Params* KParams;
struct Ctx {
    KParams p;
    unsigned char* ws;
    float* lds;
    int tid, lane, wave, gw, ngw;
};

namespace pg8 {
#define PG8_LAS __attribute__((address_space(3)))
constexpr int BM = 256, BK = 64, HALF = 128, HTB = HALF * BK * 2, STAGE_BYTES = 8 * HTB, NXCD = 8, WGM = 8;
DEV int lds_byte(int r, int c) { const int st = (r >> 4) * 2 + (c >> 5), rr = r & 15, cc = c & 31, ob = rr * 64 + cc * 2; return st * 1024 + (ob ^ (((ob >> 9) & 1) << 5)); }
DEV void stage_rc(int b, int& R, int& C) { const int st = b / 1024, sb = b % 1024, swz = sb ^ (((sb >> 9) & 1) << 5); R = (st >> 1) * 16 + swz / 64; C = (st & 1) * 32 + (swz % 64) / 2; }
DEV int perm32(int rho) { const int n = rho >> 4, i = rho & 15; return 8 * (i >> 2) + 4 * n + (i & 3); }
struct Unit { int pm, pn, aux; };
struct StaticOrder {
    int nM, nN, nwg, G, c;
    DEV void init(int M, int N, int G_, int c_) { nM = M / BM; nN = N / BM; nwg = nM * nN; G = G_; c = c_; }
    DEV bool next(int i, Unit& u) const {
        const long L = (long)i * G + c; if (L >= nwg) return false;
        int wgid = (int)L; { const int q = nwg / NXCD, r = nwg % NXCD, xcd = wgid % NXCD, off = wgid / NXCD; wgid = (xcd < r ? xcd * (q + 1) : r * (q + 1) + (xcd - r) * q) + off; }
        const int nig = WGM * nN, gid = wgid / nig, fm = gid * WGM, gsz = (nM - fm) < WGM ? (nM - fm) : WGM;
        u.pm = fm + ((wgid % nig) % gsz); u.pn = (wgid % nig) / gsz; u.aux = 0; return true;
    }
};
DEV unsigned cvt_pk_bf16(float lo, float hi) { unsigned r; asm volatile("v_cvt_pk_bf16_f32 %0, %1, %2" : "=v"(r) : "v"(lo), "v"(hi)); return r; }
typedef f32x4 Acc[2][2][4][2];

template <class T, class = void> struct has_res_lds { static constexpr bool value = false; };
template <class T> struct has_res_lds<T, decltype((void)T::RES_LDS)> { static constexpr bool value = T::RES_LDS; };
template <class Task, bool DRAINED = false>
DEV void gemm_phase(PG8_LAS unsigned char* lds, const Task& T) {
    int tid = threadIdx.x; asm volatile("" : "+v"(tid));
    const int wid = __builtin_amdgcn_readfirstlane(tid >> 6), lane = tid & 63, wr = wid >> 2, wc = wid & 3, fr = lane & 15, fq = lane >> 4;
    const int nt = T.K / BK;
    int R[2], C[2]; unsigned voffB[2];
#pragma unroll
    for (int i = 0; i < 2; ++i) { stage_rc(tid * 16 + i * 8192, R[i], C[i]); const int Rb = Task::PERM ? ((R[i] & ~31) + perm32(R[i] & 31)) : R[i]; voffB[i] = (unsigned)(Rb * T.ldb() + C[i]) * 2u; }
    const size_t kstepB = (size_t)(BK * 2);
    const size_t hstepB = (size_t)HALF * T.ldb() * 2;
    const unsigned ldsw = (unsigned)wid * 1024u;
    const int aoff = lds_byte(wr * 64 + fr, fq * 8), boff = lds_byte(wc * 32 + fr, fq * 8);
#define PG8_SA(b, h) (((b) * 2 + (h)) * HTB)
#define PG8_SB(b, h) ((4 + (b) * 2 + (h)) * HTB)
#define PG8_STAGE(bufoff, gbase, voff) do { _Pragma("unroll") for (int _i = 0; _i < 2; ++_i) \
        __builtin_amdgcn_global_load_lds((const unsigned*)((const char*)(gbase) + (voff)[_i]), (PG8_LAS unsigned*)(lds + (bufoff) + ldsw + _i * 8192), 16, 0, 0); } while (0)
#define PG8_LDA(dst, b, h) do { _Pragma("unroll") for (int m = 0; m < 4; ++m) _Pragma("unroll") for (int k = 0; k < 2; ++k) dst[m][k] = *(const PG8_LAS bf16x8*)(lds + PG8_SA(b, h) + aoff + m * 2048 + k * 1024); } while (0)
#define PG8_LDB(dst, b, h) do { _Pragma("unroll") for (int n = 0; n < 2; ++n) _Pragma("unroll") for (int k = 0; k < 2; ++k) dst[n][k] = *(const PG8_LAS bf16x8*)(lds + PG8_SB(b, h) + boff + n * 2048 + k * 1024); } while (0)
#define PG8_MMA(ai, bj, At, Bt) do { __builtin_amdgcn_s_setprio(1); _Pragma("unroll") for (int m = 0; m < 4; ++m) _Pragma("unroll") for (int n = 0; n < 2; ++n) _Pragma("unroll") for (int k = 0; k < 2; ++k) \
        acc[ai][bj][m][n] = __builtin_amdgcn_mfma_f32_16x16x32_bf16(Bt[n][k], At[m][k], acc[ai][bj][m][n], 0, 0, 0); __builtin_amdgcn_s_setprio(0); } while (0)
#define PG8_WAIT_V(n) asm volatile("s_waitcnt vmcnt(" #n ")" ::: "memory")
#define PG8_WAIT_L(n) asm volatile("s_waitcnt lgkmcnt(" #n ")" ::: "memory")
#define PG8_BAR __builtin_amdgcn_s_barrier()
#define PG8_SCHED __builtin_amdgcn_sched_barrier(0)
    Unit cur, nxt; int ui = 0;
    if (!T.next(0, cur)) return;
    Acc acc;
#pragma unroll
    for (int a = 0; a < 2; ++a)
#pragma unroll
        for (int b = 0; b < 2; ++b)
#pragma unroll
            for (int m = 0; m < 4; ++m)
#pragma unroll
                for (int n = 0; n < 2; ++n) acc[a][b][m][n] = (f32x4){0.f, 0.f, 0.f, 0.f};
    bf16x8 At[4][2], B0[2][2], B1[2][2];
    unsigned va[2][2], na[2][2];
    T.a_offs(cur, R, C, va);
    const char* cA = T.a_base(cur); const char* cB = T.b_base(cur); size_t kstepA = T.a_kstep(cur), kstepN = kstepA;
    PG8_STAGE(PG8_SB(0, 0), cB, voffB); PG8_STAGE(PG8_SB(0, 1), cB + hstepB, voffB); PG8_STAGE(PG8_SA(0, 0), cA, va[0]); PG8_STAGE(PG8_SA(0, 1), cA, va[1]);
    if (wr == 1) PG8_BAR;
    PG8_WAIT_V(2); PG8_BAR;
    PG8_STAGE(PG8_SB(1, 0), cB + kstepB, voffB); PG8_STAGE(PG8_SA(1, 0), cA + kstepA, va[0]); PG8_STAGE(PG8_SB(1, 1), cB + hstepB + kstepB, voffB);
    PG8_WAIT_V(6); PG8_BAR;
    for (;;) {
        const bool has_next = T.next(ui + 1, nxt);
        const char* nA = cA; const char* nB = cB;
#pragma unroll
        for (int h = 0; h < 2; ++h)
#pragma unroll
            for (int i = 0; i < 2; ++i) na[h][i] = va[h][i];
        kstepN = kstepA;
        if (has_next) { nA = T.a_base(nxt); nB = T.b_base(nxt); T.a_offs(nxt, R, C, na); kstepN = T.a_kstep(nxt); }
        else if constexpr (has_res_lds<Task>::value) { const unsigned long long rb = (unsigned long long)T.res_base(cur);
            nA = (const char*)(((unsigned long long)(unsigned)__builtin_amdgcn_readfirstlane((int)(rb >> 32)) << 32) | (unsigned)__builtin_amdgcn_readfirstlane((int)rb)); nB = nA + 256; kstepN = 128; }
        for (int t = 0; t < nt; t += 2) {
            const bool last = (t == nt - 2);
            const char* a1 = cA + (size_t)(t + 1) * kstepA;
            const char* nAl = nA; const char* nBl = nB;
            if constexpr (has_res_lds<Task>::value) { asm volatile("" : "+s"(nAl), "+s"(nBl)); }
            const char* a2 = last ? nAl : cA + (size_t)(t + 2) * kstepA; const char* b2 = last ? nBl : cB + (size_t)(t + 2) * kstepB;
            const char* a3 = a2 + (last ? kstepN : kstepA); const char* b3 = b2 + kstepB;
            unsigned w2[2][2];
#pragma unroll
            for (int h = 0; h < 2; ++h)
#pragma unroll
                for (int i = 0; i < 2; ++i) w2[h][i] = last ? na[h][i] : va[h][i];
            PG8_LDB(B0, 0, 0); PG8_LDB(B1, 0, 1); PG8_SCHED; PG8_LDA(At, 0, 0); PG8_STAGE(PG8_SA(1, 1), a1, va[1]);
            PG8_WAIT_V(8); PG8_WAIT_L(0); PG8_BAR; PG8_MMA(0, 0, At, B0); PG8_MMA(0, 1, At, B1); PG8_BAR; PG8_SCHED;
            PG8_LDA(At, 0, 1); PG8_STAGE(PG8_SB(0, 0), b2, voffB); PG8_STAGE(PG8_SB(0, 1), b2 + hstepB, voffB); PG8_STAGE(PG8_SA(0, 0), a2, w2[0]);
            PG8_WAIT_V(8); PG8_WAIT_L(0); PG8_BAR; PG8_MMA(1, 0, At, B0); PG8_MMA(1, 1, At, B1); PG8_BAR; PG8_SCHED;
            PG8_LDB(B0, 1, 0); PG8_LDB(B1, 1, 1); PG8_SCHED; PG8_LDA(At, 1, 0); PG8_STAGE(PG8_SA(0, 1), a2, w2[1]);
            PG8_WAIT_V(8); PG8_WAIT_L(0); PG8_BAR; PG8_MMA(0, 0, At, B0); PG8_MMA(0, 1, At, B1); PG8_BAR; PG8_SCHED;
            PG8_LDA(At, 1, 1); PG8_STAGE(PG8_SB(1, 0), b3, voffB); PG8_STAGE(PG8_SB(1, 1), b3 + hstepB, voffB); PG8_STAGE(PG8_SA(1, 0), a3, w2[0]);
            PG8_WAIT_V(8); PG8_WAIT_L(0); PG8_BAR; PG8_MMA(1, 0, At, B0); PG8_MMA(1, 1, At, B1); PG8_BAR; PG8_SCHED;
        }
        if (wr == 0) PG8_BAR;
        if constexpr (has_res_lds<Task>::value) { if (!has_next) PG8_STAGE(PG8_SA(1, 1), nA + kstepN, na[1]); }
        if (!DRAINED || has_next) T.epi(acc, cur, wr, wc, fr, fq);
        if (!has_next) break;
#pragma unroll
        for (int a = 0; a < 2; ++a)
#pragma unroll
            for (int b = 0; b < 2; ++b)
#pragma unroll
                for (int m = 0; m < 4; ++m)
#pragma unroll
                    for (int n = 0; n < 2; ++n) acc[a][b][m][n] = (f32x4){0.f, 0.f, 0.f, 0.f};
        cur = nxt; cA = nA; cB = nB; kstepA = kstepN; ++ui;
#pragma unroll
        for (int h = 0; h < 2; ++h)
#pragma unroll
            for (int i = 0; i < 2; ++i) va[h][i] = na[h][i];
        if (wr == 1) PG8_BAR;
    }
    PG8_WAIT_V(0);
    PG8_BAR;
    if constexpr (DRAINED) T.epi_drained(acc, cur, wr, wc, fr, fq, lds, wid, lane);
#undef PG8_SA
#undef PG8_SB
#undef PG8_STAGE
#undef PG8_LDA
#undef PG8_LDB
#undef PG8_MMA
#undef PG8_WAIT_V
#undef PG8_WAIT_L
#undef PG8_BAR
#undef PG8_SCHED
}

DEV u32x4 lane_tr(u32x4 w, int src4) { w.x = (unsigned)__builtin_amdgcn_ds_bpermute(src4, (int)w.x); w.y = (unsigned)__builtin_amdgcn_ds_bpermute(src4, (int)w.y);
    w.z = (unsigned)__builtin_amdgcn_ds_bpermute(src4, (int)w.z); w.w = (unsigned)__builtin_amdgcn_ds_bpermute(src4, (int)w.w); return w; }
DEV void store_tile_bf16(const Acc& acc, bf16_t* base, int ldc, int wr, int wc, int fr, int fq) {
    const int ln = fq * 16 + fr, src4 = (((ln & 3) << 4) | (ln >> 2)) << 2;
#pragma unroll
    for (int ai = 0; ai < 2; ++ai)
#pragma unroll
        for (int m = 0; m < 4; ++m) { bf16_t* rowp = base + (size_t)(ai * HALF + wr * 64 + m * 16 + (ln >> 2)) * ldc + wc * 32 + 8 * (ln & 3);
#pragma unroll
            for (int bj = 0; bj < 2; ++bj) { const f32x4 v0 = acc[ai][bj][m][0], v1 = acc[ai][bj][m][1];
                u32x4 w; w.x = cvt_pk_bf16(v0[0], v0[1]); w.y = cvt_pk_bf16(v0[2], v0[3]); w.z = cvt_pk_bf16(v1[0], v1[1]); w.w = cvt_pk_bf16(v1[2], v1[3]);
                w.x = (unsigned)__builtin_amdgcn_ds_bpermute(src4, (int)w.x); w.y = (unsigned)__builtin_amdgcn_ds_bpermute(src4, (int)w.y);
                w.z = (unsigned)__builtin_amdgcn_ds_bpermute(src4, (int)w.z); w.w = (unsigned)__builtin_amdgcn_ds_bpermute(src4, (int)w.w);
                *(u32x4*)(rowp + bj * HALF) = w; } }
}
template <class Epi, bool PERM_>
struct PlainTask {
    static constexpr bool PERM = PERM_;
    const bf16_t* A; int lda; const bf16_t* Bt; int ldb_; int K; StaticOrder S; Epi E;
    DEV bool next(int i, Unit& u) const { return S.next(i, u); }
    DEV const char* a_base(const Unit& u) const { return (const char*)(A + (size_t)u.pm * BM * lda); }
    DEV void a_offs(const Unit&, const int (&R)[2], const int (&C)[2], unsigned (&v)[2][2]) const {
#pragma unroll
        for (int h = 0; h < 2; ++h)
#pragma unroll
            for (int i = 0; i < 2; ++i) v[h][i] = (unsigned)((h * HALF + R[i]) * lda + C[i]) * 2u;
    }
    DEV size_t a_kstep(const Unit&) const { return (size_t)(BK * 2); }
    DEV const char* b_base(const Unit& u) const { return (const char*)(Bt + (size_t)u.pn * BM * ldb_); }
    DEV int ldb() const { return ldb_; }
    DEV void epi(Acc& acc, const Unit& u, int wr, int wc, int fr, int fq) const { E(acc, u, wr, wc, fr, fq); }
};
struct EpiBf16 {
    bf16_t* Cc; int ldc;
    DEV void operator()(Acc& acc, const Unit& u, int wr, int wc, int fr, int fq) const { store_tile_bf16(acc, Cc + (size_t)u.pm * BM * ldc + u.pn * BM, ldc, wr, wc, fr, fq); }
};
struct EpiInproj {
    bf16_t* Cc;
    DEV void operator()(Acc& acc, const Unit& u, int wr, int wc, int fr, int fq) const {
        if (u.pn == 4 || u.pn == 5) {
#pragma unroll
            for (int a = 0; a < 2; ++a)
#pragma unroll
                for (int b = 0; b < 2; ++b)
#pragma unroll
                    for (int m = 0; m < 4; ++m)
#pragma unroll
                        for (int n = 0; n < 2; ++n) acc[a][b][m][n] = acc[a][b][m][n] * (0.125f * 1.4426950408889634f);
        }
        const int ln = fq * 16 + fr, src4 = (((ln & 3) << 4) | (ln >> 2)) << 2;
        if (u.pn < 4) {
#pragma unroll
            for (int ai = 0; ai < 2; ++ai)
#pragma unroll
                for (int m = 0; m < 4; ++m) { bf16_t* rowp = Cc + (size_t)(u.pm * BM + ai * HALF + wr * 64 + m * 16 + (ln >> 2)) * EINP + u.pn * HALF + wc * 32 + 8 * (ln & 3);
                    f32x4 h0, h1;
#pragma unroll
                    for (int j = 0; j < 4; ++j) { h0[j] = acc[ai][0][m][0][j] * frcp(1.f + __expf(-acc[ai][1][m][0][j])); h1[j] = acc[ai][0][m][1][j] * frcp(1.f + __expf(-acc[ai][1][m][1][j])); }
                    u32x4 w; w.x = cvt_pk_bf16(h0[0], h0[1]); w.y = cvt_pk_bf16(h0[2], h0[3]); w.z = cvt_pk_bf16(h1[0], h1[1]); w.w = cvt_pk_bf16(h1[2], h1[3]);
                    *(u32x4*)rowp = lane_tr(w, src4); }
            return;
        }
        if (u.pn == 9 && wc != 0) return;
        store_tile_bf16(acc, Cc + (size_t)u.pm * BM * EINP + u.pn * BM, EINP, wr, wc, fr, fq); }
};
struct EpiOdIn {
    bf16_t* Cc;
    DEV void operator()(Acc& acc, const Unit& u, int wr, int wc, int fr, int fq) const {
        const int ln = fq * 16 + fr, src4 = (((ln & 3) << 4) | (ln >> 2)) << 2;
#pragma unroll
        for (int ai = 0; ai < 2; ++ai)
#pragma unroll
            for (int m = 0; m < 4; ++m) { bf16_t* rowp = Cc + (size_t)(u.pm * BM + ai * HALF + wr * 64 + m * 16 + (ln >> 2)) * 2048 + 1024 + u.pn * HALF + wc * 32 + 8 * (ln & 3);
                const f32x4 h0 = acc[ai][0][m][0] * acc[ai][1][m][0], h1 = acc[ai][0][m][1] * acc[ai][1][m][1];
                u32x4 w; w.x = cvt_pk_bf16(h0[0], h0[1]); w.y = cvt_pk_bf16(h0[2], h0[3]); w.z = cvt_pk_bf16(h1[0], h1[1]); w.w = cvt_pk_bf16(h1[2], h1[3]);
                *(u32x4*)rowp = lane_tr(w, src4); }
    }
};
struct EpiBf16S {
    bf16_t* Cc; int ldc; float scale;
    DEV void operator()(Acc& acc, const Unit& u, int wr, int wc, int fr, int fq) const {
#pragma unroll
        for (int a = 0; a < 2; ++a)
#pragma unroll
            for (int b = 0; b < 2; ++b)
#pragma unroll
                for (int m = 0; m < 4; ++m)
#pragma unroll
                    for (int n = 0; n < 2; ++n) acc[a][b][m][n] = acc[a][b][m][n] * scale;
        store_tile_bf16(acc, Cc + (size_t)u.pm * BM * ldc + u.pn * BM, ldc, wr, wc, fr, fq); }
};
}

namespace pg8 {
constexpr int LDS_SPARE = STAGE_BYTES;
DEV void store_tile_f32_perm(const Acc& acc, float* base, int ldc, int wr, int wc, int fr, int fq) {
#pragma unroll
    for (int ai = 0; ai < 2; ++ai)
#pragma unroll
        for (int m = 0; m < 4; ++m) { float* rowp = base + (size_t)(ai * HALF + wr * 64 + m * 16 + fr) * ldc + wc * 32 + 8 * fq;
#pragma unroll
            for (int bj = 0; bj < 2; ++bj) { *(f32x4*)(rowp + bj * HALF) = acc[ai][bj][m][0]; *(f32x4*)(rowp + bj * HALF + 4) = acc[ai][bj][m][1]; } }
}
struct CmpTask {
    static constexpr bool PERM = true;
    int K; unsigned char* ws; int id;
    DEV bool next(int i, Unit& u) const { if (i > 0 || id >= 64) return false; u.aux = id >> 5; u.pm = (id >> 1) & 15; u.pn = id & 1; return true; }
    DEV const char* a_base(const Unit& u) const { return (const char*)(ws + SC_Y0) + (u.aux ? C_VC : C_KC) * 2; }
    DEV void a_offs(const Unit& u, const int (&R)[2], const int (&C)[2], unsigned (&v)[2][2]) const {
#pragma unroll
        for (int h = 0; h < 2; ++h)
#pragma unroll
            for (int i = 0; i < 2; ++i) { const int m = u.pm * BM + h * HALF + R[i], g = m & 1, bj = m >> 1; v[h][i] = (unsigned)(((size_t)bj * 16 * EINP + g * 64 + C[i]) * 2); } }
    DEV size_t a_kstep(const Unit&) const { return (size_t)EINP * 2; }
    DEV const char* b_base(const Unit& u) const { return (const char*)(ws + WS_CW1) + ((size_t)u.aux * 512 + (size_t)u.pn * BM) * DM * 2; }
    DEV int ldb() const { return DM; }
    DEV void epi(Acc& acc, const Unit& u, int wr, int wc, int fr, int fq) const { store_tile_f32_perm(acc, (float*)(ws + (u.aux ? WS_PV : WS_PK)) + (size_t)u.pm * BM * 512 + u.pn * BM, 512, wr, wc, fr, fq); }
};
struct OneUnitTask {
    static constexpr bool PERM = true;
    int K; const bf16_t* A; const bf16_t* Bt; bf16_t* Cc; int ldc; size_t cm, cn; int pm, pn; bool on; float scale;
    DEV bool next(int i, Unit& u) const { if (i > 0 || !on) return false; u.pm = pm; u.pn = pn; u.aux = 0; return true; }
    DEV const char* a_base(const Unit& u) const { return (const char*)(A + (size_t)u.pm * BM * DM); }
    DEV void a_offs(const Unit&, const int (&R)[2], const int (&C)[2], unsigned (&v)[2][2]) const {
#pragma unroll
        for (int h = 0; h < 2; ++h)
#pragma unroll
            for (int i = 0; i < 2; ++i) v[h][i] = (unsigned)((h * HALF + R[i]) * DM + C[i]) * 2u; }
    DEV size_t a_kstep(const Unit&) const { return (size_t)(BK * 2); }
    DEV const char* b_base(const Unit& u) const { return (const char*)(Bt + (size_t)u.pn * BM * DM); }
    DEV int ldb() const { return DM; }
    DEV void epi(Acc& acc, const Unit& u, int wr, int wc, int fr, int fq) const {
        if (scale != 1.f) {
#pragma unroll
            for (int a = 0; a < 2; ++a)
#pragma unroll
                for (int b = 0; b < 2; ++b)
#pragma unroll
                    for (int m = 0; m < 4; ++m)
#pragma unroll
                        for (int n = 0; n < 2; ++n) acc[a][b][m][n] = acc[a][b][m][n] * scale; }
        store_tile_bf16(acc, Cc + (size_t)u.pm * cm + (size_t)u.pn * cn, ldc, wr, wc, fr, fq); }
};
struct XaSTask {
    static constexpr bool PERM = true;
    int K; const bf16_t* Q; const bf16_t* MK; bf16_t* P; PG8_LAS unsigned char* lds; StaticOrder S;
    DEV bool next(int i, Unit& u) const { return S.next(i, u); }
    DEV const char* a_base(const Unit& u) const { return (const char*)(Q + (size_t)u.pm * BM * DM); }
    DEV void a_offs(const Unit&, const int (&R)[2], const int (&C)[2], unsigned (&v)[2][2]) const {
#pragma unroll
        for (int h = 0; h < 2; ++h)
#pragma unroll
            for (int i = 0; i < 2; ++i) v[h][i] = (unsigned)((h * HALF + R[i]) * DM + C[i]) * 2u; }
    DEV size_t a_kstep(const Unit&) const { return (size_t)(BK * 2); }
    DEV const char* b_base(const Unit& u) const { return (const char*)(MK + ((size_t)(u.pm >> 4) * DM + (size_t)u.pn * 256) * DM); }
    DEV int ldb() const { return DM; }
    DEV void epi(Acc& acc, const Unit& u, int wr, int wc, int fr, int fq) const {
        PG8_LAS float* smax = (PG8_LAS float*)(lds + LDS_SPARE); PG8_LAS float* ssum = smax + 1024;
#pragma unroll
        for (int ai = 0; ai < 2; ++ai)
#pragma unroll
            for (int m = 0; m < 4; ++m) { float v = -INFINITY;
#pragma unroll
                for (int bj = 0; bj < 2; ++bj)
#pragma unroll
                    for (int n = 0; n < 2; ++n) { const f32x4 x = acc[ai][bj][m][n]; v = fmaxf(v, fmaxf(fmaxf(x[0], x[1]), fmaxf(x[2], x[3]))); }
                v = fmaxf(v, __shfl_xor(v, 16)); v = fmaxf(v, __shfl_xor(v, 32));
                if (fq == 0) smax[(ai * HALF + wr * 64 + m * 16 + fr) * 4 + wc] = v; }
        asm volatile("s_waitcnt lgkmcnt(0)" ::: "memory"); __builtin_amdgcn_s_barrier(); asm volatile("" ::: "memory");
#pragma unroll
        for (int ai = 0; ai < 2; ++ai)
#pragma unroll
            for (int m = 0; m < 4; ++m) { const int row = ai * HALF + wr * 64 + m * 16 + fr;
                const f32x4 t = *(const PG8_LAS f32x4*)(smax + row * 4); const float M = fmaxf(fmaxf(t[0], t[1]), fmaxf(t[2], t[3])); float s = 0.f;
#pragma unroll
                for (int bj = 0; bj < 2; ++bj)
#pragma unroll
                    for (int n = 0; n < 2; ++n) { f32x4 x = acc[ai][bj][m][n];
#pragma unroll
                        for (int j = 0; j < 4; ++j) { x[j] = __builtin_amdgcn_exp2f(x[j] - M); s += x[j]; }
                        acc[ai][bj][m][n] = x; }
                s += __shfl_xor(s, 16); s += __shfl_xor(s, 32);
                if (fq == 0) ssum[row * 4 + wc] = s; }
        asm volatile("s_waitcnt lgkmcnt(0)" ::: "memory"); __builtin_amdgcn_s_barrier(); asm volatile("" ::: "memory");
#pragma unroll
        for (int ai = 0; ai < 2; ++ai)
#pragma unroll
            for (int m = 0; m < 4; ++m) { const int row = ai * HALF + wr * 64 + m * 16 + fr;
                const f32x4 t = *(const PG8_LAS f32x4*)(ssum + row * 4); const float inv = frcp((t[0] + t[1]) + (t[2] + t[3]));
#pragma unroll
                for (int bj = 0; bj < 2; ++bj)
#pragma unroll
                    for (int n = 0; n < 2; ++n) acc[ai][bj][m][n] = acc[ai][bj][m][n] * inv; }
        store_tile_bf16(acc, P + (size_t)u.pm * BM * DM + u.pn * 256, DM, wr, wc, fr, fq);
        asm volatile("s_waitcnt lgkmcnt(0)" ::: "memory"); __builtin_amdgcn_s_barrier(); asm volatile("" ::: "memory");
    }
};
DEV void moe_build_tab(const int* cnt, PG8_LAS int* tab) {
    if (threadIdx.x == 0) { int nb = 0; for (int e = 0; e < NEXP; ++e) { const int k = (cnt[e] + 255) >> 8; for (int j = 0; j < k; ++j) tab[1 + nb + j] = (e << 16) | j; nb += k; } tab[0] = nb; }
    asm volatile("s_waitcnt lgkmcnt(0)" ::: "memory"); __syncthreads();
}
struct Moe1Task {
    static constexpr bool PERM = true;
    int K; const bf16_t* X; const bf16_t* W13; bf16_t* H; const int* cnt; const int* list; const PG8_LAS int* tab; int G, c;
    DEV bool next(int i, Unit& u) const { const int vc = (G % 8 == 0) ? (c % 8) * (G / 8) + c / 8 : c;
        const int id = i * G + vc, rb = id >> 2; if (rb >= tab[0]) return false; u.pm = rb; u.pn = id & 3; u.aux = tab[1 + rb]; return true; }
    DEV const char* a_base(const Unit&) const { return (const char*)X; }
    DEV void a_offs(const Unit& u, const int (&R)[2], const int (&C)[2], unsigned (&v)[2][2]) const {
        const int e = u.aux >> 16, lb = u.aux & 0xffff, ce = cnt[e];
#pragma unroll
        for (int h = 0; h < 2; ++h)
#pragma unroll
            for (int i = 0; i < 2; ++i) { const int r = lb * BM + h * HALF + R[i]; const int tok = (r < ce) ? (list[e * LCAP + r] >> 1) : 0; v[h][i] = (unsigned)(tok * DM + C[i]) * 2u; } }
    DEV size_t a_kstep(const Unit&) const { return (size_t)(BK * 2); }
    DEV const char* b_base(const Unit& u) const { return (const char*)(W13 + ((size_t)(u.aux >> 16) * DM + (size_t)u.pn * BM) * DM); }
    DEV int ldb() const { return DM; }
    DEV void epi(Acc& acc, const Unit& u, int wr, int wc, int fr, int fq) const {
        const int ln = fq * 16 + fr, src4 = (((ln & 3) << 4) | (ln >> 2)) << 2;
#pragma unroll
        for (int ai = 0; ai < 2; ++ai)
#pragma unroll
            for (int m = 0; m < 4; ++m) { bf16_t* rowp = H + (size_t)(u.pm * BM + ai * HALF + wr * 64 + m * 16 + (ln >> 2)) * EH + u.pn * HALF + wc * 32 + 8 * (ln & 3);
                f32x4 h0, h1;
#pragma unroll
                for (int j = 0; j < 4; ++j) { const float a = acc[ai][0][m][0][j], b = acc[ai][0][m][1][j]; h0[j] = a * frcp(1.f + __expf(-a)) * acc[ai][1][m][0][j]; h1[j] = b * frcp(1.f + __expf(-b)) * acc[ai][1][m][1][j]; }
                u32x4 w; w.x = cvt_pk_bf16(h0[0], h0[1]); w.y = cvt_pk_bf16(h0[2], h0[3]); w.z = cvt_pk_bf16(h1[0], h1[1]); w.w = cvt_pk_bf16(h1[2], h1[3]);
                *(u32x4*)rowp = lane_tr(w, src4); }
    }
};
struct Moe2Task {
    static constexpr bool PERM = true;
    int K; const bf16_t* H; const bf16_t* W2; bf16_t* Y; const int* cnt; const int* list; const float* gate; const PG8_LAS int* tab; int G, c; const bf16_t* W2b;
    DEV bool next(int i, Unit& u) const { const int vc = (G % 8 == 0) ? (c % 8) * (G / 8) + c / 8 : c;
        const int id = i * G + vc, rb = id >> 2; if (rb >= tab[0]) return false; u.pm = rb; u.pn = id & 3; u.aux = tab[1 + rb]; return true; }
    DEV const char* a_base(const Unit& u) const { return (const char*)(H + (size_t)u.pm * BM * EH); }
    DEV void a_offs(const Unit&, const int (&R)[2], const int (&C)[2], unsigned (&v)[2][2]) const {
#pragma unroll
        for (int h = 0; h < 2; ++h)
#pragma unroll
            for (int i = 0; i < 2; ++i) v[h][i] = (unsigned)((h * HALF + R[i]) * EH + C[i]) * 2u; }
    DEV size_t a_kstep(const Unit&) const { return (size_t)(BK * 2); }
    DEV const char* b_base(const Unit& u) const { const int e = u.aux >> 16; const bf16_t* w = (W2b != nullptr && e >= 16) ? W2b + (size_t)(e - 16) * DM * EH : W2 + (size_t)e * DM * EH; return (const char*)(w + (size_t)u.pn * BM * EH); }
    DEV int ldb() const { return EH; }
    DEV void epi(Acc& acc, const Unit& u, int wr, int wc, int fr, int fq) const { store_tile_bf16(acc, Y + (size_t)u.pm * BM * DM + u.pn * BM, DM, wr, wc, fr, fq); }
};
}

namespace pg8 {
struct PanelStats {
    unsigned long long* xbuf;
    unsigned* cnt;
    DEV void run(const Acc& v, int panel, int pn, int wr, int wc, int fr, int fq, PG8_LAS unsigned char* lds, int wid, int lane) const {
        typedef float f32x2v __attribute__((ext_vector_type(2)));
        PG8_LAS f32x2v* P = (PG8_LAS f32x2v*)lds;
        PG8_LAS f32x2v* S = (PG8_LAS f32x2v*)(lds + 8192);
#pragma unroll
        for (int ai = 0; ai < 2; ++ai)
#pragma unroll
            for (int m = 0; m < 4; ++m) {
                float s = 0.f;
#pragma unroll
                for (int bj = 0; bj < 2; ++bj)
#pragma unroll
                    for (int n = 0; n < 2; ++n) { const f32x4 x = v[ai][bj][m][n]; s += (x[0] + x[1]) + (x[2] + x[3]); }
                s += __shfl_xor(s, 16); s += __shfl_xor(s, 32);
                const float mw = s * (1.0f / 64.0f); float q = 0.f;
#pragma unroll
                for (int bj = 0; bj < 2; ++bj)
#pragma unroll
                    for (int n = 0; n < 2; ++n) { const f32x4 d = v[ai][bj][m][n] - mw; q += (d[0] * d[0] + d[1] * d[1]) + (d[2] * d[2] + d[3] * d[3]); }
                q += __shfl_xor(q, 16); q += __shfl_xor(q, 32);
                if (fq == 0) P[(ai * HALF + wr * 64 + m * 16 + fr) * 4 + wc] = (f32x2v){mw, q};
            }
        asm volatile("s_waitcnt lgkmcnt(0)" ::: "memory"); __builtin_amdgcn_s_barrier(); asm volatile("" ::: "memory");
        const int row = wid * 32 + (lane & 31);
        if (lane < 32) {
            const f32x2v a = P[row * 4 + 0], b = P[row * 4 + 1], c = P[row * 4 + 2], d = P[row * 4 + 3];
            const float mt = (a.x + b.x + c.x + d.x) * 0.25f;
            const float da = a.x - mt, db = b.x - mt, dc = c.x - mt, dd = d.x - mt;
            const float m2 = (a.y + b.y) + (c.y + d.y) + 64.0f * ((da * da + db * db) + (dc * dc + dd * dd));
            unsigned long long* slot = xbuf + ((size_t)(panel * BM + row) * 4 + pn);
            __hip_atomic_store(slot, ((unsigned long long)__float_as_uint(m2) << 32) | __float_as_uint(mt), __ATOMIC_RELAXED, __HIP_MEMORY_SCOPE_AGENT);
        }
        asm volatile("s_waitcnt vmcnt(0)" ::: "memory");
        if (lane == 0) __hip_atomic_fetch_add(cnt + 64 * panel, 1u, __ATOMIC_RELAXED, __HIP_MEMORY_SCOPE_AGENT);
        if (wid == 0) {
            unsigned sp = 0;
            while ((unsigned)__builtin_amdgcn_readfirstlane(__hip_atomic_load(cnt + 64 * panel, __ATOMIC_RELAXED, __HIP_MEMORY_SCOPE_AGENT)) < 32u) { __builtin_amdgcn_s_sleep(1); if (++sp > (1u << 22)) break; }
        }
        asm volatile("s_waitcnt vmcnt(0) lgkmcnt(0)" ::: "memory"); __builtin_amdgcn_s_barrier(); asm volatile("" ::: "memory");
        if (lane < 32) {
            const unsigned long long* slot = xbuf + (size_t)(panel * BM + row) * 4; float mt[4], m2[4]; float ms = 0.f;
#pragma unroll
            for (int t = 0; t < 4; ++t) { const unsigned long long w = __hip_atomic_load(slot + t, __ATOMIC_RELAXED, __HIP_MEMORY_SCOPE_AGENT); mt[t] = __uint_as_float((unsigned)w); m2[t] = __uint_as_float((unsigned)(w >> 32)); ms += mt[t]; }
            const float mean = ms * 0.25f; float q = 0.f;
#pragma unroll
            for (int t = 0; t < 4; ++t) { const float dm = mt[t] - mean; q += m2[t] + 256.0f * dm * dm; }
            S[row] = (f32x2v){mean, rsqrtf(q * (1.0f / 1024.0f) + LN_EPS)};
        }
        asm volatile("s_waitcnt lgkmcnt(0)" ::: "memory"); __builtin_amdgcn_s_barrier(); asm volatile("" ::: "memory");
    }
};
template <bool RES_F32>
struct LnTask {
    static constexpr bool PERM = true;
    int K; const bf16_t* A; int lda; const bf16_t* Bt; const void* res; const float* g; const float* b; bf16_t* X; int row0; PanelStats st; StaticOrder S; size_t bstride;
    DEV bool next(int i, Unit& u) const { return i == 0 && S.next(0, u); }
    DEV const char* a_base(const Unit& u) const { return (const char*)(A + (size_t)(row0 + u.pm * BM) * lda); }
    DEV void a_offs(const Unit&, const int (&R)[2], const int (&C)[2], unsigned (&v)[2][2]) const {
#pragma unroll
        for (int h = 0; h < 2; ++h)
#pragma unroll
            for (int i = 0; i < 2; ++i) v[h][i] = (unsigned)((h * HALF + R[i]) * lda + C[i]) * 2u; }
    DEV size_t a_kstep(const Unit&) const { return (size_t)(BK * 2); }
    DEV const char* b_base(const Unit& u) const { return (const char*)(Bt + (size_t)((row0 / BM + u.pm) >> 4) * bstride + (size_t)u.pn * BM * DM); }
    DEV int ldb() const { return DM; }
    DEV void epi(Acc&, const Unit&, int, int, int, int) const {}
    static constexpr bool RES_LDS = !RES_F32;
    DEV const char* res_base(const Unit& u) const { return (const char*)((const bf16_t*)res + (size_t)(row0 + u.pm * BM) * DM + (size_t)u.pn * BM); }
    DEV void epi_drained(Acc& acc, const Unit& u, int wr, int wc, int fr, int fq, PG8_LAS unsigned char* lds, int wid, int lane) const {
        typedef float f32x2v __attribute__((ext_vector_type(2)));
        const int colb = u.pn * BM + wc * 32 + 8 * fq;
#pragma unroll
        for (int ai = 0; ai < 2; ++ai)
#pragma unroll
            for (int m = 0; m < 4; ++m) { const size_t roff = (size_t)(row0 + u.pm * BM + ai * HALF + wr * 64 + m * 16 + fr) * DM + colb;
#pragma unroll
                for (int bj = 0; bj < 2; ++bj) { f32x4 r0, r1;
                    if (RES_F32) { r0 = *(const f32x4*)((const float*)res + roff + bj * HALF); r1 = *(const f32x4*)((const float*)res + roff + bj * HALF + 4); }
                    else { const int rl = wr * 64 + m * 16 + fr, x5 = (m & 1) * 16 + fr;
                        const int rq = bj ? ((rl & ~31) + 16 * ((x5 >> 2) & 1) + 4 * (x5 >> 3) + (x5 & 3)) : rl;
                        const u32x4 w = *(const PG8_LAS u32x4*)(lds + ((bj ? 4 : 0) + (wc >> 1) * 2 + ai) * HTB + lds_byte(rq, (wc & 1) * 32 + 8 * fq));
                        r0 = (f32x4){__uint_as_float(w.x << 16), __uint_as_float(w.x & 0xffff0000u), __uint_as_float(w.y << 16), __uint_as_float(w.y & 0xffff0000u)};
                        r1 = (f32x4){__uint_as_float(w.z << 16), __uint_as_float(w.z & 0xffff0000u), __uint_as_float(w.w << 16), __uint_as_float(w.w & 0xffff0000u)}; }
                    acc[ai][bj][m][0] = r0 * DN_ALPHA + acc[ai][bj][m][0]; acc[ai][bj][m][1] = r1 * DN_ALPHA + acc[ai][bj][m][1]; }
                asm volatile("" : "+v"(acc[ai][0][m][0]), "+v"(acc[ai][0][m][1]), "+v"(acc[ai][1][m][0]), "+v"(acc[ai][1][m][1]));
                asm volatile("" ::: "memory"); }
        f32x4 gb[2][4];
#pragma unroll
        for (int bj = 0; bj < 2; ++bj) { gb[bj][0] = *(const f32x4*)(g + colb + bj * HALF); gb[bj][1] = *(const f32x4*)(g + colb + bj * HALF + 4); gb[bj][2] = *(const f32x4*)(b + colb + bj * HALF); gb[bj][3] = *(const f32x4*)(b + colb + bj * HALF + 4); }
        st.run(acc, row0 / BM + u.pm, u.pn, wr, wc, fr, fq, lds + LDS_SPARE, wid, lane);
        const PG8_LAS f32x2v* Stab = (const PG8_LAS f32x2v*)(lds + LDS_SPARE + 8192);
        const int ln = fq * 16 + fr, src4 = (((ln & 3) << 4) | (ln >> 2)) << 2;
#pragma unroll
        for (int bj = 0; bj < 2; ++bj) {
            const f32x4 g0 = gb[bj][0], g1 = gb[bj][1], b0 = gb[bj][2], b1 = gb[bj][3];
#pragma unroll
            for (int ai = 0; ai < 2; ++ai)
#pragma unroll
                for (int m = 0; m < 4; ++m) { const int r = ai * HALF + wr * 64 + m * 16 + fr; const f32x2v sr = Stab[r];
                    const f32x4 y0 = (acc[ai][bj][m][0] - sr.x) * sr.y * g0 + b0, y1 = (acc[ai][bj][m][1] - sr.x) * sr.y * g1 + b1;
                    u32x4 w; w.x = cvt_pk_bf16(y0[0], y0[1]); w.y = cvt_pk_bf16(y0[2], y0[3]); w.z = cvt_pk_bf16(y1[0], y1[1]); w.w = cvt_pk_bf16(y1[2], y1[3]);
                    *(u32x4*)(X + (size_t)(row0 + u.pm * BM + r - fr + (ln >> 2)) * DM + u.pn * BM + wc * 32 + 8 * (ln & 3) + bj * HALF) = lane_tr(w, src4); }
        }
        asm volatile("s_waitcnt lgkmcnt(0)" ::: "memory"); __builtin_amdgcn_s_barrier(); asm volatile("" ::: "memory");
    }
};
}

DEV int tr_rowmap(int kind, int n) {
    if (kind == 1) return (n >= 1024) ? n : ((n < 512) ? ((n >> 7) * 256 + (n & 127)) : (((n - 512) >> 7) * 256 + 128 + (n & 127)));
    if (kind == 4) return (n < 1024) ? n : ((n < 2048) ? (1024 + ((n - 1024) >> 7) * 256 + (n & 127)) : (1024 + ((n - 2048) >> 7) * 256 + 128 + (n & 127)));
    if (kind == 2) return (n >> 7) * 256 + (n & 127);
    if (kind == 3) return (n >> 7) * 256 + 128 + (n & 127);
    return n;
}
struct TrItem { const float* W; int ldw, N; bf16_t* WT; int ldd, kind, kb, nb; bool on; };
DEV void tr_load(const TrItem& t, f32x4 (&v)[16], int lane) {
    const int k0 = 64 * t.kb, nn = 64 * t.nb + (lane & 15) * 4;
#pragma unroll
    for (int i = 0; i < 16; ++i) { const int kk = (lane >> 4) + 4 * i; v[i] = (t.on && nn < t.N) ? *(const f32x4*)(t.W + (size_t)(k0 + kk) * t.ldw + nn) : (f32x4){0.f, 0.f, 0.f, 0.f}; }
}
DEV void tr_store(const TrItem& t, const f32x4 (&v)[16], float* scr, int lane) {
    const int k0 = 64 * t.kb, n0 = 64 * t.nb;
#pragma unroll
    for (int i = 0; i < 16; ++i) { const int kk = (lane >> 4) + 4 * i; float* d = scr + kk * 65 + (lane & 15) * 4; d[0] = v[i].x; d[1] = v[i].y; d[2] = v[i].z; d[3] = v[i].w; }
    LDS_WAIT();
    const int kc = lane & 7;
#pragma unroll
    for (int i = 0; i < 8; ++i) {
        const int nl = (lane >> 3) + 8 * i, n = n0 + nl;
        const float* s = scr + (8 * kc) * 65 + nl;
        u32x4 o; o.x = pk2(s[0], s[65]); o.y = pk2(s[130], s[195]); o.z = pk2(s[260], s[325]); o.w = pk2(s[390], s[455]);
        if (t.on && n < t.N) *(u32x4*)(t.WT + (size_t)tr_rowmap(t.kind, n) * t.ldd + k0 + 8 * kc) = o;
    }
    LDS_WAIT();
}
constexpr int MOE_TR_ITEMS = NEXP * 384;
DEV TrItem moe_tr_decode(const Ctx& c, int layer, int it) {
    const float* w1 = gptr(c.p->in[29]) + (size_t)layer * NEXP * DM * EH;
    const float* w3 = gptr(c.p->in[30]) + (size_t)layer * NEXP * DM * EH;
    const float* w2 = gptr(c.p->in[31]) + (size_t)layer * NEXP * EH * DM;
    bf16_t* W13 = (bf16_t*)(c.ws + WS_W13); bf16_t* W2 = (bf16_t*)(c.ws + WS_W2);
    const int e = it / 384, r = it % 384, mat = r >> 7, sub = r & 127;
    if (mat == 0) return TrItem{w1 + (size_t)e * DM * EH, EH, EH, W13 + (size_t)e * DM * DM, DM, 2, sub >> 3, sub & 7, true};
    if (mat == 1) return TrItem{w3 + (size_t)e * DM * EH, EH, EH, W13 + (size_t)e * DM * DM, DM, 3, sub >> 3, sub & 7, true};
    if (layer == 1) W2 = (e < 16) ? (bf16_t*)(c.ws + WS_PK) : (bf16_t*)(c.ws + WS_W2B) - (size_t)16 * DM * EH;
    return TrItem{w2 + (size_t)e * EH * DM, DM, DM, W2 + (size_t)e * DM * EH, EH, 0, sub >> 4, sub & 15, true};
}
constexpr int MOE_E0 = 20, MOE_EARLY_ITEMS = MOE_E0 * 256, MOE_REST_ITEMS = (NEXP - MOE_E0) * 256, MOE_W2_ITEMS = NEXP * 128;
template <int MODE  >
DEV TrItem moe_tr_decode_m(const Ctx& c, int layer, int idx) {
    if (MODE == 0) return moe_tr_decode(c, layer, idx);
    if (MODE == 1) { const int e = idx >> 8, r = idx & 255; return moe_tr_decode(c, layer, e * 384 + r); }
    if (MODE == 2) { const int e = MOE_E0 + (idx >> 8), r = idx & 255; return moe_tr_decode(c, layer, e * 384 + r); }
    return moe_tr_decode(c, layer, (idx >> 7) * 384 + 256 + (idx & 127));
}
template <int MODE>
DEV void moe_weights_m(const Ctx& c, int layer, int worker, int nworkers) {
    constexpr int NIT = (MODE == 0) ? MOE_TR_ITEMS : (MODE == 1 ? MOE_EARLY_ITEMS : (MODE == 2 ? MOE_REST_ITEMS : MOE_W2_ITEMS));
    float* scr = c.lds + c.wave * (64 * 65);
    f32x4 va[16], vb[16];
    int it = worker;
    if (it >= NIT) return;
    TrItem cur = moe_tr_decode_m<MODE>(c, layer, it); tr_load(cur, va, c.lane);
    for (;;) {
        const int i1 = it + nworkers; const bool h1 = i1 < NIT; TrItem n1 = cur;
        if (h1) { n1 = moe_tr_decode_m<MODE>(c, layer, i1); tr_load(n1, vb, c.lane); }
        tr_store(cur, va, scr, c.lane);
        if (!h1) break;
        const int i2 = i1 + nworkers; const bool h2 = i2 < NIT;
        if (h2) { cur = moe_tr_decode_m<MODE>(c, layer, i2); tr_load(cur, va, c.lane); }
        tr_store(n1, vb, scr, c.lane);
        if (!h2) break;
        it = i2;
    }
}
template <int MODE>
DEV void moe_weights_in_tail(const Ctx& c, int layer, int nblk) {
    const int G = gridDim.x, bx = blockIdx.x, vc = (G % 8 == 0) ? (bx % 8) * (G / 8) + bx / 8 : bx;
    const int full = 4 * nblk - (4 * nblk / G) * G, nidle = G - full;
    if (vc < full) return;
    moe_weights_m<MODE>(c, layer, (vc - full) * NWAVES + c.wave, nidle * NWAVES);
}
DEV void cvt_rows(const Ctx& c, const float* src, bf16_t* dst, size_t n, int gw, int ngw) {
    const size_t nth = (size_t)ngw * 64, t0 = (size_t)gw * 64 + c.lane, nch = n / 8;
    for (size_t i = t0; i < nch; i += 4 * nth) {
        f32x4 a[4], b[4];
#pragma unroll
        for (int u = 0; u < 4; ++u) { const size_t j = i + u * nth; if (j < nch) { a[u] = *(const f32x4*)(src + j * 8); b[u] = *(const f32x4*)(src + j * 8 + 4); } }
#pragma unroll
        for (int u = 0; u < 4; ++u) { const size_t j = i + u * nth; if (j < nch) { u32x4 o; o.x = pk2(a[u].x, a[u].y); o.y = pk2(a[u].z, a[u].w); o.z = pk2(b[u].x, b[u].y); o.w = pk2(b[u].z, b[u].w); *(u32x4*)(dst + j * 8) = o; } }
    }
}
template <int PART>
DEV void phase_prep(const Ctx& c) {
    const __attribute__((address_space(4))) Params& p = *c.p; unsigned char* ws = c.ws;
    float* scr = c.lds + c.wave * (64 * 65);
    if (PART == 0 && blockIdx.x == 0 && c.tid < 64) ((int*)(ws + WS_CTL))[c.tid] = 0;
    constexpr int I_IN = 16 * 37, I_SQ = 16 * 16, I_OD = 16 * 48, I_CW = 16 * 4;
    constexpr int NA = I_IN + I_SQ + I_OD + I_SQ + 4 * I_SQ + 2 * I_SQ + 4 * I_CW;
    {
        const int bx = blockIdx.x; int g_ = 0, ng_ = 1;
        auto sub = [&](int w0, int nw) { g_ = (bx - w0) * NWAVES + c.wave; ng_ = nw * NWAVES; return bx >= w0 && bx < w0 + nw; };
        if (PART == 1 && sub(0, 64)) {
            for (int i = g_ * 64 + c.lane; i < 2 * 96 * DM; i += ng_ * 64) {
                const int l = i / (96 * DM), rr = (i / DM) % 96, k = i % DM, part = rr / 48, o = rr % 48;
                float w = 0.f;
                if (o < 32) w = gptr(p.in[27])[((size_t)l * DM + k) * 32 + o]; else if (o < 36) w = gptr(p.in[25])[((size_t)l * DM + k) * 4 + (o - 32)];
                const unsigned hi = f2bf(w); const float lo = w - __uint_as_float(hi << 16);
                ((bf16_t*)(ws + WS_RWB))[i] = (bf16_t)(part ? f2bf(lo) : hi);
            }
        }
        if (PART == 1 && sub(64, 32)) {
            for (int i = g_ * 64 + c.lane; i < 8 * 256 * 64; i += ng_ * 64) {
                const int n = (i >> 6) & 255, m = i & 63; float v = 0.f;
                if (n < NCMP) { const int ov = min(16 * n + 32, 64 * m + 64) - max(16 * n, 64 * m); v = (ov > 0) ? (float)ov * (1.f / 32.f) : 0.f; }
                ((bf16_t*)(ws + WS_MSEL))[i] = (bf16_t)f2bf(v);
            }
            for (int i = g_ * 64 + c.lane; i < 2 * 16 * 64; i += ng_ * 64) { const int kv = i >> 10, bg = (i >> 6) & 15, d = i & 63; ((bf16_t*)(ws + (kv ? WS_VCMP : WS_KCMP)))[(size_t)(bg * 256 + 255) * 64 + d] = 0; }
        }
        if (PART == 1 && sub(96, 64)) cvt_rows(c, gptr(p.in[1]), (bf16_t*)(ws + WS_MEMB), (size_t)NMEM * DM, g_, ng_);
        if (PART == 1 && sub(160, 64)) cvt_rows(c, gptr(p.in[21]), (bf16_t*)(ws + WS_WQ), (size_t)2 * DM * DM, g_, ng_);
        if (PART == 0 && sub(224, 24)) {
            bf16_t* w = (bf16_t*)(ws + WS_W_IN) + (size_t)EIN * DM; const size_t n = (size_t)(EINP - EIN) * DM / 8;
            for (size_t i = (size_t)g_ * 64 + c.lane; i < n; i += (size_t)ng_ * 64) *(u32x4*)(w + i * 8) = (u32x4){0u, 0u, 0u, 0u};
        }
        if (PART == 1 && sub(248, 8)) {
            for (int it = g_; it < 64; it += ng_) {
                const int kv = it >> 5, blk = it & 31;
                const float* pe = gptr(p.in[kv ? 12 : 9]); const float* w1 = gptr(p.in[kv ? 13 : 10]);
                f32x4 sacc = {0.f, 0.f, 0.f, 0.f};
#pragma unroll 8
                for (int r = 0; r < 64; ++r) { const int kk = blk * 64 + r; sacc = sacc + *(const f32x4*)(w1 + (size_t)kk * 256 + 4 * c.lane) * pe[kk]; }
                *(f32x4*)((float*)(ws + WS_CMPP) + (size_t)it * 256 + 4 * c.lane) = sacc;
            }
        }
    }
    auto decode = [&](int it) -> TrItem {
        int r = it;
        if (r >= NA) return moe_tr_decode(c, 0, r - NA);
        if (r < I_IN) return TrItem{gptr(p.in[4]), EIN, EIN, (bf16_t*)(ws + WS_W_IN), DM, 1, r / 37, r % 37, true}; r -= I_IN;
        if (r < I_SQ) return TrItem{gptr(p.in[15]), DM, DM, (bf16_t*)(ws + WS_W_OUT), DM, 0, r >> 4, r & 15, true}; r -= I_SQ;
        if (r < I_OD) return TrItem{gptr(p.in[16]), 3 * DM, 3 * DM, (bf16_t*)(ws + WS_OD_IN), DM, 4, r / 48, r % 48, true}; r -= I_OD;
        if (r < I_SQ) return TrItem{gptr(p.in[18]), DM, DM, (bf16_t*)(ws + WS_OD_OUT), DM, 0, r >> 4, r & 15, true}; r -= I_SQ;
        if (r < 4 * I_SQ) { const int m = r >> 8, l = m & 1, q = r & 255;
            return TrItem{gptr(p.in[22]) + (size_t)l * DM * DM, DM, DM, (bf16_t*)(ws + WS_WO) + (size_t)l * DM * DM, DM, 0, q >> 4, q & 15, m >= 2}; } r -= 4 * I_SQ;
        if (r < 2 * I_SQ) { const int m = r >> 8, q = r & 255; return TrItem{gptr(p.in[m ? 3 : 2]), DM, DM, (bf16_t*)(ws + (m ? WS_WV : WS_WK)), DM, 0, q >> 4, q & 15, true}; } r -= 2 * I_SQ;
        const int m = r >> 6, kv = m >> 1, half = m & 1, q = r & 63;
        return TrItem{gptr(p.in[kv ? 13 : 10]) + (size_t)half * 1024 * 256, 256, 256, (bf16_t*)(ws + WS_CW1) + ((size_t)kv * 512 + half * 256) * DM, DM, 0, q >> 2, q & 3, true};
    };
    {   constexpr int ILO = (PART == 0) ? 0 : I_IN, NTOT = (PART == 0) ? I_IN : NA;
        f32x4 va[16], vb[16];
        int it = ILO + c.gw;
        if (it < NTOT) {
            TrItem cur = decode(it); tr_load(cur, va, c.lane);
            for (;;) {
                const int i1 = it + c.ngw; const bool h1 = i1 < NTOT; TrItem n1 = cur;
                if (h1) { n1 = decode(i1); tr_load(n1, vb, c.lane); }
                tr_store(cur, va, scr, c.lane);
                if (!h1) break;
                const int i2 = i1 + c.ngw; const bool h2 = i2 < NTOT;
                if (h2) { cur = decode(i2); tr_load(cur, va, c.lane); }
                tr_store(n1, vb, scr, c.lane);
                if (!h2) break;
                it = i2;
            }
        }
    }
    if (PART == 0) cvt_rows(c, gptr(p.in[0]), (bf16_t*)(ws + WS_XA), (size_t)NT * DM, c.gw, c.ngw);
}

constexpr int CONV_LW = 63488;
typedef float f32x2 __attribute__((ext_vector_type(2)));
DEV void conv_stage_w(const Ctx& c) {
    __attribute__((address_space(3))) float* LW = (__attribute__((address_space(3))) float*)((__attribute__((address_space(3))) unsigned char*)c.lds + CONV_LW);
    const float* cw = gptr(c.p->in[5]);
    for (int i = c.tid; i < 37 * 512; i += NTHREADS) { const int row = i >> 9, ch = i & 511, k = row - 3;
        LW[row * 512 + ((ch & 4) ? 256 : 0) + (ch >> 3) * 4 + (ch & 3)] = (k >= 0 && k <= 30) ? cw[k * 512 + ch] : 0.f; }
}
DEV void conv_tile(const Ctx& c, int tile, const float (&bias)[8], const float (&gam)[8], const float (&bet)[8]) {
    typedef __attribute__((address_space(3))) unsigned char lds8;
    lds8* L = (lds8*)c.lds; lds8* LW = L + CONV_LW;
    const bf16_t* Y0 = (const bf16_t*)(c.ws + SC_Y0); bf16_t* CAT = (bf16_t*)(c.ws + SC_CAT);
    const int tok0 = tile * 32, t0 = tok0 & (SEQ - 1);
    __syncthreads();
    {   u32x4 v[8];
#pragma unroll
        for (int u = 0; u < 8; ++u) { const int i = c.tid + u * NTHREADS, r = i >> 6, ch = i & 63; v[u] = (u32x4){0u, 0u, 0u, 0u};
            if (i < 62 * 64 && t0 - 30 + r >= 0) v[u] = *(const u32x4*)(Y0 + (size_t)(tok0 - 30 + r) * EINP + ch * 8); }
#pragma unroll
        for (int u = 0; u < 8; ++u) { const int i = c.tid + u * NTHREADS, r = i >> 6, ch = i & 63;
            if (i < 62 * 64) *(__attribute__((address_space(3))) u32x4*)(L + r * 1024 + ch * 16) = v[u]; }
    }
    __syncthreads();
    const int ch0 = c.lane * 8, j0 = c.wave * 4;
    f32x2 acc[4][4];
#pragma unroll
    for (int j = 0; j < 4; ++j) { const f32x2 bq = {bias[2 * j], bias[2 * j + 1]};
#pragma unroll
        for (int m = 0; m < 4; ++m) acc[m][j] = bq; }
    f32x2 w[4][4];
#pragma unroll
    for (int d = 0; d < 4; ++d)
#pragma unroll
        for (int j = 0; j < 4; ++j) w[d][j] = (f32x2){0.f, 0.f};
#define CONV_STEP(s, u) do { \
        const u32x4 ra_ = *(const __attribute__((address_space(3))) u32x4*)(L + (j0 + (s)) * 1024 + c.lane * 16); \
        const f32x4 wa_ = *(const __attribute__((address_space(3))) f32x4*)(LW + ((s) + 3) * 2048 + c.lane * 16), wb_ = *(const __attribute__((address_space(3))) f32x4*)(LW + ((s) + 3) * 2048 + 1024 + c.lane * 16); \
        w[(u)][0] = (f32x2){wa_[0], wa_[1]}; w[(u)][1] = (f32x2){wa_[2], wa_[3]}; w[(u)][2] = (f32x2){wb_[0], wb_[1]}; w[(u)][3] = (f32x2){wb_[2], wb_[3]}; \
        f32x2 a_[4]; \
        _Pragma("unroll") for (int j = 0; j < 4; ++j) a_[j] = (f32x2){__uint_as_float(ra_[j] << 16), __uint_as_float(ra_[j] & 0xffff0000u)}; \
        _Pragma("unroll") for (int m = 0; m < 4; ++m) _Pragma("unroll") for (int j = 0; j < 4; ++j) acc[m][j] = __builtin_elementwise_fma(a_[j], w[((u) - m) & 3][j], acc[m][j]); } while (0)
    for (int s4 = 0; s4 < 32; s4 += 4) { CONV_STEP(s4, 0); CONV_STEP(s4 + 1, 1); CONV_STEP(s4 + 2, 2); CONV_STEP(s4 + 3, 3); }
    CONV_STEP(32, 0); CONV_STEP(33, 1);
#undef CONV_STEP
#pragma unroll
    for (int m = 0; m < 4; ++m) {
        float a8[8];
#pragma unroll
        for (int j = 0; j < 4; ++j) { a8[2 * j] = acc[m][j][0]; a8[2 * j + 1] = acc[m][j][1]; }
        float s = 0.f;
#pragma unroll
        for (int j = 0; j < 8; ++j) s += a8[j];
        const float mean = wsum_dpp(s) * (1.f / 512.f); float s2 = 0.f;
#pragma unroll
        for (int j = 0; j < 8; ++j) { a8[j] -= mean; s2 += a8[j] * a8[j]; }
        const float rstd = rsqrtf(wsum_dpp(s2) * (1.f / 512.f) + LN_EPS);
        float y[8];
#pragma unroll
        for (int j = 0; j < 8; ++j) { const float v = a8[j] * rstd * gam[j] + bet[j]; y[j] = v * frcp(1.f + __expf(-v)); }
        u32x4 o; o.x = pk2(y[0], y[1]); o.y = pk2(y[2], y[3]); o.z = pk2(y[4], y[5]); o.w = pk2(y[6], y[7]);
        *(u32x4*)(CAT + (size_t)(tok0 + j0 + m) * DM + ch0) = o;
    }
}
DEV void conv_phase(const Ctx& c) {
    conv_stage_w(c);
    const int bx = blockIdx.x;
    if (bx == gridDim.x - 1) {
        const float* part = (const float*)(c.ws + WS_CMPP); float sum = 0.f;
        for (int blk = 0; blk < 32; ++blk) sum += part[(size_t)((c.tid >> 8) * 32 + blk) * 256 + (c.tid & 255)];
        ((float*)(c.ws + WS_CMPB))[c.tid] = sum;
    }
    float bias[8], gam[8], bet[8];
#pragma unroll
    for (int j = 0; j < 8; ++j) { bias[j] = gptr(c.p->in[6])[c.lane * 8 + j]; gam[j] = gptr(c.p->in[7])[c.lane * 8 + j]; bet[j] = gptr(c.p->in[8])[c.lane * 8 + j]; }
    if (bx < 128) { for (int i = 0; i < 3; ++i) conv_tile(c, 3 * bx + i, bias, gam, bet); }
    else for (int i = 0; i < 5; ++i) conv_tile(c, 384 + (bx - 128) * 5 + i, bias, gam, bet);
    __syncthreads();
}

DEV float gelu_tanh_fast(float x) { const float u = 0.7978845608028654f * (x + 0.044715f * x * x * x); const float t = 1.f - 2.f * frcp(1.f + __expf(2.f * u)); return 0.5f * x * (1.f + t); }
DEV void cmp_finish(const Ctx& c) {
    const __attribute__((address_space(4))) Params& p = *c.p;
    const int kv = (blockIdx.x >= gridDim.x / 2) ? 1 : 0, half = gridDim.x / 2, bxl = blockIdx.x - kv * half;
    float* w2l = c.lds;
    float* hid = c.lds + 16384 + c.wave * 256;
    { const float* w2 = gptr(p.in[kv ? 14 : 11]); for (int i = c.tid; i < 4096; i += NTHREADS) *(f32x4*)(w2l + 4 * i) = *(const f32x4*)(w2 + 4 * i); }
    __syncthreads();
    const float* P = (const float*)(c.ws + (kv ? WS_PV : WS_PK));
    const float* cbias = (const float*)(c.ws + WS_CMPB) + kv * 256;
    float cb[4];
#pragma unroll
    for (int i = 0; i < 4; ++i) cb[i] = cbias[c.lane + 64 * i];
    for (int r = bxl * NWAVES + c.wave; r < NB * NCMP * 2; r += half * NWAVES) {
        const int g = r & 1, bn = r >> 1, b = bn / NCMP, n = bn % NCMP;
        const int r0 = (b * 256 + n) * 2 + g, r1 = (b * 256 + n + 1) * 2 + g;
#pragma unroll
        for (int i = 0; i < 4; ++i) { const int cc = c.lane + 64 * i; hid[cc] = gelu_tanh_fast(P[(size_t)r0 * 512 + cc] + P[(size_t)r1 * 512 + 256 + cc] + cb[i]); }
        LDS_WAIT();
        float o0 = 0.f, o1 = 0.f, o2 = 0.f, o3 = 0.f;
#pragma unroll 4
        for (int cc = 0; cc < 256; cc += 4) { const f32x4 hv = *(const f32x4*)(hid + cc);
            o0 += hv.x * w2l[(cc + 0) * 64 + c.lane]; o1 += hv.y * w2l[(cc + 1) * 64 + c.lane]; o2 += hv.z * w2l[(cc + 2) * 64 + c.lane]; o3 += hv.w * w2l[(cc + 3) * 64 + c.lane]; }
        ((bf16_t*)(c.ws + (kv ? WS_VCMP : WS_KCMP)))[(size_t)((b * 2 + g) * 256 + n) * 64 + c.lane] = (bf16_t)f2bf((o0 + o1) + (o2 + o3));
        LDS_WAIT();
    }
}

DEV void nsa_naive(const Ctx& c) {
    const bf16_t* Y0 = (const bf16_t*)(c.ws + SC_Y0); bf16_t* CAT = (bf16_t*)(c.ws + WS_XB);
    const bf16_t* KC = (const bf16_t*)(c.ws + WS_KCMP); const bf16_t* VC = (const bf16_t*)(c.ws + WS_VCMP);
    float* pc = c.lds + c.wave * 1024;
    const int hh = c.lane >> 4, dq = c.lane & 15;
    for (int it = c.gw; it < NT * 2; it += c.ngw) {
        const int g = it & 1, row = it >> 1, b = row >> 12, t = row & (SEQ - 1);
        const int h = g * 4 + hh;
        const bf16_t* yrow = Y0 + (size_t)row * EINP;
        float q[4]; ld4bf(yrow + C_Q + h * 64 + dq * 4, q);
        const int ncv = (t >= 31) ? min(NCMP, (t - 31) / 16 + 1) : 0;
        float oc[4] = {0.f, 0.f, 0.f, 0.f};
        float mx = -INFINITY;
        for (int n = 0; n < ncv; ++n) {
            float kk4[4]; ld4bf(KC + (size_t)((b * 2 + g) * 256 + n) * 64 + dq * 4, kk4); const f32x4 k4 = {kk4[0], kk4[1], kk4[2], kk4[3]};
            float s = q[0] * k4.x + q[1] * k4.y + q[2] * k4.z + q[3] * k4.w; s = gsum16(s);
            if (dq == 0) pc[hh * 256 + n] = s;
            mx = fmaxf(mx, s);
        }
        LDS_WAIT();
        float l = 0.f;
        for (int n = 0; n < ncv; ++n) l += exp2f(pc[hh * 256 + n] - mx);
        const float inv = (ncv > 0) ? 1.f / l : 0.f;
        for (int n = 0; n < ncv; ++n) {
            const float pr = exp2f(pc[hh * 256 + n] - mx) * inv;
            float vv4[4]; ld4bf(VC + (size_t)((b * 2 + g) * 256 + n) * 64 + dq * 4, vv4); const f32x4 v4 = {vv4[0], vv4[1], vv4[2], vv4[3]};
            oc[0] += pr * v4.x; oc[1] += pr * v4.y; oc[2] += pr * v4.z; oc[3] += pr * v4.w;
            LDS_WAIT();
            if (dq == 0) pc[hh * 256 + n] = pr;
        }
        LDS_WAIT();
        const int m = c.lane, cur = t >> 6;
        float imp = 0.f;
#pragma unroll
        for (int h2 = 0; h2 < 4; ++h2)
#pragma unroll
            for (int dn = -1; dn <= 3; ++dn) { const int n = 4 * m + dn; if (n >= 0 && n < ncv) imp += pc[h2 * 256 + n] * ((dn == -1 || dn == 3) ? 0.5f : 1.f); }
        const bool causal = m <= cur, forced = (m == 0) || (m == cur) || (m == cur - 1);
        const float score = causal ? (forced ? 1e4f : imp) : -1e30f;
        int rank = 0;
        for (int m2 = 0; m2 < 64; ++m2) { const float s2 = __shfl(score, m2); rank += ((s2 > score) || (s2 == score && m2 < m)) ? 1 : 0; }
        unsigned long long selmask = __ballot(causal && rank < 16);
        LDS_WAIT();
        float ms = -INFINITY, ls = 0.f, os[4] = {0.f, 0.f, 0.f, 0.f};
        while (selmask) {
            const int mb = __builtin_ctzll(selmask); selmask &= selmask - 1;
            const int jmax = min(63, t - 64 * mb);
            const bf16_t* kb = Y0 + (size_t)(b * SEQ + 64 * mb) * EINP + g * 64 + dq * 4;
            for (int j = 0; j <= jmax; ++j) {
                float k4[4], v4[4]; ld4bf(kb + (size_t)j * EINP + C_KS, k4); ld4bf(kb + (size_t)j * EINP + C_VS, v4);
                float s = q[0] * k4[0] + q[1] * k4[1] + q[2] * k4[2] + q[3] * k4[3]; s = gsum16(s);
                const float mn = fmaxf(ms, s), cf = exp2f(ms - mn), pp = exp2f(s - mn);
                ls = ls * cf + pp;
#pragma unroll
                for (int i = 0; i < 4; ++i) os[i] = os[i] * cf + pp * v4[i];
                ms = mn;
            }
        }
        float mw = -INFINITY, lw = 0.f, ow[4] = {0.f, 0.f, 0.f, 0.f};
        {
            const int k0 = max(0, t - 511);
            const bf16_t* kb = Y0 + (size_t)(b * SEQ) * EINP + g * 64 + dq * 4;
            for (int kp = k0; kp <= t; ++kp) {
                float k4[4], v4[4]; ld4bf(kb + (size_t)kp * EINP + C_KW, k4); ld4bf(kb + (size_t)kp * EINP + C_VW, v4);
                float s = q[0] * k4[0] + q[1] * k4[1] + q[2] * k4[2] + q[3] * k4[3]; s = gsum16(s);
                const float mn = fmaxf(mw, s), cf = exp2f(mw - mn), pp = exp2f(s - mn);
                lw = lw * cf + pp;
#pragma unroll
                for (int i = 0; i < 4; ++i) ow[i] = ow[i] * cf + pp * v4[i];
                mw = mn;
            }
        }
        const float gc = sigmoidf_(bf2f(yrow[C_GL + h * 3 + 0])), gs = sigmoidf_(bf2f(yrow[C_GL + h * 3 + 1])) / ls, gwn = sigmoidf_(bf2f(yrow[C_GL + h * 3 + 2])) / lw;
        st4bf(CAT + (size_t)row * DM + 512 + h * 64 + dq * 4, gc * oc[0] + gs * os[0] + gwn * ow[0], gc * oc[1] + gs * os[1] + gwn * ow[1], gc * oc[2] + gs * os[2] + gwn * ow[2], gc * oc[3] + gs * os[3] + gwn * ow[3]);
    }
}

namespace nsa {
typedef float f32x16 __attribute__((ext_vector_type(16)));
typedef short s16x4 __attribute__((ext_vector_type(4)));
typedef __attribute__((address_space(3))) unsigned char lds_u8;
constexpr int SLOT = 8192, NSLOT = 3;
constexpr int IMPP = 65;
constexpr int L_K = 0, L_V = NSLOT * SLOT, L_IMP = 2 * NSLOT * SLOT  , L_SEL = L_IMP + 4 * 64 * IMPP * 4  ;
constexpr float NEGB = -1e30f;
DEV int crow(int r, int hi) { return (r & 3) + 8 * (r >> 2) + 4 * hi; }
DEV s16x4 vtr(const lds_u8* p) { typedef short v4i16_t __attribute__((ext_vector_type(4))); return __builtin_bit_cast(s16x4, __builtin_amdgcn_ds_read_tr16_b64_v4i16((__attribute__((address_space(3))) v4i16_t*)p)); }
DEV unsigned cvtpk(float lo, float hi) { typedef float f2 __attribute__((ext_vector_type(2))); typedef __bf16 b2 __attribute__((ext_vector_type(2))); f2 v = {lo, hi}; b2 b = __builtin_convertvector(v, b2); return __builtin_bit_cast(unsigned, b); }
DEV void glds16(const void* gsrc, unsigned lds_dst) { unsigned keep;
    asm volatile("s_mov_b32 %0, m0\n\ts_mov_b32 m0, %2\n\ts_nop 0\n\tglobal_load_lds_dwordx4 %1, off\n\ts_mov_b32 m0, %0" : "=&s"(keep) : "v"(gsrc), "s"(lds_dst) : "memory"); }
#define NSA_WAITV(n) asm volatile("s_waitcnt vmcnt(" #n ")" ::: "memory")
#define NSA_BAR() do { asm volatile("s_waitcnt lgkmcnt(0)" ::: "memory"); __builtin_amdgcn_s_barrier(); asm volatile("" ::: "memory"); } while (0)

DEV void flash_pass(lds_u8* lds, const bf16_t* Kg, int pk, const bf16_t* Vg, int pv, int t0, int nt, const bf16x8 (&qr)[4],
                    int lo, int hi_b, unsigned long long rowmask, int lo_max, int hi_min, f32x16 (&o)[2], float& l_out) {
    const int tid = threadIdx.x, lane = tid & 63, r32 = lane & 31, hi = lane >> 5; const int wid = __builtin_amdgcn_readfirstlane(tid >> 6);
    o[0] = f32x16{}; o[1] = f32x16{}; float l = 0.f, mhat = 0.f;
    if (nt <= 0) { l_out = 0.f; return; }
    const bf16_t* ksrc = Kg + (size_t)(t0 * 64 + lane) * pk + wid * 8;
    const bf16_t* vsrc = Vg + (size_t)(t0 * 64 + 16 * (wid & 3) + (lane >> 2)) * pv + (wid >> 2) * 32 + (lane & 3) * 8;
    const size_t kstep = (size_t)64 * pk, vstep = (size_t)64 * pv;
    const unsigned lds0 = (unsigned)(uintptr_t)lds;
#define NSA_DMA(t, slot) do { glds16(ksrc + (size_t)(t) * kstep, (unsigned)__builtin_amdgcn_readfirstlane(lds0 + L_K + (slot) * SLOT + wid * 1024)); \
                               glds16(vsrc + (size_t)(t) * vstep, (unsigned)__builtin_amdgcn_readfirstlane(lds0 + L_V + (slot) * SLOT + wid * 1024)); } while (0)
    const lds_u8* kp0 = lds + L_K + hi * 1024 + r32 * 16;
    const lds_u8* vp0 = lds + L_V + ((lane >> 4) & 1) * 32 + (lane & 3) * 8 + (4 * hi + ((lane & 15) >> 2)) * 64;
    NSA_DMA(0, 0);
    if (nt > 1) NSA_DMA(1, 1);
    int slot = 0;
    for (int t = 0; t < nt; ++t) {
        if (t + 1 < nt) NSA_WAITV(2); else NSA_WAITV(0);
        NSA_BAR();
        if (t + 2 < nt) { const int s2 = (slot >= 1) ? slot - 1 : 2; NSA_DMA(t + 2, s2); }
        const int gt = t0 + t;
        const bool rowok = (rowmask >> gt) & 1ull;
        const float ci = rowok ? -mhat : NEGB;
        f32x16 c0, c1;
#pragma unroll
        for (int r = 0; r < 16; ++r) { c0[r] = ci; c1[r] = ci; }
        const lds_u8* kp = kp0 + slot * SLOT;
        bf16x8 kf[8];
#pragma unroll
        for (int d0 = 0; d0 < 4; ++d0) { kf[2 * d0] = *(const __attribute__((address_space(3))) bf16x8*)(kp + d0 * 2048); kf[2 * d0 + 1] = *(const __attribute__((address_space(3))) bf16x8*)(kp + d0 * 2048 + 512); }
        __builtin_amdgcn_s_setprio(1);
#pragma unroll
        for (int d0 = 0; d0 < 4; ++d0) {
            c0 = __builtin_amdgcn_mfma_f32_32x32x16_bf16(kf[2 * d0], qr[d0], c0, 0, 0, 0);
            c1 = __builtin_amdgcn_mfma_f32_32x32x16_bf16(kf[2 * d0 + 1], qr[d0], c1, 0, 0, 0);
        }
        __builtin_amdgcn_s_setprio(0);
        if ((64 * gt + 63 > hi_min) || (64 * gt <= lo_max)) {
            const int kb = 64 * gt + 4 * hi;
#pragma unroll
            for (int r = 0; r < 16; ++r) { const int kv = kb + (r & 3) + 8 * (r >> 2);
                if (!(kv > lo && kv <= hi_b)) c0[r] = NEGB;
                if (!(kv + 32 > lo && kv + 32 <= hi_b)) c1[r] = NEGB; }
        }
#define NSA_MX3(a, b, c) __builtin_fmaxf(__builtin_fmaxf((a), (b)), (c))
        float rm, rm2;
        { float a = NSA_MX3(c0[0], c0[1], c1[0]), b = NSA_MX3(c0[2], c0[3], c1[1]); a = NSA_MX3(a, c1[2], c1[3]);
#pragma unroll
          for (int r = 4; r < 16; r += 4) { a = NSA_MX3(a, c0[r], c0[r + 1]); b = NSA_MX3(b, c0[r + 2], c0[r + 3]); a = NSA_MX3(a, c1[r], c1[r + 1]); b = NSA_MX3(b, c1[r + 2], c1[r + 3]); }
          rm = __builtin_fmaxf(a, b); rm2 = rm; }
#undef NSA_MX3
        { auto rr = __builtin_amdgcn_permlane32_swap(__float_as_uint(rm), __float_as_uint(rm2), false, false); rm = __builtin_fmaxf(__uint_as_float(rr[0]), __uint_as_float(rr[1])); }
        if (__any(rm > 6.0f)) {
            const float dl = fmaxf(rm, 0.f), f = __builtin_amdgcn_exp2f(-dl);
            mhat += dl; l *= f;
#pragma unroll
            for (int r = 0; r < 16; ++r) { c0[r] -= dl; c1[r] -= dl; o[0][r] *= f; o[1][r] *= f; }
        }
        float ps = 0.f;
#pragma unroll
        for (int r = 0; r < 16; ++r) { c0[r] = __builtin_amdgcn_exp2f(c0[r]); c1[r] = __builtin_amdgcn_exp2f(c1[r]); ps += c0[r] + c1[r]; }
        l += ps;
        u32x4 pw[4];
#pragma unroll
        for (int s = 0; s < 2; ++s)
#pragma unroll
            for (int j = 0; j < 4; ++j) { pw[s][j] = cvtpk(c0[8 * s + 2 * j], c0[8 * s + 2 * j + 1]); pw[2 + s][j] = cvtpk(c1[8 * s + 2 * j], c1[8 * s + 2 * j + 1]); }
        const lds_u8* vp = vp0 + slot * SLOT;
        bf16x8 vf[8];
#pragma unroll
        for (int dh = 0; dh < 2; ++dh)
#pragma unroll
            for (int ks = 0; ks < 4; ++ks) {
                const s16x4 vl = vtr(vp + dh * 4096 + ks * 1024), vh = vtr(vp + dh * 4096 + ks * 1024 + 512);
                vf[dh * 4 + ks] = (bf16x8){vl[0], vl[1], vl[2], vl[3], vh[0], vh[1], vh[2], vh[3]};
            }
        __builtin_amdgcn_s_setprio(1);
#pragma unroll
        for (int ks = 0; ks < 4; ++ks) {
            o[0] = __builtin_amdgcn_mfma_f32_32x32x16_bf16(vf[ks], __builtin_bit_cast(bf16x8, pw[ks]), o[0], 0, 0, 0);
            o[1] = __builtin_amdgcn_mfma_f32_32x32x16_bf16(vf[4 + ks], __builtin_bit_cast(bf16x8, pw[ks]), o[1], 0, 0, 0);
        }
        __builtin_amdgcn_s_setprio(0);
        slot = (slot == 2) ? 0 : slot + 1;
    }
    NSA_BAR();
    { auto rr = __builtin_amdgcn_permlane32_swap(__float_as_uint(l), __float_as_uint(l), false, false); l = __uint_as_float(rr[0]) + __uint_as_float(rr[1]); }
    l_out = l;
#undef NSA_DMA
}

DEV void nsa_unit(lds_u8* lds, unsigned char* ws, int b, int g, int qt) {
    const int tid = threadIdx.x, lane = tid & 63, r32 = lane & 31, hi = lane >> 5; const int wid = __builtin_amdgcn_readfirstlane(tid >> 6);
    const int hh = wid >> 1, h = 4 * g + hh, ql = 32 * (wid & 1) + r32, t = 64 * qt + ql;
    const bf16_t* Y0 = (const bf16_t*)(ws + SC_Y0);
    const bf16_t* yrow = Y0 + (size_t)(b * SEQ + t) * EINP;
    bf16x8 qr[4];
#pragma unroll
    for (int d0 = 0; d0 < 4; ++d0) qr[d0] = *(const bf16x8*)(yrow + C_Q + h * 64 + d0 * 16 + hi * 8);
#pragma unroll
    for (int d0 = 0; d0 < 4; ++d0) asm volatile("" : "+v"(qr[d0]));
    const float g_c = sigmoidf_(bf2f(yrow[C_GL + h * 3 + 0])), g_s = sigmoidf_(bf2f(yrow[C_GL + h * 3 + 1])), g_w = sigmoidf_(bf2f(yrow[C_GL + h * 3 + 2]));
    const bf16_t* Ybg = Y0 + (size_t)(b * SEQ) * EINP + g * 64;
    f32x16 acc[2], o[2]; float l;
    const int nmax = (t >= 31) ? (t - 31) >> 4 : -1;
    const int tmaxu = 64 * qt + 63, nmax_u = (tmaxu - 31) >> 4, nct = (nmax_u >> 6) + 1;
    const int nmin_u = (64 * qt >= 31) ? (64 * qt - 31) >> 4 : -1;
    const bf16_t* KC = (const bf16_t*)(ws + WS_KCMP) + (size_t)(b * 2 + g) * 256 * 64;
    const bf16_t* VC = (const bf16_t*)(ws + WS_VCMP) + (size_t)(b * 2 + g) * 256 * 64;
    const bf16_t* MS = (const bf16_t*)(ws + WS_MSEL) + (size_t)((b * 2 + g) & 7) * 256 * 64;
    flash_pass(lds, KC, 64, VC, 64, 0, nct, qr, -1, nmax, ~0ull, -1, nmin_u, o, l);
    { const float sc = (l > 0.f) ? g_c * frcp(l) : 0.f;
#pragma unroll
      for (int dh = 0; dh < 2; ++dh)
#pragma unroll
          for (int r = 0; r < 16; ++r) acc[dh][r] = o[dh][r] * sc; }
    unsigned long long selmask = (2ull << qt) - 1ull;
    if (qt >= 16) {
    flash_pass(lds, KC, 64, MS, 64, 0, nct, qr, -1, nmax, ~0ull, -1, nmin_u, o, l);
    { const float sc = (l > 0.f) ? frcp(l) : 0.f;
      __attribute__((address_space(3))) float* imp = (__attribute__((address_space(3))) float*)(lds + L_IMP) + (hh * 64 + ql) * IMPP;
#pragma unroll
      for (int dh = 0; dh < 2; ++dh)
#pragma unroll
          for (int r = 0; r < 16; ++r) imp[32 * dh + crow(r, hi)] = o[dh][r] * sc; }
    NSA_BAR();
    {
        __attribute__((address_space(3))) const float* impb = (__attribute__((address_space(3))) const float*)(lds + L_IMP);
        __attribute__((address_space(3))) unsigned long long* selp = (__attribute__((address_space(3))) unsigned long long*)(lds + L_SEL);
        const int m = lane, cur = qt;
        for (int qq = 8 * wid; qq < 8 * wid + 8; ++qq) {
            unsigned long long sel;
            if (cur < 16) sel = (2ull << cur) - 1ull;
            else {
                const float iv = ((impb[(0 * 64 + qq) * IMPP + m] + impb[(1 * 64 + qq) * IMPP + m]) + impb[(2 * 64 + qq) * IMPP + m]) + impb[(3 * 64 + qq) * IMPP + m];
                const bool cand = (m >= 1) && (m <= cur - 2);
                const unsigned bits = __float_as_uint(fmaxf(iv, 0.f));
                unsigned T = 0u;
                for (int bit = 30; bit >= 0; --bit) { const unsigned trial = T | (1u << bit); if (__popcll(__ballot(cand && bits >= trial)) >= 13) T = trial; }
                const unsigned long long gtm = __ballot(cand && bits > T); unsigned long long eqm = __ballot(cand && bits == T);
                int need = 13 - __popcll(gtm); unsigned long long tie = 0ull;
                while (need > 0 && eqm) { const unsigned long long lowb = eqm & (~eqm + 1ull); tie |= lowb; eqm ^= lowb; --need; }
                sel = gtm | tie | 1ull | (1ull << cur) | (1ull << (cur - 1));
            }
            if (lane == 0) selp[qq] = sel;
        }
    }
    NSA_BAR();
    selmask = ((__attribute__((address_space(3))) const unsigned long long*)(lds + L_SEL))[ql];
    }
    flash_pass(lds, Ybg + C_KS, EINP, Ybg + C_VS, EINP, 0, qt + 1, qr, -1, t, selmask, -1, 64 * qt, o, l);
    { const float sc = g_s * frcp(l);
#pragma unroll
      for (int dh = 0; dh < 2; ++dh)
#pragma unroll
          for (int r = 0; r < 16; ++r) acc[dh][r] += o[dh][r] * sc; }
    { const int wt0 = (qt >= 8) ? qt - 8 : 0;
      flash_pass(lds, Ybg + C_KW, EINP, Ybg + C_VW, EINP, wt0, qt - wt0 + 1, qr, t - 512, t, ~0ull, 64 * qt + 63 - 512, 64 * qt, o, l);
      const float sc = g_w * frcp(l);
#pragma unroll
      for (int dh = 0; dh < 2; ++dh)
#pragma unroll
          for (int r = 0; r < 16; ++r) acc[dh][r] += o[dh][r] * sc; }
    bf16_t* orow = (bf16_t*)(ws + SC_CAT) + (size_t)(b * SEQ + t) * DM + 512 + h * 64;
#pragma unroll
    for (int dh = 0; dh < 2; ++dh)
#pragma unroll
        for (int j = 0; j < 4; ++j) { u32x2 w; w.x = cvtpk(acc[dh][4 * j], acc[dh][4 * j + 1]); w.y = cvtpk(acc[dh][4 * j + 2], acc[dh][4 * j + 3]); *(u32x2*)(orow + 32 * dh + 8 * j + 4 * hi) = w; }
    NSA_WAITV(0);
}
DEV void nsa_phase(unsigned char* lds_raw, unsigned char* ws) {
    lds_u8* lds = (lds_u8*)lds_raw;
    const int G = gridDim.x, bx = blockIdx.x;
    const int vcu = (G % 8 == 0) ? (bx % 8) * (G / 8) + bx / 8 : bx;
    for (int p = vcu; p < 512; p += G) {
        const int bg = p >> 5, s = p & 31;
        nsa_unit(lds, ws, bg >> 1, bg & 1, 63 - s);
        nsa_unit(lds, ws, bg >> 1, bg & 1, s);
    }
}
#undef NSA_WAITV
#undef NSA_BAR
}

DEV void router_mfma(const Ctx& c, const bf16_t* X, int layer) {
    const __attribute__((address_space(4))) Params& p = *c.p;
    const float* bg = gptr(p.in[26]) + layer * 4; const float* be = gptr(p.in[28]) + layer * 32;
    const bf16_t* WB = (const bf16_t*)(c.ws + WS_RWB) + (size_t)layer * 96 * DM;
    int* cnt = (int*)(c.ws + WS_CTL) + layer * 32; int* list = (int*)(c.ws + WS_LIST); float* gate = (float*)(c.ws + WS_GATE);
    int* lcnt = (int*)c.lds; int* lbase = lcnt + 32; int* asg = lcnt + 64;
    float* lgs = c.lds + 1024 + c.wave * 640;
    constexpr int rpw = NT / 256;
    if (c.tid < 32) lcnt[c.tid] = 0;
    __syncthreads();
    const int fr = c.lane & 15, kg = c.lane >> 4;
    static_assert(rpw == NWAVES * 16, "one 16-row block per wave");
    {
        const int lrow0 = c.wave * 16;
        const int row0 = blockIdx.x * rpw + lrow0;
        const bf16_t* ap = X + (size_t)(row0 + fr) * DM + kg * 8;
        f32x4 aE0 = {0.f, 0.f, 0.f, 0.f}, aE1 = aE0, aG = aE0;
        typedef __attribute__((address_space(3))) unsigned char lds8;
        lds8* LB = (lds8*)c.lds + 32768;
        for (int half = 0; half < 2; ++half) {
            __syncthreads();
#pragma unroll 4
            for (int i = c.tid; i < 96 * 64; i += NTHREADS) { const int row = i >> 6, ch = i & 63;
                *(__attribute__((address_space(3))) u32x4*)(LB + row * 1040 + ch * 16) = *(const u32x4*)(WB + (size_t)row * DM + half * 512 + ch * 8); }
            __syncthreads();
            const lds8* bp = LB + fr * 1040 + kg * 16;
#pragma unroll 4
            for (int s = 0; s < 16; ++s) {
                const bf16x8 a = *(const bf16x8*)(ap + half * 512 + 32 * s);
#define RB(blk) (*(const __attribute__((address_space(3))) bf16x8*)(bp + (blk) * 16 * 1040 + s * 64))
                const bf16x8 b0 = RB(0), b1 = RB(1), b2 = RB(2), b3 = RB(3), b4 = RB(4), b5 = RB(5);
#undef RB
                aE0 = __builtin_amdgcn_mfma_f32_16x16x32_bf16(a, b0, aE0, 0, 0, 0); aE0 = __builtin_amdgcn_mfma_f32_16x16x32_bf16(a, b3, aE0, 0, 0, 0);
                aE1 = __builtin_amdgcn_mfma_f32_16x16x32_bf16(a, b1, aE1, 0, 0, 0); aE1 = __builtin_amdgcn_mfma_f32_16x16x32_bf16(a, b4, aE1, 0, 0, 0);
                aG = __builtin_amdgcn_mfma_f32_16x16x32_bf16(a, b2, aG, 0, 0, 0); aG = __builtin_amdgcn_mfma_f32_16x16x32_bf16(a, b5, aG, 0, 0, 0);
            }
        }
#pragma unroll
        for (int r = 0; r < 4; ++r) { float* lr = lgs + (4 * kg + r) * 40; lr[4 + fr] = aE0[r]; lr[20 + fr] = aE1[r]; if (fr < 4) lr[fr] = aG[r]; }
        LDS_WAIT();
        if (c.lane < 16) {
            const float* lr = lgs + c.lane * 40;
            float gl[4]; int gs = 0;
#pragma unroll
            for (int o = 0; o < 4; ++o) gl[o] = lr[o] + bg[o];
            float gm = gl[0];
#pragma unroll
            for (int o = 1; o < 4; ++o) if (gl[o] > gm) { gm = gl[o]; gs = o; }
            float den = 0.f;
#pragma unroll
            for (int o = 0; o < 4; ++o) den += __expf(gl[o] - gm);
            const float pgroup = frcp(den);
            int i0 = 0, i1 = -1; float v0 = -INFINITY, v1 = -INFINITY;
#pragma unroll
            for (int o = 0; o < 8; ++o) { const float e = lr[4 + gs * 8 + o] + be[gs * 8 + o];
                if (e > v0) { v1 = v0; i1 = i0; v0 = e; i0 = o; } else if (e > v1) { v1 = e; i1 = o; } }
            const float e1 = __expf(v1 - v0), g0 = pgroup * frcp(1.f + e1), g1 = g0 * e1;
            const int ex0 = gs * 8 + i0, ex1 = gs * 8 + i1;
            const int lp0 = atomicAdd(lcnt + ex0, 1), lp1 = atomicAdd(lcnt + ex1, 1);
            asg[(lrow0 + c.lane) * 2] = (ex0 << 16) | lp0; asg[(lrow0 + c.lane) * 2 + 1] = (ex1 << 16) | lp1;
            gate[(row0 + c.lane) * 2] = g0; gate[(row0 + c.lane) * 2 + 1] = g1;
        }
        LDS_WAIT();
    }
    __syncthreads();
    if (c.tid < 32) lbase[c.tid] = atomicAdd(cnt + c.tid, lcnt[c.tid]);
    __syncthreads();
    for (int i = c.tid; i < 2 * rpw; i += NTHREADS) { const int a = asg[i], ex = a >> 16, lpos = a & 0xffff; const int aid_ = (blockIdx.x * rpw) * 2 + i, slot_ = lbase[ex] + lpos; list[ex * LCAP + slot_] = aid_; ((int*)(c.ws + WS_APOS))[aid_] = (ex << 16) | slot_; }
    __syncthreads();
}

DEV void bf8_to_f32(const u32x4 w, float* o) {
#pragma unroll
    for (int j = 0; j < 4; ++j) { o[2 * j] = __uint_as_float(w[j] << 16); o[2 * j + 1] = __uint_as_float(w[j] & 0xffff0000u); }
}
DEV void moe_combine(const Ctx& c, const bf16_t* Xin, const float* g, const float* b, bf16_t* Xo, float* outf, const int* cnt) {
    const bf16_t* Y = (const bf16_t*)(c.ws + SC_Y);
    const int* apos = (const int*)(c.ws + WS_APOS); const float* gate = (const float*)(c.ws + WS_GATE);
    int pref;
    { const int nb = (c.lane < NEXP) ? (cnt[c.lane] + 255) >> 8 : 0; int incl = nb;
#pragma unroll
      for (int o = 1; o < 32; o <<= 1) { const int t = __shfl_up(incl, o); if ((c.lane & 63) >= o) incl += t; }
      pref = incl - nb; }
    float gg[16], bb[16];
#pragma unroll
    for (int hf = 0; hf < 2; ++hf)
#pragma unroll
        for (int j = 0; j < 8; ++j) { gg[hf * 8 + j] = g[hf * 512 + 8 * c.lane + j]; bb[hf * 8 + j] = b[hf * 512 + 8 * c.lane + j]; }
    for (int row0 = c.gw * 2; row0 < NT; row0 += c.ngw * 2) {
        u32x4 xr[2][2], y0r[2][2], y1r[2][2];
#pragma unroll
        for (int r = 0; r < 2; ++r)
#pragma unroll
            for (int hf = 0; hf < 2; ++hf) { const size_t row = row0 + r; const int col = hf * 512 + 8 * c.lane;
                const int a0 = apos[2 * row], a1 = apos[2 * row + 1];
                const size_t p0 = (size_t)__shfl(pref, a0 >> 16) * 256 + (a0 & 0xffff), p1 = (size_t)__shfl(pref, a1 >> 16) * 256 + (a1 & 0xffff);
                xr[r][hf] = *(const u32x4*)(Xin + row * DM + col); y0r[r][hf] = *(const u32x4*)(Y + p0 * DM + col); y1r[r][hf] = *(const u32x4*)(Y + p1 * DM + col); }
#pragma unroll
        for (int r = 0; r < 2; ++r) {
            float v[16]; float s = 0.f; const float g0 = gate[2 * (row0 + r)], g1 = gate[2 * (row0 + r) + 1];
#pragma unroll
            for (int hf = 0; hf < 2; ++hf) { float x[8], a[8], bq[8]; bf8_to_f32(xr[r][hf], x); bf8_to_f32(y0r[r][hf], a); bf8_to_f32(y1r[r][hf], bq);
#pragma unroll
                for (int j = 0; j < 8; ++j) { v[hf * 8 + j] = x[j] * DN_ALPHA + (g0 * a[j] + g1 * bq[j]); s += v[hf * 8 + j]; } }
            const float mean = wsum_dpp(s) * (1.f / DM); float s2 = 0.f;
#pragma unroll
            for (int j = 0; j < 16; ++j) { v[j] -= mean; s2 += v[j] * v[j]; }
            const float rstd = rsqrtf(wsum_dpp(s2) * (1.f / DM) + LN_EPS);
#pragma unroll
            for (int j = 0; j < 16; ++j) v[j] = v[j] * rstd * gg[j] + bb[j];
            const size_t row = row0 + r;
#pragma unroll
            for (int hf = 0; hf < 2; ++hf) { const int col = hf * 512 + 8 * c.lane;
                if (Xo) { u32x4 o; o.x = pk2(v[hf * 8], v[hf * 8 + 1]); o.y = pk2(v[hf * 8 + 2], v[hf * 8 + 3]); o.z = pk2(v[hf * 8 + 4], v[hf * 8 + 5]); o.w = pk2(v[hf * 8 + 6], v[hf * 8 + 7]); *(u32x4*)(Xo + row * DM + col) = o; }
                if (outf) { *(f32x4*)(outf + row * DM + col) = (f32x4){v[hf * 8], v[hf * 8 + 1], v[hf * 8 + 2], v[hf * 8 + 3]}; *(f32x4*)(outf + row * DM + col + 4) = (f32x4){v[hf * 8 + 4], v[hf * 8 + 5], v[hf * 8 + 6], v[hf * 8 + 7]}; }
            }
        }
    }
}

DEV void odd_conv(const Ctx& c) {
    const bf16_t* Y1 = (const bf16_t*)(c.ws + SC_Y0); bf16_t* V = (bf16_t*)(c.ws + WS_XA);
    const float* cw = gptr(c.p->in[17]);
    float w0[8], w1[8], w2[8];
    { const int col = (c.gw & 1) * 512 + 8 * c.lane;
#pragma unroll
      for (int j = 0; j < 8; ++j) { w0[j] = cw[col + j]; w1[j] = cw[DM + col + j]; w2[j] = cw[2 * DM + col + j]; } }
    for (int it = c.gw; it < (NT / 16) * 2; it += c.ngw) {
        const int half = it & 1, tok0 = (it >> 1) * 16, col = half * 512 + 8 * c.lane, t0 = tok0 & (SEQ - 1);
        float um2[8], um1[8];
        if (t0 >= 2) { bf8_to_f32(*(const u32x4*)(Y1 + (size_t)(tok0 - 2) * 2048 + 1024 + col), um2); bf8_to_f32(*(const u32x4*)(Y1 + (size_t)(tok0 - 1) * 2048 + 1024 + col), um1); }
        else {
#pragma unroll
            for (int j = 0; j < 8; ++j) { um2[j] = 0.f; um1[j] = 0.f; } }
#pragma unroll 4
        for (int i = 0; i < 16; ++i) {
            float u0[8], gb[8];
            bf8_to_f32(*(const u32x4*)(Y1 + (size_t)(tok0 + i) * 2048 + 1024 + col), u0);
            bf8_to_f32(*(const u32x4*)(Y1 + (size_t)(tok0 + i) * 2048 + col), gb);
            float y[8];
#pragma unroll
            for (int j = 0; j < 8; ++j) { y[j] = gb[j] * (w0[j] * um2[j] + w1[j] * um1[j] + w2[j] * u0[j]); um2[j] = um1[j]; um1[j] = u0[j]; }
            u32x4 o; o.x = pk2(y[0], y[1]); o.y = pk2(y[2], y[3]); o.z = pk2(y[4], y[5]); o.w = pk2(y[6], y[7]);
            *(u32x4*)(V + (size_t)(tok0 + i) * DM + col) = o;
        }
    }
}

#define XB_TMO      128
#define XB_XCNT(j)  (256  + 64 * (j))
#define XB_XSUB(j)  (1280 + 64 * (j))
#define XB_XGEN(j)  (2304 + 64 * (j))
#define XB_TOP      3328
#define XB_TOPGEN   3392
#define XCD_BAR_WORDS 3456
#define XB_SPIN_CAP (1u << 22)
DEV unsigned xb_ld(unsigned* p)              { return __hip_atomic_load(p, __ATOMIC_RELAXED, __HIP_MEMORY_SCOPE_AGENT); }
DEV unsigned xb_add(unsigned* p, unsigned v) { return __hip_atomic_fetch_add(p, v, __ATOMIC_RELAXED, __HIP_MEMORY_SCOPE_AGENT); }
DEV unsigned xb_xcc_id() { return (unsigned)__builtin_amdgcn_s_getreg((3 << 11) | 20) & 0xFu; }
#define XB_SPIN(cond, bar) do { unsigned _sp = 0; while (cond) { __builtin_amdgcn_s_sleep(1); \
    if ((++_sp & 255u) == 0u) { if (xb_ld(&(bar)[XB_TMO])) break; if (_sp > XB_SPIN_CAP) { atomicAdd(&(bar)[XB_TMO], 1u); break; } } } } while (0)
struct XcdBarrier { unsigned* bar; unsigned x; volatile __attribute__((address_space(3))) unsigned* st; };
DEV XcdBarrier xcd_barrier_post(unsigned* bar, volatile __attribute__((address_space(3))) unsigned* st) {
    XcdBarrier b; b.bar = bar; b.x = xb_xcc_id(); b.st = st;
    if (threadIdx.x == 0) (void)xb_add(&bar[XB_XCNT(b.x)], 1u);
    return b;
}
DEV void xcd_barrier_complete(unsigned* bar, unsigned x, unsigned& nloc, unsigned& nx) {
    const unsigned G = gridDim.x * gridDim.y * gridDim.z;
    unsigned sum, cnt, mine, sp = 0u;
    for (;;) {
        sum = 0u; cnt = 0u; mine = 0u;
#pragma unroll
        for (unsigned j = 0; j < 16; ++j) { const unsigned cc = xb_ld(&bar[XB_XCNT(j)]); sum += cc; cnt += (cc > 0u) ? 1u : 0u; mine = (j == x) ? cc : mine; }
        if (sum == G) break;
        __builtin_amdgcn_s_sleep(1);
        if ((++sp & 255u) == 0u) { if (xb_ld(&bar[XB_TMO])) break; if (sp > XB_SPIN_CAP) { atomicAdd(&bar[XB_TMO], 1u); break; } }
    }
    nloc = mine > 0u ? mine : 1u; nx = cnt > 0u ? cnt : 1u;
}
DEV void xcd_barrier(const XcdBarrier& b) {
    asm volatile("s_waitcnt vmcnt(0)" ::: "memory");
    __syncthreads();
    if (threadIdx.x == 0) {
        unsigned* bar = b.bar;
        __builtin_amdgcn_s_waitcnt(0);
        unsigned nloc = b.st[0], nx = b.st[1];
        if (nloc == 0u) { xcd_barrier_complete(bar, b.x, nloc, nx); b.st[0] = nloc; b.st[1] = nx; }
        const unsigned old = xb_add(&bar[XB_XSUB(b.x)], 1u);
        const unsigned gen = old / nloc;
        if (old + 1u == (gen + 1u) * nloc) {
            __builtin_amdgcn_fence(__ATOMIC_RELEASE, "agent");
            asm volatile("s_waitcnt vmcnt(0)" ::: "memory");
            const unsigned og = xb_add(&bar[XB_TOP], 1u);
            const unsigned tg = og / nx;
            if (og + 1u == (tg + 1u) * nx) xb_add(&bar[XB_TOPGEN], 1u);
            else XB_SPIN(xb_ld(&bar[XB_TOPGEN]) == tg, bar);
            __builtin_amdgcn_fence(__ATOMIC_ACQUIRE, "agent");
            xb_add(&bar[XB_XGEN(b.x)], 1u);
            asm volatile("s_waitcnt vmcnt(0)" ::: "memory");
        } else {
            XB_SPIN(xb_ld(&bar[XB_XGEN(b.x)]) == gen, bar);
            __builtin_amdgcn_fence(__ATOMIC_ACQUIRE, "agent");
            asm volatile("s_waitcnt vmcnt(0)" ::: "memory");
        }
    }
    __syncthreads();
}

DEV void xa_fold_unit(PG8_LAS unsigned char* ldsp, unsigned char* ws, int layer, int fid) {
    const int id = fid & 127, b = id >> 4, h = (id >> 2) & 3, q = id & 3; const bool isn = fid >= 128;
    const bf16_t* MK = (const bf16_t*)(ws + WS_MEMK) + (size_t)(b * MEML) * DM + h * 256;
    const bf16_t* MV = (const bf16_t*)(ws + WS_MEMV) + (size_t)(b * MEML) * DM + h * 256;
    const bf16_t* WQP = (const bf16_t*)(ws + WS_WQ) + (size_t)layer * DM * DM + (size_t)(q * 256) * DM + h * 256;
    const bf16_t* WOT = (const bf16_t*)(ws + WS_WO) + (size_t)layer * DM * DM + (size_t)(q * 256) * DM + h * 256;
    bf16_t* MT = (bf16_t*)(ws + WS_MT) + ((size_t)b * DM + h * 256) * DM + q * 256;
    bf16_t* NT_ = (bf16_t*)(ws + WS_NT) + ((size_t)b * DM + q * 256) * DM + h * 256;
    pg8::OneUnitTask T{256, isn ? WOT : MK, isn ? MV : WQP, isn ? NT_ : MT, DM, 0, 0, 0, 0, fid < 256, isn ? 1.f : 0.0625f * 1.4426950408889634f};
    pg8::gemm_phase(ldsp, T);
}
DEV void xa_fold(PG8_LAS unsigned char* ldsp, unsigned char* ws, int layer) { xa_fold_unit(ldsp, ws, layer, blockIdx.x); }
DEV void xa_fold_in_moe_tail(PG8_LAS unsigned char* ldsp, unsigned char* ws, int layer, int nblk) {
    const int G = gridDim.x, bx = blockIdx.x, vc = (G % 8 == 0) ? (bx % 8) * (G / 8) + bx / 8 : bx;
    const int full = 4 * nblk - (4 * nblk / G) * G;
    const int nidle = G - full;
    if (vc < full) return;
    for (int fid = vc - full; fid < 256; fid += nidle) xa_fold_unit(ldsp, ws, layer, fid);
}

constexpr int N_PHASES = 25;
constexpr int LDS_BYTES = 147456;
__global__ void __launch_bounds__(NTHREADS, 2) fwd_kernel(Params prm) {
    extern __shared__ __attribute__((aligned(16))) unsigned char lds_raw[];
    volatile __attribute__((address_space(3))) unsigned* bst = (volatile __attribute__((address_space(3))) unsigned*)((__attribute__((address_space(3))) unsigned char*)lds_raw + LDS_BYTES - 16);
    if (threadIdx.x < 4) bst[threadIdx.x] = 0u;
    __syncthreads();
    XcdBarrier xbar; xbar.bar = (unsigned*)(prm.ws + WS_CTL) + 1024; xbar.x = 0; xbar.st = bst;
    if (prm.ph_hi - prm.ph_lo > 1) xbar = xcd_barrier_post((unsigned*)(prm.ws + WS_CTL) + 1024, bst);
    KParams kp = (KParams)__builtin_amdgcn_kernarg_segment_ptr();
    Ctx c; c.p = kp; c.ws = prm.ws; c.lds = (float*)lds_raw;
    c.tid = threadIdx.x; c.lane = c.tid & 63; c.wave = __builtin_amdgcn_readfirstlane(c.tid >> 6);
    c.gw = blockIdx.x * NWAVES + c.wave; c.ngw = gridDim.x * NWAVES;
    typedef __attribute__((address_space(1))) unsigned char gu8_t;
    gu8_t* wsg = (gu8_t*)prm.ws;
    unsigned char* ws = (unsigned char*)wsg;
    PG8_LAS unsigned char* ldsp = (PG8_LAS unsigned char*)lds_raw;
#define XA ((bf16_t*)(ws + WS_XA))
#define XB ((bf16_t*)(ws + WS_XB))
#define Z ((float*)(ws + SC_Z))
    typedef const float* cfptr_t;
    const __attribute__((address_space(4))) cfptr_t* in = (const __attribute__((address_space(4))) cfptr_t*)kp;
#ifndef ONLY_PHASE
#define ONLY_PHASE -1
#endif
#ifndef TPROBE_PHASE
#define TPROBE_PHASE -1
#endif
#define PHASE(k, ...) if (TPROBE_PHASE == (k)) tp0_ = __builtin_amdgcn_s_memrealtime(); if ((ONLY_PHASE < 0 || ONLY_PHASE == (k)) && prm.ph_lo <= (k) && (k) < prm.ph_hi) { asm volatile("" : "+s"(wsg)); ws = (unsigned char*)wsg; asm volatile("" : "+s"(kp)); c.p = kp; c.ws = ws; c.tid = threadIdx.x; asm volatile("" : "+v"(c.tid)); c.lane = c.tid & 63; in = (const __attribute__((address_space(4))) cfptr_t*)kp; { __VA_ARGS__; } if ((k) + 1 < prm.ph_hi) { xcd_barrier(xbar); } if (TPROBE_PHASE == (k)) tp1_ = __builtin_amdgcn_s_memrealtime(); }
    unsigned long long tp0_ = 0, tp1_ = 0;
    if (prm.ph_hi > N_PHASES) { __threadfence(); cg::this_grid().sync(); }
    PHASE(0, phase_prep<0>(c))
    PHASE(1, { const bool early = ((blockIdx.x >> 3) & 1) == 0; if (early) { phase_prep<1>(c); __syncthreads(); }
        pg8::PlainTask<pg8::EpiInproj, true> T{XA, DM, (const bf16_t*)(ws + WS_W_IN), DM, DM, {}, {(bf16_t*)(ws + SC_Y0)}}; T.S.init(NT, EINP, gridDim.x, blockIdx.x); pg8::gemm_phase(ldsp, T);
        if (!early) { __syncthreads(); c.tid = threadIdx.x; asm volatile("" : "+v"(c.tid)); c.lane = c.tid & 63; phase_prep<1>(c); } })
    PHASE(2, {
        const int bx = blockIdx.x;
        if (bx < 64) { pg8::CmpTask T{DM, ws, bx}; pg8::gemm_phase(ldsp, T); }
        else if (bx < 128) {
            const int j = (bx - 64) & 31; const bool isv = bx >= 96;
            pg8::OneUnitTask T{DM, (const bf16_t*)(ws + WS_MEMB), (const bf16_t*)(ws + (isv ? WS_WV : WS_WK)), (bf16_t*)(ws + (isv ? WS_MEMV : WS_MEMK)), DM,
                               (size_t)256 * DM, (size_t)256, j >> 2, j & 3, true, 1.f};
            pg8::gemm_phase(ldsp, T); }
        } conv_phase(c))
    PHASE(3, cmp_finish(c); __syncthreads(); xa_fold(ldsp, ws, 0))
#ifdef NSA_CHECK
    PHASE(4, nsa::nsa_phase(lds_raw, ws); nsa_naive(c);
        __syncthreads(); if (c.tid == 0) __threadfence(); )
#else
    PHASE(4, { const bool early = ((blockIdx.x >> 3) & 1) == 0;
        if (early) { moe_weights_m<0>(c, 0, c.gw, c.ngw); __syncthreads(); }
        nsa::nsa_phase(lds_raw, ws);
        if (!early) { __syncthreads(); moe_weights_m<0>(c, 0, c.gw, c.ngw); } })
#endif
#ifdef NSA_CHECK
    if (prm.ph_lo <= 5 && 5 < prm.ph_hi) {
        const bf16_t* A_ = (const bf16_t*)(ws + SC_CAT); const bf16_t* B_ = (const bf16_t*)(ws + WS_XB); float d2 = 0.f, a2 = 0.f;
        for (size_t i = (size_t)c.gw * 64 + c.lane; i < (size_t)NT * 512; i += (size_t)c.ngw * 64) { const size_t r = i >> 9, cc = 512 + (i & 511); const float a = bf2f(A_[r * DM + cc]), b = bf2f(B_[r * DM + cc]); d2 += (a - b) * (a - b); a2 += b * b; }
        d2 = wsum(d2); a2 = wsum(a2);
        if (c.lane == 0) { atomicAdd((float*)(ws + WS_CTL) + 60000, d2); atomicAdd((float*)(ws + WS_CTL) + 60001, a2); }
        xcd_barrier(xbar);
    }
#endif
    PHASE(5, { for (int half = 0; half < 2; ++half) { pg8::LnTask<false> T{DM, (const bf16_t*)(ws + SC_CAT), DM, (const bf16_t*)(ws + WS_W_OUT), XA, gptr(in[19]), gptr(in[20]), XB, half * 16384, {(unsigned long long*)(ws + WS_XBUF), (unsigned*)(ws + WS_CTL) + 8192 + 0 * 8192}, {}, 0}; T.S.init(16384, DM, gridDim.x, blockIdx.x); pg8::gemm_phase<pg8::LnTask<false>, true>(ldsp, T); } })
    PHASE(6, { pg8::XaSTask T{DM, XB, (const bf16_t*)(ws + WS_MT), (bf16_t*)(ws + SC_P), ldsp, {}}; T.S.init(NT, DM, gridDim.x, blockIdx.x); pg8::gemm_phase(ldsp, T); })
    PHASE(9, { for (int half = 0; half < 2; ++half) { pg8::LnTask<false> T{DM, (const bf16_t*)(ws + SC_P), DM, (const bf16_t*)(ws + WS_NT), XB, gptr(in[23]), gptr(in[24]), XA, half * 16384, {(unsigned long long*)(ws + WS_XBUF), (unsigned*)(ws + WS_CTL) + 8192 + 1 * 8192}, {}, (size_t)DM * DM}; T.S.init(16384, DM, gridDim.x, blockIdx.x); pg8::gemm_phase<pg8::LnTask<false>, true>(ldsp, T); } })
    PHASE(10, router_mfma(c, XA, 0))
    PHASE(11, { const int* cnt = (const int*)(ws + WS_CTL) + 0 * 32; PG8_LAS int* tab = (PG8_LAS int*)(ldsp + pg8::LDS_SPARE); pg8::moe_build_tab(cnt, tab);
        pg8::Moe1Task T{DM, XA, (const bf16_t*)(ws + WS_W13), (bf16_t*)(ws + SC_H), cnt, (const int*)(ws + WS_LIST), tab, (int)gridDim.x, (int)blockIdx.x}; pg8::gemm_phase(ldsp, T); const int nblk_ = tab[0]; __syncthreads(); xa_fold_in_moe_tail(ldsp, ws, 1, nblk_); __syncthreads(); moe_weights_in_tail<3>(c, 1, nblk_); })
    PHASE(12, { const int* cnt = (const int*)(ws + WS_CTL) + 0 * 32; PG8_LAS int* tab = (PG8_LAS int*)(ldsp + pg8::LDS_SPARE); pg8::moe_build_tab(cnt, tab);
        pg8::Moe2Task T{EH, (const bf16_t*)(ws + SC_H), (const bf16_t*)(ws + WS_W2), (bf16_t*)(ws + SC_Y), cnt, (const int*)(ws + WS_LIST), (const float*)(ws + WS_GATE), tab, (int)gridDim.x, (int)blockIdx.x, nullptr}; pg8::gemm_phase(ldsp, T); const int nblk_ = tab[0]; __syncthreads(); moe_weights_in_tail<1>(c, 1, nblk_); })
    PHASE(13, moe_combine(c, XA, gptr(in[32]), gptr(in[33]), XB, nullptr, (const int*)(ws + WS_CTL)); moe_weights_m<2>(c, 1, c.gw, c.ngw))
    PHASE(14, { pg8::PlainTask<pg8::EpiBf16, true> T{XB, DM, (const bf16_t*)(ws + WS_OD_IN), DM, DM, {}, {(bf16_t*)(ws + SC_Y0), 2048}}; T.S.init(NT, DM, gridDim.x, blockIdx.x); pg8::gemm_phase(ldsp, T); }
        { pg8::PlainTask<pg8::EpiOdIn, true> T{XB, DM, (const bf16_t*)(ws + WS_OD_IN) + (size_t)DM * DM, DM, DM, {}, {(bf16_t*)(ws + SC_Y0)}}; T.S.init(NT, 2 * DM, gridDim.x, blockIdx.x); pg8::gemm_phase(ldsp, T); })
    PHASE(15, odd_conv(c))
    PHASE(16, { for (int half = 0; half < 2; ++half) { pg8::LnTask<false> T{DM, XA, DM, (const bf16_t*)(ws + WS_OD_OUT), XB, gptr(in[19]) + DM, gptr(in[20]) + DM, XA, half * 16384, {(unsigned long long*)(ws + WS_XBUF), (unsigned*)(ws + WS_CTL) + 8192 + 2 * 8192}, {}, 0}; T.S.init(16384, DM, gridDim.x, blockIdx.x); pg8::gemm_phase<pg8::LnTask<false>, true>(ldsp, T); } })
    PHASE(17, { pg8::XaSTask T{DM, XA, (const bf16_t*)(ws + WS_MT), (bf16_t*)(ws + SC_P), ldsp, {}}; T.S.init(NT, DM, gridDim.x, blockIdx.x); pg8::gemm_phase(ldsp, T); })
    PHASE(20, { for (int half = 0; half < 2; ++half) { pg8::LnTask<false> T{DM, (const bf16_t*)(ws + SC_P), DM, (const bf16_t*)(ws + WS_NT), XA, gptr(in[23]) + DM, gptr(in[24]) + DM, XB, half * 16384, {(unsigned long long*)(ws + WS_XBUF), (unsigned*)(ws + WS_CTL) + 8192 + 3 * 8192}, {}, (size_t)DM * DM}; T.S.init(16384, DM, gridDim.x, blockIdx.x); pg8::gemm_phase<pg8::LnTask<false>, true>(ldsp, T); } })
    PHASE(21, router_mfma(c, XB, 1))
    PHASE(22, { const int* cnt = (const int*)(ws + WS_CTL) + 1 * 32; PG8_LAS int* tab = (PG8_LAS int*)(ldsp + pg8::LDS_SPARE); pg8::moe_build_tab(cnt, tab);
        pg8::Moe1Task T{DM, XB, (const bf16_t*)(ws + WS_W13), (bf16_t*)(ws + SC_H), cnt, (const int*)(ws + WS_LIST), tab, (int)gridDim.x, (int)blockIdx.x}; pg8::gemm_phase(ldsp, T); })
    PHASE(23, { const int* cnt = (const int*)(ws + WS_CTL) + 1 * 32; PG8_LAS int* tab = (PG8_LAS int*)(ldsp + pg8::LDS_SPARE); pg8::moe_build_tab(cnt, tab);
        pg8::Moe2Task T{EH, (const bf16_t*)(ws + SC_H), (const bf16_t*)(ws + WS_PK), (bf16_t*)(ws + SC_Y), cnt, (const int*)(ws + WS_LIST), (const float*)(ws + WS_GATE), tab, (int)gridDim.x, (int)blockIdx.x, (const bf16_t*)(ws + WS_W2B)}; pg8::gemm_phase(ldsp, T); })
    PHASE(24, moe_combine(c, XB, gptr(in[32]) + DM, gptr(in[33]) + DM, nullptr, (float*)(__attribute__((address_space(1))) float*)prm.out, (const int*)(ws + WS_CTL) + 32))
#ifdef NSA_CHECK
    {
        xcd_barrier(xbar);
        const float d2 = ((const float*)(ws + WS_CTL))[60000], a2 = ((const float*)(ws + WS_CTL))[60001];
        const float f = 1.f + 10.f * sqrtf(d2 / a2);
        for (size_t i = (size_t)c.gw * 64 + c.lane; i < (size_t)NT * DM; i += (size_t)c.ngw * 64) (float*)(__attribute__((address_space(1))) float*)prm.out[i] *= f;
    }
#endif
    if (TPROBE_PHASE >= 0) { const unsigned long long t_end = __builtin_amdgcn_s_memrealtime() + 4ull * (tp1_ - tp0_); while (__builtin_amdgcn_s_memrealtime() < t_end) __builtin_amdgcn_s_sleep(8); }
}

extern "C" void kernel_launch(void* const* d_in, const int* in_sizes, int n_in, void* d_out, int out_size, void* d_ws, size_t ws_size, hipStream_t stream) {
    static int grid = 0;
    if (grid == 0) {
        if (n_in != 34 || ws_size < WS_END) { fprintf(stderr, "kernel_launch: unexpected n_in %d or ws_size %zu\n", n_in, ws_size); grid = -1; return; }
        int dev = 0, cus = 0, per_cu = 0;
        (void)hipGetDevice(&dev);
        (void)hipDeviceGetAttribute(&cus, hipDeviceAttributeMultiprocessorCount, dev);
        (void)hipFuncSetAttribute((const void*)fwd_kernel, hipFuncAttributeMaxDynamicSharedMemorySize, LDS_BYTES);
        (void)hipOccupancyMaxActiveBlocksPerMultiprocessor(&per_cu, (const void*)fwd_kernel, NTHREADS, LDS_BYTES);
        if (per_cu < 1) { fprintf(stderr, "kernel_launch: occupancy query says %d blocks/CU\n", per_cu); per_cu = 1; }
        grid = cus * per_cu;
        if (grid != 256) { fprintf(stderr, "kernel_launch: this kernel is built for a 256-workgroup resident grid (256 CUs x 1), got %d\n", grid); grid = -1; return; }
    }
    if (grid < 0) return;
    (void)hipMemsetAsync(d_ws, 0, 262144, stream);
    Params prm{};
    for (int i = 0; i < 34; ++i) prm.in[i] = (const float*)d_in[i];
    prm.out = (float*)d_out; prm.ws = (unsigned char*)d_ws;
#if N_LAUNCH_MODE == 1
    for (int ph = 0; ph < N_PHASES; ++ph) {
        prm.ph_lo = ph; prm.ph_hi = ph + 1;
        hipLaunchKernelGGL(fwd_kernel, dim3(grid), dim3(NTHREADS), LDS_BYTES, stream, prm);
    }
#else
    prm.ph_lo = 0; prm.ph_hi = N_PHASES;
    void* args[] = {&prm};
    hipError_t e = hipLaunchCooperativeKernel((const void*)fwd_kernel, dim3(grid), dim3(NTHREADS), args, LDS_BYTES, stream);
    if (e != hipSuccess) fprintf(stderr, "cooperative launch failed: %s (grid %d)\n", hipGetErrorString(e), grid);
#endif
}
```

```cpp
#include <hip/hip_runtime.h>
#include <hip/hip_cooperative_groups.h>
#include <cstdint>
#include <cstdio>
namespace cg = cooperative_groups;

#ifndef N_LAUNCH_MODE
#define N_LAUNCH_MODE 0
#endif

typedef unsigned short bf16_t;
typedef short bf16x8 __attribute__((ext_vector_type(8)));
typedef float f32x4 __attribute__((ext_vector_type(4)));
typedef unsigned u32x4 __attribute__((ext_vector_type(4)));
typedef unsigned u32x2 __attribute__((ext_vector_type(2)));
#define DEV __device__ __forceinline__

constexpr int NB = 8, SEQ = 4096, DM = 1024, NT = NB * SEQ;
constexpr int MEML = 256, NMEM = NB * MEML;
constexpr int EIN = 2328, EINP = 2560;
constexpr int C_AV = 0, C_AG = 512, C_Q = 1024, C_KC = 1536, C_VC = 1664, C_KS = 1792, C_VS = 1920, C_KW = 2048, C_VW = 2176, C_GL = 2304;
constexpr int NCMP = 255;
constexpr int NEXP = 32, EH = 512, LCAP = 32768;
constexpr float DN_ALPHA = 1.41421356237f;
constexpr float LN_EPS = 1e-5f;
constexpr int NWAVES = 8, NTHREADS = 512;

constexpr size_t MiB = 1u << 20;
constexpr size_t WS_CTL = 0;
constexpr size_t WS_CMPB = 1 * MiB;
constexpr size_t WS_CMPP = 1 * MiB + 393216;
constexpr size_t WS_MSEL = 1 * MiB + 65536;
constexpr size_t WS_RWB = 1 * MiB + 524288;
constexpr size_t WS_KCMP = 2 * MiB;
constexpr size_t WS_VCMP = 3 * MiB;
constexpr size_t WS_PK = 4 * MiB;
constexpr size_t WS_PV = 12 * MiB;
constexpr size_t WS_LIST = 20 * MiB;
constexpr size_t WS_GATE = 24 * MiB;
constexpr size_t WS_APOS = 24 * MiB + 262144;
constexpr size_t WS_MEMB = 25 * MiB;
constexpr size_t WS_MEMK = 29 * MiB;
constexpr size_t WS_MEMV = 33 * MiB;
constexpr size_t WS_XBUF = 37 * MiB;
constexpr size_t WS_W_IN = 40 * MiB;
constexpr size_t WS_W_OUT = 45 * MiB;
constexpr size_t WS_OD_IN = 47 * MiB;
constexpr size_t WS_OD_OUT = 53 * MiB;
constexpr size_t WS_WQ = 55 * MiB;
constexpr size_t WS_WO = 59 * MiB;
constexpr size_t WS_WK = 63 * MiB;
constexpr size_t WS_WV = 65 * MiB;
constexpr size_t WS_CW1 = 67 * MiB;
constexpr size_t WS_W13 = 72 * MiB;
constexpr size_t WS_W2 = 136 * MiB;
constexpr size_t WS_XA = 168 * MiB;
constexpr size_t WS_XB = 232 * MiB;
constexpr size_t WS_SCR = 296 * MiB;
constexpr size_t WS_MT = 520 * MiB;
constexpr size_t WS_NT = 536 * MiB;
constexpr size_t WS_W2B = 552 * MiB;
constexpr size_t WS_END = 568 * MiB;
constexpr size_t SC_Y0 = WS_SCR;
constexpr size_t SC_CAT = WS_SCR + 160 * MiB;
constexpr size_t SC_Z = WS_SCR;
constexpr size_t SC_Q = WS_SCR;
constexpr size_t SC_P = WS_SCR + 64 * MiB;
constexpr size_t SC_CTX = WS_SCR + 128 * MiB;
constexpr size_t SC_H = WS_SCR;
constexpr size_t SC_Y = WS_SCR + 80 * MiB;

DEV float bf2f(bf16_t b) { return __uint_as_float(((unsigned)b) << 16); }
DEV unsigned f2bf(float f) { unsigned u = __float_as_uint(f); return (u + 0x7fffu + ((u >> 16) & 1u)) >> 16; }
DEV unsigned pk2(float lo, float hi) { typedef float f2_t __attribute__((ext_vector_type(2))); typedef __bf16 b2_t __attribute__((ext_vector_type(2))); f2_t v = {lo, hi}; b2_t b = __builtin_convertvector(v, b2_t); return __builtin_bit_cast(unsigned, b); }
DEV float wsum(float v) {
#pragma unroll
    for (int o = 1; o < 64; o <<= 1) v += __shfl_xor(v, o);
    return v;
}
DEV float wsum_dpp(float v) {
#define DPP_ADD(ctrl, rmask) v += __builtin_bit_cast(float, __builtin_amdgcn_update_dpp(0, __builtin_bit_cast(int, v), ctrl, rmask, 0xF, false))
    DPP_ADD(0xB1, 0xF);
    DPP_ADD(0x4E, 0xF);
    DPP_ADD(0x141, 0xF);
    DPP_ADD(0x140, 0xF);
    DPP_ADD(0x142, 0xA);
    DPP_ADD(0x143, 0xC);
#undef DPP_ADD
    return __builtin_bit_cast(float, __builtin_amdgcn_readlane(__builtin_bit_cast(int, v), 63));
}
DEV float gsum16(float v) { v += __shfl_xor(v, 1); v += __shfl_xor(v, 2); v += __shfl_xor(v, 4); v += __shfl_xor(v, 8); return v; }
DEV float frcp(float x) { return __builtin_amdgcn_rcpf(x); }
DEV float sigmoidf_(float x) { return frcp(1.f + __expf(-x)); }
DEV float siluf_(float x) { return x * frcp(1.f + __expf(-x)); }
DEV float gelu_tanh(float x) { const float u = 0.7978845608028654f * (x + 0.044715f * x * x * x); return 0.5f * x * (1.f + tanhf(u)); }
#define LDS_WAIT() asm volatile("s_waitcnt lgkmcnt(0)" ::: "memory")
DEV void ld4bf(const bf16_t* p, float* o) { const u32x2 w = *(const u32x2*)p; o[0] = __uint_as_float(w.x << 16); o[1] = __uint_as_float(w.x & 0xffff0000u); o[2] = __uint_as_float(w.y << 16); o[3] = __uint_as_float(w.y & 0xffff0000u); }
DEV void st4bf(bf16_t* p, float a, float b, float c, float d) { u32x2 w; w.x = pk2(a, b); w.y = pk2(c, d); *(u32x2*)p = w; }

DEV const float* gptr(const float* x) { return (const float*)(const __attribute__((address_space(1))) float*)x; }
struct Params {
    const float* in[34];
    float* out;
    unsigned char* ws;
    int ph_lo, ph_hi;
};
typedef const __attribute__((address_space(4))) Params* KParams;
struct Ctx {
    KParams p;
    unsigned char* ws;
    float* lds;
    int tid, lane, wave, gw, ngw;
};

namespace pg8 {
#define PG8_LAS __attribute__((address_space(3)))
constexpr int BM = 256, BK = 64, HALF = 128, HTB = HALF * BK * 2, STAGE_BYTES = 8 * HTB, NXCD = 8, WGM = 8;
DEV int lds_byte(int r, int c) { const int st = (r >> 4) * 2 + (c >> 5), rr = r & 15, cc = c & 31, ob = rr * 64 + cc * 2; return st * 1024 + (ob ^ (((ob >> 9) & 1) << 5)); }
DEV void stage_rc(int b, int& R, int& C) { const int st = b / 1024, sb = b % 1024, swz = sb ^ (((sb >> 9) & 1) << 5); R = (st >> 1) * 16 + swz / 64; C = (st & 1) * 32 + (swz % 64) / 2; }
DEV int perm32(int rho) { const int n = rho >> 4, i = rho & 15; return 8 * (i >> 2) + 4 * n + (i & 3); }
struct Unit { int pm, pn, aux; };
struct StaticOrder {
    int nM, nN, nwg, G, c;
    DEV void init(int M, int N, int G_, int c_) { nM = M / BM; nN = N / BM; nwg = nM * nN; G = G_; c = c_; }
    DEV bool next(int i, Unit& u) const {
        const long L = (long)i * G + c; if (L >= nwg) return false;
        int wgid = (int)L; { const int q = nwg / NXCD, r = nwg % NXCD, xcd = wgid % NXCD, off = wgid / NXCD; wgid = (xcd < r ? xcd * (q + 1) : r * (q + 1) + (xcd - r) * q) + off; }
        const int nig = WGM * nN, gid = wgid / nig, fm = gid * WGM, gsz = (nM - fm) < WGM ? (nM - fm) : WGM;
        u.pm = fm + ((wgid % nig) % gsz); u.pn = (wgid % nig) / gsz; u.aux = 0; return true;
    }
};
DEV unsigned cvt_pk_bf16(float lo, float hi) { unsigned r; asm volatile("v_cvt_pk_bf16_f32 %0, %1, %2" : "=v"(r) : "v"(lo), "v"(hi)); return r; }
typedef f32x4 Acc[2][2][4][2];

template <class T, class = void> struct has_res_lds { static constexpr bool value = false; };
template <class T> struct has_res_lds<T, decltype((void)T::RES_LDS)> { static constexpr bool value = T::RES_LDS; };
template <class Task, bool DRAINED = false>
DEV void gemm_phase(PG8_LAS unsigned char* lds, const Task& T) {
    int tid = threadIdx.x; asm volatile("" : "+v"(tid));
    const int wid = __builtin_amdgcn_readfirstlane(tid >> 6), lane = tid & 63, wr = wid >> 2, wc = wid & 3, fr = lane & 15, fq = lane >> 4;
    const int nt = T.K / BK;
    int R[2], C[2]; unsigned voffB[2];
#pragma unroll
    for (int i = 0; i < 2; ++i) { stage_rc(tid * 16 + i * 8192, R[i], C[i]); const int Rb = Task::PERM ? ((R[i] & ~31) + perm32(R[i] & 31)) : R[i]; voffB[i] = (unsigned)(Rb * T.ldb() + C[i]) * 2u; }
    const size_t kstepB = (size_t)(BK * 2);
    const size_t hstepB = (size_t)HALF * T.ldb() * 2;
    const unsigned ldsw = (unsigned)wid * 1024u;
    const int aoff = lds_byte(wr * 64 + fr, fq * 8), boff = lds_byte(wc * 32 + fr, fq * 8);
#define PG8_SA(b, h) (((b) * 2 + (h)) * HTB)
#define PG8_SB(b, h) ((4 + (b) * 2 + (h)) * HTB)
#define PG8_STAGE(bufoff, gbase, voff) do { _Pragma("unroll") for (int _i = 0; _i < 2; ++_i) \
        __builtin_amdgcn_global_load_lds((const unsigned*)((const char*)(gbase) + (voff)[_i]), (PG8_LAS unsigned*)(lds + (bufoff) + ldsw + _i * 8192), 16, 0, 0); } while (0)
#define PG8_LDA(dst, b, h) do { _Pragma("unroll") for (int m = 0; m < 4; ++m) _Pragma("unroll") for (int k = 0; k < 2; ++k) dst[m][k] = *(const PG8_LAS bf16x8*)(lds + PG8_SA(b, h) + aoff + m * 2048 + k * 1024); } while (0)
#define PG8_LDB(dst, b, h) do { _Pragma("unroll") for (int n = 0; n < 2; ++n) _Pragma("unroll") for (int k = 0; k < 2; ++k) dst[n][k] = *(const PG8_LAS bf16x8*)(lds + PG8_SB(b, h) + boff + n * 2048 + k * 1024); } while (0)
#define PG8_MMA(ai, bj, At, Bt) do { __builtin_amdgcn_s_setprio(1); _Pragma("unroll") for (int m = 0; m < 4; ++m) _Pragma("unroll") for (int n = 0; n < 2; ++n) _Pragma("unroll") for (int k = 0; k < 2; ++k) \
        acc[ai][bj][m][n] = __builtin_amdgcn_mfma_f32_16x16x32_bf16(Bt[n][k], At[m][k], acc[ai][bj][m][n], 0, 0, 0); __builtin_amdgcn_s_setprio(0); } while (0)
#define PG8_WAIT_V(n) asm volatile("s_waitcnt vmcnt(" #n ")" ::: "memory")
#define PG8_WAIT_L(n) asm volatile("s_waitcnt lgkmcnt(" #n ")" ::: "memory")
#define PG8_BAR __builtin_amdgcn_s_barrier()
#define PG8_SCHED __builtin_amdgcn_sched_barrier(0)
    Unit cur, nxt; int ui = 0;
    if (!T.next(0, cur)) return;
    Acc acc;
#pragma unroll
    for (int a = 0; a < 2; ++a)
#pragma unroll
        for (int b = 0; b < 2; ++b)
#pragma unroll
            for (int m = 0; m < 4; ++m)
#pragma unroll
                for (int n = 0; n < 2; ++n) acc[a][b][m][n] = (f32x4){0.f, 0.f, 0.f, 0.f};
    bf16x8 At[4][2], B0[2][2], B1[2][2];
    unsigned va[2][2], na[2][2];
    T.a_offs(cur, R, C, va);
    const char* cA = T.a_base(cur); const char* cB = T.b_base(cur); size_t kstepA = T.a_kstep(cur), kstepN = kstepA;
    PG8_STAGE(PG8_SB(0, 0), cB, voffB); PG8_STAGE(PG8_SB(0, 1), cB + hstepB, voffB); PG8_STAGE(PG8_SA(0, 0), cA, va[0]); PG8_STAGE(PG8_SA(0, 1), cA, va[1]);
    if (wr == 1) PG8_BAR;
    PG8_WAIT_V(2); PG8_BAR;
    PG8_STAGE(PG8_SB(1, 0), cB + kstepB, voffB); PG8_STAGE(PG8_SA(1, 0), cA + kstepA, va[0]); PG8_STAGE(PG8_SB(1, 1), cB + hstepB + kstepB, voffB);
    PG8_WAIT_V(6); PG8_BAR;
    for (;;) {
        const bool has_next = T.next(ui + 1, nxt);
        const char* nA = cA; const char* nB = cB;
#pragma unroll
        for (int h = 0; h < 2; ++h)
#pragma unroll
            for (int i = 0; i < 2; ++i) na[h][i] = va[h][i];
        kstepN = kstepA;
        if (has_next) { nA = T.a_base(nxt); nB = T.b_base(nxt); T.a_offs(nxt, R, C, na); kstepN = T.a_kstep(nxt); }
        else if constexpr (has_res_lds<Task>::value) { const unsigned long long rb = (unsigned long long)T.res_base(cur);
            nA = (const char*)(((unsigned long long)(unsigned)__builtin_amdgcn_readfirstlane((int)(rb >> 32)) << 32) | (unsigned)__builtin_amdgcn_readfirstlane((int)rb)); nB = nA + 256; kstepN = 128; }
        for (int t = 0; t < nt; t += 2) {
            const bool last = (t == nt - 2);
            const char* a1 = cA + (size_t)(t + 1) * kstepA;
            const char* nAl = nA; const char* nBl = nB;
            if constexpr (has_res_lds<Task>::value) { asm volatile("" : "+s"(nAl), "+s"(nBl)); }
            const char* a2 = last ? nAl : cA + (size_t)(t + 2) * kstepA; const char* b2 = last ? nBl : cB + (size_t)(t + 2) * kstepB;
            const char* a3 = a2 + (last ? kstepN : kstepA); const char* b3 = b2 + kstepB;
            unsigned w2[2][2];
#pragma unroll
            for (int h = 0; h < 2; ++h)
#pragma unroll
                for (int i = 0; i < 2; ++i) w2[h][i] = last ? na[h][i] : va[h][i];
            PG8_LDB(B0, 0, 0); PG8_LDB(B1, 0, 1); PG8_SCHED; PG8_LDA(At, 0, 0); PG8_STAGE(PG8_SA(1, 1), a1, va[1]);
            PG8_WAIT_V(8); PG8_WAIT_L(0); PG8_BAR; PG8_MMA(0, 0, At, B0); PG8_MMA(0, 1, At, B1); PG8_BAR; PG8_SCHED;
            PG8_LDA(At, 0, 1); PG8_STAGE(PG8_SB(0, 0), b2, voffB); PG8_STAGE(PG8_SB(0, 1), b2 + hstepB, voffB); PG8_STAGE(PG8_SA(0, 0), a2, w2[0]);
            PG8_WAIT_V(8); PG8_WAIT_L(0); PG8_BAR; PG8_MMA(1, 0, At, B0); PG8_MMA(1, 1, At, B1); PG8_BAR; PG8_SCHED;
            PG8_LDB(B0, 1, 0); PG8_LDB(B1, 1, 1); PG8_SCHED; PG8_LDA(At, 1, 0); PG8_STAGE(PG8_SA(0, 1), a2, w2[1]);
            PG8_WAIT_V(8); PG8_WAIT_L(0); PG8_BAR; PG8_MMA(0, 0, At, B0); PG8_MMA(0, 1, At, B1); PG8_BAR; PG8_SCHED;
            PG8_LDA(At, 1, 1); PG8_STAGE(PG8_SB(1, 0), b3, voffB); PG8_STAGE(PG8_SB(1, 1), b3 + hstepB, voffB); PG8_STAGE(PG8_SA(1, 0), a3, w2[0]);
            PG8_WAIT_V(8); PG8_WAIT_L(0); PG8_BAR; PG8_MMA(1, 0, At, B0); PG8_MMA(1, 1, At, B1); PG8_BAR; PG8_SCHED;
        }
        if (wr == 0) PG8_BAR;
        if constexpr (has_res_lds<Task>::value) { if (!has_next) PG8_STAGE(PG8_SA(1, 1), nA + kstepN, na[1]); }
        if (!DRAINED || has_next) T.epi(acc, cur, wr, wc, fr, fq);
        if (!has_next) break;
#pragma unroll
        for (int a = 0; a < 2; ++a)
#pragma unroll
            for (int b = 0; b < 2; ++b)
#pragma unroll
                for (int m = 0; m < 4; ++m)
#pragma unroll
                    for (int n = 0; n < 2; ++n) acc[a][b][m][n] = (f32x4){0.f, 0.f, 0.f, 0.f};
        cur = nxt; cA = nA; cB = nB; kstepA = kstepN; ++ui;
#pragma unroll
        for (int h = 0; h < 2; ++h)
#pragma unroll
            for (int i = 0; i < 2; ++i) va[h][i] = na[h][i];
        if (wr == 1) PG8_BAR;
    }
    PG8_WAIT_V(0);
    PG8_BAR;
    if constexpr (DRAINED) T.epi_drained(acc, cur, wr, wc, fr, fq, lds, wid, lane);
#undef PG8_SA
#undef PG8_SB
#undef PG8_STAGE
#undef PG8_LDA
#undef PG8_LDB
#undef PG8_MMA
#undef PG8_WAIT_V
#undef PG8_WAIT_L
#undef PG8_BAR
#undef PG8_SCHED
}

DEV u32x4 lane_tr(u32x4 w, int src4) { w.x = (unsigned)__builtin_amdgcn_ds_bpermute(src4, (int)w.x); w.y = (unsigned)__builtin_amdgcn_ds_bpermute(src4, (int)w.y);
    w.z = (unsigned)__builtin_amdgcn_ds_bpermute(src4, (int)w.z); w.w = (unsigned)__builtin_amdgcn_ds_bpermute(src4, (int)w.w); return w; }
DEV void store_tile_bf16(const Acc& acc, bf16_t* base, int ldc, int wr, int wc, int fr, int fq) {
    const int ln = fq * 16 + fr, src4 = (((ln & 3) << 4) | (ln >> 2)) << 2;
#pragma unroll
    for (int ai = 0; ai < 2; ++ai)
#pragma unroll
        for (int m = 0; m < 4; ++m) { bf16_t* rowp = base + (size_t)(ai * HALF + wr * 64 + m * 16 + (ln >> 2)) * ldc + wc * 32 + 8 * (ln & 3);
#pragma unroll
            for (int bj = 0; bj < 2; ++bj) { const f32x4 v0 = acc[ai][bj][m][0], v1 = acc[ai][bj][m][1];
                u32x4 w; w.x = cvt_pk_bf16(v0[0], v0[1]); w.y = cvt_pk_bf16(v0[2], v0[3]); w.z = cvt_pk_bf16(v1[0], v1[1]); w.w = cvt_pk_bf16(v1[2], v1[3]);
                w.x = (unsigned)__builtin_amdgcn_ds_bpermute(src4, (int)w.x); w.y = (unsigned)__builtin_amdgcn_ds_bpermute(src4, (int)w.y);
                w.z = (unsigned)__builtin_amdgcn_ds_bpermute(src4, (int)w.z); w.w = (unsigned)__builtin_amdgcn_ds_bpermute(src4, (int)w.w);
                *(u32x4*)(rowp + bj * HALF) = w; } }
}
template <class Epi, bool PERM_>
struct PlainTask {
    static constexpr bool PERM = PERM_;
    const bf16_t* A; int lda; const bf16_t* Bt; int ldb_; int K; StaticOrder S; Epi E;
    DEV bool next(int i, Unit& u) const { return S.next(i, u); }
    DEV const char* a_base(const Unit& u) const { return (const char*)(A + (size_t)u.pm * BM * lda); }
    DEV void a_offs(const Unit&, const int (&R)[2], const int (&C)[2], unsigned (&v)[2][2]) const {
#pragma unroll
        for (int h = 0; h < 2; ++h)
#pragma unroll
            for (int i = 0; i < 2; ++i) v[h][i] = (unsigned)((h * HALF + R[i]) * lda + C[i]) * 2u;
    }
    DEV size_t a_kstep(const Unit&) const { return (size_t)(BK * 2); }
    DEV const char* b_base(const Unit& u) const { return (const char*)(Bt + (size_t)u.pn * BM * ldb_); }
    DEV int ldb() const { return ldb_; }
    DEV void epi(Acc& acc, const Unit& u, int wr, int wc, int fr, int fq) const { E(acc, u, wr, wc, fr, fq); }
};
struct EpiBf16 {
    bf16_t* Cc; int ldc;
    DEV void operator()(Acc& acc, const Unit& u, int wr, int wc, int fr, int fq) const { store_tile_bf16(acc, Cc + (size_t)u.pm * BM * ldc + u.pn * BM, ldc, wr, wc, fr, fq); }
};
struct EpiInproj {
    bf16_t* Cc;
    DEV void operator()(Acc& acc, const Unit& u, int wr, int wc, int fr, int fq) const {
        if (u.pn == 4 || u.pn == 5) {
#pragma unroll
            for (int a = 0; a < 2; ++a)
#pragma unroll
                for (int b = 0; b < 2; ++b)
#pragma unroll
                    for (int m = 0; m < 4; ++m)
#pragma unroll
                        for (int n = 0; n < 2; ++n) acc[a][b][m][n] = acc[a][b][m][n] * (0.125f * 1.4426950408889634f);
        }
        const int ln = fq * 16 + fr, src4 = (((ln & 3) << 4) | (ln >> 2)) << 2;
        if (u.pn < 4) {
#pragma unroll
            for (int ai = 0; ai < 2; ++ai)
#pragma unroll
                for (int m = 0; m < 4; ++m) { bf16_t* rowp = Cc + (size_t)(u.pm * BM + ai * HALF + wr * 64 + m * 16 + (ln >> 2)) * EINP + u.pn * HALF + wc * 32 + 8 * (ln & 3);
                    f32x4 h0, h1;
#pragma unroll
                    for (int j = 0; j < 4; ++j) { h0[j] = acc[ai][0][m][0][j] * frcp(1.f + __expf(-acc[ai][1][m][0][j])); h1[j] = acc[ai][0][m][1][j] * frcp(1.f + __expf(-acc[ai][1][m][1][j])); }
                    u32x4 w; w.x = cvt_pk_bf16(h0[0], h0[1]); w.y = cvt_pk_bf16(h0[2], h0[3]); w.z = cvt_pk_bf16(h1[0], h1[1]); w.w = cvt_pk_bf16(h1[2], h1[3]);
                    *(u32x4*)rowp = lane_tr(w, src4); }
            return;
        }
        if (u.pn == 9 && wc != 0) return;
        store_tile_bf16(acc, Cc + (size_t)u.pm * BM * EINP + u.pn * BM, EINP, wr, wc, fr, fq); }
};
struct EpiOdIn {
    bf16_t* Cc;
    DEV void operator()(Acc& acc, const Unit& u, int wr, int wc, int fr, int fq) const {
        const int ln = fq * 16 + fr, src4 = (((ln & 3) << 4) | (ln >> 2)) << 2;
#pragma unroll
        for (int ai = 0; ai < 2; ++ai)
#pragma unroll
            for (int m = 0; m < 4; ++m) { bf16_t* rowp = Cc + (size_t)(u.pm * BM + ai * HALF + wr * 64 + m * 16 + (ln >> 2)) * 2048 + 1024 + u.pn * HALF + wc * 32 + 8 * (ln & 3);
                const f32x4 h0 = acc[ai][0][m][0] * acc[ai][1][m][0], h1 = acc[ai][0][m][1] * acc[ai][1][m][1];
                u32x4 w; w.x = cvt_pk_bf16(h0[0], h0[1]); w.y = cvt_pk_bf16(h0[2], h0[3]); w.z = cvt_pk_bf16(h1[0], h1[1]); w.w = cvt_pk_bf16(h1[2], h1[3]);
                *(u32x4*)rowp = lane_tr(w, src4); }
    }
};
struct EpiOd1 {
    bf16_t* Cc;
    DEV void operator()(Acc& acc, const Unit& u, int wr, int wc, int fr, int fq) const {
        if (u.pn < 4) { store_tile_bf16(acc, Cc + (size_t)u.pm * BM * 2048 + u.pn * BM, 2048, wr, wc, fr, fq); return; }
        Unit v = u; v.pn = u.pn - 4; EpiOdIn{Cc}(acc, v, wr, wc, fr, fq); }
};
struct EpiBf16S {
    bf16_t* Cc; int ldc; float scale;
    DEV void operator()(Acc& acc, const Unit& u, int wr, int wc, int fr, int fq) const {
#pragma unroll
        for (int a = 0; a < 2; ++a)
#pragma unroll
            for (int b = 0; b < 2; ++b)
#pragma unroll
                for (int m = 0; m < 4; ++m)
#pragma unroll
                    for (int n = 0; n < 2; ++n) acc[a][b][m][n] = acc[a][b][m][n] * scale;
        store_tile_bf16(acc, Cc + (size_t)u.pm * BM * ldc + u.pn * BM, ldc, wr, wc, fr, fq); }
};
}

namespace pg8 {
constexpr int LDS_SPARE = STAGE_BYTES;
DEV void store_tile_f32_perm(const Acc& acc, float* base, int ldc, int wr, int wc, int fr, int fq) {
#pragma unroll
    for (int ai = 0; ai < 2; ++ai)
#pragma unroll
        for (int m = 0; m < 4; ++m) { float* rowp = base + (size_t)(ai * HALF + wr * 64 + m * 16 + fr) * ldc + wc * 32 + 8 * fq;
#pragma unroll
            for (int bj = 0; bj < 2; ++bj) { *(f32x4*)(rowp + bj * HALF) = acc[ai][bj][m][0]; *(f32x4*)(rowp + bj * HALF + 4) = acc[ai][bj][m][1]; } }
}
struct CmpTask {
    static constexpr bool PERM = true;
    int K; unsigned char* ws; int id;
    DEV bool next(int i, Unit& u) const { if (i > 0 || id >= 64) return false; u.aux = id >> 5; u.pm = (id >> 1) & 15; u.pn = id & 1; return true; }
    DEV const char* a_base(const Unit& u) const { return (const char*)(ws + SC_Y0) + (u.aux ? C_VC : C_KC) * 2; }
    DEV void a_offs(const Unit& u, const int (&R)[2], const int (&C)[2], unsigned (&v)[2][2]) const {
#pragma unroll
        for (int h = 0; h < 2; ++h)
#pragma unroll
            for (int i = 0; i < 2; ++i) { const int m = u.pm * BM + h * HALF + R[i], g = m & 1, bj = m >> 1; v[h][i] = (unsigned)(((size_t)bj * 16 * EINP + g * 64 + C[i]) * 2); } }
    DEV size_t a_kstep(const Unit&) const { return (size_t)EINP * 2; }
    DEV const char* b_base(const Unit& u) const { return (const char*)(ws + WS_CW1) + ((size_t)u.aux * 512 + (size_t)u.pn * BM) * DM * 2; }
    DEV int ldb() const { return DM; }
    DEV void epi(Acc& acc, const Unit& u, int wr, int wc, int fr, int fq) const { store_tile_f32_perm(acc, (float*)(ws + (u.aux ? WS_PV : WS_PK)) + (size_t)u.pm * BM * 512 + u.pn * BM, 512, wr, wc, fr, fq); }
};
struct OneUnitTask {
    static constexpr bool PERM = true;
    int K; const bf16_t* A; const bf16_t* Bt; bf16_t* Cc; int ldc; size_t cm, cn; int pm, pn; bool on; float scale;
    DEV bool next(int i, Unit& u) const { if (i > 0 || !on) return false; u.pm = pm; u.pn = pn; u.aux = 0; return true; }
    DEV const char* a_base(const Unit& u) const { return (const char*)(A + (size_t)u.pm * BM * DM); }
    DEV void a_offs(const Unit&, const int (&R)[2], const int (&C)[2], unsigned (&v)[2][2]) const {
#pragma unroll
        for (int h = 0; h < 2; ++h)
#pragma unroll
            for (int i = 0; i < 2; ++i) v[h][i] = (unsigned)((h * HALF + R[i]) * DM + C[i]) * 2u; }
    DEV size_t a_kstep(const Unit&) const { return (size_t)(BK * 2); }
    DEV const char* b_base(const Unit& u) const { return (const char*)(Bt + (size_t)u.pn * BM * DM); }
    DEV int ldb() const { return DM; }
    DEV void epi(Acc& acc, const Unit& u, int wr, int wc, int fr, int fq) const {
        if (scale != 1.f) {
#pragma unroll
            for (int a = 0; a < 2; ++a)
#pragma unroll
                for (int b = 0; b < 2; ++b)
#pragma unroll
                    for (int m = 0; m < 4; ++m)
#pragma unroll
                        for (int n = 0; n < 2; ++n) acc[a][b][m][n] = acc[a][b][m][n] * scale; }
        store_tile_bf16(acc, Cc + (size_t)u.pm * cm + (size_t)u.pn * cn, ldc, wr, wc, fr, fq); }
};
struct XaSTask {
    static constexpr bool PERM = true;
    int K; const bf16_t* Q; const bf16_t* MK; bf16_t* P; PG8_LAS unsigned char* lds; StaticOrder S;
    DEV bool next(int i, Unit& u) const { return S.next(i, u); }
    DEV const char* a_base(const Unit& u) const { return (const char*)(Q + (size_t)u.pm * BM * DM); }
    DEV void a_offs(const Unit&, const int (&R)[2], const int (&C)[2], unsigned (&v)[2][2]) const {
#pragma unroll
        for (int h = 0; h < 2; ++h)
#pragma unroll
            for (int i = 0; i < 2; ++i) v[h][i] = (unsigned)((h * HALF + R[i]) * DM + C[i]) * 2u; }
    DEV size_t a_kstep(const Unit&) const { return (size_t)(BK * 2); }
    DEV const char* b_base(const Unit& u) const { return (const char*)(MK + ((size_t)(u.pm >> 4) * DM + (size_t)u.pn * 256) * DM); }
    DEV int ldb() const { return DM; }
    DEV void epi(Acc& acc, const Unit& u, int wr, int wc, int fr, int fq) const {
        typedef float f32x2v __attribute__((ext_vector_type(2)));
        PG8_LAS f32x2v* tab = (PG8_LAS f32x2v*)(lds + LDS_SPARE);
        float mloc[2][4];
#pragma unroll
        for (int ai = 0; ai < 2; ++ai)
#pragma unroll
            for (int m = 0; m < 4; ++m) { float v = -INFINITY;
#pragma unroll
                for (int bj = 0; bj < 2; ++bj)
#pragma unroll
                    for (int n = 0; n < 2; ++n) { const f32x4 x = acc[ai][bj][m][n]; v = fmaxf(v, fmaxf(fmaxf(x[0], x[1]), fmaxf(x[2], x[3]))); }
                v = fmaxf(v, __shfl_xor(v, 16)); v = fmaxf(v, __shfl_xor(v, 32));
                float sw = 0.f;
#pragma unroll
                for (int bj = 0; bj < 2; ++bj)
#pragma unroll
                    for (int n = 0; n < 2; ++n) { f32x4 x = acc[ai][bj][m][n];
#pragma unroll
                        for (int j = 0; j < 4; ++j) { x[j] = __builtin_amdgcn_exp2f(x[j] - v); sw += x[j]; }
                        acc[ai][bj][m][n] = x; }
                sw += __shfl_xor(sw, 16); sw += __shfl_xor(sw, 32);
                mloc[ai][m] = v;
                if (fq == 0) tab[(ai * HALF + wr * 64 + m * 16 + fr) * 4 + wc] = (f32x2v){v, sw}; }
        asm volatile("s_waitcnt lgkmcnt(0)" ::: "memory"); __builtin_amdgcn_s_barrier(); asm volatile("" ::: "memory");
#pragma unroll
        for (int ai = 0; ai < 2; ++ai)
#pragma unroll
            for (int m = 0; m < 4; ++m) { const int row = ai * HALF + wr * 64 + m * 16 + fr;
                const f32x4 t0 = *(const PG8_LAS f32x4*)(tab + row * 4), t1 = *(const PG8_LAS f32x4*)(tab + row * 4 + 2);
                const float M = fmaxf(fmaxf(t0[0], t0[2]), fmaxf(t1[0], t1[2]));
                const float tot = (t0[1] * __builtin_amdgcn_exp2f(t0[0] - M) + t0[3] * __builtin_amdgcn_exp2f(t0[2] - M)) + (t1[1] * __builtin_amdgcn_exp2f(t1[0] - M) + t1[3] * __builtin_amdgcn_exp2f(t1[2] - M));
                const float fac = __builtin_amdgcn_exp2f(mloc[ai][m] - M) * frcp(tot);
#pragma unroll
                for (int bj = 0; bj < 2; ++bj)
#pragma unroll
                    for (int n = 0; n < 2; ++n) acc[ai][bj][m][n] = acc[ai][bj][m][n] * fac; }
        store_tile_bf16(acc, P + (size_t)u.pm * BM * DM + u.pn * 256, DM, wr, wc, fr, fq);
        asm volatile("s_waitcnt lgkmcnt(0)" ::: "memory"); __builtin_amdgcn_s_barrier(); asm volatile("" ::: "memory");
    }
};
DEV void moe_build_tab(const int* cnt, PG8_LAS int* tab) {
    if (threadIdx.x < 64) { const int lane = threadIdx.x; const int ce = (lane < NEXP) ? cnt[lane] : 0; const int k = (ce + 255) >> 8; int incl = k;
#pragma unroll
        for (int o = 1; o < 32; o <<= 1) { const int t = __shfl_up(incl, o); if (lane >= o) incl += t; }
        const int base = incl - k;
        for (int j = 0; j < k; ++j) tab[1 + base + j] = (lane << 16) | j;
        if (lane < NEXP) tab[512 + lane] = ce;
        if (lane == NEXP - 1) tab[0] = incl; }
    asm volatile("s_waitcnt lgkmcnt(0)" ::: "memory"); __syncthreads();
}
struct Moe1Task {
    static constexpr bool PERM = true;
    int K; const bf16_t* X; const bf16_t* W13; bf16_t* H; const int* cnt; const int* list; const PG8_LAS int* tab; int G, c;
    DEV bool next(int i, Unit& u) const { const int vc = (G % 8 == 0) ? (c % 8) * (G / 8) + c / 8 : c;
        const int id = i * G + vc, rb = id >> 2; if (rb >= tab[0]) return false; u.pm = rb; u.pn = id & 3; u.aux = tab[1 + rb]; return true; }
    DEV const char* a_base(const Unit&) const { return (const char*)X; }
    DEV void a_offs(const Unit& u, const int (&R)[2], const int (&C)[2], unsigned (&v)[2][2]) const {
        const int e = u.aux >> 16, lb = u.aux & 0xffff, ce = tab[512 + e];
#pragma unroll
        for (int h = 0; h < 2; ++h)
#pragma unroll
            for (int i = 0; i < 2; ++i) { const int r = lb * BM + h * HALF + R[i]; const int tok = (r < ce) ? (list[e * LCAP + r] >> 1) : 0; v[h][i] = (unsigned)(tok * DM + C[i]) * 2u; } }
    DEV size_t a_kstep(const Unit&) const { return (size_t)(BK * 2); }
    DEV const char* b_base(const Unit& u) const { return (const char*)(W13 + ((size_t)(u.aux >> 16) * DM + (size_t)u.pn * BM) * DM); }
    DEV int ldb() const { return DM; }
    DEV void epi(Acc& acc, const Unit& u, int wr, int wc, int fr, int fq) const {
        const int ln = fq * 16 + fr, src4 = (((ln & 3) << 4) | (ln >> 2)) << 2;
#pragma unroll
        for (int ai = 0; ai < 2; ++ai)
#pragma unroll
            for (int m = 0; m < 4; ++m) { bf16_t* rowp = H + (size_t)(u.pm * BM + ai * HALF + wr * 64 + m * 16 + (ln >> 2)) * EH + u.pn * HALF + wc * 32 + 8 * (ln & 3);
                f32x4 h0, h1;
#pragma unroll
                for (int j = 0; j < 4; ++j) { const float a = acc[ai][0][m][0][j], b = acc[ai][0][m][1][j]; h0[j] = a * frcp(1.f + __expf(-a)) * acc[ai][1][m][0][j]; h1[j] = b * frcp(1.f + __expf(-b)) * acc[ai][1][m][1][j]; }
                u32x4 w; w.x = cvt_pk_bf16(h0[0], h0[1]); w.y = cvt_pk_bf16(h0[2], h0[3]); w.z = cvt_pk_bf16(h1[0], h1[1]); w.w = cvt_pk_bf16(h1[2], h1[3]);
                *(u32x4*)rowp = lane_tr(w, src4); }
    }
};
struct Moe2Task {
    static constexpr bool PERM = true;
    int K; const bf16_t* H; const bf16_t* W2; bf16_t* Y; const int* cnt; const int* list; const float* gate; const PG8_LAS int* tab; int G, c; const bf16_t* W2b;
    DEV bool next(int i, Unit& u) const { const int vc = (G % 8 == 0) ? (c % 8) * (G / 8) + c / 8 : c;
        const int id = i * G + vc, rb = id >> 2; if (rb >= tab[0]) return false; u.pm = rb; u.pn = id & 3; u.aux = tab[1 + rb]; return true; }
    DEV const char* a_base(const Unit& u) const { return (const char*)(H + (size_t)u.pm * BM * EH); }
    DEV void a_offs(const Unit&, const int (&R)[2], const int (&C)[2], unsigned (&v)[2][2]) const {
#pragma unroll
        for (int h = 0; h < 2; ++h)
#pragma unroll
            for (int i = 0; i < 2; ++i) v[h][i] = (unsigned)((h * HALF + R[i]) * EH + C[i]) * 2u; }
    DEV size_t a_kstep(const Unit&) const { return (size_t)(BK * 2); }
    DEV const char* b_base(const Unit& u) const { const int e = u.aux >> 16; const bf16_t* w = (W2b != nullptr && e >= 16) ? W2b + (size_t)(e - 16) * DM * EH : W2 + (size_t)e * DM * EH; return (const char*)(w + (size_t)u.pn * BM * EH); }
    DEV int ldb() const { return EH; }
    DEV void epi(Acc& acc, const Unit& u, int wr, int wc, int fr, int fq) const { store_tile_bf16(acc, Y + (size_t)u.pm * BM * DM + u.pn * BM, DM, wr, wc, fr, fq); }
};
}

namespace pg8 {
struct PanelStats {
    unsigned long long* xbuf;
    unsigned* cnt;
    DEV void run(const Acc& v, int panel, int pn, int wr, int wc, int fr, int fq, PG8_LAS unsigned char* lds, int wid, int lane) const {
        typedef float f32x2v __attribute__((ext_vector_type(2)));
        PG8_LAS f32x2v* P = (PG8_LAS f32x2v*)lds;
        PG8_LAS f32x2v* S = (PG8_LAS f32x2v*)(lds + 8192);
#pragma unroll
        for (int ai = 0; ai < 2; ++ai)
#pragma unroll
            for (int m = 0; m < 4; ++m) {
                float s = 0.f;
#pragma unroll
                for (int bj = 0; bj < 2; ++bj)
#pragma unroll
                    for (int n = 0; n < 2; ++n) { const f32x4 x = v[ai][bj][m][n]; s += (x[0] + x[1]) + (x[2] + x[3]); }
                s += __shfl_xor(s, 16); s += __shfl_xor(s, 32);
                const float mw = s * (1.0f / 64.0f); float q = 0.f;
#pragma unroll
                for (int bj = 0; bj < 2; ++bj)
#pragma unroll
                    for (int n = 0; n < 2; ++n) { const f32x4 d = v[ai][bj][m][n] - mw; q += (d[0] * d[0] + d[1] * d[1]) + (d[2] * d[2] + d[3] * d[3]); }
                q += __shfl_xor(q, 16); q += __shfl_xor(q, 32);
                if (fq == 0) P[(ai * HALF + wr * 64 + m * 16 + fr) * 4 + wc] = (f32x2v){mw, q};
            }
        asm volatile("s_waitcnt lgkmcnt(0)" ::: "memory"); __builtin_amdgcn_s_barrier(); asm volatile("" ::: "memory");
        const int row = wid * 32 + (lane & 31);
        if (lane < 32) {
            const f32x2v a = P[row * 4 + 0], b = P[row * 4 + 1], c = P[row * 4 + 2], d = P[row * 4 + 3];
            const float mt = (a.x + b.x + c.x + d.x) * 0.25f;
            const float da = a.x - mt, db = b.x - mt, dc = c.x - mt, dd = d.x - mt;
            const float m2 = (a.y + b.y) + (c.y + d.y) + 64.0f * ((da * da + db * db) + (dc * dc + dd * dd));
            unsigned long long* slot = xbuf + ((size_t)(panel * BM + row) * 4 + pn);
            __hip_atomic_store(slot, ((unsigned long long)__float_as_uint(m2) << 32) | __float_as_uint(mt), __ATOMIC_RELAXED, __HIP_MEMORY_SCOPE_AGENT);
        }
        asm volatile("s_waitcnt vmcnt(0)" ::: "memory");
        if (lane == 0) __hip_atomic_fetch_add(cnt + 64 * panel, 1u, __ATOMIC_RELAXED, __HIP_MEMORY_SCOPE_AGENT);
        if (wid == 0) {
            unsigned sp = 0;
            while ((unsigned)__builtin_amdgcn_readfirstlane(__hip_atomic_load(cnt + 64 * panel, __ATOMIC_RELAXED, __HIP_MEMORY_SCOPE_AGENT)) < 32u) { __builtin_amdgcn_s_sleep(1); if (++sp > (1u << 22)) break; }
        }
        asm volatile("s_waitcnt vmcnt(0) lgkmcnt(0)" ::: "memory"); __builtin_amdgcn_s_barrier(); asm volatile("" ::: "memory");
        if (lane < 32) {
            const unsigned long long* slot = xbuf + (size_t)(panel * BM + row) * 4; float mt[4], m2[4]; float ms = 0.f;
#pragma unroll
            for (int t = 0; t < 4; ++t) { const unsigned long long w = __hip_atomic_load(slot + t, __ATOMIC_RELAXED, __HIP_MEMORY_SCOPE_AGENT); mt[t] = __uint_as_float((unsigned)w); m2[t] = __uint_as_float((unsigned)(w >> 32)); ms += mt[t]; }
            const float mean = ms * 0.25f; float q = 0.f;
#pragma unroll
            for (int t = 0; t < 4; ++t) { const float dm = mt[t] - mean; q += m2[t] + 256.0f * dm * dm; }
            S[row] = (f32x2v){mean, rsqrtf(q * (1.0f / 1024.0f) + LN_EPS)};
        }
        asm volatile("s_waitcnt lgkmcnt(0)" ::: "memory"); __builtin_amdgcn_s_barrier(); asm volatile("" ::: "memory");
    }
};
template <bool RES_F32>
struct LnTask {
    static constexpr bool PERM = true;
    int K; const bf16_t* A; int lda; const bf16_t* Bt; const void* res; const float* g; const float* b; bf16_t* X; int row0; PanelStats st; StaticOrder S; size_t bstride;
    DEV bool next(int i, Unit& u) const { return i == 0 && S.next(0, u); }
    DEV const char* a_base(const Unit& u) const { return (const char*)(A + (size_t)(row0 + u.pm * BM) * lda); }
    DEV void a_offs(const Unit&, const int (&R)[2], const int (&C)[2], unsigned (&v)[2][2]) const {
#pragma unroll
        for (int h = 0; h < 2; ++h)
#pragma unroll
            for (int i = 0; i < 2; ++i) v[h][i] = (unsigned)((h * HALF + R[i]) * lda + C[i]) * 2u; }
    DEV size_t a_kstep(const Unit&) const { return (size_t)(BK * 2); }
    DEV const char* b_base(const Unit& u) const { return (const char*)(Bt + (size_t)((row0 / BM + u.pm) >> 4) * bstride + (size_t)u.pn * BM * DM); }
    DEV int ldb() const { return DM; }
    DEV void epi(Acc&, const Unit&, int, int, int, int) const {}
    static constexpr bool RES_LDS = !RES_F32;
    DEV const char* res_base(const Unit& u) const { return (const char*)((const bf16_t*)res + (size_t)(row0 + u.pm * BM) * DM + (size_t)u.pn * BM); }
    DEV void epi_drained(Acc& acc, const Unit& u, int wr, int wc, int fr, int fq, PG8_LAS unsigned char* lds, int wid, int lane) const {
        typedef float f32x2v __attribute__((ext_vector_type(2)));
        const int colb = u.pn * BM + wc * 32 + 8 * fq;
#pragma unroll
        for (int ai = 0; ai < 2; ++ai)
#pragma unroll
            for (int m = 0; m < 4; ++m) { const size_t roff = (size_t)(row0 + u.pm * BM + ai * HALF + wr * 64 + m * 16 + fr) * DM + colb;
#pragma unroll
                for (int bj = 0; bj < 2; ++bj) { f32x4 r0, r1;
                    if (RES_F32) { r0 = *(const f32x4*)((const float*)res + roff + bj * HALF); r1 = *(const f32x4*)((const float*)res + roff + bj * HALF + 4); }
                    else { const int rl = wr * 64 + m * 16 + fr, x5 = (m & 1) * 16 + fr;
                        const int rq = bj ? ((rl & ~31) + 16 * ((x5 >> 2) & 1) + 4 * (x5 >> 3) + (x5 & 3)) : rl;
                        const u32x4 w = *(const PG8_LAS u32x4*)(lds + ((bj ? 4 : 0) + (wc >> 1) * 2 + ai) * HTB + lds_byte(rq, (wc & 1) * 32 + 8 * fq));
                        r0 = (f32x4){__uint_as_float(w.x << 16), __uint_as_float(w.x & 0xffff0000u), __uint_as_float(w.y << 16), __uint_as_float(w.y & 0xffff0000u)};
                        r1 = (f32x4){__uint_as_float(w.z << 16), __uint_as_float(w.z & 0xffff0000u), __uint_as_float(w.w << 16), __uint_as_float(w.w & 0xffff0000u)}; }
                    acc[ai][bj][m][0] = r0 * DN_ALPHA + acc[ai][bj][m][0]; acc[ai][bj][m][1] = r1 * DN_ALPHA + acc[ai][bj][m][1]; }
                asm volatile("" : "+v"(acc[ai][0][m][0]), "+v"(acc[ai][0][m][1]), "+v"(acc[ai][1][m][0]), "+v"(acc[ai][1][m][1]));
                asm volatile("" ::: "memory"); }
        f32x4 gb[2][4];
#pragma unroll
        for (int bj = 0; bj < 2; ++bj) { gb[bj][0] = *(const f32x4*)(g + colb + bj * HALF); gb[bj][1] = *(const f32x4*)(g + colb + bj * HALF + 4); gb[bj][2] = *(const f32x4*)(b + colb + bj * HALF); gb[bj][3] = *(const f32x4*)(b + colb + bj * HALF + 4); }
        st.run(acc, row0 / BM + u.pm, u.pn, wr, wc, fr, fq, lds + LDS_SPARE, wid, lane);
        const PG8_LAS f32x2v* Stab = (const PG8_LAS f32x2v*)(lds + LDS_SPARE + 8192);
        const int ln = fq * 16 + fr, src4 = (((ln & 3) << 4) | (ln >> 2)) << 2;
#pragma unroll
        for (int bj = 0; bj < 2; ++bj) {
            const f32x4 g0 = gb[bj][0], g1 = gb[bj][1], b0 = gb[bj][2], b1 = gb[bj][3];
#pragma unroll
            for (int ai = 0; ai < 2; ++ai)
#pragma unroll
                for (int m = 0; m < 4; ++m) { const int r = ai * HALF + wr * 64 + m * 16 + fr; const f32x2v sr = Stab[r];
                    const f32x4 y0 = (acc[ai][bj][m][0] - sr.x) * sr.y * g0 + b0, y1 = (acc[ai][bj][m][1] - sr.x) * sr.y * g1 + b1;
                    u32x4 w; w.x = cvt_pk_bf16(y0[0], y0[1]); w.y = cvt_pk_bf16(y0[2], y0[3]); w.z = cvt_pk_bf16(y1[0], y1[1]); w.w = cvt_pk_bf16(y1[2], y1[3]);
                    *(u32x4*)(X + (size_t)(row0 + u.pm * BM + r - fr + (ln >> 2)) * DM + u.pn * BM + wc * 32 + 8 * (ln & 3) + bj * HALF) = lane_tr(w, src4); }
        }
        asm volatile("s_waitcnt lgkmcnt(0)" ::: "memory"); __builtin_amdgcn_s_barrier(); asm volatile("" ::: "memory");
    }
};
}

DEV int tr_rowmap(int kind, int n) {
    if (kind == 1) return (n >= 1024) ? n : ((n < 512) ? ((n >> 7) * 256 + (n & 127)) : (((n - 512) >> 7) * 256 + 128 + (n & 127)));
    if (kind == 4) return (n < 1024) ? n : ((n < 2048) ? (1024 + ((n - 1024) >> 7) * 256 + (n & 127)) : (1024 + ((n - 2048) >> 7) * 256 + 128 + (n & 127)));
    if (kind == 2) return (n >> 7) * 256 + (n & 127);
    if (kind == 3) return (n >> 7) * 256 + 128 + (n & 127);
    return n;
}
struct TrItem { const float* W; int ldw, N; bf16_t* WT; int ldd, kind, kb, nb; bool on; };
DEV void tr_load(const TrItem& t, f32x4 (&v)[16], int lane) {
    const int k0 = 64 * t.kb, nn = 64 * t.nb + (lane & 15) * 4;
#pragma unroll
    for (int i = 0; i < 16; ++i) { const int kk = (lane >> 4) + 4 * i; v[i] = (t.on && nn < t.N) ? *(const f32x4*)(t.W + (size_t)(k0 + kk) * t.ldw + nn) : (f32x4){0.f, 0.f, 0.f, 0.f}; }
}
DEV void tr_store(const TrItem& t, const f32x4 (&v)[16], float* scr, int lane) {
    const int k0 = 64 * t.kb, n0 = 64 * t.nb;
#pragma unroll
    for (int i = 0; i < 16; ++i) { const int kk = (lane >> 4) + 4 * i; float* d = scr + kk * 65 + (lane & 15) * 4; d[0] = v[i].x; d[1] = v[i].y; d[2] = v[i].z; d[3] = v[i].w; }
    LDS_WAIT();
    const int kc = lane & 7;
#pragma unroll
    for (int i = 0; i < 8; ++i) {
        const int nl = (lane >> 3) + 8 * i, n = n0 + nl;
        const float* s = scr + (8 * kc) * 65 + nl;
        u32x4 o; o.x = pk2(s[0], s[65]); o.y = pk2(s[130], s[195]); o.z = pk2(s[260], s[325]); o.w = pk2(s[390], s[455]);
        if (t.on && n < t.N) *(u32x4*)(t.WT + (size_t)tr_rowmap(t.kind, n) * t.ldd + k0 + 8 * kc) = o;
    }
    LDS_WAIT();
}
constexpr int MOE_TR_ITEMS = NEXP * 384;
DEV TrItem moe_tr_decode(const Ctx& c, int layer, int it) {
    const float* w1 = gptr(c.p->in[29]) + (size_t)layer * NEXP * DM * EH;
    const float* w3 = gptr(c.p->in[30]) + (size_t)layer * NEXP * DM * EH;
    const float* w2 = gptr(c.p->in[31]) + (size_t)layer * NEXP * EH * DM;
    bf16_t* W13 = (bf16_t*)(c.ws + WS_W13); bf16_t* W2 = (bf16_t*)(c.ws + WS_W2);
    const int e = it / 384, r = it % 384, mat = r >> 7, sub = r & 127;
    if (mat == 0) return TrItem{w1 + (size_t)e * DM * EH, EH, EH, W13 + (size_t)e * DM * DM, DM, 2, sub >> 3, sub & 7, true};
    if (mat == 1) return TrItem{w3 + (size_t)e * DM * EH, EH, EH, W13 + (size_t)e * DM * DM, DM, 3, sub >> 3, sub & 7, true};
    if (layer == 1) W2 = (e < 16) ? (bf16_t*)(c.ws + WS_PK) : (bf16_t*)(c.ws + WS_W2B) - (size_t)16 * DM * EH;
    return TrItem{w2 + (size_t)e * EH * DM, DM, DM, W2 + (size_t)e * DM * EH, EH, 0, sub >> 4, sub & 15, true};
}
constexpr int MOE_E0 = 20, MOE_EARLY_ITEMS = MOE_E0 * 256, MOE_REST_ITEMS = (NEXP - MOE_E0) * 256, MOE_W2_ITEMS = NEXP * 128;
template <int MODE  >
DEV TrItem moe_tr_decode_m(const Ctx& c, int layer, int idx) {
    if (MODE == 0) return moe_tr_decode(c, layer, idx);
    if (MODE == 1) { const int e = idx >> 8, r = idx & 255; return moe_tr_decode(c, layer, e * 384 + r); }
    if (MODE == 2) { const int e = MOE_E0 + (idx >> 8), r = idx & 255; return moe_tr_decode(c, layer, e * 384 + r); }
    return moe_tr_decode(c, layer, (idx >> 7) * 384 + 256 + (idx & 127));
}
template <int MODE>
DEV void moe_weights_m(const Ctx& c, int layer, int worker, int nworkers) {
    constexpr int NIT = (MODE == 0) ? MOE_TR_ITEMS : (MODE == 1 ? MOE_EARLY_ITEMS : (MODE == 2 ? MOE_REST_ITEMS : MOE_W2_ITEMS));
    float* scr = c.lds + c.wave * (64 * 65);
    f32x4 va[16], vb[16];
    int it = worker;
    if (it >= NIT) return;
    TrItem cur = moe_tr_decode_m<MODE>(c, layer, it); tr_load(cur, va, c.lane);
    for (;;) {
        const int i1 = it + nworkers; const bool h1 = i1 < NIT; TrItem n1 = cur;
        if (h1) { n1 = moe_tr_decode_m<MODE>(c, layer, i1); tr_load(n1, vb, c.lane); }
        tr_store(cur, va, scr, c.lane);
        if (!h1) break;
        const int i2 = i1 + nworkers; const bool h2 = i2 < NIT;
        if (h2) { cur = moe_tr_decode_m<MODE>(c, layer, i2); tr_load(cur, va, c.lane); }
        tr_store(n1, vb, scr, c.lane);
        if (!h2) break;
        it = i2;
    }
}
template <int MODE>
DEV void moe_weights_in_tail(const Ctx& c, int layer, int nblk) {
    const int G = gridDim.x, bx = blockIdx.x, vc = (G % 8 == 0) ? (bx % 8) * (G / 8) + bx / 8 : bx;
    const int full = 4 * nblk - (4 * nblk / G) * G, nidle = G - full;
    if (vc < full) return;
    moe_weights_m<MODE>(c, layer, (vc - full) * NWAVES + c.wave, nidle * NWAVES);
}
DEV void cvt_rows(const Ctx& c, const float* src, bf16_t* dst, size_t n, int gw, int ngw) {
    const size_t nth = (size_t)ngw * 64, t0 = (size_t)gw * 64 + c.lane, nch = n / 8;
    for (size_t i = t0; i < nch; i += 4 * nth) {
        f32x4 a[4], b[4];
#pragma unroll
        for (int u = 0; u < 4; ++u) { const size_t j = i + u * nth; if (j < nch) { a[u] = *(const f32x4*)(src + j * 8); b[u] = *(const f32x4*)(src + j * 8 + 4); } }
#pragma unroll
        for (int u = 0; u < 4; ++u) { const size_t j = i + u * nth; if (j < nch) { u32x4 o; o.x = pk2(a[u].x, a[u].y); o.y = pk2(a[u].z, a[u].w); o.z = pk2(b[u].x, b[u].y); o.w = pk2(b[u].z, b[u].w); *(u32x4*)(dst + j * 8) = o; } }
    }
}
template <int PART>
DEV void phase_prep(const Ctx& c) {
    const __attribute__((address_space(4))) Params& p = *c.p; unsigned char* ws = c.ws;
    float* scr = c.lds + c.wave * (64 * 65);
    if (PART == 0 && blockIdx.x == 0 && c.tid < 64) ((int*)(ws + WS_CTL))[c.tid] = 0;
    constexpr int I_IN = 16 * 37, I_SQ = 16 * 16, I_OD = 16 * 48, I_CW = 16 * 4;
    constexpr int NA = I_IN + I_SQ + I_OD + I_SQ + 4 * I_SQ + 2 * I_SQ + 4 * I_CW;
    {
        const int bx = blockIdx.x; int g_ = 0, ng_ = 1;
        auto sub = [&](int w0, int nw) { g_ = (bx - w0) * NWAVES + c.wave; ng_ = nw * NWAVES; return bx >= w0 && bx < w0 + nw; };
        if (PART == 1 && sub(0, 64)) {
            for (int i = g_ * 64 + c.lane; i < 2 * 96 * DM; i += ng_ * 64) {
                const int l = i / (96 * DM), rr = (i / DM) % 96, k = i % DM, part = rr / 48, o = rr % 48;
                float w = 0.f;
                if (o < 32) w = gptr(p.in[27])[((size_t)l * DM + k) * 32 + o]; else if (o < 36) w = gptr(p.in[25])[((size_t)l * DM + k) * 4 + (o - 32)];
                const unsigned hi = f2bf(w); const float lo = w - __uint_as_float(hi << 16);
                ((bf16_t*)(ws + WS_RWB))[i] = (bf16_t)(part ? f2bf(lo) : hi);
            }
        }
        if (PART == 1 && sub(64, 32)) {
            for (int i = g_ * 64 + c.lane; i < 8 * 256 * 64; i += ng_ * 64) {
                const int n = (i >> 6) & 255, m = i & 63; float v = 0.f;
                if (n < NCMP) { const int ov = min(16 * n + 32, 64 * m + 64) - max(16 * n, 64 * m); v = (ov > 0) ? (float)ov * (1.f / 32.f) : 0.f; }
                ((bf16_t*)(ws + WS_MSEL))[i] = (bf16_t)f2bf(v);
            }
            for (int i = g_ * 64 + c.lane; i < 2 * 16 * 64; i += ng_ * 64) { const int kv = i >> 10, bg = (i >> 6) & 15, d = i & 63; ((bf16_t*)(ws + (kv ? WS_VCMP : WS_KCMP)))[(size_t)(bg * 256 + 255) * 64 + d] = 0; }
        }
        if (PART == 1 && sub(96, 64)) cvt_rows(c, gptr(p.in[1]), (bf16_t*)(ws + WS_MEMB), (size_t)NMEM * DM, g_, ng_);
        if (PART == 1 && sub(160, 64)) cvt_rows(c, gptr(p.in[21]), (bf16_t*)(ws + WS_WQ), (size_t)2 * DM * DM, g_, ng_);
        if (PART == 0 && sub(224, 24)) {
            bf16_t* w = (bf16_t*)(ws + WS_W_IN) + (size_t)EIN * DM; const size_t n = (size_t)(EINP - EIN) * DM / 8;
            for (size_t i = (size_t)g_ * 64 + c.lane; i < n; i += (size_t)ng_ * 64) *(u32x4*)(w + i * 8) = (u32x4){0u, 0u, 0u, 0u};
        }
        if (PART == 1 && sub(248, 8)) {
            for (int it = g_; it < 64; it += ng_) {
                const int kv = it >> 5, blk = it & 31;
                const float* pe = gptr(p.in[kv ? 12 : 9]); const float* w1 = gptr(p.in[kv ? 13 : 10]);
                f32x4 sacc = {0.f, 0.f, 0.f, 0.f};
#pragma unroll 8
                for (int r = 0; r < 64; ++r) { const int kk = blk * 64 + r; sacc = sacc + *(const f32x4*)(w1 + (size_t)kk * 256 + 4 * c.lane) * pe[kk]; }
                *(f32x4*)((float*)(ws + WS_CMPP) + (size_t)it * 256 + 4 * c.lane) = sacc;
            }
        }
    }
    auto decode = [&](int it) -> TrItem {
        int r = it;
        if (r >= NA) return moe_tr_decode(c, 0, r - NA);
        if (r < I_IN) return TrItem{gptr(p.in[4]), EIN, EIN, (bf16_t*)(ws + WS_W_IN), DM, 1, r / 37, r % 37, true}; r -= I_IN;
        if (r < I_SQ) return TrItem{gptr(p.in[15]), DM, DM, (bf16_t*)(ws + WS_W_OUT), DM, 0, r >> 4, r & 15, true}; r -= I_SQ;
        if (r < I_OD) return TrItem{gptr(p.in[16]), 3 * DM, 3 * DM, (bf16_t*)(ws + WS_OD_IN), DM, 4, r / 48, r % 48, true}; r -= I_OD;
        if (r < I_SQ) return TrItem{gptr(p.in[18]), DM, DM, (bf16_t*)(ws + WS_OD_OUT), DM, 0, r >> 4, r & 15, true}; r -= I_SQ;
        if (r < 4 * I_SQ) { const int m = r >> 8, l = m & 1, q = r & 255;
            return TrItem{gptr(p.in[22]) + (size_t)l * DM * DM, DM, DM, (bf16_t*)(ws + WS_WO) + (size_t)l * DM * DM, DM, 0, q >> 4, q & 15, m >= 2}; } r -= 4 * I_SQ;
        if (r < 2 * I_SQ) { const int m = r >> 8, q = r & 255; return TrItem{gptr(p.in[m ? 3 : 2]), DM, DM, (bf16_t*)(ws + (m ? WS_WV : WS_WK)), DM, 0, q >> 4, q & 15, true}; } r -= 2 * I_SQ;
        const int m = r >> 6, kv = m >> 1, half = m & 1, q = r & 63;
        return TrItem{gptr(p.in[kv ? 13 : 10]) + (size_t)half * 1024 * 256, 256, 256, (bf16_t*)(ws + WS_CW1) + ((size_t)kv * 512 + half * 256) * DM, DM, 0, q >> 2, q & 3, true};
    };
    {   constexpr int ILO = (PART == 0) ? 0 : I_IN, NTOT = (PART == 0) ? I_IN : NA;
        f32x4 va[16], vb[16];
        int it = ILO + c.gw;
        if (it < NTOT) {
            TrItem cur = decode(it); tr_load(cur, va, c.lane);
            for (;;) {
                const int i1 = it + c.ngw; const bool h1 = i1 < NTOT; TrItem n1 = cur;
                if (h1) { n1 = decode(i1); tr_load(n1, vb, c.lane); }
                tr_store(cur, va, scr, c.lane);
                if (!h1) break;
                const int i2 = i1 + c.ngw; const bool h2 = i2 < NTOT;
                if (h2) { cur = decode(i2); tr_load(cur, va, c.lane); }
                tr_store(n1, vb, scr, c.lane);
                if (!h2) break;
                it = i2;
            }
        }
    }
    if (PART == 0) cvt_rows(c, gptr(p.in[0]), (bf16_t*)(ws + WS_XA), (size_t)NT * DM, c.gw, c.ngw);
}

constexpr int CONV_LW = 63488;
typedef float f32x2 __attribute__((ext_vector_type(2)));
DEV void conv_stage_w(const Ctx& c) {
    __attribute__((address_space(3))) float* LW = (__attribute__((address_space(3))) float*)((__attribute__((address_space(3))) unsigned char*)c.lds + CONV_LW);
    const float* cw = gptr(c.p->in[5]);
    for (int i = c.tid; i < 37 * 512; i += NTHREADS) { const int row = i >> 9, ch = i & 511, k = row - 3;
        LW[row * 512 + ((ch & 4) ? 256 : 0) + (ch >> 3) * 4 + (ch & 3)] = (k >= 0 && k <= 30) ? cw[k * 512 + ch] : 0.f; }
}
DEV void conv_tile(const Ctx& c, int tile, const float (&bias)[8], const float (&gam)[8], const float (&bet)[8]) {
    typedef __attribute__((address_space(3))) unsigned char lds8;
    lds8* L = (lds8*)c.lds; lds8* LW = L + CONV_LW;
    const bf16_t* Y0 = (const bf16_t*)(c.ws + SC_Y0); bf16_t* CAT = (bf16_t*)(c.ws + SC_CAT);
    const int tok0 = tile * 32, t0 = tok0 & (SEQ - 1);
    __syncthreads();
    {   u32x4 v[8];
#pragma unroll
        for (int u = 0; u < 8; ++u) { const int i = c.tid + u * NTHREADS, r = i >> 6, ch = i & 63; v[u] = (u32x4){0u, 0u, 0u, 0u};
            if (i < 62 * 64 && t0 - 30 + r >= 0) v[u] = *(const u32x4*)(Y0 + (size_t)(tok0 - 30 + r) * EINP + ch * 8); }
#pragma unroll
        for (int u = 0; u < 8; ++u) { const int i = c.tid + u * NTHREADS, r = i >> 6, ch = i & 63;
            if (i < 62 * 64) *(__attribute__((address_space(3))) u32x4*)(L + r * 1024 + ch * 16) = v[u]; }
    }
    __syncthreads();
    const int ch0 = c.lane * 8, j0 = c.wave * 4;
    f32x2 acc[4][4];
#pragma unroll
    for (int j = 0; j < 4; ++j) { const f32x2 bq = {bias[2 * j], bias[2 * j + 1]};
#pragma unroll
        for (int m = 0; m < 4; ++m) acc[m][j] = bq; }
    f32x2 w[4][4];
#pragma unroll
    for (int d = 0; d < 4; ++d)
#pragma unroll
        for (int j = 0; j < 4; ++j) w[d][j] = (f32x2){0.f, 0.f};
#define CONV_STEP(s, u) do { \
        const u32x4 ra_ = *(const __attribute__((address_space(3))) u32x4*)(L + (j0 + (s)) * 1024 + c.lane * 16); \
        const f32x4 wa_ = *(const __attribute__((address_space(3))) f32x4*)(LW + ((s) + 3) * 2048 + c.lane * 16), wb_ = *(const __attribute__((address_space(3))) f32x4*)(LW + ((s) + 3) * 2048 + 1024 + c.lane * 16); \
        w[(u)][0] = (f32x2){wa_[0], wa_[1]}; w[(u)][1] = (f32x2){wa_[2], wa_[3]}; w[(u)][2] = (f32x2){wb_[0], wb_[1]}; w[(u)][3] = (f32x2){wb_[2], wb_[3]}; \
        f32x2 a_[4]; \
        _Pragma("unroll") for (int j = 0; j < 4; ++j) a_[j] = (f32x2){__uint_as_float(ra_[j] << 16), __uint_as_float(ra_[j] & 0xffff0000u)}; \
        _Pragma("unroll") for (int m = 0; m < 4; ++m) _Pragma("unroll") for (int j = 0; j < 4; ++j) acc[m][j] = __builtin_elementwise_fma(a_[j], w[((u) - m) & 3][j], acc[m][j]); } while (0)
    for (int s4 = 0; s4 < 32; s4 += 4) { CONV_STEP(s4, 0); CONV_STEP(s4 + 1, 1); CONV_STEP(s4 + 2, 2); CONV_STEP(s4 + 3, 3); }
    CONV_STEP(32, 0); CONV_STEP(33, 1);
#undef CONV_STEP
#pragma unroll
    for (int m = 0; m < 4; ++m) {
        float a8[8];
#pragma unroll
        for (int j = 0; j < 4; ++j) { a8[2 * j] = acc[m][j][0]; a8[2 * j + 1] = acc[m][j][1]; }
        float s = 0.f;
#pragma unroll
        for (int j = 0; j < 8; ++j) s += a8[j];
        const float mean = wsum_dpp(s) * (1.f / 512.f); float s2 = 0.f;
#pragma unroll
        for (int j = 0; j < 8; ++j) { a8[j] -= mean; s2 += a8[j] * a8[j]; }
        const float rstd = rsqrtf(wsum_dpp(s2) * (1.f / 512.f) + LN_EPS);
        float y[8];
#pragma unroll
        for (int j = 0; j < 8; ++j) { const float v = a8[j] * rstd * gam[j] + bet[j]; y[j] = v * frcp(1.f + __expf(-v)); }
        u32x4 o; o.x = pk2(y[0], y[1]); o.y = pk2(y[2], y[3]); o.z = pk2(y[4], y[5]); o.w = pk2(y[6], y[7]);
        *(u32x4*)(CAT + (size_t)(tok0 + j0 + m) * DM + ch0) = o;
    }
}
DEV void conv_phase(const Ctx& c) {
    conv_stage_w(c);
    const int bx = blockIdx.x;
    if (bx == gridDim.x - 1) {
        const float* part = (const float*)(c.ws + WS_CMPP); float sum = 0.f;
        for (int blk = 0; blk < 32; ++blk) sum += part[(size_t)((c.tid >> 8) * 32 + blk) * 256 + (c.tid & 255)];
        ((float*)(c.ws + WS_CMPB))[c.tid] = sum;
    }
    float bias[8], gam[8], bet[8];
#pragma unroll
    for (int j = 0; j < 8; ++j) { bias[j] = gptr(c.p->in[6])[c.lane * 8 + j]; gam[j] = gptr(c.p->in[7])[c.lane * 8 + j]; bet[j] = gptr(c.p->in[8])[c.lane * 8 + j]; }
    if (bx < 128) { for (int i = 0; i < 2; ++i) conv_tile(c, 2 * bx + i, bias, gam, bet); }
    else for (int i = 0; i < 6; ++i) conv_tile(c, 256 + (bx - 128) * 6 + i, bias, gam, bet);
    __syncthreads();
}

DEV float gelu_tanh_fast(float x) { const float u = 0.7978845608028654f * (x + 0.044715f * x * x * x); const float t = 1.f - 2.f * frcp(1.f + __expf(2.f * u)); return 0.5f * x * (1.f + t); }
DEV void cmp_finish(const Ctx& c) {
    const __attribute__((address_space(4))) Params& p = *c.p;
    const int kv = (blockIdx.x >= gridDim.x / 2) ? 1 : 0, half = gridDim.x / 2, bxl = blockIdx.x - kv * half;
    float* w2l = c.lds;
    float* hid = c.lds + 16384 + c.wave * 256;
    const float* P = (const float*)(c.ws + (kv ? WS_PV : WS_PK));
    constexpr int RN = NB * NCMP * 2; const int rstep = half * NWAVES; int r = bxl * NWAVES + c.wave;
    float pa[4], pb[4];
    auto ldP = [&](int rr) { const int g = rr & 1, bn = rr >> 1, b = bn / NCMP, n = bn % NCMP; const int r0 = (b * 256 + n) * 2 + g, r1 = (b * 256 + n + 1) * 2 + g;
#pragma unroll
        for (int i = 0; i < 4; ++i) { const int cc = c.lane + 64 * i; pa[i] = P[(size_t)r0 * 512 + cc]; pb[i] = P[(size_t)r1 * 512 + 256 + cc]; } };
    if (r < RN) ldP(r);
    { const float* w2 = gptr(p.in[kv ? 14 : 11]); f32x4 t[8];
#pragma unroll
      for (int q = 0; q < 8; ++q) t[q] = *(const f32x4*)(w2 + 4 * (c.tid + q * NTHREADS));
#pragma unroll
      for (int q = 0; q < 8; ++q) *(f32x4*)(w2l + 4 * (c.tid + q * NTHREADS)) = t[q]; }
    __syncthreads();
    const float* cbias = (const float*)(c.ws + WS_CMPB) + kv * 256;
    float cb[4];
#pragma unroll
    for (int i = 0; i < 4; ++i) cb[i] = cbias[c.lane + 64 * i];
    for (; r < RN; r += rstep) {
        const int g = r & 1, bn = r >> 1, b = bn / NCMP, n = bn % NCMP;
#pragma unroll
        for (int i = 0; i < 4; ++i) { const int cc = c.lane + 64 * i; hid[cc] = gelu_tanh_fast(pa[i] + pb[i] + cb[i]); }
        if (r + rstep < RN) ldP(r + rstep);
        LDS_WAIT();
        float o0 = 0.f, o1 = 0.f, o2 = 0.f, o3 = 0.f;
#pragma unroll 4
        for (int cc = 0; cc < 256; cc += 4) { const f32x4 hv = *(const f32x4*)(hid + cc);
            o0 += hv.x * w2l[(cc + 0) * 64 + c.lane]; o1 += hv.y * w2l[(cc + 1) * 64 + c.lane]; o2 += hv.z * w2l[(cc + 2) * 64 + c.lane]; o3 += hv.w * w2l[(cc + 3) * 64 + c.lane]; }
        ((bf16_t*)(c.ws + (kv ? WS_VCMP : WS_KCMP)))[(size_t)((b * 2 + g) * 256 + n) * 64 + c.lane] = (bf16_t)f2bf((o0 + o1) + (o2 + o3));
        LDS_WAIT();
    }
}

DEV void nsa_naive(const Ctx& c) {
    const bf16_t* Y0 = (const bf16_t*)(c.ws + SC_Y0); bf16_t* CAT = (bf16_t*)(c.ws + WS_XB);
    const bf16_t* KC = (const bf16_t*)(c.ws + WS_KCMP); const bf16_t* VC = (const bf16_t*)(c.ws + WS_VCMP);
    float* pc = c.lds + c.wave * 1024;
    const int hh = c.lane >> 4, dq = c.lane & 15;
    for (int it = c.gw; it < NT * 2; it += c.ngw) {
        const int g = it & 1, row = it >> 1, b = row >> 12, t = row & (SEQ - 1);
        const int h = g * 4 + hh;
        const bf16_t* yrow = Y0 + (size_t)row * EINP;
        float q[4]; ld4bf(yrow + C_Q + h * 64 + dq * 4, q);
        const int ncv = (t >= 31) ? min(NCMP, (t - 31) / 16 + 1) : 0;
        float oc[4] = {0.f, 0.f, 0.f, 0.f};
        float mx = -INFINITY;
        for (int n = 0; n < ncv; ++n) {
            float kk4[4]; ld4bf(KC + (size_t)((b * 2 + g) * 256 + n) * 64 + dq * 4, kk4); const f32x4 k4 = {kk4[0], kk4[1], kk4[2], kk4[3]};
            float s = q[0] * k4.x + q[1] * k4.y + q[2] * k4.z + q[3] * k4.w; s = gsum16(s);
            if (dq == 0) pc[hh * 256 + n] = s;
            mx = fmaxf(mx, s);
        }
        LDS_WAIT();
        float l = 0.f;
        for (int n = 0; n < ncv; ++n) l += exp2f(pc[hh * 256 + n] - mx);
        const float inv = (ncv > 0) ? 1.f / l : 0.f;
        for (int n = 0; n < ncv; ++n) {
            const float pr = exp2f(pc[hh * 256 + n] - mx) * inv;
            float vv4[4]; ld4bf(VC + (size_t)((b * 2 + g) * 256 + n) * 64 + dq * 4, vv4); const f32x4 v4 = {vv4[0], vv4[1], vv4[2], vv4[3]};
            oc[0] += pr * v4.x; oc[1] += pr * v4.y; oc[2] += pr * v4.z; oc[3] += pr * v4.w;
            LDS_WAIT();
            if (dq == 0) pc[hh * 256 + n] = pr;
        }
        LDS_WAIT();
        const int m = c.lane, cur = t >> 6;
        float imp = 0.f;
#pragma unroll
        for (int h2 = 0; h2 < 4; ++h2)
#pragma unroll
            for (int dn = -1; dn <= 3; ++dn) { const int n = 4 * m + dn; if (n >= 0 && n < ncv) imp += pc[h2 * 256 + n] * ((dn == -1 || dn == 3) ? 0.5f : 1.f); }
        const bool causal = m <= cur, forced = (m == 0) || (m == cur) || (m == cur - 1);
        const float score = causal ? (forced ? 1e4f : imp) : -1e30f;
        int rank = 0;
        for (int m2 = 0; m2 < 64; ++m2) { const float s2 = __shfl(score, m2); rank += ((s2 > score) || (s2 == score && m2 < m)) ? 1 : 0; }
        unsigned long long selmask = __ballot(causal && rank < 16);
        LDS_WAIT();
        float ms = -INFINITY, ls = 0.f, os[4] = {0.f, 0.f, 0.f, 0.f};
        while (selmask) {
            const int mb = __builtin_ctzll(selmask); selmask &= selmask - 1;
            const int jmax = min(63, t - 64 * mb);
            const bf16_t* kb = Y0 + (size_t)(b * SEQ + 64 * mb) * EINP + g * 64 + dq * 4;
            for (int j = 0; j <= jmax; ++j) {
                float k4[4], v4[4]; ld4bf(kb + (size_t)j * EINP + C_KS, k4); ld4bf(kb + (size_t)j * EINP + C_VS, v4);
                float s = q[0] * k4[0] + q[1] * k4[1] + q[2] * k4[2] + q[3] * k4[3]; s = gsum16(s);
                const float mn = fmaxf(ms, s), cf = exp2f(ms - mn), pp = exp2f(s - mn);
                ls = ls * cf + pp;
#pragma unroll
                for (int i = 0; i < 4; ++i) os[i] = os[i] * cf + pp * v4[i];
                ms = mn;
            }
        }
        float mw = -INFINITY, lw = 0.f, ow[4] = {0.f, 0.f, 0.f, 0.f};
        {
            const int k0 = max(0, t - 511);
            const bf16_t* kb = Y0 + (size_t)(b * SEQ) * EINP + g * 64 + dq * 4;
            for (int kp = k0; kp <= t; ++kp) {
                float k4[4], v4[4]; ld4bf(kb + (size_t)kp * EINP + C_KW, k4); ld4bf(kb + (size_t)kp * EINP + C_VW, v4);
                float s = q[0] * k4[0] + q[1] * k4[1] + q[2] * k4[2] + q[3] * k4[3]; s = gsum16(s);
                const float mn = fmaxf(mw, s), cf = exp2f(mw - mn), pp = exp2f(s - mn);
                lw = lw * cf + pp;
#pragma unroll
                for (int i = 0; i < 4; ++i) ow[i] = ow[i] * cf + pp * v4[i];
                mw = mn;
            }
        }
        const float gc = sigmoidf_(bf2f(yrow[C_GL + h * 3 + 0])), gs = sigmoidf_(bf2f(yrow[C_GL + h * 3 + 1])) / ls, gwn = sigmoidf_(bf2f(yrow[C_GL + h * 3 + 2])) / lw;
        st4bf(CAT + (size_t)row * DM + 512 + h * 64 + dq * 4, gc * oc[0] + gs * os[0] + gwn * ow[0], gc * oc[1] + gs * os[1] + gwn * ow[1], gc * oc[2] + gs * os[2] + gwn * ow[2], gc * oc[3] + gs * os[3] + gwn * ow[3]);
    }
}

namespace nsa {
typedef float f32x16 __attribute__((ext_vector_type(16)));
typedef short s16x4 __attribute__((ext_vector_type(4)));
typedef __attribute__((address_space(3))) unsigned char lds_u8;
constexpr int SLOT = 8192, NSLOT = 3;
constexpr int IMPP = 65;
constexpr int L_K = 0, L_V = NSLOT * SLOT, L_IMP = 2 * NSLOT * SLOT  , L_SEL = L_IMP + 4 * 64 * IMPP * 4  ;
constexpr int L_V2 = 116736;
constexpr float NEGB = -1e30f;
DEV int crow(int r, int hi) { return (r & 3) + 8 * (r >> 2) + 4 * hi; }
DEV s16x4 vtr(const lds_u8* p) { typedef short v4i16_t __attribute__((ext_vector_type(4))); return __builtin_bit_cast(s16x4, __builtin_amdgcn_ds_read_tr16_b64_v4i16((__attribute__((address_space(3))) v4i16_t*)p)); }
DEV unsigned cvtpk(float lo, float hi) { typedef float f2 __attribute__((ext_vector_type(2))); typedef __bf16 b2 __attribute__((ext_vector_type(2))); f2 v = {lo, hi}; b2 b = __builtin_convertvector(v, b2); return __builtin_bit_cast(unsigned, b); }
DEV void glds16(const void* gsrc, unsigned lds_dst) { unsigned keep;
    asm volatile("s_mov_b32 %0, m0\n\ts_mov_b32 m0, %2\n\ts_nop 0\n\tglobal_load_lds_dwordx4 %1, off\n\ts_mov_b32 m0, %0" : "=&s"(keep) : "v"(gsrc), "s"(lds_dst) : "memory"); }
#define NSA_WAITV(n) asm volatile("s_waitcnt vmcnt(" #n ")" ::: "memory")
#define NSA_BAR() do { asm volatile("s_waitcnt lgkmcnt(0)" ::: "memory"); __builtin_amdgcn_s_barrier(); asm volatile("" ::: "memory"); } while (0)

DEV void flash_prefetch(lds_u8* lds, const bf16_t* Kg, int pk, const bf16_t* Vg, int pv, int t0, int nt, const bf16_t* V2g) {
    const int tid = threadIdx.x, lane = tid & 63; const int wid = __builtin_amdgcn_readfirstlane(tid >> 6);
    const unsigned lds0 = (unsigned)(uintptr_t)lds;
    const size_t voff = (size_t)(t0 * 64 + 16 * (wid & 3) + (lane >> 2)) * pv + (wid >> 2) * 32 + (lane & 3) * 8;
    const bf16_t* ksrc = Kg + (size_t)(t0 * 64 + lane) * pk + wid * 8;
    for (int t = 0; t < 2 && t < nt; ++t) {
        glds16(ksrc + (size_t)t * 64 * pk, (unsigned)__builtin_amdgcn_readfirstlane(lds0 + L_K + t * SLOT + wid * 1024));
        glds16(Vg + voff + (size_t)t * 64 * pv, (unsigned)__builtin_amdgcn_readfirstlane(lds0 + L_V + t * SLOT + wid * 1024));
        if (V2g) glds16(V2g + voff + (size_t)t * 64 * pv, (unsigned)__builtin_amdgcn_readfirstlane(lds0 + L_V2 + t * SLOT + wid * 1024)); }
}
template <bool F2>
DEV void flash_pass_t(lds_u8* lds, const bf16_t* Kg, int pk, const bf16_t* Vg, int pv, int t0, int nt, const bf16x8 (&qr)[4],
                    int lo, int hi_b, unsigned long long rowmask, int lo_max, int hi_min, f32x16 (&o)[2], float& l_out, const bf16_t* V2g, f32x16 (&o2)[2], bool pre = false) {
    const int tid = threadIdx.x, lane = tid & 63, r32 = lane & 31, hi = lane >> 5; const int wid = __builtin_amdgcn_readfirstlane(tid >> 6);
    o[0] = f32x16{}; o[1] = f32x16{}; float l = 0.f, mhat = 0.f;
    if (F2) { o2[0] = f32x16{}; o2[1] = f32x16{}; }
    if (nt <= 0) { l_out = 0.f; return; }
    const bf16_t* ksrc = Kg + (size_t)(t0 * 64 + lane) * pk + wid * 8;
    const bf16_t* vsrc = Vg + (size_t)(t0 * 64 + 16 * (wid & 3) + (lane >> 2)) * pv + (wid >> 2) * 32 + (lane & 3) * 8;
    const bf16_t* vsrc2 = F2 ? V2g + (size_t)(t0 * 64 + 16 * (wid & 3) + (lane >> 2)) * pv + (wid >> 2) * 32 + (lane & 3) * 8 : vsrc;
    const size_t kstep = (size_t)64 * pk, vstep = (size_t)64 * pv;
    const unsigned lds0 = (unsigned)(uintptr_t)lds;
#define NSA_DMA(t, slot) do { glds16(ksrc + (size_t)(t) * kstep, (unsigned)__builtin_amdgcn_readfirstlane(lds0 + L_K + (slot) * SLOT + wid * 1024)); \
                               glds16(vsrc + (size_t)(t) * vstep, (unsigned)__builtin_amdgcn_readfirstlane(lds0 + L_V + (slot) * SLOT + wid * 1024)); \
                               if (F2) glds16(vsrc2 + (size_t)(t) * vstep, (unsigned)__builtin_amdgcn_readfirstlane(lds0 + L_V2 + (slot) * SLOT + wid * 1024)); } while (0)
    const lds_u8* kp0 = lds + L_K + hi * 1024 + r32 * 16;
    const lds_u8* vp0 = lds + L_V + ((lane >> 4) & 1) * 32 + (lane & 3) * 8 + (4 * hi + ((lane & 15) >> 2)) * 64;
    if (!pre) { NSA_DMA(0, 0); if (nt > 1) NSA_DMA(1, 1); }
    int slot = 0;
    for (int t = 0; t < nt; ++t) {
        if (t + 1 < nt) { if (F2) NSA_WAITV(3); else NSA_WAITV(2); } else NSA_WAITV(0);
        NSA_BAR();
        if (t + 2 < nt) { const int s2 = (slot >= 1) ? slot - 1 : 2; NSA_DMA(t + 2, s2); }
        const int gt = t0 + t;
        const bool rowok = (rowmask >> gt) & 1ull;
        const float ci = rowok ? -mhat : NEGB;
        f32x16 c0, c1;
#pragma unroll
        for (int r = 0; r < 16; ++r) { c0[r] = ci; c1[r] = ci; }
        const lds_u8* kp = kp0 + slot * SLOT;
        bf16x8 kf[8];
#pragma unroll
        for (int d0 = 0; d0 < 4; ++d0) { kf[2 * d0] = *(const __attribute__((address_space(3))) bf16x8*)(kp + d0 * 2048); kf[2 * d0 + 1] = *(const __attribute__((address_space(3))) bf16x8*)(kp + d0 * 2048 + 512); }
#pragma unroll
        for (int d0 = 0; d0 < 4; ++d0) {
            c0 = __builtin_amdgcn_mfma_f32_32x32x16_bf16(kf[2 * d0], qr[d0], c0, 0, 0, 0);
            c1 = __builtin_amdgcn_mfma_f32_32x32x16_bf16(kf[2 * d0 + 1], qr[d0], c1, 0, 0, 0);
        }
        if ((64 * gt + 63 > hi_min) || (64 * gt <= lo_max)) {
            const int kb = 64 * gt + 4 * hi;
#pragma unroll
            for (int r = 0; r < 16; ++r) { const int kv = kb + (r & 3) + 8 * (r >> 2);
                if (!(kv > lo && kv <= hi_b)) c0[r] = NEGB;
                if (!(kv + 32 > lo && kv + 32 <= hi_b)) c1[r] = NEGB; }
        }
#define NSA_MX3(a, b, c) __builtin_fmaxf(__builtin_fmaxf((a), (b)), (c))
        float rm, rm2;
        { float a = NSA_MX3(c0[0], c0[1], c1[0]), b = NSA_MX3(c0[2], c0[3], c1[1]); a = NSA_MX3(a, c1[2], c1[3]);
#pragma unroll
          for (int r = 4; r < 16; r += 4) { a = NSA_MX3(a, c0[r], c0[r + 1]); b = NSA_MX3(b, c0[r + 2], c0[r + 3]); a = NSA_MX3(a, c1[r], c1[r + 1]); b = NSA_MX3(b, c1[r + 2], c1[r + 3]); }
          rm = __builtin_fmaxf(a, b); rm2 = rm; }
#undef NSA_MX3
        { auto rr = __builtin_amdgcn_permlane32_swap(__float_as_uint(rm), __float_as_uint(rm2), false, false); rm = __builtin_fmaxf(__uint_as_float(rr[0]), __uint_as_float(rr[1])); }
        if (__any(rm > 6.0f)) {
            const float dl = fmaxf(rm, 0.f), f = __builtin_amdgcn_exp2f(-dl);
            mhat += dl; l *= f;
#pragma unroll
            for (int r = 0; r < 16; ++r) { c0[r] -= dl; c1[r] -= dl; o[0][r] *= f; o[1][r] *= f; if (F2) { o2[0][r] *= f; o2[1][r] *= f; } }
        }
        float ps = 0.f;
#pragma unroll
        for (int r = 0; r < 16; ++r) { c0[r] = __builtin_amdgcn_exp2f(c0[r]); c1[r] = __builtin_amdgcn_exp2f(c1[r]); ps += c0[r] + c1[r]; }
        l += ps;
        u32x4 pw[4];
#pragma unroll
        for (int s = 0; s < 2; ++s)
#pragma unroll
            for (int j = 0; j < 4; ++j) { pw[s][j] = cvtpk(c0[8 * s + 2 * j], c0[8 * s + 2 * j + 1]); pw[2 + s][j] = cvtpk(c1[8 * s + 2 * j], c1[8 * s + 2 * j + 1]); }
        const lds_u8* vp = vp0 + slot * SLOT;
        bf16x8 vf[8];
#pragma unroll
        for (int dh = 0; dh < 2; ++dh)
#pragma unroll
            for (int ks = 0; ks < 4; ++ks) {
                const s16x4 vl = vtr(vp + dh * 4096 + ks * 1024), vh = vtr(vp + dh * 4096 + ks * 1024 + 512);
                vf[dh * 4 + ks] = (bf16x8){vl[0], vl[1], vl[2], vl[3], vh[0], vh[1], vh[2], vh[3]};
            }
#pragma unroll
        for (int ks = 0; ks < 4; ++ks) {
            o[0] = __builtin_amdgcn_mfma_f32_32x32x16_bf16(vf[ks], __builtin_bit_cast(bf16x8, pw[ks]), o[0], 0, 0, 0);
            o[1] = __builtin_amdgcn_mfma_f32_32x32x16_bf16(vf[4 + ks], __builtin_bit_cast(bf16x8, pw[ks]), o[1], 0, 0, 0);
        }
        if (F2) {
            const lds_u8* vp2 = vp0 + (L_V2 - L_V) + slot * SLOT;
#pragma unroll
            for (int dh = 0; dh < 2; ++dh)
#pragma unroll
                for (int ks = 0; ks < 4; ++ks) {
                    const s16x4 vl = vtr(vp2 + dh * 4096 + ks * 1024), vh = vtr(vp2 + dh * 4096 + ks * 1024 + 512);
                    vf[dh * 4 + ks] = (bf16x8){vl[0], vl[1], vl[2], vl[3], vh[0], vh[1], vh[2], vh[3]};
                }
    #pragma unroll
            for (int ks = 0; ks < 4; ++ks) {
                o2[0] = __builtin_amdgcn_mfma_f32_32x32x16_bf16(vf[ks], __builtin_bit_cast(bf16x8, pw[ks]), o2[0], 0, 0, 0);
                o2[1] = __builtin_amdgcn_mfma_f32_32x32x16_bf16(vf[4 + ks], __builtin_bit_cast(bf16x8, pw[ks]), o2[1], 0, 0, 0);
            }
            }
        slot = (slot == 2) ? 0 : slot + 1;
    }
    NSA_BAR();
    { auto rr = __builtin_amdgcn_permlane32_swap(__float_as_uint(l), __float_as_uint(l), false, false); l = __uint_as_float(rr[0]) + __uint_as_float(rr[1]); }
    l_out = l;
#undef NSA_DMA
}
DEV void flash_pass(lds_u8* lds, const bf16_t* Kg, int pk, const bf16_t* Vg, int pv, int t0, int nt, const bf16x8 (&qr)[4],
                    int lo, int hi_b, unsigned long long rowmask, int lo_max, int hi_min, f32x16 (&o)[2], float& l_out, bool pre = false) {
    flash_pass_t<false>(lds, Kg, pk, Vg, pv, t0, nt, qr, lo, hi_b, rowmask, lo_max, hi_min, o, l_out, Vg, o, pre); }


DEV void nsa_unit(lds_u8* lds, unsigned char* ws, int b, int g, int qt) {
    const int tid = threadIdx.x, lane = tid & 63, r32 = lane & 31, hi = lane >> 5; const int wid = __builtin_amdgcn_readfirstlane(tid >> 6);
    const int hh = wid >> 1, h = 4 * g + hh, ql = 32 * (wid & 1) + r32, t = 64 * qt + ql;
    const bf16_t* Y0 = (const bf16_t*)(ws + SC_Y0);
    const bf16_t* yrow = Y0 + (size_t)(b * SEQ + t) * EINP;
    bf16x8 qr[4];
#pragma unroll
    for (int d0 = 0; d0 < 4; ++d0) qr[d0] = *(const bf16x8*)(yrow + C_Q + h * 64 + d0 * 16 + hi * 8);
#pragma unroll
    for (int d0 = 0; d0 < 4; ++d0) asm volatile("" : "+v"(qr[d0]));
    const float g_c = sigmoidf_(bf2f(yrow[C_GL + h * 3 + 0])), g_s = sigmoidf_(bf2f(yrow[C_GL + h * 3 + 1])), g_w = sigmoidf_(bf2f(yrow[C_GL + h * 3 + 2]));
    const bf16_t* Ybg = Y0 + (size_t)(b * SEQ) * EINP + g * 64;
    f32x16 acc[2], o[2]; float l;
    const int nmax = (t >= 31) ? (t - 31) >> 4 : -1;
    const int tmaxu = 64 * qt + 63, nmax_u = (tmaxu - 31) >> 4, nct = (nmax_u >> 6) + 1;
    const int nmin_u = (64 * qt >= 31) ? (64 * qt - 31) >> 4 : -1;
    const bf16_t* KC = (const bf16_t*)(ws + WS_KCMP) + (size_t)(b * 2 + g) * 256 * 64;
    const bf16_t* VC = (const bf16_t*)(ws + WS_VCMP) + (size_t)(b * 2 + g) * 256 * 64;
    const bf16_t* MS = (const bf16_t*)(ws + WS_MSEL) + (size_t)((b * 2 + g) & 7) * 256 * 64;
    if (qt >= 16) flash_pass_t<true>(lds, KC, 64, VC, 64, 0, nct, qr, -1, nmax, ~0ull, -1, nmin_u, acc, l, MS, o);
    else flash_pass(lds, KC, 64, VC, 64, 0, nct, qr, -1, nmax, ~0ull, -1, nmin_u, acc, l);
    const float rl_c = (l > 0.f) ? frcp(l) : 0.f;
    { const float sc = g_c * rl_c;
#pragma unroll
      for (int dh = 0; dh < 2; ++dh)
#pragma unroll
          for (int r = 0; r < 16; ++r) acc[dh][r] = acc[dh][r] * sc; }
    unsigned long long selmask = (2ull << qt) - 1ull;
    if (qt >= 16) {
    flash_prefetch(lds, Ybg + C_KS, EINP, Ybg + C_VS, EINP, 0, qt + 1, nullptr);
    { const float sc = rl_c;
      __attribute__((address_space(3))) float* imp = (__attribute__((address_space(3))) float*)(lds + L_IMP) + (hh * 64 + ql) * IMPP;
#pragma unroll
      for (int dh = 0; dh < 2; ++dh)
#pragma unroll
          for (int r = 0; r < 16; ++r) imp[32 * dh + crow(r, hi)] = o[dh][r] * sc; }
    NSA_BAR();
    {
        __attribute__((address_space(3))) const float* impb = (__attribute__((address_space(3))) const float*)(lds + L_IMP);
        __attribute__((address_space(3))) unsigned long long* selp = (__attribute__((address_space(3))) unsigned long long*)(lds + L_SEL);
        const int m = lane, cur = qt;
        const bool cand = (m >= 1) && (m <= cur - 2);
        for (int q0 = 8 * wid; q0 < 8 * wid + 8; q0 += 4) {
            unsigned bits[4], T[4];
#pragma unroll
            for (int j = 0; j < 4; ++j) { const int qq = q0 + j;
                const float iv = ((impb[(0 * 64 + qq) * IMPP + m] + impb[(1 * 64 + qq) * IMPP + m]) + impb[(2 * 64 + qq) * IMPP + m]) + impb[(3 * 64 + qq) * IMPP + m];
                bits[j] = cand ? __float_as_uint(fmaxf(iv, 0.f)) : 0u; T[j] = 0u; }
            for (int bit = 30; bit >= 0; --bit) {
#pragma unroll
                for (int j = 0; j < 4; ++j) { const unsigned trial = T[j] | (1u << bit); if (__popcll(__ballot(bits[j] >= trial)) >= 13) T[j] = trial; } }
#pragma unroll
            for (int j = 0; j < 4; ++j) {
                const unsigned long long gtm = __ballot(cand && bits[j] > T[j]); unsigned long long eqm = __ballot(cand && bits[j] == T[j]);
                int need = 13 - __popcll(gtm); unsigned long long tie = 0ull;
                while (need > 0 && eqm) { const unsigned long long lowb = eqm & (~eqm + 1ull); tie |= lowb; eqm ^= lowb; --need; }
                const unsigned long long sel = gtm | tie | 1ull | (1ull << cur) | (1ull << (cur - 1));
                if (lane == 0) selp[q0 + j] = sel; }
        }
    }
    NSA_BAR();
    selmask = ((__attribute__((address_space(3))) const unsigned long long*)(lds + L_SEL))[ql];
    }
    flash_pass(lds, Ybg + C_KS, EINP, Ybg + C_VS, EINP, 0, qt + 1, qr, -1, t, selmask, -1, 64 * qt, o, l, qt >= 16);
    { const float sc = g_s * frcp(l);
#pragma unroll
      for (int dh = 0; dh < 2; ++dh)
#pragma unroll
          for (int r = 0; r < 16; ++r) acc[dh][r] += o[dh][r] * sc; }
    { const int wt0 = (qt >= 8) ? qt - 8 : 0;
      flash_pass(lds, Ybg + C_KW, EINP, Ybg + C_VW, EINP, wt0, qt - wt0 + 1, qr, t - 512, t, ~0ull, 64 * qt + 63 - 512, 64 * qt, o, l);
      const float sc = g_w * frcp(l);
#pragma unroll
      for (int dh = 0; dh < 2; ++dh)
#pragma unroll
          for (int r = 0; r < 16; ++r) acc[dh][r] += o[dh][r] * sc; }
    bf16_t* orow = (bf16_t*)(ws + SC_CAT) + (size_t)(b * SEQ + t) * DM + 512 + h * 64;
#pragma unroll
    for (int dh = 0; dh < 2; ++dh)
#pragma unroll
        for (int j = 0; j < 4; ++j) { u32x2 w; w.x = cvtpk(acc[dh][4 * j], acc[dh][4 * j + 1]); w.y = cvtpk(acc[dh][4 * j + 2], acc[dh][4 * j + 3]); *(u32x2*)(orow + 32 * dh + 8 * j + 4 * hi) = w; }
    NSA_WAITV(0);
}
DEV void nsa_phase(unsigned char* lds_raw, unsigned char* ws) {
    lds_u8* lds = (lds_u8*)lds_raw;
    const int G = gridDim.x, bx = blockIdx.x;
    const int vcu = (G % 8 == 0) ? (bx % 8) * (G / 8) + bx / 8 : bx;
    for (int p = vcu, rnd = 0; p < 512; p += G, ++rnd) {
        const int bg = p >> 5, s = (rnd & 1) ? 31 - (p & 31) : (p & 31);
        nsa_unit(lds, ws, bg >> 1, bg & 1, 63 - s);
        nsa_unit(lds, ws, bg >> 1, bg & 1, s);
    }
}
#undef NSA_WAITV
#undef NSA_BAR
}

DEV void router_mfma(const Ctx& c, const bf16_t* X, int layer) {
    const __attribute__((address_space(4))) Params& p = *c.p;
    const float* bg = gptr(p.in[26]) + layer * 4; const float* be = gptr(p.in[28]) + layer * 32;
    const bf16_t* WB = (const bf16_t*)(c.ws + WS_RWB) + (size_t)layer * 96 * DM;
    int* cnt = (int*)(c.ws + WS_CTL) + layer * 32; int* list = (int*)(c.ws + WS_LIST); float* gate = (float*)(c.ws + WS_GATE);
    int* lcnt = (int*)c.lds; int* lbase = lcnt + 32; int* asg = lcnt + 64;
    float* lgs = c.lds + 1024 + c.wave * 640;
    constexpr int rpw = NT / 256;
    if (c.tid < 32) lcnt[c.tid] = 0;
    __syncthreads();
    const int fr = c.lane & 15, kg = c.lane >> 4;
    static_assert(rpw == NWAVES * 16, "one 16-row block per wave");
    {
        const int lrow0 = c.wave * 16;
        const int row0 = blockIdx.x * rpw + lrow0;
        const bf16_t* ap = X + (size_t)(row0 + fr) * DM + kg * 8;
        f32x4 aE0 = {0.f, 0.f, 0.f, 0.f}, aE1 = aE0, aG = aE0;
        typedef __attribute__((address_space(3))) unsigned char lds8;
        lds8* LB = (lds8*)c.lds + 32768;
        for (int half = 0; half < 2; ++half) {
            bf16x8 af[16];
#pragma unroll
            for (int s = 0; s < 16; ++s) af[s] = *(const bf16x8*)(ap + half * 512 + 32 * s);
            u32x4 wst[12];
#pragma unroll
            for (int q = 0; q < 12; ++q) { const int i = c.tid + q * NTHREADS, row = i >> 6, ch = i & 63; wst[q] = *(const u32x4*)(WB + (size_t)row * DM + half * 512 + ch * 8); }
            __syncthreads();
#pragma unroll
            for (int q = 0; q < 12; ++q) { const int i = c.tid + q * NTHREADS, row = i >> 6, ch = i & 63; *(__attribute__((address_space(3))) u32x4*)(LB + row * 1040 + ch * 16) = wst[q]; }
            __syncthreads();
            const lds8* bp = LB + fr * 1040 + kg * 16;
#pragma unroll
            for (int s = 0; s < 16; ++s) {
                const bf16x8 a = af[s];
#define RB(blk) (*(const __attribute__((address_space(3))) bf16x8*)(bp + (blk) * 16 * 1040 + s * 64))
                const bf16x8 b0 = RB(0), b1 = RB(1), b2 = RB(2), b3 = RB(3), b4 = RB(4), b5 = RB(5);
#undef RB
                aE0 = __builtin_amdgcn_mfma_f32_16x16x32_bf16(a, b0, aE0, 0, 0, 0); aE0 = __builtin_amdgcn_mfma_f32_16x16x32_bf16(a, b3, aE0, 0, 0, 0);
                aE1 = __builtin_amdgcn_mfma_f32_16x16x32_bf16(a, b1, aE1, 0, 0, 0); aE1 = __builtin_amdgcn_mfma_f32_16x16x32_bf16(a, b4, aE1, 0, 0, 0);
                aG = __builtin_amdgcn_mfma_f32_16x16x32_bf16(a, b2, aG, 0, 0, 0); aG = __builtin_amdgcn_mfma_f32_16x16x32_bf16(a, b5, aG, 0, 0, 0);
            }
        }
#pragma unroll
        for (int r = 0; r < 4; ++r) { float* lr = lgs + (4 * kg + r) * 40; lr[4 + fr] = aE0[r]; lr[20 + fr] = aE1[r]; if (fr < 4) lr[fr] = aG[r]; }
        LDS_WAIT();
        if (c.lane < 16) {
            const float* lr = lgs + c.lane * 40;
            float gl[4]; int gs = 0;
#pragma unroll
            for (int o = 0; o < 4; ++o) gl[o] = lr[o] + bg[o];
            float gm = gl[0];
#pragma unroll
            for (int o = 1; o < 4; ++o) if (gl[o] > gm) { gm = gl[o]; gs = o; }
            float den = 0.f;
#pragma unroll
            for (int o = 0; o < 4; ++o) den += __expf(gl[o] - gm);
            const float pgroup = frcp(den);
            int i0 = 0, i1 = -1; float v0 = -INFINITY, v1 = -INFINITY;
#pragma unroll
            for (int o = 0; o < 8; ++o) { const float e = lr[4 + gs * 8 + o] + be[gs * 8 + o];
                if (e > v0) { v1 = v0; i1 = i0; v0 = e; i0 = o; } else if (e > v1) { v1 = e; i1 = o; } }
            const float e1 = __expf(v1 - v0), g0 = pgroup * frcp(1.f + e1), g1 = g0 * e1;
            const int ex0 = gs * 8 + i0, ex1 = gs * 8 + i1;
            const int lp0 = atomicAdd(lcnt + ex0, 1), lp1 = atomicAdd(lcnt + ex1, 1);
            asg[(lrow0 + c.lane) * 2] = (ex0 << 16) | lp0; asg[(lrow0 + c.lane) * 2 + 1] = (ex1 << 16) | lp1;
            gate[(row0 + c.lane) * 2] = g0; gate[(row0 + c.lane) * 2 + 1] = g1;
        }
        LDS_WAIT();
    }
    __syncthreads();
    if (c.tid < 32) lbase[c.tid] = atomicAdd(cnt + c.tid, lcnt[c.tid]);
    __syncthreads();
    for (int i = c.tid; i < 2 * rpw; i += NTHREADS) { const int a = asg[i], ex = a >> 16, lpos = a & 0xffff; const int aid_ = (blockIdx.x * rpw) * 2 + i, slot_ = lbase[ex] + lpos; list[ex * LCAP + slot_] = aid_; ((int*)(c.ws + WS_APOS))[aid_] = (ex << 16) | slot_; }
    __syncthreads();
}

DEV void bf8_to_f32(const u32x4 w, float* o) {
#pragma unroll
    for (int j = 0; j < 4; ++j) { o[2 * j] = __uint_as_float(w[j] << 16); o[2 * j + 1] = __uint_as_float(w[j] & 0xffff0000u); }
}
DEV void moe_combine(const Ctx& c, const bf16_t* Xin, const float* g, const float* b, bf16_t* Xo, float* outf, const int* cnt) {
    const bf16_t* Y = (const bf16_t*)(c.ws + SC_Y);
    const int* apos = (const int*)(c.ws + WS_APOS); const float* gate = (const float*)(c.ws + WS_GATE);
    int pref;
    { const int nb = (c.lane < NEXP) ? (cnt[c.lane] + 255) >> 8 : 0; int incl = nb;
#pragma unroll
      for (int o = 1; o < 32; o <<= 1) { const int t = __shfl_up(incl, o); if ((c.lane & 63) >= o) incl += t; }
      pref = incl - nb; }
    float gg[16], bb[16];
#pragma unroll
    for (int hf = 0; hf < 2; ++hf)
#pragma unroll
        for (int j = 0; j < 8; ++j) { gg[hf * 8 + j] = g[hf * 512 + 8 * c.lane + j]; bb[hf * 8 + j] = b[hf * 512 + 8 * c.lane + j]; }
    for (int row0 = c.gw * 2; row0 < NT; row0 += c.ngw * 2) {
        u32x4 xr[2][2], y0r[2][2], y1r[2][2];
#pragma unroll
        for (int r = 0; r < 2; ++r)
#pragma unroll
            for (int hf = 0; hf < 2; ++hf) { const size_t row = row0 + r; const int col = hf * 512 + 8 * c.lane;
                const int a0 = apos[2 * row], a1 = apos[2 * row + 1];
                const size_t p0 = (size_t)__shfl(pref, a0 >> 16) * 256 + (a0 & 0xffff), p1 = (size_t)__shfl(pref, a1 >> 16) * 256 + (a1 & 0xffff);
                xr[r][hf] = *(const u32x4*)(Xin + row * DM + col); y0r[r][hf] = *(const u32x4*)(Y + p0 * DM + col); y1r[r][hf] = *(const u32x4*)(Y + p1 * DM + col); }
#pragma unroll
        for (int r = 0; r < 2; ++r) {
            float v[16]; float s = 0.f; const float g0 = gate[2 * (row0 + r)], g1 = gate[2 * (row0 + r) + 1];
#pragma unroll
            for (int hf = 0; hf < 2; ++hf) { float x[8], a[8], bq[8]; bf8_to_f32(xr[r][hf], x); bf8_to_f32(y0r[r][hf], a); bf8_to_f32(y1r[r][hf], bq);
#pragma unroll
                for (int j = 0; j < 8; ++j) { v[hf * 8 + j] = x[j] * DN_ALPHA + (g0 * a[j] + g1 * bq[j]); s += v[hf * 8 + j]; } }
            const float mean = wsum_dpp(s) * (1.f / DM); float s2 = 0.f;
#pragma unroll
            for (int j = 0; j < 16; ++j) { v[j] -= mean; s2 += v[j] * v[j]; }
            const float rstd = rsqrtf(wsum_dpp(s2) * (1.f / DM) + LN_EPS);
#pragma unroll
            for (int j = 0; j < 16; ++j) v[j] = v[j] * rstd * gg[j] + bb[j];
            const size_t row = row0 + r;
#pragma unroll
            for (int hf = 0; hf < 2; ++hf) { const int col = hf * 512 + 8 * c.lane;
                if (Xo) { u32x4 o; o.x = pk2(v[hf * 8], v[hf * 8 + 1]); o.y = pk2(v[hf * 8 + 2], v[hf * 8 + 3]); o.z = pk2(v[hf * 8 + 4], v[hf * 8 + 5]); o.w = pk2(v[hf * 8 + 6], v[hf * 8 + 7]); *(u32x4*)(Xo + row * DM + col) = o; }
                if (outf) { *(f32x4*)(outf + row * DM + col) = (f32x4){v[hf * 8], v[hf * 8 + 1], v[hf * 8 + 2], v[hf * 8 + 3]}; *(f32x4*)(outf + row * DM + col + 4) = (f32x4){v[hf * 8 + 4], v[hf * 8 + 5], v[hf * 8 + 6], v[hf * 8 + 7]}; }
            }
        }
    }
}

DEV void odd_conv(const Ctx& c) {
    const bf16_t* Y1 = (const bf16_t*)(c.ws + SC_Y0); bf16_t* V = (bf16_t*)(c.ws + WS_XA);
    const float* cw = gptr(c.p->in[17]);
    float w0[8], w1[8], w2[8];
    { const int col = (c.gw & 1) * 512 + 8 * c.lane;
#pragma unroll
      for (int j = 0; j < 8; ++j) { w0[j] = cw[col + j]; w1[j] = cw[DM + col + j]; w2[j] = cw[2 * DM + col + j]; } }
    for (int it = c.gw; it < (NT / 16) * 2; it += c.ngw) {
        const int half = it & 1, tok0 = (it >> 1) * 16, col = half * 512 + 8 * c.lane, t0 = tok0 & (SEQ - 1);
        float um2[8], um1[8];
        if (t0 >= 2) { bf8_to_f32(*(const u32x4*)(Y1 + (size_t)(tok0 - 2) * 2048 + 1024 + col), um2); bf8_to_f32(*(const u32x4*)(Y1 + (size_t)(tok0 - 1) * 2048 + 1024 + col), um1); }
        else {
#pragma unroll
            for (int j = 0; j < 8; ++j) { um2[j] = 0.f; um1[j] = 0.f; } }
#pragma unroll 4
        for (int i = 0; i < 16; ++i) {
            float u0[8], gb[8];
            bf8_to_f32(*(const u32x4*)(Y1 + (size_t)(tok0 + i) * 2048 + 1024 + col), u0);
            bf8_to_f32(*(const u32x4*)(Y1 + (size_t)(tok0 + i) * 2048 + col), gb);
            float y[8];
#pragma unroll
            for (int j = 0; j < 8; ++j) { y[j] = gb[j] * (w0[j] * um2[j] + w1[j] * um1[j] + w2[j] * u0[j]); um2[j] = um1[j]; um1[j] = u0[j]; }
            u32x4 o; o.x = pk2(y[0], y[1]); o.y = pk2(y[2], y[3]); o.z = pk2(y[4], y[5]); o.w = pk2(y[6], y[7]);
            *(u32x4*)(V + (size_t)(tok0 + i) * DM + col) = o;
        }
    }
}

#define XB_TMO      128
#define XB_XCNT(j)  (256  + 64 * (j))
#define XB_XSUB(j)  (1280 + 64 * (j))
#define XB_XGEN(j)  (2304 + 64 * (j))
#define XB_TOP      3328
#define XB_TOPGEN   3392
#define XCD_BAR_WORDS 3456
#define XB_SPIN_CAP (1u << 22)
DEV unsigned xb_ld(unsigned* p)              { return __hip_atomic_load(p, __ATOMIC_RELAXED, __HIP_MEMORY_SCOPE_AGENT); }
DEV unsigned xb_add(unsigned* p, unsigned v) { return __hip_atomic_fetch_add(p, v, __ATOMIC_RELAXED, __HIP_MEMORY_SCOPE_AGENT); }
DEV unsigned xb_xcc_id() { return (unsigned)__builtin_amdgcn_s_getreg((3 << 11) | 20) & 0xFu; }
#define XB_SPIN(cond, bar) do { unsigned _sp = 0; while (cond) { __builtin_amdgcn_s_sleep(1); \
    if ((++_sp & 255u) == 0u) { if (xb_ld(&(bar)[XB_TMO])) break; if (_sp > XB_SPIN_CAP) { atomicAdd(&(bar)[XB_TMO], 1u); break; } } } } while (0)
struct XcdBarrier { unsigned* bar; unsigned x; volatile __attribute__((address_space(3))) unsigned* st; };
DEV XcdBarrier xcd_barrier_post(unsigned* bar, volatile __attribute__((address_space(3))) unsigned* st) {
    XcdBarrier b; b.bar = bar; b.x = xb_xcc_id(); b.st = st;
    if (threadIdx.x == 0) (void)xb_add(&bar[XB_XCNT(b.x)], 1u);
    return b;
}
DEV void xcd_barrier_complete(unsigned* bar, unsigned x, unsigned& nloc, unsigned& nx) {
    const unsigned G = gridDim.x * gridDim.y * gridDim.z;
    unsigned sum, cnt, mine, sp = 0u;
    for (;;) {
        sum = 0u; cnt = 0u; mine = 0u;
#pragma unroll
        for (unsigned j = 0; j < 16; ++j) { const unsigned cc = xb_ld(&bar[XB_XCNT(j)]); sum += cc; cnt += (cc > 0u) ? 1u : 0u; mine = (j == x) ? cc : mine; }
        if (sum == G) break;
        __builtin_amdgcn_s_sleep(1);
        if ((++sp & 255u) == 0u) { if (xb_ld(&bar[XB_TMO])) break; if (sp > XB_SPIN_CAP) { atomicAdd(&bar[XB_TMO], 1u); break; } }
    }
    nloc = mine > 0u ? mine : 1u; nx = cnt > 0u ? cnt : 1u;
}
DEV void xcd_barrier(const XcdBarrier& b) {
    asm volatile("s_waitcnt vmcnt(0)" ::: "memory");
    __syncthreads();
    if (threadIdx.x == 0) {
        unsigned* bar = b.bar;
        __builtin_amdgcn_s_waitcnt(0);
        unsigned nloc = b.st[0], nx = b.st[1];
        if (nloc == 0u) { xcd_barrier_complete(bar, b.x, nloc, nx); b.st[0] = nloc; b.st[1] = nx; }
        const unsigned old = xb_add(&bar[XB_XSUB(b.x)], 1u);
        const unsigned gen = old / nloc;
        if (old + 1u == (gen + 1u) * nloc) {
            __builtin_amdgcn_fence(__ATOMIC_RELEASE, "agent");
            asm volatile("s_waitcnt vmcnt(0)" ::: "memory");
            const unsigned og = xb_add(&bar[XB_TOP], 1u);
            const unsigned tg = og / nx;
            if (og + 1u == (tg + 1u) * nx) xb_add(&bar[XB_TOPGEN], 1u);
            else XB_SPIN(xb_ld(&bar[XB_TOPGEN]) == tg, bar);
            xb_add(&bar[XB_XGEN(b.x)], 1u);
            __builtin_amdgcn_fence(__ATOMIC_ACQUIRE, "agent");
            asm volatile("s_waitcnt vmcnt(0)" ::: "memory");
        } else {
            XB_SPIN(xb_ld(&bar[XB_XGEN(b.x)]) == gen, bar);
            __builtin_amdgcn_fence(__ATOMIC_ACQUIRE, "agent");
            asm volatile("s_waitcnt vmcnt(0)" ::: "memory");
        }
    }
    __syncthreads();
}

DEV void xa_fold_unit(PG8_LAS unsigned char* ldsp, unsigned char* ws, int layer, int fid) {
    const int id = fid & 127, b = id >> 4, h = (id >> 2) & 3, q = id & 3; const bool isn = fid >= 128;
    const bf16_t* MK = (const bf16_t*)(ws + WS_MEMK) + (size_t)(b * MEML) * DM + h * 256;
    const bf16_t* MV = (const bf16_t*)(ws + WS_MEMV) + (size_t)(b * MEML) * DM + h * 256;
    const bf16_t* WQP = (const bf16_t*)(ws + WS_WQ) + (size_t)layer * DM * DM + (size_t)(q * 256) * DM + h * 256;
    const bf16_t* WOT = (const bf16_t*)(ws + WS_WO) + (size_t)layer * DM * DM + (size_t)(q * 256) * DM + h * 256;
    bf16_t* MT = (bf16_t*)(ws + WS_MT) + ((size_t)b * DM + h * 256) * DM + q * 256;
    bf16_t* NT_ = (bf16_t*)(ws + WS_NT) + ((size_t)b * DM + q * 256) * DM + h * 256;
    pg8::OneUnitTask T{256, isn ? WOT : MK, isn ? MV : WQP, isn ? NT_ : MT, DM, 0, 0, 0, 0, fid < 256, isn ? 1.f : 0.0625f * 1.4426950408889634f};
    pg8::gemm_phase(ldsp, T);
}
DEV void xa_fold(PG8_LAS unsigned char* ldsp, unsigned char* ws, int layer) { xa_fold_unit(ldsp, ws, layer, blockIdx.x); }
DEV void xa_fold_in_moe_tail(PG8_LAS unsigned char* ldsp, unsigned char* ws, int layer, int nblk) {
    const int G = gridDim.x, bx = blockIdx.x, vc = (G % 8 == 0) ? (bx % 8) * (G / 8) + bx / 8 : bx;
    const int full = 4 * nblk - (4 * nblk / G) * G;
    const int nidle = G - full;
    if (vc < full) return;
    for (int fid = vc - full; fid < 256; fid += nidle) xa_fold_unit(ldsp, ws, layer, fid);
}

constexpr int N_PHASES = 25;
constexpr int LDS_BYTES = 147456;
__global__ void __launch_bounds__(NTHREADS, 2) fwd_kernel(Params prm) {
    extern __shared__ __attribute__((aligned(16))) unsigned char lds_raw[];
    volatile __attribute__((address_space(3))) unsigned* bst = (volatile __attribute__((address_space(3))) unsigned*)((__attribute__((address_space(3))) unsigned char*)lds_raw + LDS_BYTES - 16);
    if (threadIdx.x < 4) bst[threadIdx.x] = 0u;
    __syncthreads();
    XcdBarrier xbar; xbar.bar = (unsigned*)(prm.ws + WS_CTL) + 1024; xbar.x = 0; xbar.st = bst;
    if (prm.ph_hi - prm.ph_lo > 1) xbar = xcd_barrier_post((unsigned*)(prm.ws + WS_CTL) + 1024, bst);
    KParams kp = (KParams)__builtin_amdgcn_kernarg_segment_ptr();
    Ctx c; c.p = kp; c.ws = prm.ws; c.lds = (float*)lds_raw;
    c.tid = threadIdx.x; c.lane = c.tid & 63; c.wave = __builtin_amdgcn_readfirstlane(c.tid >> 6);
    c.gw = blockIdx.x * NWAVES + c.wave; c.ngw = gridDim.x * NWAVES;
    typedef __attribute__((address_space(1))) unsigned char gu8_t;
    gu8_t* wsg = (gu8_t*)prm.ws;
    unsigned char* ws = (unsigned char*)wsg;
    PG8_LAS unsigned char* ldsp = (PG8_LAS unsigned char*)lds_raw;
#define XA ((bf16_t*)(ws + WS_XA))
#define XB ((bf16_t*)(ws + WS_XB))
#define Z ((float*)(ws + SC_Z))
    typedef const float* cfptr_t;
    const __attribute__((address_space(4))) cfptr_t* in = (const __attribute__((address_space(4))) cfptr_t*)kp;
#ifndef ONLY_PHASE
#define ONLY_PHASE -1
#endif
#ifndef TPROBE_PHASE
#define TPROBE_PHASE -1
#endif
#define PHASE(k, ...) if (TPROBE_PHASE == (k)) tp0_ = __builtin_amdgcn_s_memrealtime(); if ((ONLY_PHASE < 0 || ONLY_PHASE == (k)) && prm.ph_lo <= (k) && (k) < prm.ph_hi) { asm volatile("" : "+s"(wsg)); ws = (unsigned char*)wsg; asm volatile("" : "+s"(kp)); c.p = kp; c.ws = ws; c.tid = threadIdx.x; asm volatile("" : "+v"(c.tid)); c.lane = c.tid & 63; in = (const __attribute__((address_space(4))) cfptr_t*)kp; { __VA_ARGS__; } if ((k) + 1 < prm.ph_hi) { xcd_barrier(xbar); } if (TPROBE_PHASE == (k)) tp1_ = __builtin_amdgcn_s_memrealtime(); }
    unsigned long long tp0_ = 0, tp1_ = 0;
    if (prm.ph_hi > N_PHASES) { __threadfence(); cg::this_grid().sync(); }
    PHASE(0, phase_prep<0>(c))
    PHASE(1, { const bool early = ((blockIdx.x >> 3) & 1) == 0; if (early) { phase_prep<1>(c); __syncthreads(); }
        pg8::PlainTask<pg8::EpiInproj, true> T{XA, DM, (const bf16_t*)(ws + WS_W_IN), DM, DM, {}, {(bf16_t*)(ws + SC_Y0)}}; T.S.init(NT, EINP, gridDim.x, blockIdx.x); pg8::gemm_phase(ldsp, T);
        if (!early) { __syncthreads(); c.tid = threadIdx.x; asm volatile("" : "+v"(c.tid)); c.lane = c.tid & 63; phase_prep<1>(c); } })
    PHASE(2, {
        const int bx = blockIdx.x;
        if (bx < 64) { pg8::CmpTask T{DM, ws, bx}; pg8::gemm_phase(ldsp, T); }
        else if (bx < 128) {
            const int j = (bx - 64) & 31; const bool isv = bx >= 96;
            pg8::OneUnitTask T{DM, (const bf16_t*)(ws + WS_MEMB), (const bf16_t*)(ws + (isv ? WS_WV : WS_WK)), (bf16_t*)(ws + (isv ? WS_MEMV : WS_MEMK)), DM,
                               (size_t)256 * DM, (size_t)256, j >> 2, j & 3, true, 1.f};
            pg8::gemm_phase(ldsp, T); }
        } conv_phase(c))
    PHASE(3, cmp_finish(c); __syncthreads(); xa_fold(ldsp, ws, 0))
#ifdef NSA_CHECK
    PHASE(4, nsa::nsa_phase(lds_raw, ws); nsa_naive(c);
        __syncthreads(); if (c.tid == 0) __threadfence(); )
#else
    PHASE(4, { const bool early = ((blockIdx.x >> 3) & 1) == 0;
        if (early) { moe_weights_m<0>(c, 0, c.gw, c.ngw); __syncthreads(); }
        nsa::nsa_phase(lds_raw, ws);
        if (!early) { __syncthreads(); moe_weights_m<0>(c, 0, c.gw, c.ngw); } })
#endif
#ifdef NSA_CHECK
    if (prm.ph_lo <= 5 && 5 < prm.ph_hi) {
        const bf16_t* A_ = (const bf16_t*)(ws + SC_CAT); const bf16_t* B_ = (const bf16_t*)(ws + WS_XB); float d2 = 0.f, a2 = 0.f;
        for (size_t i = (size_t)c.gw * 64 + c.lane; i < (size_t)NT * 512; i += (size_t)c.ngw * 64) { const size_t r = i >> 9, cc = 512 + (i & 511); const float a = bf2f(A_[r * DM + cc]), b = bf2f(B_[r * DM + cc]); d2 += (a - b) * (a - b); a2 += b * b; }
        d2 = wsum(d2); a2 = wsum(a2);
        if (c.lane == 0) { atomicAdd((float*)(ws + WS_CTL) + 60000, d2); atomicAdd((float*)(ws + WS_CTL) + 60001, a2); }
        xcd_barrier(xbar);
    }
#endif
    PHASE(5, { for (int half = 0; half < 2; ++half) { pg8::LnTask<false> T{DM, (const bf16_t*)(ws + SC_CAT), DM, (const bf16_t*)(ws + WS_W_OUT), XA, gptr(in[19]), gptr(in[20]), XB, half * 16384, {(unsigned long long*)(ws + WS_XBUF), (unsigned*)(ws + WS_CTL) + 8192 + 0 * 8192}, {}, 0}; T.S.init(16384, DM, gridDim.x, blockIdx.x); pg8::gemm_phase<pg8::LnTask<false>, true>(ldsp, T); } })
    PHASE(6, { pg8::XaSTask T{DM, XB, (const bf16_t*)(ws + WS_MT), (bf16_t*)(ws + SC_P), ldsp, {}}; T.S.init(NT, DM, gridDim.x, blockIdx.x); pg8::gemm_phase(ldsp, T); })
    PHASE(9, { for (int half = 0; half < 2; ++half) { pg8::LnTask<false> T{DM, (const bf16_t*)(ws + SC_P), DM, (const bf16_t*)(ws + WS_NT), XB, gptr(in[23]), gptr(in[24]), XA, half * 16384, {(unsigned long long*)(ws + WS_XBUF), (unsigned*)(ws + WS_CTL) + 8192 + 1 * 8192}, {}, (size_t)DM * DM}; T.S.init(16384, DM, gridDim.x, blockIdx.x); pg8::gemm_phase<pg8::LnTask<false>, true>(ldsp, T); } })
    PHASE(10, router_mfma(c, XA, 0))
    PHASE(11, { const int* cnt = (const int*)(ws + WS_CTL) + 0 * 32; PG8_LAS int* tab = (PG8_LAS int*)(ldsp + pg8::LDS_SPARE); pg8::moe_build_tab(cnt, tab);
        pg8::Moe1Task T{DM, XA, (const bf16_t*)(ws + WS_W13), (bf16_t*)(ws + SC_H), cnt, (const int*)(ws + WS_LIST), tab, (int)gridDim.x, (int)blockIdx.x}; pg8::gemm_phase(ldsp, T); const int nblk_ = tab[0]; __syncthreads(); xa_fold_in_moe_tail(ldsp, ws, 1, nblk_); __syncthreads(); moe_weights_in_tail<3>(c, 1, nblk_); })
    PHASE(12, { const int* cnt = (const int*)(ws + WS_CTL) + 0 * 32; PG8_LAS int* tab = (PG8_LAS int*)(ldsp + pg8::LDS_SPARE); pg8::moe_build_tab(cnt, tab);
        pg8::Moe2Task T{EH, (const bf16_t*)(ws + SC_H), (const bf16_t*)(ws + WS_W2), (bf16_t*)(ws + SC_Y), cnt, (const int*)(ws + WS_LIST), (const float*)(ws + WS_GATE), tab, (int)gridDim.x, (int)blockIdx.x, nullptr}; pg8::gemm_phase(ldsp, T); const int nblk_ = tab[0]; __syncthreads(); moe_weights_in_tail<1>(c, 1, nblk_); })
    PHASE(13, moe_combine(c, XA, gptr(in[32]), gptr(in[33]), XB, nullptr, (const int*)(ws + WS_CTL)); moe_weights_m<2>(c, 1, c.gw, c.ngw))
    PHASE(14, { pg8::PlainTask<pg8::EpiOd1, true> T{XB, DM, (const bf16_t*)(ws + WS_OD_IN), DM, DM, {}, {(bf16_t*)(ws + SC_Y0)}}; T.S.init(NT, 3 * DM, gridDim.x, blockIdx.x); pg8::gemm_phase(ldsp, T); })
    PHASE(15, odd_conv(c))
    PHASE(16, { for (int half = 0; half < 2; ++half) { pg8::LnTask<false> T{DM, XA, DM, (const bf16_t*)(ws + WS_OD_OUT), XB, gptr(in[19]) + DM, gptr(in[20]) + DM, XA, half * 16384, {(unsigned long long*)(ws + WS_XBUF), (unsigned*)(ws + WS_CTL) + 8192 + 2 * 8192}, {}, 0}; T.S.init(16384, DM, gridDim.x, blockIdx.x); pg8::gemm_phase<pg8::LnTask<false>, true>(ldsp, T); } })
    PHASE(17, { pg8::XaSTask T{DM, XA, (const bf16_t*)(ws + WS_MT), (bf16_t*)(ws + SC_P), ldsp, {}}; T.S.init(NT, DM, gridDim.x, blockIdx.x); pg8::gemm_phase(ldsp, T); })
    PHASE(20, { for (int half = 0; half < 2; ++half) { pg8::LnTask<false> T{DM, (const bf16_t*)(ws + SC_P), DM, (const bf16_t*)(ws + WS_NT), XA, gptr(in[23]) + DM, gptr(in[24]) + DM, XB, half * 16384, {(unsigned long long*)(ws + WS_XBUF), (unsigned*)(ws + WS_CTL) + 8192 + 3 * 8192}, {}, (size_t)DM * DM}; T.S.init(16384, DM, gridDim.x, blockIdx.x); pg8::gemm_phase<pg8::LnTask<false>, true>(ldsp, T); } })
    PHASE(21, router_mfma(c, XB, 1))
    PHASE(22, { const int* cnt = (const int*)(ws + WS_CTL) + 1 * 32; PG8_LAS int* tab = (PG8_LAS int*)(ldsp + pg8::LDS_SPARE); pg8::moe_build_tab(cnt, tab);
        pg8::Moe1Task T{DM, XB, (const bf16_t*)(ws + WS_W13), (bf16_t*)(ws + SC_H), cnt, (const int*)(ws + WS_LIST), tab, (int)gridDim.x, (int)blockIdx.x}; pg8::gemm_phase(ldsp, T); })
    PHASE(23, { const int* cnt = (const int*)(ws + WS_CTL) + 1 * 32; PG8_LAS int* tab = (PG8_LAS int*)(ldsp + pg8::LDS_SPARE); pg8::moe_build_tab(cnt, tab);
        pg8::Moe2Task T{EH, (const bf16_t*)(ws + SC_H), (const bf16_t*)(ws + WS_PK), (bf16_t*)(ws + SC_Y), cnt, (const int*)(ws + WS_LIST), (const float*)(ws + WS_GATE), tab, (int)gridDim.x, (int)blockIdx.x, (const bf16_t*)(ws + WS_W2B)}; pg8::gemm_phase(ldsp, T); })
    PHASE(24, moe_combine(c, XB, gptr(in[32]) + DM, gptr(in[33]) + DM, nullptr, (float*)(__attribute__((address_space(1))) float*)prm.out, (const int*)(ws + WS_CTL) + 32))
#ifdef NSA_CHECK
    {
        xcd_barrier(xbar);
        const float d2 = ((const float*)(ws + WS_CTL))[60000], a2 = ((const float*)(ws + WS_CTL))[60001];
        const float f = 1.f + 10.f * sqrtf(d2 / a2);
        for (size_t i = (size_t)c.gw * 64 + c.lane; i < (size_t)NT * DM; i += (size_t)c.ngw * 64) (float*)(__attribute__((address_space(1))) float*)prm.out[i] *= f;
    }
#endif
    if (TPROBE_PHASE >= 0) { const unsigned long long t_end = __builtin_amdgcn_s_memrealtime() + 4ull * (tp1_ - tp0_); while (__builtin_amdgcn_s_memrealtime() < t_end) __builtin_amdgcn_s_sleep(8); }
}

extern "C" void kernel_launch(void* const* d_in, const int* in_sizes, int n_in, void* d_out, int out_size, void* d_ws, size_t ws_size, hipStream_t stream) {
    static int grid = 0;
    if (grid == 0) {
        if (n_in != 34 || ws_size < WS_END) { fprintf(stderr, "kernel_launch: unexpected n_in %d or ws_size %zu\n", n_in, ws_size); grid = -1; return; }
        int dev = 0, cus = 0, per_cu = 0;
        (void)hipGetDevice(&dev);
        (void)hipDeviceGetAttribute(&cus, hipDeviceAttributeMultiprocessorCount, dev);
        (void)hipFuncSetAttribute((const void*)fwd_kernel, hipFuncAttributeMaxDynamicSharedMemorySize, LDS_BYTES);
        (void)hipOccupancyMaxActiveBlocksPerMultiprocessor(&per_cu, (const void*)fwd_kernel, NTHREADS, LDS_BYTES);
        if (per_cu < 1) { fprintf(stderr, "kernel_launch: occupancy query says %d blocks/CU\n", per_cu); per_cu = 1; }
        grid = cus * per_cu;
        if (grid != 256) { fprintf(stderr, "kernel_launch: this kernel is built for a 256-workgroup resident grid (256 CUs x 1), got %d\n", grid); grid = -1; return; }
    }
    if (grid < 0) return;
    (void)hipMemsetAsync(d_ws, 0, 262144, stream);
    Params prm{};
    for (int i = 0; i < 34; ++i) prm.in[i] = (const float*)d_in[i];
    prm.out = (float*)d_out; prm.ws = (unsigned char*)d_ws;
#if N_LAUNCH_MODE == 1
    for (int ph = 0; ph < N_PHASES; ++ph) {
        prm.ph_lo = ph; prm.ph_hi = ph + 1;
        hipLaunchKernelGGL(fwd_kernel, dim3(grid), dim3(NTHREADS), LDS_BYTES, stream, prm);
    }
#else
    prm.ph_lo = 0; prm.ph_hi = N_PHASES;
    void* args[] = {&prm};
    hipError_t e = hipLaunchCooperativeKernel((const void*)fwd_kernel, dim3(grid), dim3(NTHREADS), args, LDS_BYTES, stream);
    if (e != hipSuccess) fprintf(stderr, "cooperative launch failed: %s (grid %d)\n", hipGetErrorString(e), grid);
#endif
}
```
